# Optimizing an MI355X kernel written in HIP

```python
import math
import jax, jax.numpy as jnp
from jax import lax
import numpy as np

D_MODEL = 1024
BATCH = 8
SEQ = 2048
DEPTH = 2

CHUNK = 64
Q_BLOCK = 128
EPS = 1e-6

MLA_HEADS = 8
MLA_NOPE = 64
MLA_ROPE = 32
MLA_V = 64
MLA_Q_RANK = 256
MLA_KV_RANK = 128
MLA_WIDTH = MLA_HEADS * MLA_V
MLA_QK_DIM = MLA_NOPE + MLA_ROPE
ROPE_THETA = 10000.0

FOX_HEADS = 8
FOX_HEAD_DIM = 64
FOX_WIDTH = FOX_HEADS * FOX_HEAD_DIM

S5_WIDTH = 512
S5_GROUP = 16
S5_GROUPS = S5_WIDTH // S5_GROUP
S5_STATE = 64
DT_MIN = 1e-3
DT_MAX = 1e-1

BRANCH_WIDTH = MLA_WIDTH + FOX_WIDTH + S5_WIDTH
IN_SPLITS = (MLA_Q_RANK, MLA_KV_RANK, MLA_ROPE,
             FOX_WIDTH, FOX_WIDTH, FOX_WIDTH, FOX_HEADS,
             S5_WIDTH,
             MLA_WIDTH, FOX_WIDTH, S5_WIDTH,
             D_MODEL, D_MODEL, D_MODEL)
IN_WIDTH = MLA_Q_RANK + MLA_KV_RANK + MLA_ROPE + 3 * FOX_WIDTH + FOX_HEADS + S5_WIDTH + BRANCH_WIDTH + 3 * D_MODEL

kernel_name = "hybrid_mla_fox_s5_gated_trunk"


def rmsnorm(x, g):
    xf = x.astype(jnp.float32)
    y = xf * lax.rsqrt(jnp.mean(xf * xf, axis=-1, keepdims=True) + EPS)
    return (y * g.astype(jnp.float32)).astype(x.dtype)


def rope_tables(positions, dtype):
    inv = 1.0 / (ROPE_THETA ** (jnp.arange(0, MLA_ROPE, 2, dtype=jnp.float32) / MLA_ROPE))
    ang = positions.astype(jnp.float32)[..., None] * inv
    return jnp.cos(ang).astype(dtype)[:, :, None, :], jnp.sin(ang).astype(dtype)[:, :, None, :]


def apply_rope(x, cos, sin):
    x1, x2 = jnp.split(x, 2, axis=-1)
    return jnp.concatenate([x1 * cos - x2 * sin, x1 * sin + x2 * cos], axis=-1)


def swept_attention(q, k, v, scale, chunk_causal, cum_logf=None):
    S = q.shape[1]
    outs = []
    for i in range(S // Q_BLOCK):
        q0, q1 = i * Q_BLOCK, (i + 1) * Q_BLOCK
        kv_end = q1
        logits = jnp.einsum('bqhd,bkhd->bhqk', q[:, q0:q1], k[:, :kv_end]).astype(jnp.float32) * scale
        qpos = jnp.arange(q0, q1)[:, None]
        kpos = jnp.arange(kv_end)[None, :]
        if chunk_causal:
            allowed = (kpos // CHUNK) <= (qpos // CHUNK)
        else:
            allowed = kpos <= qpos
        if cum_logf is not None:
            c_q = jnp.transpose(cum_logf[:, q0:q1], (0, 2, 1))[..., :, None]
            c_k = jnp.transpose(cum_logf[:, :kv_end], (0, 2, 1))[..., None, :]
            logits = logits + (c_q - c_k)
        logits = jnp.where(allowed, logits, -jnp.inf)
        p = jax.nn.softmax(logits, axis=-1).astype(v.dtype)
        outs.append(jnp.einsum('bhqk,bkhd->bqhd', p, v[:, :kv_end]))
    return jnp.concatenate(outs, axis=1)


def mla_branch(cq, ckv, kpe, cos, sin, q_a_norm, w_q_up, kv_a_norm, w_kv_up, q_norm, k_norm):
    Bsz, S, _ = cq.shape
    q = (rmsnorm(cq, q_a_norm) @ w_q_up).reshape(Bsz, S, MLA_HEADS, MLA_QK_DIM)
    q_nope, q_pe = jnp.split(q, [MLA_NOPE], axis=-1)
    kv = (rmsnorm(ckv, kv_a_norm) @ w_kv_up).reshape(Bsz, S, MLA_HEADS, MLA_NOPE + MLA_V)
    k_nope, v = jnp.split(kv, [MLA_NOPE], axis=-1)
    k_pe = apply_rope(kpe[:, :, None, :], cos, sin)
    q = jnp.concatenate([q_nope, apply_rope(q_pe, cos, sin)], axis=-1)
    k = jnp.concatenate([k_nope, jnp.broadcast_to(k_pe, (Bsz, S, MLA_HEADS, MLA_ROPE))], axis=-1)
    q = rmsnorm(q, q_norm)
    k = rmsnorm(k, k_norm)
    y = swept_attention(q, k, v, 1.0 / math.sqrt(MLA_QK_DIM), chunk_causal=True)
    return y.reshape(Bsz, S, MLA_WIDTH)


def fox_branch(fq, fk, fv, ff, b_f, q_norm, k_norm):
    Bsz, S, _ = fq.shape
    q = rmsnorm(fq.reshape(Bsz, S, FOX_HEADS, FOX_HEAD_DIM), q_norm)
    k = rmsnorm(fk.reshape(Bsz, S, FOX_HEADS, FOX_HEAD_DIM), k_norm)
    v = fv.reshape(Bsz, S, FOX_HEADS, FOX_HEAD_DIM)
    log_f = jax.nn.log_sigmoid(ff.astype(jnp.float32) + b_f.astype(jnp.float32))
    cum = jnp.cumsum(log_f, axis=1)
    y = swept_attention(q, k, v, 1.0 / math.sqrt(FOX_HEAD_DIM), chunk_causal=False, cum_logf=cum)
    return y.reshape(Bsz, S, FOX_WIDTH)


def _ssm_combine(e1, e2):
    a1r, a1i, b1r, b1i = e1
    a2r, a2i, b2r, b2i = e2
    return (a2r * a1r - a2i * a1i,
            a2r * a1i + a2i * a1r,
            a2r * b1r - a2i * b1i + b2r,
            a2r * b1i + a2i * b1r + b2i)


def s5_branch(u, lam_re, lam_im, log_dt, b_re, b_im, c_re, c_im, d_skip, w_glu, b_glu):
    Bsz, S, _ = u.shape
    uf = u.astype(jnp.float32).reshape(Bsz, S, S5_GROUPS, S5_GROUP)
    dt = jnp.exp(log_dt.astype(jnp.float32))[:, None]
    lr = lam_re.astype(jnp.float32)
    li = lam_im.astype(jnp.float32)
    mag = jnp.exp(lr * dt)
    a_re = mag * jnp.cos(li * dt)
    a_im = mag * jnp.sin(li * dt)
    den = lr * lr + li * li
    f_re = ((a_re - 1.0) * lr + a_im * li) / den
    f_im = (a_im * lr - (a_re - 1.0) * li) / den
    br = b_re.astype(jnp.float32)
    bi = b_im.astype(jnp.float32)
    bb_re = f_re[..., None] * br - f_im[..., None] * bi
    bb_im = f_re[..., None] * bi + f_im[..., None] * br
    bu_re = jnp.einsum('bsgc,gnc->bsgn', uf, bb_re)
    bu_im = jnp.einsum('bsgc,gnc->bsgn', uf, bb_im)
    a_re_full = jnp.broadcast_to(a_re, bu_re.shape)
    a_im_full = jnp.broadcast_to(a_im, bu_re.shape)
    _, _, x_re, x_im = lax.associative_scan(_ssm_combine, (a_re_full, a_im_full, bu_re, bu_im), axis=1)
    y = (jnp.einsum('bsgn,gcn->bsgc', x_re, c_re.astype(jnp.float32))
         - jnp.einsum('bsgn,gcn->bsgc', x_im, c_im.astype(jnp.float32)))
    y = (y + d_skip.astype(jnp.float32).reshape(S5_GROUPS, S5_GROUP) * uf).reshape(Bsz, S, S5_WIDTH)
    z = jax.nn.gelu(y)
    z = z * jax.nn.sigmoid(z @ w_glu.astype(jnp.float32) + b_glu.astype(jnp.float32))
    return z.astype(u.dtype)


def hybrid_layer(x, cos, sin, norm_g, w_in,
                 mla_q_a_norm, mla_w_q_up, mla_kv_a_norm, mla_w_kv_up, mla_q_norm, mla_k_norm,
                 fox_b_f, fox_q_norm, fox_k_norm,
                 s5_lambda_re, s5_lambda_im, s5_log_dt, s5_b_re, s5_b_im, s5_c_re, s5_c_im,
                 s5_d, s5_w_glu, s5_b_glu, w_branch_out, w_out):
    h = rmsnorm(x, norm_g)
    proj = h @ w_in
    offsets = np.cumsum(IN_SPLITS)[:-1].tolist()
    (cq, ckv, kpe, fq, fk, fv, ff, s5u,
     g_mla, g_fox, g_s5, m_mla, m_fox, m_s5) = jnp.split(proj, offsets, axis=-1)

    y_mla = mla_branch(cq, ckv, kpe, cos, sin, mla_q_a_norm, mla_w_q_up,
                       mla_kv_a_norm, mla_w_kv_up, mla_q_norm, mla_k_norm)
    y_fox = fox_branch(fq, fk, fv, ff, fox_b_f, fox_q_norm, fox_k_norm)
    y_s5 = s5_branch(s5u, s5_lambda_re, s5_lambda_im, s5_log_dt, s5_b_re, s5_b_im,
                     s5_c_re, s5_c_im, s5_d, s5_w_glu, s5_b_glu)

    wo_mla, wo_fox, wo_s5 = jnp.split(w_branch_out, [MLA_WIDTH, MLA_WIDTH + FOX_WIDTH], axis=0)
    o_mla = (y_mla * jax.nn.silu(g_mla)) @ wo_mla
    o_fox = (y_fox * jax.nn.silu(g_fox)) @ wo_fox
    o_s5 = (y_s5 * jax.nn.silu(g_s5)) @ wo_s5
    merged = jax.nn.sigmoid(m_mla) * o_mla + jax.nn.sigmoid(m_fox) * o_fox + jax.nn.sigmoid(m_s5) * o_s5
    return x + merged @ w_out


def setup_inputs(seed: int = 0) -> dict:
    key = jax.random.key(seed)
    ks = jax.random.split(key, 32)
    f32 = jnp.float32

    def nrm(k, shape, scale):
        return jax.random.normal(k, shape, f32) * scale

    def gain(k, shape):
        return 1.0 + 0.02 * jax.random.normal(k, shape, f32)

    L = DEPTH
    x = jax.random.normal(ks[0], (BATCH, SEQ, D_MODEL), f32)
    start = jax.random.randint(ks[1], (BATCH, 1), 0, 4096, dtype=jnp.int32)
    positions = start + jnp.arange(SEQ, dtype=jnp.int32)[None, :]
    n_idx = jnp.arange(S5_STATE, dtype=f32)
    log_dt = jax.random.uniform(ks[17], (L, S5_GROUPS), f32, math.log(DT_MIN), math.log(DT_MAX))
    return {
        "x": x,
        "positions": positions,
        "norm_g": gain(ks[2], (L, D_MODEL)),
        "w_in": nrm(ks[3], (L, D_MODEL, IN_WIDTH), D_MODEL ** -0.5),
        "mla_q_a_norm": gain(ks[4], (L, MLA_Q_RANK)),
        "mla_w_q_up": nrm(ks[5], (L, MLA_Q_RANK, MLA_HEADS * MLA_QK_DIM), MLA_Q_RANK ** -0.5),
        "mla_kv_a_norm": gain(ks[6], (L, MLA_KV_RANK)),
        "mla_w_kv_up": nrm(ks[7], (L, MLA_KV_RANK, MLA_HEADS * (MLA_NOPE + MLA_V)), MLA_KV_RANK ** -0.5),
        "mla_q_norm": gain(ks[8], (L, MLA_QK_DIM)),
        "mla_k_norm": gain(ks[9], (L, MLA_QK_DIM)),
        "fox_b_f": 1.0 + 0.5 * jax.random.normal(ks[10], (L, FOX_HEADS), f32),
        "fox_q_norm": gain(ks[11], (L, FOX_HEAD_DIM)),
        "fox_k_norm": gain(ks[12], (L, FOX_HEAD_DIM)),
        "s5_lambda_re": -0.5 * (1.0 + 0.02 * jax.random.normal(ks[13], (L, S5_GROUPS, S5_STATE), f32)),
        "s5_lambda_im": math.pi * n_idx + 0.01 * jax.random.normal(ks[14], (L, S5_GROUPS, S5_STATE), f32),
        "s5_log_dt": log_dt,
        "s5_b_re": nrm(ks[15], (L, S5_GROUPS, S5_STATE, S5_GROUP), (2.0 * S5_GROUP) ** -0.5),
        "s5_b_im": nrm(ks[16], (L, S5_GROUPS, S5_STATE, S5_GROUP), (2.0 * S5_GROUP) ** -0.5),
        "s5_c_re": nrm(ks[18], (L, S5_GROUPS, S5_GROUP, S5_STATE), (2.0 * S5_STATE) ** -0.5),
        "s5_c_im": nrm(ks[19], (L, S5_GROUPS, S5_GROUP, S5_STATE), (2.0 * S5_STATE) ** -0.5),
        "s5_d": nrm(ks[20], (L, S5_WIDTH), 1.0),
        "s5_w_glu": nrm(ks[21], (L, S5_WIDTH, S5_WIDTH), S5_WIDTH ** -0.5),
        "s5_b_glu": nrm(ks[22], (L, S5_WIDTH), 0.02),
        "w_branch_out": nrm(ks[23], (L, BRANCH_WIDTH, D_MODEL), MLA_WIDTH ** -0.5),
        "w_out": nrm(ks[24], (L, D_MODEL, D_MODEL), D_MODEL ** -0.5),
    }


def reference(x, positions, norm_g, w_in,
              mla_q_a_norm, mla_w_q_up, mla_kv_a_norm, mla_w_kv_up, mla_q_norm, mla_k_norm,
              fox_b_f, fox_q_norm, fox_k_norm,
              s5_lambda_re, s5_lambda_im, s5_log_dt, s5_b_re, s5_b_im, s5_c_re, s5_c_im,
              s5_d, s5_w_glu, s5_b_glu, w_branch_out, w_out):
    cos, sin = rope_tables(positions, x.dtype)
    h = x
    for l in range(DEPTH):
        h = hybrid_layer(h, cos, sin, norm_g[l], w_in[l],
                         mla_q_a_norm[l], mla_w_q_up[l], mla_kv_a_norm[l], mla_w_kv_up[l],
                         mla_q_norm[l], mla_k_norm[l],
                         fox_b_f[l], fox_q_norm[l], fox_k_norm[l],
                         s5_lambda_re[l], s5_lambda_im[l], s5_log_dt[l], s5_b_re[l], s5_b_im[l],
                         s5_c_re[l], s5_c_im[l], s5_d[l], s5_w_glu[l], s5_b_glu[l],
                         w_branch_out[l], w_out[l])
    return h
```

```cpp
#include <hip/hip_runtime.h>
#include <hip/hip_cooperative_groups.h>
#include <cstdint>
#include <cstdio>
namespace cg = cooperative_groups;

#ifndef MK_LAUNCHES
#define MK_LAUNCHES 1
#endif
#ifndef USE_XCD_BAR
#define USE_XCD_BAR 1
#endif

#define LAS __attribute__((address_space(3)))
typedef unsigned short bf16_t;
typedef short bf16x8 __attribute__((ext_vector_type(8)));
typedef short s16x4 __attribute__((ext_vector_type(4)));
typedef float f32x2 __attribute__((ext_vector_type(2)));
typedef float f32x4 __attribute__((ext_vector_type(4)));
typedef float f32x16 __attribute__((ext_vector_type(16)));
typedef unsigned u32x2 __attribute__((ext_vector_type(2)));
typedef unsigned u32x4 __attribute__((ext_vector_type(4)));

constexpr int T_ = 16384, S_ = 2048, NB_ = 8, DM = 1024, NL = 2;
constexpr int NPROJ = 2560;
constexpr int NIN = 7168;
constexpr int IN_SRC = 7080;
constexpr float EPS = 1e-6f;
constexpr float LOG2E = 1.4426950408889634f;
constexpr int NPH = 1 + 7 * NL;

constexpr size_t KiB = 1024, MiB = 1024 * 1024;
constexpr size_t WS_CTL = 0;
constexpr size_t WS_SS = 64 * KiB;
constexpr size_t WS_FF32 = 256 * KiB;
constexpr size_t WS_CUM = 768 * KiB;
constexpr size_t WS_TA = 1280 * KiB;
constexpr size_t WS_TBB = 1344 * KiB;
constexpr size_t WS_TC = 1856 * KiB;
constexpr size_t WS_SSQ = 2432 * KiB;
constexpr size_t WS_SSKV = 2560 * KiB;
constexpr size_t WS_PBAR = 2688 * KiB;
constexpr size_t WS_E = 3 * MiB;
constexpr size_t WS_WQ = 7 * MiB;
constexpr size_t WS_WKV = WS_WQ + 768 * KiB;
constexpr size_t WS_WGLU = WS_WKV + 1 * MiB;
constexpr size_t WS_WBO = WS_WGLU + 1 * MiB;
constexpr size_t WS_WOUT = WS_WBO + 6 * MiB;
constexpr size_t WS_WIN = 20 * MiB;
constexpr size_t WS_XG = 48 * MiB;
constexpr size_t WS_PROJ = 80 * MiB;
constexpr size_t WS_QUP = 160 * MiB;
constexpr size_t WS_KVUP = 184 * MiB;
constexpr size_t WS_KM = 216 * MiB;
constexpr size_t WS_Z = 240 * MiB;
constexpr size_t WS_END = 256 * MiB;
static_assert(WS_WOUT + 4 * MiB <= WS_WIN && WS_WIN + 28 * MiB <= WS_XG, "ws map");

__device__ __forceinline__ unsigned pk_bf16(float lo, float hi) {
    typedef __bf16 b2 __attribute__((ext_vector_type(2)));
    f32x2 v = {lo, hi}; b2 b = __builtin_convertvector(v, b2); return __builtin_bit_cast(unsigned, b);
}
__device__ __forceinline__ float bf_lo(unsigned w) { return __uint_as_float(w << 16); }
__device__ __forceinline__ float bf_hi(unsigned w) { return __uint_as_float(w & 0xffff0000u); }
__device__ __forceinline__ float bf2f(bf16_t h) { return __uint_as_float(((unsigned)h) << 16); }
__device__ __forceinline__ bf16_t f2bf(float f) { return (bf16_t)(pk_bf16(f, 0.f) & 0xffffu); }
__device__ __forceinline__ float sigmoidf_(float v) { return 1.f / (1.f + __expf(-v)); }
__device__ __forceinline__ float siluf_(float v) { return v / (1.f + __expf(-v)); }
__device__ __forceinline__ float gelu_tanh(float y) {
    const float v = 0.7978845608028654f * (y + 0.044715f * y * y * y);
    const float t = 1.f - 2.f / (1.f + __expf(2.f * v));
    return 0.5f * y * (1.f + t);
}
template <int CTRL> __device__ __forceinline__ float dpp_f(float v) { return __builtin_bit_cast(float, __builtin_amdgcn_update_dpp(0, __builtin_bit_cast(int, v), CTRL, 0xF, 0xF, true)); }
__device__ __forceinline__ float sum8(float v) { v += dpp_f<0xB1>(v); v += dpp_f<0x4E>(v); v += dpp_f<0x141>(v); return v; }
__device__ __forceinline__ float wave_sum(float v) {
    v = sum8(v); v += dpp_f<0x140>(v);
    const int iv = __builtin_bit_cast(int, v);
    const float a = __builtin_bit_cast(float, __builtin_amdgcn_readlane(iv, 0)), b = __builtin_bit_cast(float, __builtin_amdgcn_readlane(iv, 16));
    const float c = __builtin_bit_cast(float, __builtin_amdgcn_readlane(iv, 32)), d = __builtin_bit_cast(float, __builtin_amdgcn_readlane(iv, 48));
    return (a + b) + (c + d);
}
#define SBAR() __builtin_amdgcn_sched_barrier(0)

namespace pg8 {
constexpr int BM = 256, BK = 64, HALF = 128, HTB = HALF * BK * 2, STAGE_BYTES = 8 * HTB;
__device__ __forceinline__ int lds_byte(int r, int c) { const int st = (r >> 4) * 2 + (c >> 5), rr = r & 15, cc = c & 31, ob = rr * 64 + cc * 2; return st * 1024 + (ob ^ (((ob >> 9) & 1) << 5)); }
__device__ __forceinline__ void stage_rc(int b, int& R, int& C) { const int st = b / 1024, sb = b % 1024, swz = sb ^ (((sb >> 9) & 1) << 5); R = (st >> 1) * 16 + swz / 64; C = (st & 1) * 32 + (swz % 64) / 2; }
__device__ __forceinline__ int perm32(int rho) { const int n = rho >> 4, i = rho & 15; return 8 * (i >> 2) + 4 * n + (i & 3); }

struct Unit { const char* A; const char* B; int pm, pn, kind; };

__device__ __forceinline__ bool tile_at(long L, int nM, int nN, int& pm, int& pn) {
    const int nwg = nM * nN; if (L >= nwg) return false;
    int wgid = (int)L; { const int q = nwg / 8, r = nwg % 8, xcd = wgid % 8, off = wgid / 8; wgid = (xcd < r ? xcd * (q + 1) : r * (q + 1) + (xcd - r) * q) + off; }
    const int WGM = 8, nig = WGM * nN, gid = wgid / nig, fm = gid * WGM;
    pm = fm + ((wgid % nig) & (WGM - 1)); pn = (wgid % nig) / WGM; return true;
}

template <class Epi, class Sched>
__device__ __forceinline__ void gemm_phase(LAS unsigned char* lds, const int lda, const int ldb, const int nt, const Sched& S, const Epi& E) {
    int tid = threadIdx.x; asm volatile("" : "+v"(tid));
    const int wid = __builtin_amdgcn_readfirstlane(tid >> 6), lane = tid & 63, wr = wid >> 2, wc = wid & 3, fr = lane & 15, fq = lane >> 4;
    unsigned voffA[2], voffB[2];
#pragma unroll
    for (int i = 0; i < 2; ++i) { int R, C; stage_rc(tid * 16 + i * 8192, R, C); const int Rb = Epi::PERM ? ((R & ~31) + perm32(R & 31)) : R;
        voffA[i] = (unsigned)(R * lda + C) * 2u; voffB[i] = (unsigned)(Rb * ldb + C) * 2u; }
    int ntv = nt; asm volatile("" : "+s"(ntv));
    const size_t kstep = (size_t)(BK * 2);
    const size_t hstepA = (size_t)HALF * lda * 2, hstepB = (size_t)HALF * ldb * 2;
    const unsigned ldsw = (unsigned)wid * 1024u;
    const int aoff = lds_byte(wr * 64 + fr, fq * 8), boff = lds_byte(wc * 32 + fr, fq * 8);
#define PG8_SA(b, h) (((b) * 2 + (h)) * HTB)
#define PG8_SB(b, h) ((4 + (b) * 2 + (h)) * HTB)
#define PG8_STAGE(bufoff, gbase, voff) do { _Pragma("unroll") for (int _i = 0; _i < 2; ++_i) \
        __builtin_amdgcn_global_load_lds((const unsigned*)((const char*)(gbase) + (voff)[_i]), (LAS unsigned*)(lds + (bufoff) + ldsw + _i * 8192), 16, 0, 0); } while (0)
#define PG8_LDA(dst, b, h) do { _Pragma("unroll") for (int m = 0; m < 4; ++m) _Pragma("unroll") for (int k = 0; k < 2; ++k) dst[m][k] = *(const LAS bf16x8*)(lds + PG8_SA(b, h) + aoff + m * 2048 + k * 1024); } while (0)
#define PG8_LDB(dst, b, h) do { _Pragma("unroll") for (int n = 0; n < 2; ++n) _Pragma("unroll") for (int k = 0; k < 2; ++k) dst[n][k] = *(const LAS bf16x8*)(lds + PG8_SB(b, h) + boff + n * 2048 + k * 1024); } while (0)
#define PG8_MMA(ai, bj, At, Bt) do { __builtin_amdgcn_s_setprio(1); _Pragma("unroll") for (int m = 0; m < 4; ++m) _Pragma("unroll") for (int n = 0; n < 2; ++n) _Pragma("unroll") for (int k = 0; k < 2; ++k) \
        acc[ai][bj][m][n] = __builtin_amdgcn_mfma_f32_16x16x32_bf16(Bt[n][k], At[m][k], acc[ai][bj][m][n], 0, 0, 0); __builtin_amdgcn_s_setprio(0); } while (0)
#define PG8_WAIT_V(n) asm volatile("s_waitcnt vmcnt(" #n ")" ::: "memory")
#define PG8_WAIT_L(n) asm volatile("s_waitcnt lgkmcnt(" #n ")" ::: "memory")
#define PG8_BAR __builtin_amdgcn_s_barrier()
#define PG8_SCHED __builtin_amdgcn_sched_barrier(0)
    Unit cur, nxt; int ui = 0;
    if (!S.next(0, cur)) return;
    f32x4 acc[2][2][4][2];
#pragma unroll
    for (int a = 0; a < 2; ++a)
#pragma unroll
        for (int b = 0; b < 2; ++b)
#pragma unroll
            for (int m = 0; m < 4; ++m)
#pragma unroll
                for (int n = 0; n < 2; ++n) acc[a][b][m][n] = (f32x4){0.f, 0.f, 0.f, 0.f};
    bf16x8 At[4][2], B0[2][2], B1[2][2];
    const char* cA = cur.A; const char* cB = cur.B;
    PG8_STAGE(PG8_SB(0, 0), cB, voffB); PG8_STAGE(PG8_SB(0, 1), cB + hstepB, voffB); PG8_STAGE(PG8_SA(0, 0), cA, voffA); PG8_STAGE(PG8_SA(0, 1), cA + hstepA, voffA);
    if (wr == 1) PG8_BAR;
    PG8_WAIT_V(2); PG8_BAR;
    PG8_STAGE(PG8_SB(1, 0), cB + kstep, voffB); PG8_STAGE(PG8_SA(1, 0), cA + kstep, voffA); PG8_STAGE(PG8_SB(1, 1), cB + hstepB + kstep, voffB);
    PG8_WAIT_V(6); PG8_BAR;
    for (;;) {
        const bool has_next = S.next(ui + 1, nxt);
        const char* nA = has_next ? nxt.A : cA; const char* nB = has_next ? nxt.B : cB;
        for (int t = 0; t < ntv; t += 2) {
            const bool last = (t == ntv - 2);
            const char* a1 = cA + (size_t)(t + 1) * kstep;
            const char* a2 = last ? nA : cA + (size_t)(t + 2) * kstep; const char* b2 = last ? nB : cB + (size_t)(t + 2) * kstep;
            const char* a3 = a2 + kstep; const char* b3 = b2 + kstep;
            PG8_LDB(B0, 0, 0); PG8_LDB(B1, 0, 1); PG8_SCHED; PG8_LDA(At, 0, 0); PG8_STAGE(PG8_SA(1, 1), a1 + hstepA, voffA);
            PG8_WAIT_V(8); PG8_WAIT_L(0); PG8_BAR; PG8_MMA(0, 0, At, B0); PG8_MMA(0, 1, At, B1); PG8_BAR; PG8_SCHED;
            PG8_LDA(At, 0, 1); PG8_STAGE(PG8_SB(0, 0), b2, voffB); PG8_STAGE(PG8_SB(0, 1), b2 + hstepB, voffB); PG8_STAGE(PG8_SA(0, 0), a2, voffA);
            PG8_WAIT_V(8); PG8_WAIT_L(0); PG8_BAR; PG8_MMA(1, 0, At, B0); PG8_MMA(1, 1, At, B1); PG8_BAR; PG8_SCHED;
            PG8_LDB(B0, 1, 0); PG8_LDB(B1, 1, 1); PG8_SCHED; PG8_LDA(At, 1, 0); PG8_STAGE(PG8_SA(0, 1), a2 + hstepA, voffA);
            PG8_WAIT_V(8); PG8_WAIT_L(0); PG8_BAR; PG8_MMA(0, 0, At, B0); PG8_MMA(0, 1, At, B1); PG8_BAR; PG8_SCHED;
            PG8_LDA(At, 1, 1); PG8_STAGE(PG8_SB(1, 0), b3, voffB); PG8_STAGE(PG8_SB(1, 1), b3 + hstepB, voffB); PG8_STAGE(PG8_SA(1, 0), a3, voffA);
            PG8_WAIT_V(8); PG8_WAIT_L(0); PG8_BAR; PG8_MMA(1, 0, At, B0); PG8_MMA(1, 1, At, B1); PG8_BAR; PG8_SCHED;
        }
        if (wr == 0) PG8_BAR;
        const bool keep = E(acc, cur, wr, wc, fr, fq);
        if (!has_next) break;
        if (!keep) {
#pragma unroll
            for (int a = 0; a < 2; ++a)
#pragma unroll
                for (int b = 0; b < 2; ++b)
#pragma unroll
                    for (int m = 0; m < 4; ++m)
#pragma unroll
                        for (int n = 0; n < 2; ++n) acc[a][b][m][n] = (f32x4){0.f, 0.f, 0.f, 0.f};
        }
        cur = nxt; cA = nA; cB = nB; ++ui;
        if (wr == 1) PG8_BAR;
    }
    PG8_WAIT_V(0);
    PG8_BAR;
#undef PG8_SA
#undef PG8_SB
#undef PG8_STAGE
#undef PG8_LDA
#undef PG8_LDB
#undef PG8_MMA
#undef PG8_WAIT_V
#undef PG8_WAIT_L
#undef PG8_BAR
#undef PG8_SCHED
}
}

struct Args {
    const float* in[25];
    float* out;
    unsigned char* ws;
    int ph_lo, ph_hi, probe, pad;
};
enum { I_X = 0, I_POS, I_NORMG, I_WIN, I_QAN, I_WQUP, I_KVAN, I_WKVUP, I_MQN, I_MKN, I_FBF, I_FQN, I_FKN,
       I_LRE, I_LIM, I_LDT, I_BRE, I_BIM, I_CRE, I_CIM, I_S5D, I_WGLU, I_BGLU, I_WBO, I_WOUT };

typedef const __attribute__((address_space(4))) Args* ArgsP;
__device__ __forceinline__ ArgsP get_args() { ArgsP p = (ArgsP)__builtin_amdgcn_kernarg_segment_ptr(); asm volatile("" : "+s"(p)); return p; }
__device__ __forceinline__ int grid_g() { int g = (int)gridDim.x; asm volatile("" : "+s"(g)); return g; }
struct Ctx {
    LAS unsigned char* lds;
    char* ldsg;
    int G, bid;
    int vb;
};
#define PHASE_IDS() int tid = threadIdx.x; asm volatile("" : "+v"(tid)); const int lane = tid & 63, wave = __builtin_amdgcn_readfirstlane(tid >> 6); (void)lane; (void)wave

using pg8::Unit;
using pg8::tile_at;

__device__ __forceinline__ float rstd_of(const float* ss, int row) { return rsqrtf(ss[row] * (1.f / DM) + EPS); }

struct SchedIn {
    const char* XG; const char* WIN; int mode, G, c;
    __device__ __forceinline__ bool next(int i, Unit& u) const {
        int pm, pn; if (!tile_at((long)(i >> 1) * G + c, 64, mode ? 2 : 8, pm, pn)) return false;
        pn = mode ? pn + 6 : (pn >= 6 ? pn + 2 : pn);
        const int h = i & 1;
        u.A = XG + ((size_t)h * T_ + (size_t)pm * 256) * 512 * 2;
        u.B = WIN + ((size_t)h * NIN + (size_t)pn * 256) * 512 * 2;
        u.pm = pm; u.pn = pn; u.kind = h; return true;
    }
};
struct EpiProj {
    static constexpr bool PERM = true;
    bf16_t* P; const float* ss; float* ff32; float* ssq;
    __device__ __forceinline__ bool operator()(f32x4 (&acc)[2][2][4][2], const Unit& u, int wr, int wc, int fr, int fq) const {
        if (u.kind == 0) return true;
        const int row0 = u.pm * 256 + wr * 64 + fr, col0 = u.pn * 256 + wc * 32 + 8 * fq;
        float rs[2][4];
#pragma unroll
        for (int ai = 0; ai < 2; ++ai)
#pragma unroll
            for (int m = 0; m < 4; ++m) rs[ai][m] = ss[row0 + ai * 128 + m * 16];
#pragma unroll
        for (int ai = 0; ai < 2; ++ai)
#pragma unroll
            for (int m = 0; m < 4; ++m) { const int row = row0 + ai * 128 + m * 16; const float r_ = rsqrtf(rs[ai][m] * (1.f / DM) + EPS); bf16_t* rp = P + (size_t)row * NPROJ + col0;
#pragma unroll
                for (int bj = 0; bj < 2; ++bj) { const f32x4 v0 = acc[ai][bj][m][0] * r_, v1 = acc[ai][bj][m][1] * r_;
                    u32x4 w; w.x = pk_bf16(v0[0], v0[1]); w.y = pk_bf16(v0[2], v0[3]); w.z = pk_bf16(v1[0], v1[1]); w.w = pk_bf16(v1[2], v1[3]);
                    *(u32x4*)(rp + bj * 128) = w;
                    if (u.pn == 1 && bj == 1 && wc == 1 && fq == 0) { float* f = ff32 + (size_t)row * 8; *(f32x4*)f = v0; *(f32x4*)(f + 4) = v1; } }
                if (u.pn < 2) {
                    const f32x4 a0 = acc[ai][0][m][0] * r_, a1 = acc[ai][0][m][1] * r_; float sq = (a0[0] * a0[0] + a0[1] * a0[1]) + (a0[2] * a0[2] + a0[3] * a0[3]) + (a1[0] * a1[0] + a1[1] * a1[1]) + (a1[2] * a1[2] + a1[3] * a1[3]);
                    if (u.pn == 0) { const f32x4 b0 = acc[ai][1][m][0] * r_, b1 = acc[ai][1][m][1] * r_; sq += (b0[0] * b0[0] + b0[1] * b0[1]) + (b0[2] * b0[2] + b0[3] * b0[3]) + (b1[0] * b1[0] + b1[1] * b1[1]) + (b1[2] * b1[2] + b1[3] * b1[3]); }
                    sq += __shfl_xor(sq, 16); sq += __shfl_xor(sq, 32);
                    if (fq == 0) atomicAdd(ssq + (u.pn == 0 ? 0 : NL * T_) + row, sq); } }
        return false;
    }
};

struct SchedUp { const char* P; const char* WQ; const char* WKV; int G, c;
    __device__ __forceinline__ bool next(int i, Unit& u) const {
        long L = (long)i * G + c; int pm, pn;
        if (G == 256) { if (c < 128 || i >= 4) return false; L = (long)i * 128 + (c - 128); }
        if (L < 256) { tile_at(L, 64, 4, pm, pn); u.A = P + (size_t)pm * 256 * NPROJ * 2 + 256 * 2; u.B = WKV + (size_t)pn * 256 * 256 * 2; u.kind = 1; }
        else { if (!tile_at(L - 256, 64, 3, pm, pn)) return false; u.A = P + (size_t)pm * 256 * NPROJ * 2; u.B = WQ + (size_t)pn * 256 * 256 * 2; u.kind = 0; }
        u.pm = pm; u.pn = pn; return true; }
};
struct SchedPlain { const char* A; size_t a_tile_bytes, a_batch_bytes; const char* B; size_t b_tile_bytes; int nN, G, c;
    __device__ __forceinline__ bool next(int i, Unit& u) const {
        int pm, pn; if (!tile_at((long)i * G + c, 64, nN, pm, pn)) return false;
        u.A = A + (size_t)(pm >> 3) * a_batch_bytes + (size_t)(pm & 7) * a_tile_bytes; u.B = B + (size_t)pn * b_tile_bytes; u.pm = pm; u.pn = pn; u.kind = 0; return true; }
};
struct EpiUp { static constexpr bool PERM = true; bf16_t* QUP; bf16_t* KM; bf16_t* VM; const float* ssq;
    __device__ __forceinline__ bool operator()(f32x4 (&acc)[2][2][4][2], const Unit& u, int wr, int wc, int fr, int fq) const {
        const int row0 = u.pm * 256 + wr * 64 + fr, col0 = u.pn * 256 + wc * 32 + 8 * fq;
        float rs[2][4];
#pragma unroll
        for (int ai = 0; ai < 2; ++ai)
#pragma unroll
            for (int m = 0; m < 4; ++m) rs[ai][m] = ssq[(u.kind ? NL * T_ : 0) + row0 + ai * 128 + m * 16];
        const float inv = u.kind ? (1.f / 128) : (1.f / 256);
        bf16_t* dbase[2]; int dstr[2];
#pragma unroll
        for (int bj = 0; bj < 2; ++bj) { const int col = col0 + bj * 128;
            if (u.kind == 0) { dbase[bj] = QUP + col; dstr[bj] = 768; }
            else { const int hd = col >> 7, d = col & 127; if (d < 64) { dbase[bj] = KM + 96 * hd + d; dstr[bj] = 768; } else { dbase[bj] = VM + 64 * hd + (d - 64); dstr[bj] = 512; } } }
#pragma unroll
        for (int ai = 0; ai < 2; ++ai)
#pragma unroll
            for (int m = 0; m < 4; ++m) { const int row = row0 + ai * 128 + m * 16; const float r_ = rsqrtf(rs[ai][m] * inv + EPS);
#pragma unroll
                for (int bj = 0; bj < 2; ++bj) { const f32x4 v0 = acc[ai][bj][m][0] * r_, v1 = acc[ai][bj][m][1] * r_;
                    u32x4 w; w.x = pk_bf16(v0[0], v0[1]); w.y = pk_bf16(v0[2], v0[3]); w.z = pk_bf16(v1[0], v1[1]); w.w = pk_bf16(v1[2], v1[3]);
                    *(u32x4*)(dbase[bj] + (size_t)row * dstr[bj]) = w; } }
        return false;
    }
};
struct SchedGate { const char* ws; int l, G, c;
    __device__ __forceinline__ bool next(int i, Unit& u) const {
        const char* XG = ws + WS_XG; const char* WIN = ws + WS_WIN + (size_t)l * 2 * NIN * 512 * 2; const char* Z = ws + WS_Z; const char* WGLU = ws + WS_WGLU + (size_t)l * 512 * 512 * 2;
        int pm, pn, j;
        if (G == 256) {
            const int x = c & 7, k = c >> 3;
            if (k < 16) { if (i >= 4) return false; pm = 8 * x + (k >> 1); pn = 2 * (k & 1) + (i >> 1); j = i & 1; }
            else { if (i >= 3) return false; const int kk = k - 16; pm = 8 * x + (kk >> 1); pn = 4 + (kk & 1); j = i - 1; }
        } else {
            int Gv = G; asm volatile("" : "+s"(Gv));
            const int t3 = (128 - c + Gv - 1) / Gv;
            const int ns5 = (c < 128) ? t3 : 0;
            if (i < 3 * ns5) { const int m = c + (i / 3) * G; pm = m >> 1; pn = 4 + (m & 1); j = i % 3 - 1; }
            else { const int i2 = i - 3 * ns5; const long n = (long)(i2 >> 1) * G + c; if (n >= 256) return false; pm = (int)(n >> 2); pn = (int)(n & 3); j = i2 & 1; }
        }
        if (j < 0) { u.A = Z + (size_t)pm * 256 * 512 * 2; u.B = WGLU + (size_t)(pn & 1) * 256 * 512 * 2; u.kind = 2; }
        else { u.A = XG + ((size_t)j * T_ + (size_t)pm * 256) * 512 * 2; u.B = WIN + ((size_t)j * NIN + 2560 + (size_t)pn * 256) * 512 * 2; u.kind = j; }
        u.pm = pm; u.pn = pn; return true;
    }
};
struct EpiGate { static constexpr bool PERM = true; unsigned char* ws; const float* bias; int l;
    __device__ __forceinline__ bool operator()(f32x4 (&acc)[2][2][4][2], const Unit& u, int wr, int wc, int fr, int fq) const {
        if (u.kind == 0) return true;
        bf16_t* P = (bf16_t*)(ws + WS_PROJ); const bf16_t* QUP = (const bf16_t*)(ws + WS_QUP); const bf16_t* Z = (const bf16_t*)(ws + WS_Z); bf16_t* ABO = (bf16_t*)(ws + WS_KVUP); const float* ss = (const float*)(ws + WS_SS) + (size_t)l * T_;
        const int br = u.pn >> 1;
        const int row0 = u.pm * 256 + wr * 64 + fr, c0 = (u.pn & 1) * 256 + wc * 32 + 8 * fq;
        if (u.kind == 2) {
            f32x4 bv[2][2];
#pragma unroll
            for (int bj = 0; bj < 2; ++bj) { bv[bj][0] = *(const f32x4*)(bias + c0 + bj * 128); bv[bj][1] = *(const f32x4*)(bias + c0 + bj * 128 + 4); }
#pragma unroll
            for (int ai = 0; ai < 2; ++ai) {
                u32x4 yv[4][2];
#pragma unroll
                for (int m = 0; m < 4; ++m)
#pragma unroll
                    for (int bj = 0; bj < 2; ++bj) yv[m][bj] = *(const u32x4*)(Z + (size_t)(row0 + ai * 128 + m * 16) * 512 + c0 + bj * 128);
#pragma unroll
                for (int m = 0; m < 4; ++m) { const int row = row0 + ai * 128 + m * 16;
#pragma unroll
                    for (int bj = 0; bj < 2; ++bj) { const int c = c0 + bj * 128; const f32x4 v0 = acc[ai][bj][m][0] + bv[bj][0], v1 = acc[ai][bj][m][1] + bv[bj][1];
                        const u32x4 z = yv[m][bj];
                        u32x4 w;
                        w.x = pk_bf16(bf_lo(z.x) * sigmoidf_(v0[0]), bf_hi(z.x) * sigmoidf_(v0[1]));
                        w.y = pk_bf16(bf_lo(z.y) * sigmoidf_(v0[2]), bf_hi(z.y) * sigmoidf_(v0[3]));
                        w.z = pk_bf16(bf_lo(z.z) * sigmoidf_(v1[0]), bf_hi(z.z) * sigmoidf_(v1[1]));
                        w.w = pk_bf16(bf_lo(z.w) * sigmoidf_(v1[2]), bf_hi(z.w) * sigmoidf_(v1[3]));
                        *(u32x4*)(P + (size_t)row * NPROJ + c) = w; } }
            }
            return false;
        }
        const unsigned abo2 = (br == 2) ? (unsigned)(u.pm >> 3) * (512u << 10) : 0u;
        float rs[2][4];
#pragma unroll
        for (int ai = 0; ai < 2; ++ai)
#pragma unroll
            for (int m = 0; m < 4; ++m) rs[ai][m] = ss[row0 + ai * 128 + m * 16];
#pragma unroll
        for (int ai = 0; ai < 2; ++ai) {
            u32x4 yv[4][2];
#pragma unroll
            for (int m = 0; m < 4; ++m) { const int row = row0 + ai * 128 + m * 16;
#pragma unroll
                for (int bj = 0; bj < 2; ++bj) { const int c = c0 + bj * 128;
                    const bf16_t* ysrc = (br == 0) ? (QUP + (size_t)row * 768 + 96 * (c >> 6) + (c & 63)) : (br == 1) ? (P + (size_t)row * NPROJ + 512 + c) : (P + (size_t)row * NPROJ + c);
                    yv[m][bj] = *(const u32x4*)ysrc; } }
#pragma unroll
            for (int m = 0; m < 4; ++m) { const int row = row0 + ai * 128 + m * 16; const float r_ = rsqrtf(rs[ai][m] * (1.f / DM) + EPS);
#pragma unroll
                for (int bj = 0; bj < 2; ++bj) { const int c = c0 + bj * 128;
                    const u32x4 y = yv[m][bj];
                    const f32x4 v0 = acc[ai][bj][m][0] * r_, v1 = acc[ai][bj][m][1] * r_;
                    u32x4 w;
                    w.x = pk_bf16(bf_lo(y.x) * siluf_(v0[0]), bf_hi(y.x) * siluf_(v0[1]));
                    w.y = pk_bf16(bf_lo(y.y) * siluf_(v0[2]), bf_hi(y.y) * siluf_(v0[3]));
                    w.z = pk_bf16(bf_lo(y.z) * siluf_(v1[0]), bf_hi(y.z) * siluf_(v1[1]));
                    w.w = pk_bf16(bf_lo(y.w) * siluf_(v1[2]), bf_hi(y.w) * siluf_(v1[3]));
                    *(u32x4*)(ABO + ((size_t)br * T_ + row) * 512 + abo2 + c) = w; } }
        }
        return false;
    }
};
enum { MOP_KEEP = 0, MOP_STORE_O = 1, MOP_GATE_RMW = 2, MOP_STORE_S = 3, MOP_O_RMW = 4, MOP_FIRST = 8 };
struct SchedMerge { const char* ws; int l, G, c;
    __device__ __forceinline__ bool next(int i, Unit& u) const {
        const char* ABO = ws + WS_KVUP; const char* WBO = ws + WS_WBO + (size_t)l * 3 * 1024 * 512 * 2; const char* XG = ws + WS_XG; const char* WIN = ws + WS_WIN + (size_t)l * 2 * NIN * 512 * 2;
        int pm, pn; if (!tile_at((long)(i / 9) * G + c, 64, 4, pm, pn)) return false;
        const int j = i % 9; int typ, br, h = 0, op;
        if (G != 256 || !(c & 1)) { br = j / 3; const int s_ = j % 3; typ = s_ != 0; h = s_ - 1; op = s_ == 0 ? MOP_STORE_O : s_ == 1 ? MOP_KEEP : (MOP_GATE_RMW | (br == 0 ? MOP_FIRST : 0)); }
        else if (j < 2) { typ = 1; br = 2; h = j; op = j ? MOP_STORE_S : MOP_KEEP; }
        else { const int jj = j - 2, g = jj / 3, r = jj % 3; br = g;
            if (g == 2) { typ = 0; op = MOP_O_RMW; }
            else if (r == 0) { typ = 0; op = MOP_STORE_O; }
            else { typ = 1; h = r - 1; op = r == 1 ? MOP_KEEP : (MOP_GATE_RMW | (g == 0 ? MOP_FIRST : 0)); } }
        if (typ == 0) { u.A = ABO + ((size_t)br * T_ + (size_t)pm * 256) * 512 * 2 + (br == 2 ? (size_t)(pm >> 3) << 20 : 0); u.B = WBO + ((size_t)br * 1024 + (size_t)pn * 256) * 512 * 2; }
        else { u.A = XG + ((size_t)h * T_ + (size_t)pm * 256) * 512 * 2; u.B = WIN + ((size_t)h * NIN + 4096 + (size_t)br * 1024 + (size_t)pn * 256) * 512 * 2; }
        u.pm = pm; u.pn = pn; u.kind = op; return true;
    }
};
struct EpiMerge { static constexpr bool PERM = true; unsigned char* ws; int l, bid;
    __device__ __forceinline__ bf16_t* scr2() const { unsigned b_ = (unsigned)bid; asm volatile("" : "+s"(b_)); const unsigned sb = b_ & 7u, sk = (b_ >> 3) & 31u;
        return (bf16_t*)(ws + (sk < 16u ? (unsigned)WS_Z + sb * (2u << 20) + sk * 131072u : (unsigned)WS_PROJ + sb * (10u << 20) + (8u << 20) + (sk - 16u) * 131072u)); }
    __device__ __forceinline__ bool operator()(f32x4 (&acc)[2][2][4][2], const Unit& u, int wr, int wc, int fr, int fq) const {
        const int op = u.kind & 7; const bool first = (u.kind & MOP_FIRST) != 0;
        if (op == MOP_KEEP) return true;
        bf16_t* OSCR = (bf16_t*)(ws + WS_PROJ) + (unsigned)(u.pm >> 3) * (3u << 20); bf16_t* MERGED = OSCR + (size_t)S_ * 1024; const float* ss = (const float*)(ws + WS_SS) + (size_t)l * T_;
        const int rt0 = wr * 64 + fr, ct0 = wc * 32 + 8 * fq;
        const int row0 = u.pm * 256 + rt0, col0 = u.pn * 256 + ct0;
        if (op == MOP_STORE_O) {
#pragma unroll
            for (int ai = 0; ai < 2; ++ai)
#pragma unroll
                for (int m = 0; m < 4; ++m) { const size_t off = (size_t)(row0 + ai * 128 + m * 16) * 1024 + col0;
#pragma unroll
                    for (int bj = 0; bj < 2; ++bj) { const f32x4 v0 = acc[ai][bj][m][0], v1 = acc[ai][bj][m][1];
                        u32x4 w; w.x = pk_bf16(v0[0], v0[1]); w.y = pk_bf16(v0[2], v0[3]); w.z = pk_bf16(v1[0], v1[1]); w.w = pk_bf16(v1[2], v1[3]);
                        *(u32x4*)(OSCR + off + bj * 128) = w; } }
            return false;
        }
        if (op == MOP_O_RMW) {
            bf16_t* SCR2 = scr2();
#pragma unroll
            for (int qd = 0; qd < 4; ++qd) { const int ai = qd >> 1, m0 = (qd & 1) * 2;
                u32x4 sv[2][2], pv[2][2];
#pragma unroll
                for (int mm = 0; mm < 2; ++mm) { const int rr = ai * 128 + (m0 + mm) * 16; const size_t off = (size_t)(row0 + rr) * 1024 + col0;
#pragma unroll
                    for (int bj = 0; bj < 2; ++bj) { sv[mm][bj] = *(const u32x4*)(SCR2 + (size_t)(rt0 + rr) * 256 + ct0 + bj * 128); pv[mm][bj] = *(const u32x4*)(MERGED + off + bj * 128); } }
#pragma unroll
                for (int mm = 0; mm < 2; ++mm) { const int m = m0 + mm; const size_t off = (size_t)(row0 + ai * 128 + m * 16) * 1024 + col0;
#pragma unroll
                    for (int bj = 0; bj < 2; ++bj) { const f32x4 v0 = acc[ai][bj][m][0], v1 = acc[ai][bj][m][1]; const u32x4 g = sv[mm][bj], p = pv[mm][bj];
                        u32x4 w;
                        w.x = pk_bf16(bf_lo(p.x) + bf_lo(g.x) * v0[0], bf_hi(p.x) + bf_hi(g.x) * v0[1]); w.y = pk_bf16(bf_lo(p.y) + bf_lo(g.y) * v0[2], bf_hi(p.y) + bf_hi(g.y) * v0[3]);
                        w.z = pk_bf16(bf_lo(p.z) + bf_lo(g.z) * v1[0], bf_hi(p.z) + bf_hi(g.z) * v1[1]); w.w = pk_bf16(bf_lo(p.w) + bf_lo(g.w) * v1[2], bf_hi(p.w) + bf_hi(g.w) * v1[3]);
                        *(u32x4*)(MERGED + off + bj * 128) = w; } }
            }
            return false;
        }
        if (op == MOP_STORE_S) {
            bf16_t* SCR2 = scr2();
            float rs[2][4];
#pragma unroll
            for (int ai = 0; ai < 2; ++ai)
#pragma unroll
                for (int m = 0; m < 4; ++m) rs[ai][m] = ss[row0 + ai * 128 + m * 16];
#pragma unroll
            for (int ai = 0; ai < 2; ++ai)
#pragma unroll
                for (int m = 0; m < 4; ++m) { const int rr = ai * 128 + m * 16; const float r_ = rsqrtf(rs[ai][m] * (1.f / DM) + EPS);
#pragma unroll
                    for (int bj = 0; bj < 2; ++bj) { const f32x4 v0 = acc[ai][bj][m][0] * r_, v1 = acc[ai][bj][m][1] * r_;
                        u32x4 w; w.x = pk_bf16(sigmoidf_(v0[0]), sigmoidf_(v0[1])); w.y = pk_bf16(sigmoidf_(v0[2]), sigmoidf_(v0[3])); w.z = pk_bf16(sigmoidf_(v1[0]), sigmoidf_(v1[1])); w.w = pk_bf16(sigmoidf_(v1[2]), sigmoidf_(v1[3]));
                        *(u32x4*)(SCR2 + (size_t)(rt0 + rr) * 256 + ct0 + bj * 128) = w; } }
            return false;
        }
#pragma unroll
        for (int ai = 0; ai < 2; ++ai)
#pragma unroll
            for (int m = 0; m < 4; ++m) { const size_t off = (size_t)(row0 + ai * 128 + m * 16) * 1024 + col0;
                u32x4 ov[2], pv[2]; const float rq_ = ss[row0 + ai * 128 + m * 16];
#pragma unroll
                for (int bj = 0; bj < 2; ++bj) { ov[bj] = *(const u32x4*)(OSCR + off + bj * 128); pv[bj] = (u32x4){0u, 0u, 0u, 0u}; if (!first) pv[bj] = *(const u32x4*)(MERGED + off + bj * 128); }
                const float r_ = rsqrtf(rq_ * (1.f / DM) + EPS);
#pragma unroll
                for (int bj = 0; bj < 2; ++bj) { const f32x4 v0 = acc[ai][bj][m][0] * r_, v1 = acc[ai][bj][m][1] * r_;
                    const u32x4 o = ov[bj], p = pv[bj];
                    u32x4 w;
                    w.x = pk_bf16(bf_lo(p.x) + bf_lo(o.x) * sigmoidf_(v0[0]), bf_hi(p.x) + bf_hi(o.x) * sigmoidf_(v0[1]));
                    w.y = pk_bf16(bf_lo(p.y) + bf_lo(o.y) * sigmoidf_(v0[2]), bf_hi(p.y) + bf_hi(o.y) * sigmoidf_(v0[3]));
                    w.z = pk_bf16(bf_lo(p.z) + bf_lo(o.z) * sigmoidf_(v1[0]), bf_hi(p.z) + bf_hi(o.z) * sigmoidf_(v1[1]));
                    w.w = pk_bf16(bf_lo(p.w) + bf_lo(o.w) * sigmoidf_(v1[2]), bf_hi(p.w) + bf_hi(o.w) * sigmoidf_(v1[3]));
                    *(u32x4*)(MERGED + off + bj * 128) = w; } }
        return false;
    }
};
struct EpiOut { static constexpr bool PERM = false; const float* xres; float* out; bf16_t* XG; float* ssn; bool dry;
    __device__ __forceinline__ bool operator()(f32x4 (&acc)[2][2][4][2], const Unit& u, int wr, int wc, int fr, int fq) const {
        const int row0 = u.pm * 256 + wr * 64 + fr, col0 = u.pn * 256 + wc * 32 + 4 * fq;
#pragma unroll
        for (int qd = 0; qd < 4; ++qd) { const int ai = qd >> 1, m0 = (qd & 1) * 2;
            f32x4 xr[2][2][2];
            if (xres) {
#pragma unroll
                for (int mm = 0; mm < 2; ++mm) { const size_t off = (size_t)(row0 + ai * 128 + (m0 + mm) * 16) * DM + col0;
#pragma unroll
                    for (int bj = 0; bj < 2; ++bj)
#pragma unroll
                        for (int n = 0; n < 2; ++n) xr[mm][bj][n] = *(const f32x4*)(xres + off + bj * 128 + n * 16); }
            } else {
                u32x2 xb[2][2][2];
#pragma unroll
                for (int mm = 0; mm < 2; ++mm) { const int row = row0 + ai * 128 + (m0 + mm) * 16;
#pragma unroll
                    for (int bj = 0; bj < 2; ++bj)
#pragma unroll
                        for (int n = 0; n < 2; ++n) { const int col = col0 + bj * 128 + n * 16; xb[mm][bj][n] = *(const u32x2*)(XG + ((size_t)(col >> 9) * T_ + row) * 512 + (col & 511)); } }
#pragma unroll
                for (int mm = 0; mm < 2; ++mm)
#pragma unroll
                    for (int bj = 0; bj < 2; ++bj)
#pragma unroll
                        for (int n = 0; n < 2; ++n) { const u32x2 b = xb[mm][bj][n]; xr[mm][bj][n] = (f32x4){bf_lo(b.x), bf_hi(b.x), bf_lo(b.y), bf_hi(b.y)}; }
            }
#pragma unroll
            for (int mm = 0; mm < 2; ++mm) { const int m = m0 + mm; const int row = row0 + ai * 128 + m * 16; const size_t off = (size_t)row * DM + col0; float sq = 0.f;
#pragma unroll
                for (int bj = 0; bj < 2; ++bj)
#pragma unroll
                    for (int n = 0; n < 2; ++n) { const int cc = bj * 128 + n * 16; const f32x4 o = xr[mm][bj][n] + acc[ai][bj][m][n];
                        if (!ssn && !dry) *(f32x4*)(out + off + cc) = o;
                        if (ssn && !dry) { const int col = col0 + cc; sq += (o[0] * o[0] + o[1] * o[1]) + (o[2] * o[2] + o[3] * o[3]);
                            u32x2 w; w.x = pk_bf16(o[0], o[1]); w.y = pk_bf16(o[2], o[3]);
                            *(u32x2*)(XG + ((size_t)(col >> 9) * T_ + row) * 512 + (col & 511)) = w; } }
                if (ssn && !dry) { sq += __shfl_xor(sq, 16); sq += __shfl_xor(sq, 32); if (fq == 0) atomicAdd(ssn + row, sq); } }
        }
        return false;
    }
};

namespace attn {
constexpr int QBLK = 32, KVBLK = 64;
constexpr int SHM_K = KVBLK * 256, SHM_V = KVBLK * 64 * 2;
constexpr int NBUF = 3;
constexpr int LDS_V = 0, LDS_K = NBUF * SHM_V, LDS_CK = LDS_K + NBUF * SHM_K, LDS_WS = LDS_CK + NBUF * 256, LDS_OST = LDS_WS + 8 * 256, LDS_BYTES = LDS_OST + 8 * 4096;
constexpr float THR2 = 8.f;
#define KSWZ(row, colB) ((row) * 256 + ((colB) ^ (((row) & 15) << 4)))
__device__ __forceinline__ int crow(int r, int hi) { return (r & 3) + 8 * (r >> 2) + 4 * hi; }
__device__ __forceinline__ void partialSM(f32x16& p0, f32x16& p1, float& m_reg, float& alpha) {
    float pmax = p0[0];
#pragma unroll
    for (int r = 1; r < 16; ++r) pmax = fmaxf(pmax, p0[r]);
#pragma unroll
    for (int r = 0; r < 16; ++r) pmax = fmaxf(pmax, p1[r]);
    { auto rr = __builtin_amdgcn_permlane32_swap(__float_as_uint(pmax), __float_as_uint(pmax), false, false);
      pmax = fmaxf(__uint_as_float(rr[0]), __uint_as_float(rr[1])); }
    if (__builtin_expect(__all(pmax <= THR2), 1)) { alpha = 1.f; }
    else { const float dl = fmaxf(pmax, 0.f); m_reg += dl; alpha = __builtin_amdgcn_exp2f(-dl);
#pragma unroll
        for (int r = 0; r < 16; ++r) { p0[r] -= dl; p1[r] -= dl; } }
#pragma unroll
    for (int r = 0; r < 16; ++r) p0[r] = __builtin_amdgcn_exp2f(p0[r]);
}
__device__ __forceinline__ void finishSM(f32x16& p0, f32x16& p1, float alpha, float& l_reg, bf16x8& pa0, bf16x8& pa1, bf16x8& pa2, bf16x8& pa3) {
#pragma unroll
    for (int r = 0; r < 16; ++r) p1[r] = __builtin_amdgcn_exp2f(p1[r]);
    float ps = 0;
#pragma unroll
    for (int r = 0; r < 16; ++r) ps += p0[r];
#pragma unroll
    for (int r = 0; r < 16; ++r) ps += p1[r];
    { auto rr = __builtin_amdgcn_permlane32_swap(__float_as_uint(ps), __float_as_uint(ps), false, false);
      ps = __uint_as_float(rr[0]) + __uint_as_float(rr[1]); }
    l_reg = l_reg * alpha + ps;
#define PK4(P, BASE, OUT) do { unsigned a0 = pk_bf16(P[BASE + 0], P[BASE + 1]), a1 = pk_bf16(P[BASE + 2], P[BASE + 3]);   \
    unsigned b0 = pk_bf16(P[BASE + 4], P[BASE + 5]), b1 = pk_bf16(P[BASE + 6], P[BASE + 7]);                              \
    auto r0 = __builtin_amdgcn_permlane32_swap(a0, b0, false, false); auto r1 = __builtin_amdgcn_permlane32_swap(a1, b1, false, false); \
    u32x4 w = {r0[0], r1[0], r0[1], r1[1]}; OUT = __builtin_bit_cast(bf16x8, w); } while (0)
    PK4(p0, 0, pa0); PK4(p0, 8, pa1); PK4(p1, 0, pa2); PK4(p1, 8, pa3);
#undef PK4
}
__device__ __forceinline__ int v_st(int k, int c) { const int kk = (k & ~0xC) | ((k & 4) << 1) | ((k & 8) >> 1); return ((kk >> 3) * 2 + (c >> 5)) * 512 + ((kk & 7) * 32 + (c & 31)) * 2; }
__device__ __forceinline__ int v_rd_base(int lane) { return ((lane & 3) << 3) | (((lane >> 2) & 3) << 6) | (((lane >> 4) & 1) << 5) | (((lane >> 5) & 1) << 8); }
constexpr int v_rd_off(int d0, int ks, int half) { return d0 * 512 + ks * 2048 + half * 1024; }
template <int OFF> __device__ __forceinline__ s16x4 tr_read(int vb) {
    s16x4 r; asm volatile("ds_read_b64_tr_b16 %0, %1 offset:%2" : "=&v"(r) : "v"(vb), "i"(OFF) : "memory"); return r;
}
template <int D0> __device__ __forceinline__ void pv_one(f32x16& od, int vb, bf16x8 pa0, bf16x8 pa1, bf16x8 pa2, bf16x8 pa3) {
    const s16x4 l0 = tr_read<v_rd_off(D0, 0, 0)>(vb), h0 = tr_read<v_rd_off(D0, 0, 1)>(vb), l1 = tr_read<v_rd_off(D0, 1, 0)>(vb), h1 = tr_read<v_rd_off(D0, 1, 1)>(vb);
    const s16x4 l2 = tr_read<v_rd_off(D0, 2, 0)>(vb), h2 = tr_read<v_rd_off(D0, 2, 1)>(vb), l3 = tr_read<v_rd_off(D0, 3, 0)>(vb), h3 = tr_read<v_rd_off(D0, 3, 1)>(vb);
    asm volatile("s_waitcnt lgkmcnt(0)" ::: "memory"); SBAR();
#define PKV(L, H) (bf16x8){L[0], L[1], L[2], L[3], H[0], H[1], H[2], H[3]}
    od = __builtin_amdgcn_mfma_f32_32x32x16_bf16(pa0, PKV(l0, h0), od, 0, 0, 0);
    od = __builtin_amdgcn_mfma_f32_32x32x16_bf16(pa1, PKV(l1, h1), od, 0, 0, 0);
    od = __builtin_amdgcn_mfma_f32_32x32x16_bf16(pa2, PKV(l2, h2), od, 0, 0, 0);
    od = __builtin_amdgcn_mfma_f32_32x32x16_bf16(pa3, PKV(l3, h3), od, 0, 0, 0);
#undef PKV
}

template <int DQK, bool FOX>
__device__ __forceinline__ void attn_unit(bf16_t* Qh, int ldq, const bf16_t* Kh, int ldk, const bf16_t* Vh, int ldv, const float* cum, int q0, char* lds, bool dry, float sbound, int T0) {
    constexpr int ND = DQK / 16, KCH = DQK / 8;
    int tid = threadIdx.x; asm volatile("" : "+v"(tid));
    const int wid = __builtin_amdgcn_readfirstlane(tid >> 6), lane = tid & 63, r32 = lane & 31, hi = lane >> 5;
    char* V_lds = lds + LDS_V; char* K_lds = lds + LDS_K; float* CK_lds = (float*)(lds + LDS_CK);
    float* ws = (float*)(lds + LDS_WS) + wid * 64; float* li_l = ws; float* al_l = ws + 32;
    float m_reg = 0.f, l_reg = 0; f32x16 o[2]; o[0] = f32x16{}; o[1] = f32x16{}; bf16x8 qr[ND];
    const int qrow = q0 + wid * QBLK + r32;
    { const bf16_t* Qw = Qh + (size_t)qrow * ldq + hi * 8;
#pragma unroll
      for (int d0 = 0; d0 < ND; ++d0) qr[d0] = *reinterpret_cast<const bf16x8*>(Qw + d0 * 16); }
    float cq = 0.f; if (FOX) cq = cum[qrow];
    const int kr0 = tid / KCH, kc0 = tid % KCH;
    const int kr1 = (tid + 512) / KCH, kc1 = (tid + 512) % KCH;
    const bool k2 = (KCH * 64 > 512) && (tid + 512 < KCH * 64);
    const int vr = tid >> 3, vc = (tid & 7) * 8, vst = v_st(vr, vc);
    const int vb0 = (int)(uintptr_t)V_lds + v_rd_base(lane);
    struct Stg { bf16x8 k0, k1, v; f32x4 ck; } st[2];
    const int kr1c = (kr1 < 64) ? kr1 : 63;
    const int ckc = (tid & 15) * 4;
#define SLOAD(i, k0_) do { st[i].k0 = *reinterpret_cast<const bf16x8*>(Kh + (size_t)((k0_) + kr0) * ldk + kc0 * 8); \
      if (KCH * 64 > 512) st[i].k1 = *reinterpret_cast<const bf16x8*>(Kh + (size_t)((k0_) + kr1c) * ldk + kc1 * 8); \
      st[i].v = *reinterpret_cast<const bf16x8*>(Vh + (size_t)((k0_) + vr) * ldv + vc); \
      if (FOX) st[i].ck = *reinterpret_cast<const f32x4*>(cum + (k0_) + ckc); } while (0)
#define SWRITE(b, i) do { *(bf16x8*)(K_lds + (b) * SHM_K + KSWZ(kr0, kc0 * 16)) = st[i].k0; \
      if (k2) *(bf16x8*)(K_lds + (b) * SHM_K + KSWZ(kr1, kc1 * 16)) = st[i].k1; \
      *(bf16x8*)(V_lds + (b) * SHM_V + vst) = st[i].v; \
      if (FOX && tid < 16) *(f32x4*)(CK_lds + (b) * 64 + tid * 4) = st[i].ck; } while (0)
#define RESC(a) do { if (__any((a) < 1.f)) { if (hi == 0) al_l[r32] = (a); asm volatile("s_waitcnt lgkmcnt(0)" ::: "memory"); \
      _Pragma("unroll") for (int d = 0; d < 2; ++d) _Pragma("unroll") for (int r = 0; r < 16; ++r) o[d][r] *= al_l[crow(r, hi)]; } } while (0)
    const int NT = (q0 + 256) / KVBLK;
    const int tlast = __builtin_amdgcn_readfirstlane((q0 + wid * QBLK + (FOX ? 31 : 0)) >> 6);
    int tfirst = 0;
    if (FOX) { const float c0w = cum[q0 + wid * QBLK]; bool need = false; const int nbw = (q0 + wid * QBLK) >> 6;
        if (lane < nbw) need = (sbound + c0w - cum[64 * lane + 63] >= -40.f);
        const unsigned long long bal = __ballot(need);
        tfirst = __builtin_amdgcn_readfirstlane(bal ? (__ffsll((long long)bal) - 1) : nbw); }
    auto qkt = [&](f32x16& p0, f32x16& p1, int b, int t) {
        if (t > tlast || t < tfirst) return;
        const char* Ks = K_lds + b * SHM_K;
        if (FOX) { const float* ck = CK_lds + b * 64; const float cqm = cq - m_reg;
#pragma unroll
            for (int g = 0; g < 4; ++g) { const f32x4 c0 = *(const f32x4*)(ck + 8 * g + 4 * hi), c1 = *(const f32x4*)(ck + 32 + 8 * g + 4 * hi);
#pragma unroll
                for (int i = 0; i < 4; ++i) { p0[4 * g + i] = cqm - c0[i]; p1[4 * g + i] = cqm - c1[i]; } }
        } else { const float nm = -m_reg;
#pragma unroll
            for (int r = 0; r < 16; ++r) { p0[r] = nm; p1[r] = nm; } }
#pragma unroll
        for (int d0 = 0; d0 < ND; ++d0) { const int cb = (d0 * 16 + hi * 8) * 2;
            const bf16x8 b0 = *reinterpret_cast<const bf16x8*>(Ks + KSWZ(r32, cb));
            const bf16x8 b1 = *reinterpret_cast<const bf16x8*>(Ks + KSWZ(32 + r32, cb));
            p0 = __builtin_amdgcn_mfma_f32_32x32x16_bf16(b0, qr[d0], p0, 0, 0, 0);
            p1 = __builtin_amdgcn_mfma_f32_32x32x16_bf16(b1, qr[d0], p1, 0, 0, 0); }
        if (FOX && t >= NT - 4) {
            asm volatile("" ::: "memory");
            const int kb = t * KVBLK + 4 * hi;
#pragma unroll
            for (int r = 0; r < 16; ++r) { const int kv = kb + (r & 3) + 8 * (r >> 2);
                if (kv > qrow) p0[r] = -INFINITY; if (kv + 32 > qrow) p1[r] = -INFINITY; }
        }
    };
#define PSM(P0, P1, AL, t) do { if ((t) <= tlast && (t) >= tfirst) partialSM(P0, P1, m_reg, AL); else AL = 1.f; } while (0)
#define FSM(P0, P1, AL, t) do { if ((t) <= tlast && (t) >= tfirst) finishSM(P0, P1, AL, l_reg, pa0, pa1, pa2, pa3); } while (0)
#define PV(vb, t) do { if ((t) <= tlast && (t) >= tfirst) { pv_one<0>(o[0], vb, pa0, pa1, pa2, pa3); pv_one<1>(o[1], vb, pa0, pa1, pa2, pa3); } } while (0)
    f32x16 pA0, pA1, pB0, pB1; float alA, alB; bf16x8 pa0, pa1, pa2, pa3;
    SLOAD(0, T0 * KVBLK); SWRITE(0, 0); __syncthreads();
    qkt(pA0, pA1, 0, T0); PSM(pA0, pA1, alA, T0);
    SLOAD(1, (T0 + 1) * KVBLK); SLOAD(0, (T0 + 2) * KVBLK);
    SWRITE(1, 1); __syncthreads();
    int bp = 0, bc = 1, bn = 2;
    for (int j = T0 + 1; j + 1 < NT; j += 2) {
        SBAR(); qkt(pB0, pB1, bc, j);
        FSM(pA0, pA1, alA, j - 1); SBAR();
        SLOAD(1, (j + 2) * KVBLK); SBAR();
        PV(vb0 + bp * SHM_V, j - 1); PSM(pB0, pB1, alB, j);
        SWRITE(bn, 0);
        RESC(alB); __syncthreads();
        { const int t_ = bp; bp = bc; bc = bn; bn = t_; }
        SBAR(); qkt(pA0, pA1, bc, j + 1);
        FSM(pB0, pB1, alB, j); SBAR();
        if (j + 3 < NT) SLOAD(0, (j + 3) * KVBLK); SBAR();
        PV(vb0 + bp * SHM_V, j); PSM(pA0, pA1, alA, j + 1);
        SWRITE(bn, 1);
        RESC(alA); __syncthreads();
        { const int t_ = bp; bp = bc; bc = bn; bn = t_; }
    }
    SBAR(); qkt(pB0, pB1, bc, NT - 1);
    FSM(pA0, pA1, alA, NT - 2); SBAR();
    PV(vb0 + bp * SHM_V, NT - 2); PSM(pB0, pB1, alB, NT - 1);
    RESC(alB);
    FSM(pB0, pB1, alB, NT - 1); SBAR();
    PV(vb0 + bc * SHM_V, NT - 1);
#undef PSM
#undef FSM
#undef PV
    if (hi == 0) li_l[r32] = l_reg; asm volatile("s_waitcnt lgkmcnt(0)" ::: "memory");
    float rli[16];
#pragma unroll
    for (int r = 0; r < 16; ++r) rli[r] = __builtin_amdgcn_rcpf(li_l[crow(r, hi)]);
    { bf16_t* stg = (bf16_t*)(lds + LDS_OST) + wid * 2048;
#pragma unroll
      for (int r = 0; r < 16; ++r) { const int orow = crow(r, hi);
#pragma unroll
          for (int d0 = 0; d0 < 2; ++d0) stg[orow * 64 + d0 * 32 + r32] = f2bf(o[d0][r] * rli[r]); }
      asm volatile("s_waitcnt lgkmcnt(0)" ::: "memory");
      bf16_t* Ow = Qh + (size_t)(q0 + wid * QBLK) * ldq;
#pragma unroll
      for (int i = 0; i < 4; ++i) { const int row = i * 8 + (lane >> 3), ch = lane & 7; const u32x4 v = *(const u32x4*)(stg + row * 64 + ch * 8); if (!dry) *(u32x4*)(Ow + (size_t)row * ldq + ch * 8) = v; } }
    __syncthreads();
#undef SLOAD
#undef SWRITE
#undef RESC
}
}

__device__ __forceinline__ int map_in(int n) {
    if (n < 416) return n;
    if (n < 424) return 1952 + (n - 416);
    if (n < 512) return -1;
    if (n < 2048) return n - 512 + 416;
    if (n < 2560) return n - 2048 + 1960;
    if (n < 4096) return n - 2560 + 2472;
    return n - 4096 + 4008;
}
struct ConvD { const float* src; const float* kscale; bf16_t* dst; int ldsrc, K, N, dld, item; bool split512, mapped; };
__device__ __forceinline__ void conv_load(const ConvD& d, int lane, float (&x)[32]) {
    const int nblk = d.N / 32, kb = d.item / nblk, nb = d.item % nblk, k0 = 64 * kb, n0 = 32 * nb;
    const int sn = d.mapped ? map_in(n0 + (lane & 31)) : n0 + (lane & 31);
#pragma unroll
    for (int i = 0; i < 32; ++i) { const int kk = 2 * i + (lane >> 5); float v = 0.f; if (sn >= 0) v = d.src[(size_t)(k0 + kk) * d.ldsrc + sn]; if (d.kscale) v *= d.kscale[k0 + kk]; x[i] = v; }
}
__device__ __forceinline__ void conv_finish(const ConvD& d, LAS float* scr, int lane, const float (&x)[32]) {
    const int nblk = d.N / 32, kb = d.item / nblk, nb = d.item % nblk, k0 = 64 * kb, n0 = 32 * nb;
#pragma unroll
    for (int i = 0; i < 32; ++i) scr[(2 * i + (lane >> 5)) * 33 + (lane & 31)] = x[i];
    asm volatile("s_waitcnt lgkmcnt(0)" ::: "memory");
    const int cch = lane & 7;
#pragma unroll
    for (int j = 0; j < 4; ++j) { const int n = (lane >> 3) + 8 * j; const LAS float* sp = scr + (8 * cch) * 33 + n;
        u32x4 o; o.x = pk_bf16(sp[0 * 33], sp[1 * 33]); o.y = pk_bf16(sp[2 * 33], sp[3 * 33]); o.z = pk_bf16(sp[4 * 33], sp[5 * 33]); o.w = pk_bf16(sp[6 * 33], sp[7 * 33]);
        bf16_t* dp = d.split512 ? (d.dst + ((size_t)(k0 >> 9) * d.N + n0 + n) * 512 + (k0 & 511) + 8 * cch) : (d.dst + (size_t)(n0 + n) * d.dld + k0 + 8 * cch);
        *(u32x4*)dp = o; }
    asm volatile("s_waitcnt lgkmcnt(0)" ::: "memory");
}
__device__ __forceinline__ void phase0(const Ctx& c, const int part) {
    PHASE_IDS(); ArgsP ap = get_args(); unsigned char* ws = ap->ws;
    const long gtid = (long)c.bid * 512 + tid, gthreads = (long)grid_g() * 512;
    const int gw = c.bid * 8 + wave, ngw = grid_g() * 8;
    LAS float* scr = (LAS float*)(c.lds + wave * 8448);
    constexpr int I_IN_ = 16 * 224, I_Q_ = 4 * 24, I_KV_ = 2 * 32, I_GLU_ = 8 * 16, I_BO_ = 8 * 32, I_OUT_ = 16 * 32, I_L = I_IN_ + I_Q_ + I_KV_ + I_GLU_ + 3 * I_BO_ + I_OUT_;
    auto conv_desc = [&](int it) -> ConvD { ConvD d; const int l = it / I_L; int r = it % I_L; d.kscale = nullptr; d.split512 = false; d.mapped = false;
        if (r < I_IN_) { d.src = ap->in[I_WIN] + (size_t)l * DM * IN_SRC; d.ldsrc = IN_SRC; d.K = DM; d.N = NIN; d.dst = (bf16_t*)(ws + WS_WIN) + (size_t)l * 2 * NIN * 512; d.dld = 512; d.split512 = true; d.mapped = true; d.kscale = ap->in[I_NORMG] + l * DM; d.item = r; return d; } r -= I_IN_;
        if (r < I_Q_) { d.src = ap->in[I_WQUP] + (size_t)l * 256 * 768; d.ldsrc = 768; d.K = 256; d.N = 768; d.dst = (bf16_t*)(ws + WS_WQ) + (size_t)l * 768 * 256; d.dld = 256; d.kscale = ap->in[I_QAN] + l * 256; d.item = r; return d; } r -= I_Q_;
        if (r < I_KV_) { d.src = ap->in[I_WKVUP] + (size_t)l * 128 * 1024; d.ldsrc = 1024; d.K = 128; d.N = 1024; d.dst = (bf16_t*)(ws + WS_WKV) + (size_t)l * 1024 * 256; d.dld = 256; d.kscale = ap->in[I_KVAN] + l * 128; d.item = r; return d; } r -= I_KV_;
        if (r < I_GLU_) { d.src = ap->in[I_WGLU] + (size_t)l * 512 * 512; d.ldsrc = 512; d.K = 512; d.N = 512; d.dst = (bf16_t*)(ws + WS_WGLU) + (size_t)l * 512 * 512; d.dld = 512; d.item = r; return d; } r -= I_GLU_;
        if (r < 3 * I_BO_) { const int br = r / I_BO_; d.src = ap->in[I_WBO] + ((size_t)l * 1536 + br * 512) * 1024; d.ldsrc = 1024; d.K = 512; d.N = 1024; d.dst = (bf16_t*)(ws + WS_WBO) + ((size_t)l * 3 + br) * 1024 * 512; d.dld = 512; d.item = r % I_BO_; return d; } r -= 3 * I_BO_;
        d.src = ap->in[I_WOUT] + (size_t)l * DM * DM; d.ldsrc = DM; d.K = DM; d.N = DM; d.dst = (bf16_t*)(ws + WS_WOUT) + (size_t)l * DM * DM; d.dld = DM; d.item = r; return d; };
    constexpr int N_A = 16 * 80, N_B = NL * I_L - N_A;
    auto item_of = [&](int idx) -> int { if (part == 0) return (idx / 80) * 224 + (idx % 80);
        return idx < 16 * 144 ? (idx / 144) * 224 + 80 + (idx % 144) : I_IN_ + (idx - 16 * 144); };
    const int n_items = part == 0 ? N_A : N_B;
    if (gw < n_items) {
        ConvD dc = conv_desc(item_of(gw)); float xc[32]; conv_load(dc, lane, xc);
        for (int it = gw; it < n_items; it += ngw) {
            const int nit = it + ngw; const bool hn = nit < n_items;
            ConvD dn = dc; float xn[32];
#pragma unroll
            for (int i = 0; i < 32; ++i) xn[i] = 0.f;
            if (hn) { dn = conv_desc(item_of(nit)); conv_load(dn, lane, xn); }
            SBAR();
            conv_finish(dc, scr, lane, xc);
            dc = dn;
#pragma unroll
            for (int i = 0; i < 32; ++i) xc[i] = xn[i];
        }
    }
    if (part == 1) {
    for (long it = (wave == 1 ? (long)c.bid * 64 + lane : (long)NL * 32 * 64); it < NL * 32 * 64; it += (long)grid_g() * 64) {
        const int n = (int)(it & 63), g = (int)((it >> 6) & 31), l = (int)(it >> 11);
        const float dt = expf(ap->in[I_LDT][l * 32 + g]);
        const float lr = ap->in[I_LRE][(l * 32 + g) * 64 + n], li = ap->in[I_LIM][(l * 32 + g) * 64 + n];
        const float mag = expf(lr * dt), ang = li * dt;
        float rev = ang * 0.15915494309189535f; rev -= floorf(rev);
        const float are = mag * __builtin_amdgcn_cosf(rev), aim = mag * __builtin_amdgcn_sinf(rev);
        float pr = are, pi = aim;
#pragma unroll
        for (int s = 0; s < 6; ++s) { const float nr = pr * pr - pi * pi, ni = 2.f * pr * pi; pr = nr; pi = ni; }
        ((f32x4*)(ws + WS_TA))[it] = (f32x4){are, aim, pr, pi};
        const float den = lr * lr + li * li;
        const float fre = ((are - 1.f) * lr + aim * li) / den, fim = (aim * lr - (are - 1.f) * li) / den;
        const float* bre = ap->in[I_BRE] + it * 16; const float* bim = ap->in[I_BIM] + it * 16;
        float bbr[16], bbi[16];
#pragma unroll
        for (int cc = 0; cc < 16; ++cc) { const float br = bre[cc], bi = bim[cc]; bbr[cc] = fre * br - fim * bi; bbi[cc] = fre * bi + fim * br; }
        { const int nre = (n < 32) ? n : 64 + (n - 32), nim = nre + 32; bf16_t* tb = (bf16_t*)(ws + WS_TBB) + (size_t)(l * 32 + g) * 128 * 16;
          u32x4 w0, w1;
          w0.x = pk_bf16(bbr[0], bbr[1]); w0.y = pk_bf16(bbr[2], bbr[3]); w0.z = pk_bf16(bbr[4], bbr[5]); w0.w = pk_bf16(bbr[6], bbr[7]);
          w1.x = pk_bf16(bbr[8], bbr[9]); w1.y = pk_bf16(bbr[10], bbr[11]); w1.z = pk_bf16(bbr[12], bbr[13]); w1.w = pk_bf16(bbr[14], bbr[15]);
          *(u32x4*)(tb + nre * 16) = w0; *(u32x4*)(tb + nre * 16 + 8) = w1;
          w0.x = pk_bf16(bbi[0], bbi[1]); w0.y = pk_bf16(bbi[2], bbi[3]); w0.z = pk_bf16(bbi[4], bbi[5]); w0.w = pk_bf16(bbi[6], bbi[7]);
          w1.x = pk_bf16(bbi[8], bbi[9]); w1.y = pk_bf16(bbi[10], bbi[11]); w1.z = pk_bf16(bbi[12], bbi[13]); w1.w = pk_bf16(bbi[14], bbi[15]);
          *(u32x4*)(tb + nim * 16) = w0; *(u32x4*)(tb + nim * 16 + 8) = w1; }
        { bf16_t* tc = (bf16_t*)(ws + WS_TC) + (size_t)(l * 32 + g) * 16 * 128;
#pragma unroll
          for (int cc = 0; cc < 16; ++cc) { const float cr = ap->in[I_CRE][((size_t)(l * 32 + g) * 16 + cc) * 64 + n], ci = ap->in[I_CIM][((size_t)(l * 32 + g) * 16 + cc) * 64 + n];
              *(unsigned*)(tc + cc * 128 + 2 * n) = pk_bf16(cr, -ci); } }
    }
    }
    if (part == 0) { const float* x = ap->in[I_X]; bf16_t* XG = (bf16_t*)(ws + WS_XG); float* ss = (float*)(ws + WS_SS);
      f32x4 nxv[4];
      const int gwv = c.vb * 8 + wave; const bool g256 = grid_g() == 256; const int row_b = g256 ? gwv * 8 : gw, row_s = g256 ? 1 : ngw, row_e = g256 ? gwv * 8 + 8 : T_;
#pragma unroll
      for (int j = 0; j < 4; ++j) nxv[j] = *(const f32x4*)(x + (size_t)(row_b < T_ ? row_b : 0) * DM + j * 256 + lane * 4);
      for (int row = row_b; row < row_e; row += row_s) { float s = 0.f; f32x4 v[4];
#pragma unroll
          for (int j = 0; j < 4; ++j) v[j] = nxv[j];
          { const int nrow = (row + row_s < row_e) ? row + row_s : row;
#pragma unroll
            for (int j = 0; j < 4; ++j) nxv[j] = *(const f32x4*)(x + (size_t)nrow * DM + j * 256 + lane * 4); }
          SBAR();
#pragma unroll
          for (int j = 0; j < 4; ++j) { const int col = j * 256 + lane * 4;
              s += (v[j][0] * v[j][0] + v[j][1] * v[j][1]) + (v[j][2] * v[j][2] + v[j][3] * v[j][3]);
              u32x2 w; w.x = pk_bf16(v[j][0], v[j][1]); w.y = pk_bf16(v[j][2], v[j][3]);
              *(u32x2*)(XG + ((size_t)(col >> 9) * T_ + row) * 512 + (col & 511)) = w; }
          s = wave_sum(s); if (lane == 0) ss[row] = s; }
      for (long i = gtid; i < T_; i += gthreads) ss[T_ + i] = 0.f;
      for (long i = gtid; i < 2 * NL * T_; i += gthreads) ((float*)(ws + WS_SSQ))[i] = 0.f;
      for (long i = gtid; i < 8 * 3456; i += gthreads) ((unsigned*)(ws + WS_PBAR))[i] = 0u;
      for (long i = gtid; i < (long)NL * 1024 * 16; i += gthreads) *(u32x4*)((bf16_t*)(ws + WS_WKV) + (i >> 4) * 256 + 128 + (i & 15) * 8) = (u32x4){0u, 0u, 0u, 0u}; }
}

struct S5Coef { float a1r, a1i, a2r, a2i, a3r, a3i, a4r, a4i; };
__device__ __forceinline__ S5Coef s5_coef(float ar, float ai) { S5Coef q; q.a1r = ar; q.a1i = ai; q.a2r = ar * ar - ai * ai; q.a2i = 2.f * ar * ai; q.a3r = q.a2r * ar - q.a2i * ai; q.a3i = q.a2r * ai + q.a2i * ar; q.a4r = q.a2r * q.a2r - q.a2i * q.a2i; q.a4i = 2.f * q.a2r * q.a2i; return q; }
__device__ __forceinline__ float other_half(float v, int hi) { auto rr = __builtin_amdgcn_permlane32_swap(__float_as_uint(v), __float_as_uint(v), false, false); return __uint_as_float(hi ? rr[0] : rr[1]); }
template <bool NEEDX>
__device__ __forceinline__ void s5_scan32(f32x16& xr, f32x16& xi, const S5Coef& q, float& sr, float& si, int hi) {
    float er[4], ei[4];
#pragma unroll
    for (int k = 0; k < 4; ++k) {
        const float r0 = xr[4 * k], i0 = xi[4 * k];
        const float r1 = q.a1r * r0 - q.a1i * i0 + xr[4 * k + 1], i1 = q.a1r * i0 + q.a1i * r0 + xi[4 * k + 1];
        const float r2 = q.a1r * r1 - q.a1i * i1 + xr[4 * k + 2], i2 = q.a1r * i1 + q.a1i * r1 + xi[4 * k + 2];
        const float r3 = q.a1r * r2 - q.a1i * i2 + xr[4 * k + 3], i3 = q.a1r * i2 + q.a1i * r2 + xi[4 * k + 3];
        if (NEEDX) { xr[4 * k + 1] = r1; xi[4 * k + 1] = i1; xr[4 * k + 2] = r2; xi[4 * k + 2] = i2; xr[4 * k + 3] = r3; xi[4 * k + 3] = i3; }
        er[k] = r3; ei[k] = i3;
    }
    float pr[4], pi[4];
#pragma unroll
    for (int k = 0; k < 4; ++k) {
        const float orr = other_half(er[k], hi), oii = other_half(ei[k], hi);
        const float e0r = hi ? orr : er[k], e0i = hi ? oii : ei[k], e1r = hi ? er[k] : orr, e1i = hi ? ei[k] : oii;
        const float p0r = sr, p0i = si;
        float nr = q.a4r * sr - q.a4i * si + e0r, ni = q.a4r * si + q.a4i * sr + e0i; sr = nr; si = ni;
        const float p1r = sr, p1i = si;
        nr = q.a4r * sr - q.a4i * si + e1r; ni = q.a4r * si + q.a4i * sr + e1i; sr = nr; si = ni;
        pr[k] = hi ? p1r : p0r; pi[k] = hi ? p1i : p0i;
    }
    if (NEEDX) {
#pragma unroll
        for (int k = 0; k < 4; ++k) {
            xr[4 * k + 0] += q.a1r * pr[k] - q.a1i * pi[k]; xi[4 * k + 0] += q.a1r * pi[k] + q.a1i * pr[k];
            xr[4 * k + 1] += q.a2r * pr[k] - q.a2i * pi[k]; xi[4 * k + 1] += q.a2r * pi[k] + q.a2i * pr[k];
            xr[4 * k + 2] += q.a3r * pr[k] - q.a3i * pi[k]; xi[4 * k + 2] += q.a3r * pi[k] + q.a3i * pr[k];
            xr[4 * k + 3] += q.a4r * pr[k] - q.a4i * pi[k]; xi[4 * k + 3] += q.a4r * pi[k] + q.a4i * pr[k];
        }
    }
}
constexpr int S5_XPITCH = 272, S5_XWAVE = 32 * S5_XPITCH;
template <bool FULL>
__device__ __forceinline__ void s5_pass(const Ctx& c, int l, bool dry) {
    PHASE_IDS(); ArgsP ap = get_args(); unsigned char* ws = ap->ws; bf16_t* P = (bf16_t*)(ws + WS_PROJ); const float* dsk = ap->in[I_S5D] + l * 512;
    const int cl = lane & 31, hi = lane >> 5;
    char* Xl = c.ldsg + wave * S5_XWAVE;
    const int gw = c.vb * 8 + wave, ngw = grid_g() * 8;
    for (int task = gw; task < NB_ * 32 * 8; task += ngw) {
        const int g = task & 31, q8 = (task >> 5) & 7, b = task >> 8;
        const int tb0 = (l * 32 + g) * 64;
        const f32x4 taA = ((const f32x4*)(ws + WS_TA))[tb0 + cl], taB = ((const f32x4*)(ws + WS_TA))[tb0 + 32 + cl];
        const S5Coef qA = s5_coef(taA[0], taA[1]), qB = s5_coef(taB[0], taB[1]);
        bf16x8 bbf[4];
        { const bf16_t* tbb = (const bf16_t*)(ws + WS_TBB) + (size_t)(l * 32 + g) * 128 * 16;
#pragma unroll
          for (int blk = 0; blk < 4; ++blk) bbf[blk] = *(const bf16x8*)(tbb + (blk * 32 + cl) * 16 + 8 * hi); }
        float sAr = 0.f, sAi = 0.f, sBr = 0.f, sBi = 0.f;
        bf16x8 cm[4];
        if (FULL) {
            const bf16_t* tcm = (const bf16_t*)(ws + WS_TC) + (size_t)(l * 32 + g) * 16 * 128;
#pragma unroll
            for (int ks = 0; ks < 4; ++ks) cm[ks] = *(const bf16x8*)(tcm + (lane & 15) * 128 + ks * 32 + 8 * (lane >> 4));
            const f32x2* Ep = (const f32x2*)(ws + WS_E) + ((size_t)(b * 32) * 32 + g) * 64;
            const int nprev = 4 * q8;
            for (int j0 = 0; j0 < nprev; j0 += 8) {
                f32x2 eA[8], eB[8];
#pragma unroll
                for (int i = 0; i < 8; ++i) { const int cp = (j0 + i < nprev) ? j0 + i : 0; eA[i] = Ep[(size_t)cp * 2048 + cl]; eB[i] = Ep[(size_t)cp * 2048 + 32 + cl]; }
#pragma unroll
                for (int i = 0; i < 8; ++i) if (j0 + i < nprev) {
                    float nr = taA[2] * sAr - taA[3] * sAi + eA[i][0], ni = taA[2] * sAi + taA[3] * sAr + eA[i][1]; sAr = nr; sAi = ni;
                    nr = taB[2] * sBr - taB[3] * sBi + eB[i][0]; ni = taB[2] * sBi + taB[3] * sBr + eB[i][1]; sBr = nr; sBi = ni; }
            }
        }
        const f32x4 dv = *(const f32x4*)(dsk + 16 * g + 4 * (lane >> 4));
        const size_t ubase = (size_t)(b * S_ + 4 * q8 * 64 + cl) * NPROJ + 2048 + 16 * g + 8 * hi;
        bf16x8 ua_n = *(const bf16x8*)(P + ubase);
        const size_t uebase = (size_t)(b * S_ + 4 * q8 * 64 + (lane & 15)) * NPROJ + 2048 + 16 * g + 4 * (lane >> 4);
        for (int i8 = 0; i8 < 8; ++i8) {
            const bf16x8 ua = ua_n;
            if (i8 < 7) ua_n = *(const bf16x8*)(P + ubase + (size_t)(i8 + 1) * 32 * NPROJ);
            u32x2 ue0 = (u32x2){0u, 0u}, ue1 = (u32x2){0u, 0u};
            if (FULL) { ue0 = *(const u32x2*)(P + uebase + (size_t)i8 * 32 * NPROJ); ue1 = *(const u32x2*)(P + uebase + (size_t)(i8 * 32 + 16) * NPROJ); }
            const int ch = 4 * q8 + (i8 >> 1), rb = i8 & 1, tok0 = b * S_ + ch * 64;
            if (!FULL && rb == 0) { sAr = 0.f; sAi = 0.f; sBr = 0.f; sBi = 0.f; }
            f32x16 bu0 = __builtin_amdgcn_mfma_f32_32x32x16_bf16(ua, bbf[0], f32x16{}, 0, 0, 0);
            f32x16 bu1 = __builtin_amdgcn_mfma_f32_32x32x16_bf16(ua, bbf[1], f32x16{}, 0, 0, 0);
            f32x16 bu2 = __builtin_amdgcn_mfma_f32_32x32x16_bf16(ua, bbf[2], f32x16{}, 0, 0, 0);
            f32x16 bu3 = __builtin_amdgcn_mfma_f32_32x32x16_bf16(ua, bbf[3], f32x16{}, 0, 0, 0);
            s5_scan32<FULL>(bu0, bu1, qA, sAr, sAi, hi);
            s5_scan32<FULL>(bu2, bu3, qB, sBr, sBi, hi);
            if (FULL) {
#pragma unroll
                for (int r = 0; r < 16; ++r) { const int t = (r & 3) + 8 * (r >> 2) + 4 * hi;
                    *(unsigned*)(Xl + t * S5_XPITCH + 4 * cl) = pk_bf16(bu0[r], bu1[r]);
                    *(unsigned*)(Xl + t * S5_XPITCH + 128 + 4 * cl) = pk_bf16(bu2[r], bu3[r]); }
                asm volatile("s_waitcnt lgkmcnt(0)" ::: "memory");
#pragma unroll
                for (int tb = 0; tb < 2; ++tb) {
                    f32x4 y = (f32x4){0.f, 0.f, 0.f, 0.f};
#pragma unroll
                    for (int ks = 0; ks < 4; ++ks) { const bf16x8 xb = *(const bf16x8*)(Xl + (16 * tb + (lane & 15)) * S5_XPITCH + (ks * 32 + 8 * (lane >> 4)) * 2);
                        y = __builtin_amdgcn_mfma_f32_16x16x32_bf16(cm[ks], xb, y, 0, 0, 0); }
                    const int q4 = lane >> 4;
                    const size_t tokz = (size_t)(tok0 + rb * 32 + tb * 16 + (lane & 15));
                    bf16_t* zp = (bf16_t*)(ws + WS_Z) + tokz * 512 + 16 * g + 4 * q4;
                    const u32x2 uu = tb ? ue1 : ue0;
                    const float y0 = y[0] + dv[0] * bf_lo(uu.x), y1 = y[1] + dv[1] * bf_hi(uu.x), y2 = y[2] + dv[2] * bf_lo(uu.y), y3 = y[3] + dv[3] * bf_hi(uu.y);
                    u32x2 w; w.x = pk_bf16(gelu_tanh(y0), gelu_tanh(y1)); w.y = pk_bf16(gelu_tanh(y2), gelu_tanh(y3));
                    if (!dry) *(u32x2*)zp = w;
                }
                asm volatile("s_waitcnt lgkmcnt(0)" ::: "memory");
            }
            if (!FULL && rb == 1) { if (hi == 0) { f32x2* Eo = (f32x2*)(ws + WS_E) + (size_t)((b * 32 + ch) * 32 + g) * 64; Eo[cl] = (f32x2){sAr, sAi}; Eo[32 + cl] = (f32x2){sBr, sBi}; } }
        }
    }
}

__device__ __forceinline__ void unpack8(const u32x4 w, float (&v)[8]) { v[0] = bf_lo(w.x); v[1] = bf_hi(w.x); v[2] = bf_lo(w.y); v[3] = bf_hi(w.y); v[4] = bf_lo(w.z); v[5] = bf_hi(w.z); v[6] = bf_lo(w.w); v[7] = bf_hi(w.w); }
__device__ __forceinline__ u32x4 pack8(const float (&v)[8]) { u32x4 w; w.x = pk_bf16(v[0], v[1]); w.y = pk_bf16(v[2], v[3]); w.z = pk_bf16(v[4], v[5]); w.w = pk_bf16(v[6], v[7]); return w; }
__device__ __forceinline__ void prep_phase(const Ctx& c, int l, bool dry) {
    PHASE_IDS(); ArgsP ap = get_args(); unsigned char* ws = ap->ws;

    bf16_t* P = (bf16_t*)(ws + WS_PROJ); bf16_t* QUP = (bf16_t*)(ws + WS_QUP); bf16_t* KVUP = (bf16_t*)(ws + WS_KVUP); bf16_t* KM = (bf16_t*)(ws + WS_KM);
    if (wave == 0) for (int bq = (grid_g() == 256) ? ((c.bid >> 3) < 8 ? (c.bid & 7) * 8 + (c.bid >> 3) : 64) : c.bid; bq < 64; bq += grid_g()) {
        const int bh = bq, b = bh >> 3, h = bh & 7; const float bf = ap->in[I_FBF][l * 8 + h];
        const float* ff = (const float*)(ws + WS_FF32) + (size_t)(b * S_) * 8 + h; float* cum = (float*)(ws + WS_CUM) + (size_t)bh * S_;
        float xv[32];
#pragma unroll
        for (int it = 0; it < 32; ++it) xv[it] = ff[(size_t)(it * 64 + lane) * 8];
        float carry = 0.f;
#pragma unroll
        for (int it = 0; it < 32; ++it) { const float xx = xv[it] + bf;
            float v = fminf(xx, 0.f) - log1pf(__expf(-fabsf(xx)));
            v += __builtin_bit_cast(float, __builtin_amdgcn_update_dpp(0, __builtin_bit_cast(int, v), 0x111, 0xF, 0xF, false));
            v += __builtin_bit_cast(float, __builtin_amdgcn_update_dpp(0, __builtin_bit_cast(int, v), 0x112, 0xF, 0xF, false));
            v += __builtin_bit_cast(float, __builtin_amdgcn_update_dpp(0, __builtin_bit_cast(int, v), 0x114, 0xF, 0xF, false));
            v += __builtin_bit_cast(float, __builtin_amdgcn_update_dpp(0, __builtin_bit_cast(int, v), 0x118, 0xF, 0xF, false));
            const int iv = __builtin_bit_cast(int, v);
            const float t0 = __builtin_bit_cast(float, __builtin_amdgcn_readlane(iv, 15)), t1 = __builtin_bit_cast(float, __builtin_amdgcn_readlane(iv, 31));
            const float t2 = __builtin_bit_cast(float, __builtin_amdgcn_readlane(iv, 47)), t3 = __builtin_bit_cast(float, __builtin_amdgcn_readlane(iv, 63));
            const int rw = lane >> 4;
            v += carry + (rw == 1 ? t0 : rw == 2 ? t0 + t1 : rw == 3 ? (t0 + t1) + t2 : 0.f);
            if (!dry) cum[it * 64 + lane] = v * LOG2E;
            carry += ((t0 + t1) + t2) + t3; }
    }
    const float* qn = ap->in[I_MQN] + l * 96; const float* kn = ap->in[I_MKN] + l * 96; const float* fqn = ap->in[I_FQN] + l * 64; const float* fkn = ap->in[I_FKN] + l * 64;
    const int* pos = (const int*)ap->in[I_POS];
    const int hd = lane >> 3, j = lane & 7;
    const float QSC = 0.10206207261596575f * LOG2E, FSC = 0.125f * LOG2E;
    const int gw = c.vb * 8 + wave, ngw = grid_g() * 8;
    const bool g256 = grid_g() == 256;
    const int row_b = g256 ? gw * 8 : gw, row_s = g256 ? 1 : ngw, row_e = g256 ? gw * 8 + 8 : T_;
    float gq[12], gk[12], gfq[8], gfk[8];
#pragma unroll
    for (int e = 0; e < 8; ++e) { gq[e] = qn[8 * j + e]; gk[e] = kn[8 * j + e]; gfq[e] = fqn[8 * j + e]; gfk[e] = fkn[8 * j + e]; }
    gq[8] = qn[64 + 2 * j]; gq[9] = qn[65 + 2 * j]; gq[10] = qn[80 + 2 * j]; gq[11] = qn[81 + 2 * j];
    gk[8] = kn[64 + 2 * j]; gk[9] = kn[65 + 2 * j]; gk[10] = kn[80 + 2 * j]; gk[11] = kn[81 + 2 * j];
    struct PrepIn { float pf; u32x4 q; unsigned q1, q2; u32x4 k; unsigned p1, p2; u32x4 fq, fk; };
    auto prep_load = [&](int row) -> PrepIn { PrepIn r_;
        const bf16_t* pr = P + (size_t)row * NPROJ; const bf16_t* qp = QUP + (size_t)row * 768 + 96 * hd; const bf16_t* kp = KM + (size_t)row * 768 + 96 * hd;
        r_.pf = (float)pos[row];
        r_.q = *(const u32x4*)(qp + 8 * j); r_.q1 = *(const unsigned*)(qp + 64 + 2 * j); r_.q2 = *(const unsigned*)(qp + 80 + 2 * j);
        r_.k = *(const u32x4*)(kp + 8 * j);
        r_.p1 = *(const unsigned*)(pr + 384 + 2 * j); r_.p2 = *(const unsigned*)(pr + 400 + 2 * j);
        r_.fq = *(const u32x4*)(pr + 512 + 64 * hd + 8 * j); r_.fk = *(const u32x4*)(pr + 1024 + 64 * hd + 8 * j); return r_; };
    PrepIn nx_ = prep_load(row_b < T_ ? row_b : 0);
    for (int row = row_b; row < row_e; row += row_s) {
        bf16_t* pr = P + (size_t)row * NPROJ;
        bf16_t* qp = QUP + (size_t)row * 768 + 96 * hd; bf16_t* ko = KM + (size_t)row * 768 + 96 * hd;
        bf16_t* fqp = pr + 512 + 64 * hd + 8 * j; bf16_t* fkp = pr + 1024 + 64 * hd + 8 * j;
        const PrepIn in_ = nx_;
        { const int nrow = row + row_s; nx_ = prep_load(nrow < row_e ? nrow : row); }
        SBAR();
        const float pf = in_.pf;
        const u32x4 l_q = in_.q; const unsigned l_q1 = in_.q1, l_q2 = in_.q2;
        const u32x4 l_k = in_.k; const unsigned l_p1 = in_.p1, l_p2 = in_.p2;
        const u32x4 l_fq = in_.fq, l_fk = in_.fk;
        float cs[2], sn[2];
#pragma unroll
        for (int e = 0; e < 2; ++e) { const int i = 2 * j + e; const float inv = exp2f(-(float)i * (13.287712379549449f / 16.f)); const float ang = pf * inv;
            float rev = ang * 0.15915494309189535f; rev -= floorf(rev); cs[e] = __builtin_amdgcn_cosf(rev); sn[e] = __builtin_amdgcn_sinf(rev); }
        u32x4 o_q, o_k, o_fq, o_fk; unsigned o_q1, o_q2, o_k1, o_k2;
        { float v[8]; unpack8(l_q, v);
          const float x1[2] = {bf_lo(l_q1), bf_hi(l_q1)}, x2[2] = {bf_lo(l_q2), bf_hi(l_q2)};
          float ssq = 0.f;
#pragma unroll
          for (int e = 0; e < 8; ++e) ssq += v[e] * v[e];
          float r1[2], r2[2];
#pragma unroll
          for (int e = 0; e < 2; ++e) { r1[e] = x1[e] * cs[e] - x2[e] * sn[e]; r2[e] = x1[e] * sn[e] + x2[e] * cs[e]; ssq += r1[e] * r1[e] + r2[e] * r2[e]; }
          const float rn = rsqrtf(sum8(ssq) * (1.f / 96) + EPS) * QSC;
#pragma unroll
          for (int e = 0; e < 8; ++e) v[e] *= rn * gq[e];
          o_q = pack8(v);
          o_q1 = pk_bf16(r1[0] * rn * gq[8], r1[1] * rn * gq[9]);
          o_q2 = pk_bf16(r2[0] * rn * gq[10], r2[1] * rn * gq[11]); }
        { float v[8]; unpack8(l_k, v);
          const float x1[2] = {bf_lo(l_p1), bf_hi(l_p1)}, x2[2] = {bf_lo(l_p2), bf_hi(l_p2)};
          float ssq = 0.f;
#pragma unroll
          for (int e = 0; e < 8; ++e) ssq += v[e] * v[e];
          float r1[2], r2[2];
#pragma unroll
          for (int e = 0; e < 2; ++e) { r1[e] = x1[e] * cs[e] - x2[e] * sn[e]; r2[e] = x1[e] * sn[e] + x2[e] * cs[e]; ssq += r1[e] * r1[e] + r2[e] * r2[e]; }
          const float rn = rsqrtf(sum8(ssq) * (1.f / 96) + EPS);
#pragma unroll
          for (int e = 0; e < 8; ++e) v[e] *= rn * gk[e];
          o_k = pack8(v);
          o_k1 = pk_bf16(r1[0] * rn * gk[8], r1[1] * rn * gk[9]);
          o_k2 = pk_bf16(r2[0] * rn * gk[10], r2[1] * rn * gk[11]); }
        { float v[8]; unpack8(l_fq, v); float ssq = 0.f;
#pragma unroll
          for (int e = 0; e < 8; ++e) ssq += v[e] * v[e];
          const float rn = rsqrtf(sum8(ssq) * (1.f / 64) + EPS) * FSC;
#pragma unroll
          for (int e = 0; e < 8; ++e) v[e] *= rn * gfq[e];
          o_fq = pack8(v); }
        { float v[8]; unpack8(l_fk, v); float ssq = 0.f;
#pragma unroll
          for (int e = 0; e < 8; ++e) ssq += v[e] * v[e];
          const float rn = rsqrtf(sum8(ssq) * (1.f / 64) + EPS);
#pragma unroll
          for (int e = 0; e < 8; ++e) v[e] *= rn * gfk[e];
          o_fk = pack8(v); }
        if (!dry) {
            *(u32x4*)(qp + 8 * j) = o_q; *(unsigned*)(qp + 64 + 2 * j) = o_q1; *(unsigned*)(qp + 80 + 2 * j) = o_q2;
            *(u32x4*)(ko + 8 * j) = o_k; *(unsigned*)(ko + 64 + 2 * j) = o_k1; *(unsigned*)(ko + 80 + 2 * j) = o_k2;
            *(u32x4*)fqp = o_fq; *(u32x4*)fkp = o_fk;
        }
    }
}

__device__ __forceinline__ void attn_phase(const Ctx& c, int l, bool dry) {
    PHASE_IDS(); ArgsP ap = get_args(); unsigned char* ws = ap->ws;
    bf16_t* P = (bf16_t*)(ws + WS_PROJ); bf16_t* QUP = (bf16_t*)(ws + WS_QUP); const bf16_t* KVUP = (const bf16_t*)(ws + WS_KVUP); const bf16_t* KM = (const bf16_t*)(ws + WS_KM);
    const float* CUM = (const float*)(ws + WS_CUM);
    float sbound;
    { float mq = fabsf(ap->in[I_FQN][l * 64 + lane]), mk = fabsf(ap->in[I_FKN][l * 64 + lane]);
#pragma unroll
      for (int o = 1; o < 64; o <<= 1) { mq = fmaxf(mq, __shfl_xor(mq, o)); mk = fmaxf(mk, __shfl_xor(mk, o)); }
      sbound = 2.f * 1.05f * 8.f * LOG2E * mq * mk; }
    for (int L = c.vb; L < 256; L += grid_g()) {
        const int bh = (L >> 5) * 8 + (L & 7), p = (L >> 3) & 3, b = bh >> 3, h = bh & 7; const size_t r0 = (size_t)b * S_;
        const float* cum = CUM + (size_t)bh * S_;
        int T0f[2];
#pragma unroll
        for (int e = 0; e < 2; ++e) { const int q0 = (2 * p + e) * 256, nb = q0 >> 6; const float c0 = cum[q0]; bool need = false;
            if (lane < nb) need = (sbound + c0 - cum[64 * lane + 63] >= -40.f);
            const unsigned long long bal = __ballot(need);
            T0f[e] = __builtin_amdgcn_readfirstlane((bal ? (__ffsll((long long)bal) - 1) : nb) & ~1); }
#pragma unroll 1
        for (int e = 0; e < 2; ++e)
            attn::attn_unit<96, false>(QUP + r0 * 768 + 96 * h, 768, KM + r0 * 768 + 96 * h, 768, KVUP + r0 * 512 + 64 * h, 512, nullptr, (e ? p : 7 - p) * 256, c.ldsg, dry, 0.f, 0);
#pragma unroll 1
        for (int e = 0; e < 2; ++e)
            attn::attn_unit<64, true>(P + r0 * NPROJ + 512 + 64 * h, NPROJ, P + r0 * NPROJ + 1024 + 64 * h, NPROJ, P + r0 * NPROJ + 1536 + 64 * h, NPROJ, cum, (2 * p + e) * 256, c.ldsg, dry, sbound, e ? T0f[1] : T0f[0]);
    }
}

#if USE_XCD_BAR
#define XB_TMO      128
#define XB_XCNT(j)  (256  + 64 * (j))
#define XB_XSUB(j)  (1280 + 64 * (j))
#define XB_XGEN(j)  (2304 + 64 * (j))
#define XB_TOP      3328
#define XB_TOPGEN   3392
#define XCD_BAR_WORDS 3456
#define XB_SPIN_CAP (1u << 22)
__device__ __forceinline__ unsigned xb_ld(unsigned* p)              { return __hip_atomic_load(p, __ATOMIC_RELAXED, __HIP_MEMORY_SCOPE_AGENT); }
__device__ __forceinline__ unsigned xb_add(unsigned* p, unsigned v) { return __hip_atomic_fetch_add(p, v, __ATOMIC_RELAXED, __HIP_MEMORY_SCOPE_AGENT); }
__device__ __forceinline__ unsigned xb_xcc_id() { return (unsigned)__builtin_amdgcn_s_getreg((3 << 11) | 20) & 0xFu; }
#define XB_SPIN(cond, bar) do { unsigned _sp = 0; while (cond) { __builtin_amdgcn_s_sleep(1); \
    if ((++_sp & 255u) == 0u) { if (xb_ld(&(bar)[XB_TMO])) break; if (_sp > XB_SPIN_CAP) { atomicAdd(&(bar)[XB_TMO], 1u); break; } } } } while (0)
struct XcdBarrier { unsigned* bar; unsigned x; volatile LAS unsigned* st; unsigned nexp; };
__device__ __forceinline__ XcdBarrier xcd_barrier_post(unsigned* bar, volatile LAS unsigned* st, unsigned nexp) {
    XcdBarrier b; b.bar = bar; b.x = xb_xcc_id(); b.st = st; b.nexp = nexp;
    if (threadIdx.x == 0) (void)xb_add(&bar[XB_XCNT(b.x)], 1u);
    return b;
}
__device__ __forceinline__ void xcd_barrier_complete(unsigned* bar, unsigned x, unsigned G, unsigned& nloc, unsigned& nx) {
    unsigned sum, cnt, mine, sp = 0u;
    for (;;) {
        sum = 0u; cnt = 0u; mine = 0u;
#pragma unroll
        for (unsigned j = 0; j < 16; ++j) { const unsigned c = xb_ld(&bar[XB_XCNT(j)]); sum += c; cnt += (c > 0u) ? 1u : 0u; mine = (j == x) ? c : mine; }
        if (sum == G) break;
        __builtin_amdgcn_s_sleep(1);
        if ((++sp & 255u) == 0u) { if (xb_ld(&bar[XB_TMO])) break; if (sp > XB_SPIN_CAP) { atomicAdd(&bar[XB_TMO], 1u); break; } }
    }
    nloc = mine > 0u ? mine : 1u; nx = cnt > 0u ? cnt : 1u;
}
__device__ __forceinline__ void xcd_barrier(const XcdBarrier& b) {
    asm volatile("s_waitcnt vmcnt(0)" ::: "memory");
    __syncthreads();
    if (threadIdx.x == 0) {
        unsigned* bar = b.bar;
        __builtin_amdgcn_s_waitcnt(0);
        unsigned nloc = b.st[0], nx = b.st[1];
        if (nloc == 0u) { xcd_barrier_complete(bar, b.x, b.nexp, nloc, nx); b.st[0] = nloc; b.st[1] = nx; }
        const unsigned old = xb_add(&bar[XB_XSUB(b.x)], 1u);
        const unsigned gen = old / nloc;
        if (old + 1u == (gen + 1u) * nloc) {
            __builtin_amdgcn_fence(__ATOMIC_RELEASE, "agent");
            asm volatile("s_waitcnt vmcnt(0)" ::: "memory");
            const unsigned og = xb_add(&bar[XB_TOP], 1u);
            const unsigned tg = og / nx;
            if (og + 1u == (tg + 1u) * nx) xb_add(&bar[XB_TOPGEN], 1u);
            else XB_SPIN(xb_ld(&bar[XB_TOPGEN]) == tg, bar);
            __builtin_amdgcn_fence(__ATOMIC_ACQUIRE, "agent");
            xb_add(&bar[XB_XGEN(b.x)], 1u);
            asm volatile("s_waitcnt vmcnt(0)" ::: "memory");
        } else {
            XB_SPIN(xb_ld(&bar[XB_XGEN(b.x)]) == gen, bar);
            __builtin_amdgcn_fence(__ATOMIC_ACQUIRE, "agent");
            asm volatile("s_waitcnt vmcnt(0)" ::: "memory");
        }
    }
    __syncthreads();
}
#endif

constexpr int LDS_MAIN = 131072, LDS_BYTES = LDS_MAIN + 1024;
static_assert(attn::LDS_BYTES <= LDS_MAIN && 8 * S5_XWAVE <= LDS_MAIN && 8 * 8448 <= LDS_MAIN, "LDS map");

__device__ __forceinline__ void ph_inproj(const Ctx& c, int l) {
    ArgsP ap = get_args(); unsigned char* ws = ap->ws;
    SchedIn S{(const char*)(ws + WS_XG), (const char*)(ws + WS_WIN) + (size_t)l * 2 * NIN * 512 * 2, 0, grid_g(), c.bid};
    EpiProj E{(bf16_t*)(ws + WS_PROJ), (const float*)(ws + WS_SS) + (size_t)l * T_, (float*)(ws + WS_FF32), (float*)(ws + WS_SSQ) + (size_t)l * T_};
    pg8::gemm_phase(c.lds, 512, 512, 8, S, E);
}
__device__ __forceinline__ void ph_fv(const Ctx& c, int l) {
    ArgsP ap = get_args(); unsigned char* ws = ap->ws;
    SchedIn S{(const char*)(ws + WS_XG), (const char*)(ws + WS_WIN) + (size_t)l * 2 * NIN * 512 * 2, 1, grid_g(), c.bid};
    EpiProj E{(bf16_t*)(ws + WS_PROJ), (const float*)(ws + WS_SS) + (size_t)l * T_, (float*)(ws + WS_FF32), (float*)(ws + WS_SSQ) + (size_t)l * T_};
    pg8::gemm_phase(c.lds, 512, 512, 8, S, E);
}
__device__ __forceinline__ void ph_up(const Ctx& c, int l) {
    ArgsP ap = get_args(); unsigned char* ws = ap->ws;
    SchedUp S{(const char*)(ws + WS_PROJ), (const char*)(ws + WS_WQ) + (size_t)l * 768 * 256 * 2, (const char*)(ws + WS_WKV) + (size_t)l * 1024 * 256 * 2, grid_g(), c.bid};
    EpiUp E{(bf16_t*)(ws + WS_QUP), (bf16_t*)(ws + WS_KM), (bf16_t*)(ws + WS_KVUP), (const float*)(ws + WS_SSQ) + (size_t)l * T_}; pg8::gemm_phase(c.lds, NPROJ, 256, 4, S, E);
}
__device__ __forceinline__ void ph_gate(const Ctx& c, int l) {
    ArgsP ap = get_args(); unsigned char* ws = ap->ws;
    SchedGate S{(const char*)ws, l, grid_g(), c.bid};
    EpiGate E{ws, ap->in[I_BGLU] + l * 512, l};
    pg8::gemm_phase(c.lds, 512, 512, 8, S, E);
}
__device__ __forceinline__ void ph_merge(const Ctx& c, int l) {
    ArgsP ap = get_args(); unsigned char* ws = ap->ws;
    SchedMerge S{(const char*)ws, l, grid_g(), c.bid};
    EpiMerge E{ws, l, c.bid};
    pg8::gemm_phase(c.lds, 512, 512, 8, S, E);
}
__device__ __forceinline__ void ph_out(const Ctx& c, int l, bool dry) {
    ArgsP ap = get_args(); unsigned char* ws = ap->ws;
    SchedPlain S{(const char*)(ws + WS_PROJ) + (size_t)S_ * 1024 * 2, (size_t)256 * 1024 * 2, (size_t)10 << 20, (const char*)(ws + WS_WOUT) + (size_t)l * DM * DM * 2, (size_t)256 * 1024 * 2, 4, grid_g(), c.bid};
    const bool lastl = (l == NL - 1);
    EpiOut E{l == 0 ? ap->in[I_X] : nullptr, ap->out, (bf16_t*)(ws + WS_XG), lastl ? nullptr : (float*)(ws + WS_SS) + (size_t)(l + 1) * T_, dry};
    pg8::gemm_phase(c.lds, 1024, 1024, 16, S, E);
}

__global__ void __launch_bounds__(512, 2) trunk_fwd(Args args) {
    extern __shared__ __attribute__((aligned(16))) unsigned char lds[];
    Ctx c; c.lds = (LAS unsigned char*)lds; c.ldsg = (char*)lds; c.G = gridDim.x; c.bid = blockIdx.x; c.vb = (gridDim.x == 256) ? (int)((blockIdx.x & 7) * 32 + (blockIdx.x >> 3)) : (int)blockIdx.x;
#if MK_LAUNCHES == 1
#if USE_XCD_BAR
    if (threadIdx.x < 4) ((volatile LAS unsigned*)(c.lds + LDS_MAIN))[threadIdx.x] = 0u;
    __syncthreads();
    XcdBarrier bar = xcd_barrier_post((unsigned*)(args.ws + WS_CTL) + 4096, (volatile LAS unsigned*)(c.lds + LDS_MAIN), gridDim.x);
    XcdBarrier pbar = bar;
#define GRID_BAR() xcd_barrier(bar)
#define PIPE_BAR() xcd_barrier(pbar)
#define HAVE_PIPE_BAR 1
#else
    cg::grid_group grid = cg::this_grid();
#define GRID_BAR() grid.sync()
#endif
#else
#define GRID_BAR() do {} while (0)
#endif
    const int lo = args.ph_lo, hi = args.ph_hi;
#ifndef PH_MASK
#define PH_MASK 0xfff
#endif
#define IN(k) (lo <= (k) && (k) < hi)
#define PHM(j) ((PH_MASK >> (j)) & 1)
#define SEAM(k) do { if (IN(k) && IN((k) + 1)) GRID_BAR(); } while (0)
#ifdef HAVE_PIPE_BAR
#define SEAMP(k) do { if (IN(k) && IN((k) + 1)) PIPE_BAR(); } while (0)
#else
#define SEAMP(k) SEAM(k)
#endif

#ifndef ENABLE_PROBES
#define ENABLE_PROBES 0
#endif
#if ENABLE_PROBES
    const int probe = args.probe;
#define REP(j) for (int rep = (probe == (j)) ? 0 : 1; rep < 2; ++rep)
#else
#define REP(j) for (int rep = 1; rep < 2; ++rep)
#endif
    if (PHM(0) && IN(0)) { REP(1) phase0(c, 0); } SEAM(0);
#ifdef HAVE_PIPE_BAR
    if (gridDim.x == 256 && lo == 0 && hi == NPH)
        pbar = xcd_barrier_post((unsigned*)(args.ws + WS_PBAR) + (blockIdx.x & 7) * XCD_BAR_WORDS, (volatile LAS unsigned*)(c.lds + LDS_MAIN) + 2, 32u);
#endif
    for (int l = 0; l < NL; ++l) {
        const int pb = 1 + 7 * l;
        if (PHM(1) && IN(pb + 0)) {
            if (l == 0 && (c.bid & 1)) { phase0(c, 1); __syncthreads(); }
            REP(2) ph_inproj(c, l);
            if (l == 0 && !(c.bid & 1)) phase0(c, 1); }
        if (l == 0) SEAM(pb + 0); else SEAMP(pb + 0);
        if (IN(pb + 1)) {
            if (c.bid & 1) { if (PHM(9)) REP(5) s5_pass<false>(c, l, false); if (PHM(2)) REP(4) ph_fv(c, l); if (PHM(2)) REP(3) ph_up(c, l); }
            else { if (PHM(2)) REP(4) ph_fv(c, l); if (PHM(2)) REP(3) ph_up(c, l); if (PHM(9)) REP(5) s5_pass<false>(c, l, false); } }
        SEAMP(pb + 1);
        if (IN(pb + 2)) {
            if (c.bid & 1) { if (PHM(10)) REP(7) s5_pass<true>(c, l, rep == 0); if (PHM(3)) REP(6) prep_phase(c, l, rep == 0); }
            else { if (PHM(3)) REP(6) prep_phase(c, l, rep == 0); if (PHM(10)) REP(7) s5_pass<true>(c, l, rep == 0); } }
        SEAMP(pb + 2);
        if (IN(pb + 3)) { if (PHM(4)) REP(8) attn_phase(c, l, rep == 0); }
        SEAMP(pb + 3);
        if (PHM(5) && IN(pb + 4)) REP(10) ph_gate(c, l);
        SEAMP(pb + 4);
        if (PHM(6) && IN(pb + 5)) REP(11) ph_merge(c, l);
        SEAMP(pb + 5);
        if (PHM(7) && IN(pb + 6)) REP(12) ph_out(c, l, rep == 0);
        SEAMP(pb + 6);
    }
#undef IN
#undef SEAM
}

extern "C" void kernel_launch(void* const* d_in, const int* in_sizes, int n_in, void* d_out, int out_size, void* d_ws, size_t ws_size, hipStream_t stream) {
    static int grid = 0;
    if (grid == 0) {
        if (n_in != 25 || in_sizes[0] != T_ * DM || out_size != T_ * DM || ws_size < WS_END) {
            fprintf(stderr, "kernel_launch: shape mismatch n_in %d in0 %d out %d ws %zu (need %zu)\n", n_in, n_in > 0 ? in_sizes[0] : -1, out_size, ws_size, (size_t)WS_END); grid = -1; return; }
        int dev = 0, cus = 0, per_cu = 0;
        hipGetDevice(&dev); hipDeviceGetAttribute(&cus, hipDeviceAttributeMultiprocessorCount, dev);
        if (hipFuncSetAttribute((const void*)trunk_fwd, hipFuncAttributeMaxDynamicSharedMemorySize, LDS_BYTES) != hipSuccess) { fprintf(stderr, "kernel_launch: hipFuncSetAttribute failed\n"); grid = -1; return; }
        if (hipOccupancyMaxActiveBlocksPerMultiprocessor(&per_cu, (const void*)trunk_fwd, 512, LDS_BYTES) != hipSuccess || per_cu < 1) { fprintf(stderr, "kernel_launch: occupancy query says %d\n", per_cu); per_cu = 1; }
        (void)hipGetLastError();
        grid = cus;
    }
    if (grid < 0) return;
    hipMemsetAsync((char*)d_ws + WS_CTL, 0, 64 * KiB, stream);
    Args a{};
    for (int i = 0; i < 25; ++i) a.in[i] = (const float*)d_in[i];
    a.out = (float*)d_out; a.ws = (unsigned char*)d_ws;
#ifdef PROBE_PHASE
    a.probe = PROBE_PHASE;
#endif
#if MK_LAUNCHES == 1
    a.ph_lo = 0; a.ph_hi = NPH;
#ifndef PLAIN_LAUNCH
#define PLAIN_LAUNCH 0
#endif
#if PLAIN_LAUNCH
    hipLaunchKernelGGL(trunk_fwd, dim3(grid), dim3(512), LDS_BYTES, stream, a);
#else
    void* kargs[] = {&a};
    hipError_t e = hipLaunchCooperativeKernel((const void*)trunk_fwd, dim3(grid), dim3(512), kargs, LDS_BYTES, stream);
    if (e != hipSuccess) fprintf(stderr, "cooperative launch failed: %s (grid %d)\n", hipGetErrorString(e), grid);
#endif
#else
    for (int ph = 0; ph < NPH; ++ph) { a.ph_lo = ph; a.ph_hi = ph + 1; hipLaunchKernelGGL(trunk_fwd, dim3(grid), dim3(512), LDS_BYTES, stream, a); }
#endif
}
```

```cpp
#include <hip/hip_runtime.h>
#include <hip/hip_cooperative_groups.h>
#include <cstdint>
#include <cstdio>
namespace cg = cooperative_groups;

#ifndef MK_LAUNCHES
#define MK_LAUNCHES 1
#endif
#ifndef USE_XCD_BAR
#define USE_XCD_BAR 1
#endif

#define LAS __attribute__((address_space(3)))
typedef unsigned short bf16_t;
typedef short bf16x8 __attribute__((ext_vector_type(8)));
typedef short s16x4 __attribute__((ext_vector_type(4)));
typedef float f32x2 __attribute__((ext_vector_type(2)));
typedef float f32x4 __attribute__((ext_vector_type(4)));
typedef float f32x16 __attribute__((ext_vector_type(16)));
typedef unsigned u32x2 __attribute__((ext_vector_type(2)));
typedef unsigned u32x4 __attribute__((ext_vector_type(4)));

constexpr int T_ = 16384, S_ = 2048, NB_ = 8, DM = 1024, NL = 2;
constexpr int NPROJ = 2560;
constexpr int NIN = 7168;
constexpr int IN_SRC = 7080;
constexpr float EPS = 1e-6f;
constexpr float LOG2E = 1.4426950408889634f;
constexpr int NPH = 1 + 7 * NL;

constexpr size_t KiB = 1024, MiB = 1024 * 1024;
constexpr size_t WS_CTL = 0;
constexpr size_t WS_SS = 64 * KiB;
constexpr size_t WS_FF32 = 256 * KiB;
constexpr size_t WS_CUM = 768 * KiB;
constexpr size_t WS_TA = 1280 * KiB;
constexpr size_t WS_TBB = 1344 * KiB;
constexpr size_t WS_TC = 1856 * KiB;
constexpr size_t WS_SSQ = 2432 * KiB;
constexpr size_t WS_SSKV = 2560 * KiB;
constexpr size_t WS_PBAR = 2688 * KiB;
constexpr size_t WS_E = 3 * MiB;
constexpr size_t WS_WQ = 7 * MiB;
constexpr size_t WS_WKV = WS_WQ + 768 * KiB;
constexpr size_t WS_WGLU = WS_WKV + 1 * MiB;
constexpr size_t WS_WBO = WS_WGLU + 1 * MiB;
constexpr size_t WS_WOUT = WS_WBO + 6 * MiB;
constexpr size_t WS_WIN = 20 * MiB;
constexpr size_t WS_XG = 48 * MiB;
constexpr size_t WS_PROJ = 80 * MiB;
constexpr size_t WS_QUP = 160 * MiB;
constexpr size_t WS_KVUP = 184 * MiB;
constexpr size_t WS_KM = 216 * MiB;
constexpr size_t WS_Z = 240 * MiB;
constexpr size_t WS_END = 256 * MiB;
static_assert(WS_WOUT + 4 * MiB <= WS_WIN && WS_WIN + 28 * MiB <= WS_XG, "ws map");

__device__ __forceinline__ unsigned pk_bf16(float lo, float hi) {
    typedef __bf16 b2 __attribute__((ext_vector_type(2)));
    f32x2 v = {lo, hi}; b2 b = __builtin_convertvector(v, b2); return __builtin_bit_cast(unsigned, b);
}
__device__ __forceinline__ float bf_lo(unsigned w) { return __uint_as_float(w << 16); }
__device__ __forceinline__ float bf_hi(unsigned w) { return __uint_as_float(w & 0xffff0000u); }
__device__ __forceinline__ float bf2f(bf16_t h) { return __uint_as_float(((unsigned)h) << 16); }
__device__ __forceinline__ bf16_t f2bf(float f) { return (bf16_t)(pk_bf16(f, 0.f) & 0xffffu); }
__device__ __forceinline__ float sigmoidf_(float v) { return 1.f / (1.f + __expf(-v)); }
__device__ __forceinline__ float siluf_(float v) { return v / (1.f + __expf(-v)); }
__device__ __forceinline__ float gelu_tanh(float y) {
    const float v = 0.7978845608028654f * (y + 0.044715f * y * y * y);
    const float t = 1.f - 2.f / (1.f + __expf(2.f * v));
    return 0.5f * y * (1.f + t);
}
template <int CTRL> __device__ __forceinline__ float dpp_f(float v) { return __builtin_bit_cast(float, __builtin_amdgcn_update_dpp(0, __builtin_bit_cast(int, v), CTRL, 0xF, 0xF, true)); }
__device__ __forceinline__ float sum8(float v) { v += dpp_f<0xB1>(v); v += dpp_f<0x4E>(v); v += dpp_f<0x141>(v); return v; }
__device__ __forceinline__ float wave_sum(float v) {
    v = sum8(v); v += dpp_f<0x140>(v);
    const int iv = __builtin_bit_cast(int, v);
    const float a = __builtin_bit_cast(float, __builtin_amdgcn_readlane(iv, 0)), b = __builtin_bit_cast(float, __builtin_amdgcn_readlane(iv, 16));
    const float c = __builtin_bit_cast(float, __builtin_amdgcn_readlane(iv, 32)), d = __builtin_bit_cast(float, __builtin_amdgcn_readlane(iv, 48));
    return (a + b) + (c + d);
}
#define SBAR() __builtin_amdgcn_sched_barrier(0)

namespace pg8 {
constexpr int BM = 256, BK = 64, HALF = 128, HTB = HALF * BK * 2, STAGE_BYTES = 8 * HTB;
__device__ __forceinline__ int lds_byte(int r, int c) { const int st = (r >> 4) * 2 + (c >> 5), rr = r & 15, cc = c & 31, ob = rr * 64 + cc * 2; return st * 1024 + (ob ^ (((ob >> 9) & 1) << 5)); }
__device__ __forceinline__ void stage_rc(int b, int& R, int& C) { const int st = b / 1024, sb = b % 1024, swz = sb ^ (((sb >> 9) & 1) << 5); R = (st >> 1) * 16 + swz / 64; C = (st & 1) * 32 + (swz % 64) / 2; }
__device__ __forceinline__ int perm32(int rho) { const int n = rho >> 4, i = rho & 15; return 8 * (i >> 2) + 4 * n + (i & 3); }

struct Unit { const char* A; const char* B; int pm, pn, kind; };

__device__ __forceinline__ bool tile_at(long L, int nM, int nN, int& pm, int& pn) {
    const int nwg = nM * nN; if (L >= nwg) return false;
    int wgid = (int)L; { const int q = nwg / 8, r = nwg % 8, xcd = wgid % 8, off = wgid / 8; wgid = (xcd < r ? xcd * (q + 1) : r * (q + 1) + (xcd - r) * q) + off; }
    const int WGM = 8, nig = WGM * nN, gid = wgid / nig, fm = gid * WGM;
    pm = fm + ((wgid % nig) & (WGM - 1)); pn = (wgid % nig) / WGM; return true;
}

template <class Epi, class Sched>
__device__ __forceinline__ void gemm_phase(LAS unsigned char* lds, const int lda, const int ldb, const int nt, const Sched& S, const Epi& E) {
    int tid = threadIdx.x; asm volatile("" : "+v"(tid));
    const int wid = __builtin_amdgcn_readfirstlane(tid >> 6), lane = tid & 63, wr = wid >> 2, wc = wid & 3, fr = lane & 15, fq = lane >> 4;
    unsigned voffA[2], voffB[2];
#pragma unroll
    for (int i = 0; i < 2; ++i) { int R, C; stage_rc(tid * 16 + i * 8192, R, C); const int Rb = Epi::PERM ? ((R & ~31) + perm32(R & 31)) : R;
        voffA[i] = (unsigned)(R * lda + C) * 2u; voffB[i] = (unsigned)(Rb * ldb + C) * 2u; }
    int ntv = nt; asm volatile("" : "+s"(ntv));
    const size_t kstep = (size_t)(BK * 2);
    const size_t hstepA = (size_t)HALF * lda * 2, hstepB = (size_t)HALF * ldb * 2;
    const unsigned ldsw = (unsigned)wid * 1024u;
    const int aoff = lds_byte(wr * 64 + fr, fq * 8), boff = lds_byte(wc * 32 + fr, fq * 8);
#define PG8_SA(b, h) (((b) * 2 + (h)) * HTB)
#define PG8_SB(b, h) ((4 + (b) * 2 + (h)) * HTB)
#define PG8_STAGE(bufoff, gbase, voff) do { _Pragma("unroll") for (int _i = 0; _i < 2; ++_i) \
        __builtin_amdgcn_global_load_lds((const unsigned*)((const char*)(gbase) + (voff)[_i]), (LAS unsigned*)(lds + (bufoff) + ldsw + _i * 8192), 16, 0, 0); } while (0)
#define PG8_LDA(dst, b, h) do { _Pragma("unroll") for (int m = 0; m < 4; ++m) _Pragma("unroll") for (int k = 0; k < 2; ++k) dst[m][k] = *(const LAS bf16x8*)(lds + PG8_SA(b, h) + aoff + m * 2048 + k * 1024); } while (0)
#define PG8_LDB(dst, b, h) do { _Pragma("unroll") for (int n = 0; n < 2; ++n) _Pragma("unroll") for (int k = 0; k < 2; ++k) dst[n][k] = *(const LAS bf16x8*)(lds + PG8_SB(b, h) + boff + n * 2048 + k * 1024); } while (0)
#define PG8_MMA(ai, bj, At, Bt) do { __builtin_amdgcn_s_setprio(1); _Pragma("unroll") for (int m = 0; m < 4; ++m) _Pragma("unroll") for (int n = 0; n < 2; ++n) _Pragma("unroll") for (int k = 0; k < 2; ++k) \
        acc[ai][bj][m][n] = __builtin_amdgcn_mfma_f32_16x16x32_bf16(Bt[n][k], At[m][k], acc[ai][bj][m][n], 0, 0, 0); __builtin_amdgcn_s_setprio(0); } while (0)
#define PG8_WAIT_V(n) asm volatile("s_waitcnt vmcnt(" #n ")" ::: "memory")
#define PG8_WAIT_L(n) asm volatile("s_waitcnt lgkmcnt(" #n ")" ::: "memory")
#define PG8_BAR __builtin_amdgcn_s_barrier()
#define PG8_SCHED __builtin_amdgcn_sched_barrier(0)
    Unit cur, nxt; int ui = 0;
    if (!S.next(0, cur)) return;
    f32x4 acc[2][2][4][2];
#pragma unroll
    for (int a = 0; a < 2; ++a)
#pragma unroll
        for (int b = 0; b < 2; ++b)
#pragma unroll
            for (int m = 0; m < 4; ++m)
#pragma unroll
                for (int n = 0; n < 2; ++n) acc[a][b][m][n] = (f32x4){0.f, 0.f, 0.f, 0.f};
    bf16x8 At[4][2], B0[2][2], B1[2][2];
    const char* cA = cur.A; const char* cB = cur.B;
    PG8_STAGE(PG8_SB(0, 0), cB, voffB); PG8_STAGE(PG8_SB(0, 1), cB + hstepB, voffB); PG8_STAGE(PG8_SA(0, 0), cA, voffA); PG8_STAGE(PG8_SA(0, 1), cA + hstepA, voffA);
    if (wr == 1) PG8_BAR;
    PG8_WAIT_V(2); PG8_BAR;
    PG8_STAGE(PG8_SB(1, 0), cB + kstep, voffB); PG8_STAGE(PG8_SA(1, 0), cA + kstep, voffA); PG8_STAGE(PG8_SB(1, 1), cB + hstepB + kstep, voffB);
    PG8_WAIT_V(6); PG8_BAR;
    for (;;) {
        const bool has_next = S.next(ui + 1, nxt);
        const char* nA = has_next ? nxt.A : cA; const char* nB = has_next ? nxt.B : cB;
        for (int t = 0; t < ntv; t += 2) {
            const bool last = (t == ntv - 2);
            const char* a1 = cA + (size_t)(t + 1) * kstep;
            const char* a2 = last ? nA : cA + (size_t)(t + 2) * kstep; const char* b2 = last ? nB : cB + (size_t)(t + 2) * kstep;
            const char* a3 = a2 + kstep; const char* b3 = b2 + kstep;
            PG8_LDB(B0, 0, 0); PG8_LDB(B1, 0, 1); PG8_SCHED; PG8_LDA(At, 0, 0); PG8_STAGE(PG8_SA(1, 1), a1 + hstepA, voffA);
            PG8_WAIT_V(8); PG8_WAIT_L(0); PG8_BAR; PG8_MMA(0, 0, At, B0); PG8_MMA(0, 1, At, B1); PG8_BAR; PG8_SCHED;
            PG8_LDA(At, 0, 1); PG8_STAGE(PG8_SB(0, 0), b2, voffB); PG8_STAGE(PG8_SB(0, 1), b2 + hstepB, voffB); PG8_STAGE(PG8_SA(0, 0), a2, voffA);
            PG8_WAIT_V(8); PG8_WAIT_L(0); PG8_BAR; PG8_MMA(1, 0, At, B0); PG8_MMA(1, 1, At, B1); PG8_BAR; PG8_SCHED;
            PG8_LDB(B0, 1, 0); PG8_LDB(B1, 1, 1); PG8_SCHED; PG8_LDA(At, 1, 0); PG8_STAGE(PG8_SA(0, 1), a2 + hstepA, voffA);
            PG8_WAIT_V(8); PG8_WAIT_L(0); PG8_BAR; PG8_MMA(0, 0, At, B0); PG8_MMA(0, 1, At, B1); PG8_BAR; PG8_SCHED;
            PG8_LDA(At, 1, 1); PG8_STAGE(PG8_SB(1, 0), b3, voffB); PG8_STAGE(PG8_SB(1, 1), b3 + hstepB, voffB); PG8_STAGE(PG8_SA(1, 0), a3, voffA);
            PG8_WAIT_V(8); PG8_WAIT_L(0); PG8_BAR; PG8_MMA(1, 0, At, B0); PG8_MMA(1, 1, At, B1); PG8_BAR; PG8_SCHED;
        }
        if (wr == 0) PG8_BAR;
        const bool keep = E(acc, cur, wr, wc, fr, fq);
        if (!has_next) break;
        if (!keep) {
#pragma unroll
            for (int a = 0; a < 2; ++a)
#pragma unroll
                for (int b = 0; b < 2; ++b)
#pragma unroll
                    for (int m = 0; m < 4; ++m)
#pragma unroll
                        for (int n = 0; n < 2; ++n) acc[a][b][m][n] = (f32x4){0.f, 0.f, 0.f, 0.f};
        }
        cur = nxt; cA = nA; cB = nB; ++ui;
        if (wr == 1) PG8_BAR;
    }
    PG8_WAIT_V(0);
    PG8_BAR;
#undef PG8_SA
#undef PG8_SB
#undef PG8_STAGE
#undef PG8_LDA
#undef PG8_LDB
#undef PG8_MMA
#undef PG8_WAIT_V
#undef PG8_WAIT_L
#undef PG8_BAR
#undef PG8_SCHED
}
}

struct Args {
    const float* in[25];
    float* out;
    unsigned char* ws;
    int ph_lo, ph_hi, probe, pad;
};
enum { I_X = 0, I_POS, I_NORMG, I_WIN, I_QAN, I_WQUP, I_KVAN, I_WKVUP, I_MQN, I_MKN, I_FBF, I_FQN, I_FKN,
       I_LRE, I_LIM, I_LDT, I_BRE, I_BIM, I_CRE, I_CIM, I_S5D, I_WGLU, I_BGLU, I_WBO, I_WOUT };

typedef const __attribute__((address_space(4))) Args* ArgsP;
__device__ __forceinline__ ArgsP get_args() { ArgsP p = (ArgsP)__builtin_amdgcn_kernarg_segment_ptr(); asm volatile("" : "+s"(p)); return p; }
__device__ __forceinline__ int grid_g() { int g = (int)gridDim.x; asm volatile("" : "+s"(g)); return g; }
struct Ctx {
    LAS unsigned char* lds;
    char* ldsg;
    int G, bid;
    int vb;
};
#define PHASE_IDS() int tid = threadIdx.x; asm volatile("" : "+v"(tid)); const int lane = tid & 63, wave = __builtin_amdgcn_readfirstlane(tid >> 6); (void)lane; (void)wave

using pg8::Unit;
using pg8::tile_at;

__device__ __forceinline__ float rstd_of(const float* ss, int row) { return rsqrtf(ss[row] * (1.f / DM) + EPS); }

struct SchedIn {
    const char* XG; const char* WIN; int mode, G, c;
    __device__ __forceinline__ bool next(int i, Unit& u) const {
        int pm, pn; if (!tile_at((long)(i >> 1) * G + c, 64, mode ? 2 : 8, pm, pn)) return false;
        pn = mode ? pn + 6 : (pn >= 6 ? pn + 2 : pn);
        const int h = i & 1;
        u.A = XG + ((size_t)h * T_ + (size_t)pm * 256) * 512 * 2;
        u.B = WIN + ((size_t)h * NIN + (size_t)pn * 256) * 512 * 2;
        u.pm = pm; u.pn = pn; u.kind = h; return true;
    }
};
struct EpiProj {
    static constexpr bool PERM = true;
    bf16_t* P; const float* ss; float* ff32; float* ssq;
    __device__ __forceinline__ bool operator()(f32x4 (&acc)[2][2][4][2], const Unit& u, int wr, int wc, int fr, int fq) const {
        if (u.kind == 0) return true;
        const int row0 = u.pm * 256 + wr * 64 + fr, col0 = u.pn * 256 + wc * 32 + 8 * fq;
        float rs[2][4];
#pragma unroll
        for (int ai = 0; ai < 2; ++ai)
#pragma unroll
            for (int m = 0; m < 4; ++m) rs[ai][m] = ss[row0 + ai * 128 + m * 16];
#pragma unroll
        for (int ai = 0; ai < 2; ++ai)
#pragma unroll
            for (int m = 0; m < 4; ++m) { const int row = row0 + ai * 128 + m * 16; const float r_ = rsqrtf(rs[ai][m] * (1.f / DM) + EPS); bf16_t* rp = P + (size_t)row * NPROJ + col0;
#pragma unroll
                for (int bj = 0; bj < 2; ++bj) { const f32x4 v0 = acc[ai][bj][m][0] * r_, v1 = acc[ai][bj][m][1] * r_;
                    u32x4 w; w.x = pk_bf16(v0[0], v0[1]); w.y = pk_bf16(v0[2], v0[3]); w.z = pk_bf16(v1[0], v1[1]); w.w = pk_bf16(v1[2], v1[3]);
                    *(u32x4*)(rp + bj * 128) = w;
                    if (u.pn == 1 && bj == 1 && wc == 1 && fq == 0) { float* f = ff32 + (size_t)row * 8; *(f32x4*)f = v0; *(f32x4*)(f + 4) = v1; } }
                if (u.pn < 2) {
                    const f32x4 a0 = acc[ai][0][m][0] * r_, a1 = acc[ai][0][m][1] * r_; float sq = (a0[0] * a0[0] + a0[1] * a0[1]) + (a0[2] * a0[2] + a0[3] * a0[3]) + (a1[0] * a1[0] + a1[1] * a1[1]) + (a1[2] * a1[2] + a1[3] * a1[3]);
                    if (u.pn == 0) { const f32x4 b0 = acc[ai][1][m][0] * r_, b1 = acc[ai][1][m][1] * r_; sq += (b0[0] * b0[0] + b0[1] * b0[1]) + (b0[2] * b0[2] + b0[3] * b0[3]) + (b1[0] * b1[0] + b1[1] * b1[1]) + (b1[2] * b1[2] + b1[3] * b1[3]); }
                    sq += __shfl_xor(sq, 16); sq += __shfl_xor(sq, 32);
                    if (fq == 0) atomicAdd(ssq + (u.pn == 0 ? 0 : NL * T_) + row, sq); } }
        return false;
    }
};

struct SchedUp { const char* P; const char* WQ; const char* WKV; int G, c;
    __device__ __forceinline__ bool next(int i, Unit& u) const {
        long L = (long)i * G + c; int pm, pn;
        if (G == 256) { if (c < 128 || i >= 4) return false; L = (long)i * 128 + (c - 128); }
        if (L < 256) { tile_at(L, 64, 4, pm, pn); u.A = P + (size_t)pm * 256 * NPROJ * 2 + 256 * 2; u.B = WKV + (size_t)pn * 256 * 256 * 2; u.kind = 1; }
        else { if (!tile_at(L - 256, 64, 3, pm, pn)) return false; u.A = P + (size_t)pm * 256 * NPROJ * 2; u.B = WQ + (size_t)pn * 256 * 256 * 2; u.kind = 0; }
        u.pm = pm; u.pn = pn; return true; }
};
struct SchedPlain { const char* A; size_t a_tile_bytes, a_batch_bytes; const char* B; size_t b_tile_bytes; int nN, G, c;
    __device__ __forceinline__ bool next(int i, Unit& u) const {
        int pm, pn; if (!tile_at((long)i * G + c, 64, nN, pm, pn)) return false;
        u.A = A + (size_t)(pm >> 3) * a_batch_bytes + (size_t)(pm & 7) * a_tile_bytes; u.B = B + (size_t)pn * b_tile_bytes; u.pm = pm; u.pn = pn; u.kind = 0; return true; }
};
struct EpiUp { static constexpr bool PERM = true; bf16_t* QUP; bf16_t* KM; bf16_t* VM; const float* ssq;
    __device__ __forceinline__ bool operator()(f32x4 (&acc)[2][2][4][2], const Unit& u, int wr, int wc, int fr, int fq) const {
        const int row0 = u.pm * 256 + wr * 64 + fr, col0 = u.pn * 256 + wc * 32 + 8 * fq;
        float rs[2][4];
#pragma unroll
        for (int ai = 0; ai < 2; ++ai)
#pragma unroll
            for (int m = 0; m < 4; ++m) rs[ai][m] = ssq[(u.kind ? NL * T_ : 0) + row0 + ai * 128 + m * 16];
        const float inv = u.kind ? (1.f / 128) : (1.f / 256);
        bf16_t* dbase[2]; int dstr[2];
#pragma unroll
        for (int bj = 0; bj < 2; ++bj) { const int col = col0 + bj * 128;
            if (u.kind == 0) { dbase[bj] = QUP + col; dstr[bj] = 768; }
            else { const int hd = col >> 7, d = col & 127; if (d < 64) { dbase[bj] = KM + 96 * hd + d; dstr[bj] = 768; } else { dbase[bj] = VM + 64 * hd + (d - 64); dstr[bj] = 512; } } }
#pragma unroll
        for (int ai = 0; ai < 2; ++ai)
#pragma unroll
            for (int m = 0; m < 4; ++m) { const int row = row0 + ai * 128 + m * 16; const float r_ = rsqrtf(rs[ai][m] * inv + EPS);
#pragma unroll
                for (int bj = 0; bj < 2; ++bj) { const f32x4 v0 = acc[ai][bj][m][0] * r_, v1 = acc[ai][bj][m][1] * r_;
                    u32x4 w; w.x = pk_bf16(v0[0], v0[1]); w.y = pk_bf16(v0[2], v0[3]); w.z = pk_bf16(v1[0], v1[1]); w.w = pk_bf16(v1[2], v1[3]);
                    *(u32x4*)(dbase[bj] + (size_t)row * dstr[bj]) = w; } }
        return false;
    }
};
struct SchedGate { const char* ws; int l, G, c;
    __device__ __forceinline__ bool next(int i, Unit& u) const {
        const char* XG = ws + WS_XG; const char* WIN = ws + WS_WIN + (size_t)l * 2 * NIN * 512 * 2; const char* Z = ws + WS_Z; const char* WGLU = ws + WS_WGLU + (size_t)l * 512 * 512 * 2;
        int pm, pn, j;
        if (G == 256) {
            const int x = c & 7, k = c >> 3;
            if (k < 16) { if (i >= 4) return false; pm = 8 * x + (k >> 1); pn = 2 * (k & 1) + (i >> 1); j = i & 1; }
            else { if (i >= 3) return false; const int kk = k - 16; pm = 8 * x + (kk >> 1); pn = 4 + (kk & 1); j = i - 1; }
        } else {
            int Gv = G; asm volatile("" : "+s"(Gv));
            const int t3 = (128 - c + Gv - 1) / Gv;
            const int ns5 = (c < 128) ? t3 : 0;
            if (i < 3 * ns5) { const int m = c + (i / 3) * G; pm = m >> 1; pn = 4 + (m & 1); j = i % 3 - 1; }
            else { const int i2 = i - 3 * ns5; const long n = (long)(i2 >> 1) * G + c; if (n >= 256) return false; pm = (int)(n >> 2); pn = (int)(n & 3); j = i2 & 1; }
        }
        if (j < 0) { u.A = Z + (size_t)pm * 256 * 512 * 2; u.B = WGLU + (size_t)(pn & 1) * 256 * 512 * 2; u.kind = 2; }
        else { u.A = XG + ((size_t)j * T_ + (size_t)pm * 256) * 512 * 2; u.B = WIN + ((size_t)j * NIN + 2560 + (size_t)pn * 256) * 512 * 2; u.kind = j; }
        u.pm = pm; u.pn = pn; return true;
    }
};
struct EpiGate { static constexpr bool PERM = true; unsigned char* ws; const float* bias; int l;
    __device__ __forceinline__ bool operator()(f32x4 (&acc)[2][2][4][2], const Unit& u, int wr, int wc, int fr, int fq) const {
        if (u.kind == 0) return true;
        bf16_t* P = (bf16_t*)(ws + WS_PROJ); const bf16_t* QUP = (const bf16_t*)(ws + WS_QUP); const bf16_t* Z = (const bf16_t*)(ws + WS_Z); bf16_t* ABO = (bf16_t*)(ws + WS_KVUP); const float* ss = (const float*)(ws + WS_SS) + (size_t)l * T_;
        const int br = u.pn >> 1;
        const int row0 = u.pm * 256 + wr * 64 + fr, c0 = (u.pn & 1) * 256 + wc * 32 + 8 * fq;
        if (u.kind == 2) {
            f32x4 bv[2][2];
#pragma unroll
            for (int bj = 0; bj < 2; ++bj) { bv[bj][0] = *(const f32x4*)(bias + c0 + bj * 128); bv[bj][1] = *(const f32x4*)(bias + c0 + bj * 128 + 4); }
#pragma unroll
            for (int ai = 0; ai < 2; ++ai) {
                u32x4 yv[4][2];
#pragma unroll
                for (int m = 0; m < 4; ++m)
#pragma unroll
                    for (int bj = 0; bj < 2; ++bj) yv[m][bj] = *(const u32x4*)(Z + (size_t)(row0 + ai * 128 + m * 16) * 512 + c0 + bj * 128);
#pragma unroll
                for (int m = 0; m < 4; ++m) { const int row = row0 + ai * 128 + m * 16;
#pragma unroll
                    for (int bj = 0; bj < 2; ++bj) { const int c = c0 + bj * 128; const f32x4 v0 = acc[ai][bj][m][0] + bv[bj][0], v1 = acc[ai][bj][m][1] + bv[bj][1];
                        const u32x4 z = yv[m][bj];
                        u32x4 w;
                        w.x = pk_bf16(bf_lo(z.x) * sigmoidf_(v0[0]), bf_hi(z.x) * sigmoidf_(v0[1]));
                        w.y = pk_bf16(bf_lo(z.y) * sigmoidf_(v0[2]), bf_hi(z.y) * sigmoidf_(v0[3]));
                        w.z = pk_bf16(bf_lo(z.z) * sigmoidf_(v1[0]), bf_hi(z.z) * sigmoidf_(v1[1]));
                        w.w = pk_bf16(bf_lo(z.w) * sigmoidf_(v1[2]), bf_hi(z.w) * sigmoidf_(v1[3]));
                        *(u32x4*)(P + (size_t)row * NPROJ + c) = w; } }
            }
            return false;
        }
        const unsigned abo2 = (br == 2) ? (unsigned)(u.pm >> 3) * (512u << 10) : 0u;
        float rs[2][4];
#pragma unroll
        for (int ai = 0; ai < 2; ++ai)
#pragma unroll
            for (int m = 0; m < 4; ++m) rs[ai][m] = ss[row0 + ai * 128 + m * 16];
#pragma unroll
        for (int ai = 0; ai < 2; ++ai) {
            u32x4 yv[4][2];
#pragma unroll
            for (int m = 0; m < 4; ++m) { const int row = row0 + ai * 128 + m * 16;
#pragma unroll
                for (int bj = 0; bj < 2; ++bj) { const int c = c0 + bj * 128;
                    const bf16_t* ysrc = (br == 0) ? (QUP + (size_t)row * 768 + 96 * (c >> 6) + (c & 63)) : (br == 1) ? (P + (size_t)row * NPROJ + 512 + c) : (P + (size_t)row * NPROJ + c);
                    yv[m][bj] = *(const u32x4*)ysrc; } }
#pragma unroll
            for (int m = 0; m < 4; ++m) { const int row = row0 + ai * 128 + m * 16; const float r_ = rsqrtf(rs[ai][m] * (1.f / DM) + EPS);
#pragma unroll
                for (int bj = 0; bj < 2; ++bj) { const int c = c0 + bj * 128;
                    const u32x4 y = yv[m][bj];
                    const f32x4 v0 = acc[ai][bj][m][0] * r_, v1 = acc[ai][bj][m][1] * r_;
                    u32x4 w;
                    w.x = pk_bf16(bf_lo(y.x) * siluf_(v0[0]), bf_hi(y.x) * siluf_(v0[1]));
                    w.y = pk_bf16(bf_lo(y.y) * siluf_(v0[2]), bf_hi(y.y) * siluf_(v0[3]));
                    w.z = pk_bf16(bf_lo(y.z) * siluf_(v1[0]), bf_hi(y.z) * siluf_(v1[1]));
                    w.w = pk_bf16(bf_lo(y.w) * siluf_(v1[2]), bf_hi(y.w) * siluf_(v1[3]));
                    *(u32x4*)(ABO + ((size_t)br * T_ + row) * 512 + abo2 + c) = w; } }
        }
        return false;
    }
};
enum { MOP_KEEP = 0, MOP_STORE_O = 1, MOP_GATE_RMW = 2, MOP_STORE_S = 3, MOP_O_RMW = 4, MOP_FIRST = 8 };
struct SchedMerge { const char* ws; int l, G, c;
    __device__ __forceinline__ bool next(int i, Unit& u) const {
        const char* ABO = ws + WS_KVUP; const char* WBO = ws + WS_WBO + (size_t)l * 3 * 1024 * 512 * 2; const char* XG = ws + WS_XG; const char* WIN = ws + WS_WIN + (size_t)l * 2 * NIN * 512 * 2;
        int pm, pn; if (!tile_at((long)(i / 9) * G + c, 64, 4, pm, pn)) return false;
        const int j = i % 9; int typ, br, h = 0, op;
        if (G != 256 || !(c & 1)) { br = j / 3; const int s_ = j % 3; typ = s_ != 0; h = s_ - 1; op = s_ == 0 ? MOP_STORE_O : s_ == 1 ? MOP_KEEP : (MOP_GATE_RMW | (br == 0 ? MOP_FIRST : 0)); }
        else if (j < 2) { typ = 1; br = 2; h = j; op = j ? MOP_STORE_S : MOP_KEEP; }
        else { const int jj = j - 2, g = jj / 3, r = jj % 3; br = g;
            if (g == 2) { typ = 0; op = MOP_O_RMW; }
            else if (r == 0) { typ = 0; op = MOP_STORE_O; }
            else { typ = 1; h = r - 1; op = r == 1 ? MOP_KEEP : (MOP_GATE_RMW | (g == 0 ? MOP_FIRST : 0)); } }
        if (typ == 0) { u.A = ABO + ((size_t)br * T_ + (size_t)pm * 256) * 512 * 2 + (br == 2 ? (size_t)(pm >> 3) << 20 : 0); u.B = WBO + ((size_t)br * 1024 + (size_t)pn * 256) * 512 * 2; }
        else { u.A = XG + ((size_t)h * T_ + (size_t)pm * 256) * 512 * 2; u.B = WIN + ((size_t)h * NIN + 4096 + (size_t)br * 1024 + (size_t)pn * 256) * 512 * 2; }
        u.pm = pm; u.pn = pn; u.kind = op; return true;
    }
};
struct EpiMerge { static constexpr bool PERM = true; unsigned char* ws; int l, bid;
    __device__ __forceinline__ bf16_t* scr2() const { unsigned b_ = (unsigned)bid; asm volatile("" : "+s"(b_)); const unsigned sb = b_ & 7u, sk = (b_ >> 3) & 31u;
        return (bf16_t*)(ws + (sk < 16u ? (unsigned)WS_Z + sb * (2u << 20) + sk * 131072u : (unsigned)WS_PROJ + sb * (10u << 20) + (8u << 20) + (sk - 16u) * 131072u)); }
    __device__ __forceinline__ bool operator()(f32x4 (&acc)[2][2][4][2], const Unit& u, int wr, int wc, int fr, int fq) const {
        const int op = u.kind & 7; const bool first = (u.kind & MOP_FIRST) != 0;
        if (op == MOP_KEEP) return true;
        bf16_t* OSCR = (bf16_t*)(ws + WS_PROJ) + (unsigned)(u.pm >> 3) * (3u << 20); bf16_t* MERGED = OSCR + (size_t)S_ * 1024; const float* ss = (const float*)(ws + WS_SS) + (size_t)l * T_;
        const int rt0 = wr * 64 + fr, ct0 = wc * 32 + 8 * fq;
        const int row0 = u.pm * 256 + rt0, col0 = u.pn * 256 + ct0;
        if (op == MOP_STORE_O) {
#pragma unroll
            for (int ai = 0; ai < 2; ++ai)
#pragma unroll
                for (int m = 0; m < 4; ++m) { const size_t off = (size_t)(row0 + ai * 128 + m * 16) * 1024 + col0;
#pragma unroll
                    for (int bj = 0; bj < 2; ++bj) { const f32x4 v0 = acc[ai][bj][m][0], v1 = acc[ai][bj][m][1];
                        u32x4 w; w.x = pk_bf16(v0[0], v0[1]); w.y = pk_bf16(v0[2], v0[3]); w.z = pk_bf16(v1[0], v1[1]); w.w = pk_bf16(v1[2], v1[3]);
                        *(u32x4*)(OSCR + off + bj * 128) = w; } }
            return false;
        }
        if (op == MOP_O_RMW) {
            bf16_t* SCR2 = scr2();
#pragma unroll
            for (int qd = 0; qd < 4; ++qd) { const int ai = qd >> 1, m0 = (qd & 1) * 2;
                u32x4 sv[2][2], pv[2][2];
#pragma unroll
                for (int mm = 0; mm < 2; ++mm) { const int rr = ai * 128 + (m0 + mm) * 16; const size_t off = (size_t)(row0 + rr) * 1024 + col0;
#pragma unroll
                    for (int bj = 0; bj < 2; ++bj) { sv[mm][bj] = *(const u32x4*)(SCR2 + (size_t)(rt0 + rr) * 256 + ct0 + bj * 128); pv[mm][bj] = *(const u32x4*)(MERGED + off + bj * 128); } }
#pragma unroll
                for (int mm = 0; mm < 2; ++mm) { const int m = m0 + mm; const size_t off = (size_t)(row0 + ai * 128 + m * 16) * 1024 + col0;
#pragma unroll
                    for (int bj = 0; bj < 2; ++bj) { const f32x4 v0 = acc[ai][bj][m][0], v1 = acc[ai][bj][m][1]; const u32x4 g = sv[mm][bj], p = pv[mm][bj];
                        u32x4 w;
                        w.x = pk_bf16(bf_lo(p.x) + bf_lo(g.x) * v0[0], bf_hi(p.x) + bf_hi(g.x) * v0[1]); w.y = pk_bf16(bf_lo(p.y) + bf_lo(g.y) * v0[2], bf_hi(p.y) + bf_hi(g.y) * v0[3]);
                        w.z = pk_bf16(bf_lo(p.z) + bf_lo(g.z) * v1[0], bf_hi(p.z) + bf_hi(g.z) * v1[1]); w.w = pk_bf16(bf_lo(p.w) + bf_lo(g.w) * v1[2], bf_hi(p.w) + bf_hi(g.w) * v1[3]);
                        *(u32x4*)(MERGED + off + bj * 128) = w; } }
            }
            return false;
        }
        if (op == MOP_STORE_S) {
            bf16_t* SCR2 = scr2();
            float rs[2][4];
#pragma unroll
            for (int ai = 0; ai < 2; ++ai)
#pragma unroll
                for (int m = 0; m < 4; ++m) rs[ai][m] = ss[row0 + ai * 128 + m * 16];
#pragma unroll
            for (int ai = 0; ai < 2; ++ai)
#pragma unroll
                for (int m = 0; m < 4; ++m) { const int rr = ai * 128 + m * 16; const float r_ = rsqrtf(rs[ai][m] * (1.f / DM) + EPS);
#pragma unroll
                    for (int bj = 0; bj < 2; ++bj) { const f32x4 v0 = acc[ai][bj][m][0] * r_, v1 = acc[ai][bj][m][1] * r_;
                        u32x4 w; w.x = pk_bf16(sigmoidf_(v0[0]), sigmoidf_(v0[1])); w.y = pk_bf16(sigmoidf_(v0[2]), sigmoidf_(v0[3])); w.z = pk_bf16(sigmoidf_(v1[0]), sigmoidf_(v1[1])); w.w = pk_bf16(sigmoidf_(v1[2]), sigmoidf_(v1[3]));
                        *(u32x4*)(SCR2 + (size_t)(rt0 + rr) * 256 + ct0 + bj * 128) = w; } }
            return false;
        }
#pragma unroll
        for (int ai = 0; ai < 2; ++ai)
#pragma unroll
            for (int m = 0; m < 4; ++m) { const size_t off = (size_t)(row0 + ai * 128 + m * 16) * 1024 + col0;
                u32x4 ov[2], pv[2]; const float rq_ = ss[row0 + ai * 128 + m * 16];
#pragma unroll
                for (int bj = 0; bj < 2; ++bj) { ov[bj] = *(const u32x4*)(OSCR + off + bj * 128); pv[bj] = (u32x4){0u, 0u, 0u, 0u}; if (!first) pv[bj] = *(const u32x4*)(MERGED + off + bj * 128); }
                const float r_ = rsqrtf(rq_ * (1.f / DM) + EPS);
#pragma unroll
                for (int bj = 0; bj < 2; ++bj) { const f32x4 v0 = acc[ai][bj][m][0] * r_, v1 = acc[ai][bj][m][1] * r_;
                    const u32x4 o = ov[bj], p = pv[bj];
                    u32x4 w;
                    w.x = pk_bf16(bf_lo(p.x) + bf_lo(o.x) * sigmoidf_(v0[0]), bf_hi(p.x) + bf_hi(o.x) * sigmoidf_(v0[1]));
                    w.y = pk_bf16(bf_lo(p.y) + bf_lo(o.y) * sigmoidf_(v0[2]), bf_hi(p.y) + bf_hi(o.y) * sigmoidf_(v0[3]));
                    w.z = pk_bf16(bf_lo(p.z) + bf_lo(o.z) * sigmoidf_(v1[0]), bf_hi(p.z) + bf_hi(o.z) * sigmoidf_(v1[1]));
                    w.w = pk_bf16(bf_lo(p.w) + bf_lo(o.w) * sigmoidf_(v1[2]), bf_hi(p.w) + bf_hi(o.w) * sigmoidf_(v1[3]));
                    *(u32x4*)(MERGED + off + bj * 128) = w; } }
        return false;
    }
};
struct EpiOut { static constexpr bool PERM = false; const float* xres; float* out; bf16_t* XG; float* ssn; bool dry;
    __device__ __forceinline__ bool operator()(f32x4 (&acc)[2][2][4][2], const Unit& u, int wr, int wc, int fr, int fq) const {
        const int row0 = u.pm * 256 + wr * 64 + fr, col0 = u.pn * 256 + wc * 32 + 4 * fq;
#pragma unroll
        for (int qd = 0; qd < 4; ++qd) { const int ai = qd >> 1, m0 = (qd & 1) * 2;
            f32x4 xr[2][2][2];
            if (xres) {
#pragma unroll
                for (int mm = 0; mm < 2; ++mm) { const size_t off = (size_t)(row0 + ai * 128 + (m0 + mm) * 16) * DM + col0;
#pragma unroll
                    for (int bj = 0; bj < 2; ++bj)
#pragma unroll
                        for (int n = 0; n < 2; ++n) xr[mm][bj][n] = *(const f32x4*)(xres + off + bj * 128 + n * 16); }
            } else {
                u32x2 xb[2][2][2];
#pragma unroll
                for (int mm = 0; mm < 2; ++mm) { const int row = row0 + ai * 128 + (m0 + mm) * 16;
#pragma unroll
                    for (int bj = 0; bj < 2; ++bj)
#pragma unroll
                        for (int n = 0; n < 2; ++n) { const int col = col0 + bj * 128 + n * 16; xb[mm][bj][n] = *(const u32x2*)(XG + ((size_t)(col >> 9) * T_ + row) * 512 + (col & 511)); } }
#pragma unroll
                for (int mm = 0; mm < 2; ++mm)
#pragma unroll
                    for (int bj = 0; bj < 2; ++bj)
#pragma unroll
                        for (int n = 0; n < 2; ++n) { const u32x2 b = xb[mm][bj][n]; xr[mm][bj][n] = (f32x4){bf_lo(b.x), bf_hi(b.x), bf_lo(b.y), bf_hi(b.y)}; }
            }
#pragma unroll
            for (int mm = 0; mm < 2; ++mm) { const int m = m0 + mm; const int row = row0 + ai * 128 + m * 16; const size_t off = (size_t)row * DM + col0; float sq = 0.f;
#pragma unroll
                for (int bj = 0; bj < 2; ++bj)
#pragma unroll
                    for (int n = 0; n < 2; ++n) { const int cc = bj * 128 + n * 16; const f32x4 o = xr[mm][bj][n] + acc[ai][bj][m][n];
                        if (!ssn && !dry) *(f32x4*)(out + off + cc) = o;
                        if (ssn && !dry) { const int col = col0 + cc; sq += (o[0] * o[0] + o[1] * o[1]) + (o[2] * o[2] + o[3] * o[3]);
                            u32x2 w; w.x = pk_bf16(o[0], o[1]); w.y = pk_bf16(o[2], o[3]);
                            *(u32x2*)(XG + ((size_t)(col >> 9) * T_ + row) * 512 + (col & 511)) = w; } }
                if (ssn && !dry) { sq += __shfl_xor(sq, 16); sq += __shfl_xor(sq, 32); if (fq == 0) atomicAdd(ssn + row, sq); } }
        }
        return false;
    }
};

namespace attn {
constexpr int QBLK = 32, KVBLK = 64;
constexpr int SHM_K = KVBLK * 256, SHM_V = KVBLK * 64 * 2;
constexpr int NBUF = 3;
constexpr int LDS_V = 0, LDS_K = NBUF * SHM_V, LDS_CK = LDS_K + NBUF * SHM_K, LDS_WS = LDS_CK + NBUF * 256, LDS_OST = LDS_WS + 8 * 256, LDS_BYTES = LDS_OST + 8 * 4096;
constexpr float THR2 = 8.f;
#define KSWZ(row, colB) ((row) * 256 + ((colB) ^ (((row) & 15) << 4)))
__device__ __forceinline__ int crow(int r, int hi) { return (r & 3) + 8 * (r >> 2) + 4 * hi; }
__device__ __forceinline__ void partialSM(f32x16& p0, f32x16& p1, float& m_reg, float& alpha) {
    float pmax = p0[0];
#pragma unroll
    for (int r = 1; r < 16; ++r) pmax = fmaxf(pmax, p0[r]);
#pragma unroll
    for (int r = 0; r < 16; ++r) pmax = fmaxf(pmax, p1[r]);
    { auto rr = __builtin_amdgcn_permlane32_swap(__float_as_uint(pmax), __float_as_uint(pmax), false, false);
      pmax = fmaxf(__uint_as_float(rr[0]), __uint_as_float(rr[1])); }
    if (__builtin_expect(__all(pmax <= THR2), 1)) { alpha = 1.f; }
    else { const float dl = fmaxf(pmax, 0.f); m_reg += dl; alpha = __builtin_amdgcn_exp2f(-dl);
#pragma unroll
        for (int r = 0; r < 16; ++r) { p0[r] -= dl; p1[r] -= dl; } }
#pragma unroll
    for (int r = 0; r < 16; ++r) p0[r] = __builtin_amdgcn_exp2f(p0[r]);
}
__device__ __forceinline__ void finishSM(f32x16& p0, f32x16& p1, float alpha, float& l_reg, bf16x8& pa0, bf16x8& pa1, bf16x8& pa2, bf16x8& pa3) {
#pragma unroll
    for (int r = 0; r < 16; ++r) p1[r] = __builtin_amdgcn_exp2f(p1[r]);
    float ps = 0;
#pragma unroll
    for (int r = 0; r < 16; ++r) ps += p0[r];
#pragma unroll
    for (int r = 0; r < 16; ++r) ps += p1[r];
    { auto rr = __builtin_amdgcn_permlane32_swap(__float_as_uint(ps), __float_as_uint(ps), false, false);
      ps = __uint_as_float(rr[0]) + __uint_as_float(rr[1]); }
    l_reg = l_reg * alpha + ps;
#define PK4(P, BASE, OUT) do { unsigned a0 = pk_bf16(P[BASE + 0], P[BASE + 1]), a1 = pk_bf16(P[BASE + 2], P[BASE + 3]);   \
    unsigned b0 = pk_bf16(P[BASE + 4], P[BASE + 5]), b1 = pk_bf16(P[BASE + 6], P[BASE + 7]);                              \
    auto r0 = __builtin_amdgcn_permlane32_swap(a0, b0, false, false); auto r1 = __builtin_amdgcn_permlane32_swap(a1, b1, false, false); \
    u32x4 w = {r0[0], r1[0], r0[1], r1[1]}; OUT = __builtin_bit_cast(bf16x8, w); } while (0)
    PK4(p0, 0, pa0); PK4(p0, 8, pa1); PK4(p1, 0, pa2); PK4(p1, 8, pa3);
#undef PK4
}
__device__ __forceinline__ int v_st(int k, int c) { const int kk = (k & ~0xC) | ((k & 4) << 1) | ((k & 8) >> 1); return ((kk >> 3) * 2 + (c >> 5)) * 512 + ((kk & 7) * 32 + (c & 31)) * 2; }
__device__ __forceinline__ int v_rd_base(int lane) { return ((lane & 3) << 3) | (((lane >> 2) & 3) << 6) | (((lane >> 4) & 1) << 5) | (((lane >> 5) & 1) << 8); }
constexpr int v_rd_off(int d0, int ks, int half) { return d0 * 512 + ks * 2048 + half * 1024; }
template <int OFF> __device__ __forceinline__ s16x4 tr_read(int vb) {
    s16x4 r; asm volatile("ds_read_b64_tr_b16 %0, %1 offset:%2" : "=&v"(r) : "v"(vb), "i"(OFF) : "memory"); return r;
}
template <int D0> __device__ __forceinline__ void pv_one(f32x16& od, int vb, bf16x8 pa0, bf16x8 pa1, bf16x8 pa2, bf16x8 pa3) {
    const s16x4 l0 = tr_read<v_rd_off(D0, 0, 0)>(vb), h0 = tr_read<v_rd_off(D0, 0, 1)>(vb), l1 = tr_read<v_rd_off(D0, 1, 0)>(vb), h1 = tr_read<v_rd_off(D0, 1, 1)>(vb);
    const s16x4 l2 = tr_read<v_rd_off(D0, 2, 0)>(vb), h2 = tr_read<v_rd_off(D0, 2, 1)>(vb), l3 = tr_read<v_rd_off(D0, 3, 0)>(vb), h3 = tr_read<v_rd_off(D0, 3, 1)>(vb);
    asm volatile("s_waitcnt lgkmcnt(0)" ::: "memory"); SBAR();
#define PKV(L, H) (bf16x8){L[0], L[1], L[2], L[3], H[0], H[1], H[2], H[3]}
    od = __builtin_amdgcn_mfma_f32_32x32x16_bf16(pa0, PKV(l0, h0), od, 0, 0, 0);
    od = __builtin_amdgcn_mfma_f32_32x32x16_bf16(pa1, PKV(l1, h1), od, 0, 0, 0);
    od = __builtin_amdgcn_mfma_f32_32x32x16_bf16(pa2, PKV(l2, h2), od, 0, 0, 0);
    od = __builtin_amdgcn_mfma_f32_32x32x16_bf16(pa3, PKV(l3, h3), od, 0, 0, 0);
#undef PKV
}

template <int DQK, bool FOX>
__device__ __forceinline__ void attn_unit(bf16_t* Qh, int ldq, const bf16_t* Kh, int ldk, const bf16_t* Vh, int ldv, const float* cum, int q0, char* lds, bool dry, float sbound, int T0) {
    constexpr int ND = DQK / 16, KCH = DQK / 8;
    int tid = threadIdx.x; asm volatile("" : "+v"(tid));
    const int wid = __builtin_amdgcn_readfirstlane(tid >> 6), lane = tid & 63, r32 = lane & 31, hi = lane >> 5;
    char* V_lds = lds + LDS_V; char* K_lds = lds + LDS_K; float* CK_lds = (float*)(lds + LDS_CK);
    float* ws = (float*)(lds + LDS_WS) + wid * 64; float* li_l = ws; float* al_l = ws + 32;
    float m_reg = 0.f, l_reg = 0; f32x16 o[2]; o[0] = f32x16{}; o[1] = f32x16{}; bf16x8 qr[ND];
    const int qrow = q0 + wid * QBLK + r32;
    { const bf16_t* Qw = Qh + (size_t)qrow * ldq + hi * 8;
#pragma unroll
      for (int d0 = 0; d0 < ND; ++d0) qr[d0] = *reinterpret_cast<const bf16x8*>(Qw + d0 * 16); }
    float cq = 0.f; if (FOX) cq = cum[qrow];
    const int kr0 = tid / KCH, kc0 = tid % KCH;
    const int kr1 = (tid + 512) / KCH, kc1 = (tid + 512) % KCH;
    const bool k2 = (KCH * 64 > 512) && (tid + 512 < KCH * 64);
    const int vr = tid >> 3, vc = (tid & 7) * 8, vst = v_st(vr, vc);
    const int vb0 = (int)(uintptr_t)V_lds + v_rd_base(lane);
    struct Stg { bf16x8 k0, k1, v; f32x4 ck; } st[2];
    const int kr1c = (kr1 < 64) ? kr1 : 63;
    const int ckc = (tid & 15) * 4;
#define SLOAD(i, k0_) do { st[i].k0 = *reinterpret_cast<const bf16x8*>(Kh + (size_t)((k0_) + kr0) * ldk + kc0 * 8); \
      if (KCH * 64 > 512) st[i].k1 = *reinterpret_cast<const bf16x8*>(Kh + (size_t)((k0_) + kr1c) * ldk + kc1 * 8); \
      st[i].v = *reinterpret_cast<const bf16x8*>(Vh + (size_t)((k0_) + vr) * ldv + vc); \
      if (FOX) st[i].ck = *reinterpret_cast<const f32x4*>(cum + (k0_) + ckc); } while (0)
#define SWRITE(b, i) do { *(bf16x8*)(K_lds + (b) * SHM_K + KSWZ(kr0, kc0 * 16)) = st[i].k0; \
      if (k2) *(bf16x8*)(K_lds + (b) * SHM_K + KSWZ(kr1, kc1 * 16)) = st[i].k1; \
      *(bf16x8*)(V_lds + (b) * SHM_V + vst) = st[i].v; \
      if (FOX && tid < 16) *(f32x4*)(CK_lds + (b) * 64 + tid * 4) = st[i].ck; } while (0)
#define RESC(a) do { if (__any((a) < 1.f)) { if (hi == 0) al_l[r32] = (a); asm volatile("s_waitcnt lgkmcnt(0)" ::: "memory"); \
      _Pragma("unroll") for (int d = 0; d < 2; ++d) _Pragma("unroll") for (int r = 0; r < 16; ++r) o[d][r] *= al_l[crow(r, hi)]; } } while (0)
    const int NT = (q0 + 256) / KVBLK;
    const int tlast = __builtin_amdgcn_readfirstlane((q0 + wid * QBLK + (FOX ? 31 : 0)) >> 6);
    int tfirst = 0;
    if (FOX) { const float c0w = cum[q0 + wid * QBLK]; bool need = false; const int nbw = (q0 + wid * QBLK) >> 6;
        if (lane < nbw) need = (sbound + c0w - cum[64 * lane + 63] >= -40.f);
        const unsigned long long bal = __ballot(need);
        tfirst = __builtin_amdgcn_readfirstlane(bal ? (__ffsll((long long)bal) - 1) : nbw); }
    auto qkt = [&](f32x16& p0, f32x16& p1, int b, int t) {
        if (t > tlast || t < tfirst) return;
        const char* Ks = K_lds + b * SHM_K;
        if (FOX) { const float* ck = CK_lds + b * 64; const float cqm = cq - m_reg;
#pragma unroll
            for (int g = 0; g < 4; ++g) { const f32x4 c0 = *(const f32x4*)(ck + 8 * g + 4 * hi), c1 = *(const f32x4*)(ck + 32 + 8 * g + 4 * hi);
#pragma unroll
                for (int i = 0; i < 4; ++i) { p0[4 * g + i] = cqm - c0[i]; p1[4 * g + i] = cqm - c1[i]; } }
        } else { const float nm = -m_reg;
#pragma unroll
            for (int r = 0; r < 16; ++r) { p0[r] = nm; p1[r] = nm; } }
#pragma unroll
        for (int d0 = 0; d0 < ND; ++d0) { const int cb = (d0 * 16 + hi * 8) * 2;
            const bf16x8 b0 = *reinterpret_cast<const bf16x8*>(Ks + KSWZ(r32, cb));
            const bf16x8 b1 = *reinterpret_cast<const bf16x8*>(Ks + KSWZ(32 + r32, cb));
            p0 = __builtin_amdgcn_mfma_f32_32x32x16_bf16(b0, qr[d0], p0, 0, 0, 0);
            p1 = __builtin_amdgcn_mfma_f32_32x32x16_bf16(b1, qr[d0], p1, 0, 0, 0); }
        if (FOX && t >= NT - 4) {
            asm volatile("" ::: "memory");
            const int kb = t * KVBLK + 4 * hi;
#pragma unroll
            for (int r = 0; r < 16; ++r) { const int kv = kb + (r & 3) + 8 * (r >> 2);
                if (kv > qrow) p0[r] = -INFINITY; if (kv + 32 > qrow) p1[r] = -INFINITY; }
        }
    };
#define PSM(P0, P1, AL, t) do { if ((t) <= tlast && (t) >= tfirst) partialSM(P0, P1, m_reg, AL); else AL = 1.f; } while (0)
#define FSM(P0, P1, AL, t) do { if ((t) <= tlast && (t) >= tfirst) finishSM(P0, P1, AL, l_reg, pa0, pa1, pa2, pa3); } while (0)
#define PV(vb, t) do { if ((t) <= tlast && (t) >= tfirst) { pv_one<0>(o[0], vb, pa0, pa1, pa2, pa3); pv_one<1>(o[1], vb, pa0, pa1, pa2, pa3); } } while (0)
    f32x16 pA0, pA1, pB0, pB1; float alA, alB; bf16x8 pa0, pa1, pa2, pa3;
    SLOAD(0, T0 * KVBLK); SWRITE(0, 0); __syncthreads();
    qkt(pA0, pA1, 0, T0); PSM(pA0, pA1, alA, T0);
    SLOAD(1, (T0 + 1) * KVBLK); SLOAD(0, (T0 + 2) * KVBLK);
    SWRITE(1, 1); __syncthreads();
    int bp = 0, bc = 1, bn = 2;
    for (int j = T0 + 1; j + 1 < NT; j += 2) {
        SBAR(); qkt(pB0, pB1, bc, j);
        FSM(pA0, pA1, alA, j - 1); SBAR();
        SLOAD(1, (j + 2) * KVBLK); SBAR();
        PV(vb0 + bp * SHM_V, j - 1); PSM(pB0, pB1, alB, j);
        SWRITE(bn, 0);
        RESC(alB); __syncthreads();
        { const int t_ = bp; bp = bc; bc = bn; bn = t_; }
        SBAR(); qkt(pA0, pA1, bc, j + 1);
        FSM(pB0, pB1, alB, j); SBAR();
        if (j + 3 < NT) SLOAD(0, (j + 3) * KVBLK); SBAR();
        PV(vb0 + bp * SHM_V, j); PSM(pA0, pA1, alA, j + 1);
        SWRITE(bn, 1);
        RESC(alA); __syncthreads();
        { const int t_ = bp; bp = bc; bc = bn; bn = t_; }
    }
    SBAR(); qkt(pB0, pB1, bc, NT - 1);
    FSM(pA0, pA1, alA, NT - 2); SBAR();
    PV(vb0 + bp * SHM_V, NT - 2); PSM(pB0, pB1, alB, NT - 1);
    RESC(alB);
    FSM(pB0, pB1, alB, NT - 1); SBAR();
    PV(vb0 + bc * SHM_V, NT - 1);
#undef PSM
#undef FSM
#undef PV
    if (hi == 0) li_l[r32] = l_reg; asm volatile("s_waitcnt lgkmcnt(0)" ::: "memory");
    float rli[16];
#pragma unroll
    for (int r = 0; r < 16; ++r) rli[r] = __builtin_amdgcn_rcpf(li_l[crow(r, hi)]);
    { bf16_t* stg = (bf16_t*)(lds + LDS_OST) + wid * 2048;
#pragma unroll
      for (int r = 0; r < 16; ++r) { const int orow = crow(r, hi);
#pragma unroll
          for (int d0 = 0; d0 < 2; ++d0) stg[orow * 64 + d0 * 32 + r32] = f2bf(o[d0][r] * rli[r]); }
      asm volatile("s_waitcnt lgkmcnt(0)" ::: "memory");
      bf16_t* Ow = Qh + (size_t)(q0 + wid * QBLK) * ldq;
#pragma unroll
      for (int i = 0; i < 4; ++i) { const int row = i * 8 + (lane >> 3), ch = lane & 7; const u32x4 v = *(const u32x4*)(stg + row * 64 + ch * 8); if (!dry) *(u32x4*)(Ow + (size_t)row * ldq + ch * 8) = v; } }
    __syncthreads();
#undef SLOAD
#undef SWRITE
#undef RESC
}
}

__device__ __forceinline__ int map_in(int n) {
    if (n < 416) return n;
    if (n < 424) return 1952 + (n - 416);
    if (n < 512) return -1;
    if (n < 2048) return n - 512 + 416;
    if (n < 2560) return n - 2048 + 1960;
    if (n < 4096) return n - 2560 + 2472;
    return n - 4096 + 4008;
}
struct ConvD { const float* src; const float* kscale; bf16_t* dst; int ldsrc, K, N, dld, item; bool split512, mapped; };
__device__ __forceinline__ void conv_load(const ConvD& d, int lane, float (&x)[32], float& ks) {
    const int nblk = d.N / 32, kb = d.item / nblk, nb = d.item % nblk, k0 = 64 * kb, n0 = 32 * nb;
    const int sn = d.mapped ? map_in(n0 + (lane & 31)) : n0 + (lane & 31);
#pragma unroll
    for (int i = 0; i < 32; ++i) { const int kk = 2 * i + (lane >> 5); float v = 0.f; if (sn >= 0) v = d.src[(size_t)(k0 + kk) * d.ldsrc + sn]; x[i] = v; }
    ks = d.kscale ? d.kscale[k0 + lane] : 1.f;
}
__device__ __forceinline__ void conv_finish(const ConvD& d, LAS float* scr, int lane, const float (&x)[32], const float ks) {
    const int nblk = d.N / 32, kb = d.item / nblk, nb = d.item % nblk, k0 = 64 * kb, n0 = 32 * nb;
#pragma unroll
    for (int i = 0; i < 32; ++i) { const float s0 = __uint_as_float(__builtin_amdgcn_readlane(__float_as_uint(ks), 2 * i)), s1 = __uint_as_float(__builtin_amdgcn_readlane(__float_as_uint(ks), 2 * i + 1));
        scr[(2 * i + (lane >> 5)) * 33 + (lane & 31)] = x[i] * ((lane >> 5) ? s1 : s0); }
    asm volatile("s_waitcnt lgkmcnt(0)" ::: "memory");
    const int cch = lane & 7;
#pragma unroll
    for (int j = 0; j < 4; ++j) { const int n = (lane >> 3) + 8 * j; const LAS float* sp = scr + (8 * cch) * 33 + n;
        u32x4 o; o.x = pk_bf16(sp[0 * 33], sp[1 * 33]); o.y = pk_bf16(sp[2 * 33], sp[3 * 33]); o.z = pk_bf16(sp[4 * 33], sp[5 * 33]); o.w = pk_bf16(sp[6 * 33], sp[7 * 33]);
        bf16_t* dp = d.split512 ? (d.dst + ((size_t)(k0 >> 9) * d.N + n0 + n) * 512 + (k0 & 511) + 8 * cch) : (d.dst + (size_t)(n0 + n) * d.dld + k0 + 8 * cch);
        *(u32x4*)dp = o; }
    asm volatile("s_waitcnt lgkmcnt(0)" ::: "memory");
}
__device__ __forceinline__ void phase0(const Ctx& c, const int part) {
    PHASE_IDS(); ArgsP ap = get_args(); unsigned char* ws = ap->ws;
    const long gtid = (long)c.bid * 512 + tid, gthreads = (long)grid_g() * 512;
    const int gw = c.bid * 8 + wave, ngw = grid_g() * 8;
    LAS float* scr = (LAS float*)(c.lds + wave * 8448);
    constexpr int I_IN_ = 16 * 224, I_Q_ = 4 * 24, I_KV_ = 2 * 32, I_GLU_ = 8 * 16, I_BO_ = 8 * 32, I_OUT_ = 16 * 32, I_L = I_IN_ + I_Q_ + I_KV_ + I_GLU_ + 3 * I_BO_ + I_OUT_;
    auto conv_desc = [&](int it) -> ConvD { ConvD d; const int l = it / I_L; int r = it % I_L; d.kscale = nullptr; d.split512 = false; d.mapped = false;
        if (r < I_IN_) { d.src = ap->in[I_WIN] + (size_t)l * DM * IN_SRC; d.ldsrc = IN_SRC; d.K = DM; d.N = NIN; d.dst = (bf16_t*)(ws + WS_WIN) + (size_t)l * 2 * NIN * 512; d.dld = 512; d.split512 = true; d.mapped = true; d.kscale = ap->in[I_NORMG] + l * DM; d.item = r; return d; } r -= I_IN_;
        if (r < I_Q_) { d.src = ap->in[I_WQUP] + (size_t)l * 256 * 768; d.ldsrc = 768; d.K = 256; d.N = 768; d.dst = (bf16_t*)(ws + WS_WQ) + (size_t)l * 768 * 256; d.dld = 256; d.kscale = ap->in[I_QAN] + l * 256; d.item = r; return d; } r -= I_Q_;
        if (r < I_KV_) { d.src = ap->in[I_WKVUP] + (size_t)l * 128 * 1024; d.ldsrc = 1024; d.K = 128; d.N = 1024; d.dst = (bf16_t*)(ws + WS_WKV) + (size_t)l * 1024 * 256; d.dld = 256; d.kscale = ap->in[I_KVAN] + l * 128; d.item = r; return d; } r -= I_KV_;
        if (r < I_GLU_) { d.src = ap->in[I_WGLU] + (size_t)l * 512 * 512; d.ldsrc = 512; d.K = 512; d.N = 512; d.dst = (bf16_t*)(ws + WS_WGLU) + (size_t)l * 512 * 512; d.dld = 512; d.item = r; return d; } r -= I_GLU_;
        if (r < 3 * I_BO_) { const int br = r / I_BO_; d.src = ap->in[I_WBO] + ((size_t)l * 1536 + br * 512) * 1024; d.ldsrc = 1024; d.K = 512; d.N = 1024; d.dst = (bf16_t*)(ws + WS_WBO) + ((size_t)l * 3 + br) * 1024 * 512; d.dld = 512; d.item = r % I_BO_; return d; } r -= 3 * I_BO_;
        d.src = ap->in[I_WOUT] + (size_t)l * DM * DM; d.ldsrc = DM; d.K = DM; d.N = DM; d.dst = (bf16_t*)(ws + WS_WOUT) + (size_t)l * DM * DM; d.dld = DM; d.item = r; return d; };
    constexpr int N_A = 16 * 80, N_B = NL * I_L - N_A;
    auto item_of = [&](int idx) -> int { if (part == 0) return (idx / 80) * 224 + (idx % 80);
        return idx < 16 * 144 ? (idx / 144) * 224 + 80 + (idx % 144) : I_IN_ + (idx - 16 * 144); };
    const int n_items = part == 0 ? N_A : N_B;
    if (gw < n_items) {
        ConvD dc = conv_desc(item_of(gw)); float xc[32], kc; conv_load(dc, lane, xc, kc);
        for (int it = gw; it < n_items; it += ngw) {
            const int nit = it + ngw; const bool hn = nit < n_items;
            ConvD dn = dc; float xn[32], kn = 1.f;
#pragma unroll
            for (int i = 0; i < 32; ++i) xn[i] = 0.f;
            if (hn) { dn = conv_desc(item_of(nit)); conv_load(dn, lane, xn, kn); }
            SBAR();
            conv_finish(dc, scr, lane, xc, kc);
            dc = dn; kc = kn;
#pragma unroll
            for (int i = 0; i < 32; ++i) xc[i] = xn[i];
        }
    }
    if (part == 1) {
    for (long it = (wave == 1 ? (long)c.bid * 64 + lane : (long)NL * 32 * 64); it < NL * 32 * 64; it += (long)grid_g() * 64) {
        const int n = (int)(it & 63), g = (int)((it >> 6) & 31), l = (int)(it >> 11);
        const float dt = expf(ap->in[I_LDT][l * 32 + g]);
        const float lr = ap->in[I_LRE][(l * 32 + g) * 64 + n], li = ap->in[I_LIM][(l * 32 + g) * 64 + n];
        const float mag = expf(lr * dt), ang = li * dt;
        float rev = ang * 0.15915494309189535f; rev -= floorf(rev);
        const float are = mag * __builtin_amdgcn_cosf(rev), aim = mag * __builtin_amdgcn_sinf(rev);
        float pr = are, pi = aim;
#pragma unroll
        for (int s = 0; s < 6; ++s) { const float nr = pr * pr - pi * pi, ni = 2.f * pr * pi; pr = nr; pi = ni; }
        ((f32x4*)(ws + WS_TA))[it] = (f32x4){are, aim, pr, pi};
        const float den = lr * lr + li * li;
        const float fre = ((are - 1.f) * lr + aim * li) / den, fim = (aim * lr - (are - 1.f) * li) / den;
        const float* bre = ap->in[I_BRE] + it * 16; const float* bim = ap->in[I_BIM] + it * 16;
        float bbr[16], bbi[16];
#pragma unroll
        for (int cc = 0; cc < 16; ++cc) { const float br = bre[cc], bi = bim[cc]; bbr[cc] = fre * br - fim * bi; bbi[cc] = fre * bi + fim * br; }
        { const int nre = (n < 32) ? n : 64 + (n - 32), nim = nre + 32; bf16_t* tb = (bf16_t*)(ws + WS_TBB) + (size_t)(l * 32 + g) * 128 * 16;
          u32x4 w0, w1;
          w0.x = pk_bf16(bbr[0], bbr[1]); w0.y = pk_bf16(bbr[2], bbr[3]); w0.z = pk_bf16(bbr[4], bbr[5]); w0.w = pk_bf16(bbr[6], bbr[7]);
          w1.x = pk_bf16(bbr[8], bbr[9]); w1.y = pk_bf16(bbr[10], bbr[11]); w1.z = pk_bf16(bbr[12], bbr[13]); w1.w = pk_bf16(bbr[14], bbr[15]);
          *(u32x4*)(tb + nre * 16) = w0; *(u32x4*)(tb + nre * 16 + 8) = w1;
          w0.x = pk_bf16(bbi[0], bbi[1]); w0.y = pk_bf16(bbi[2], bbi[3]); w0.z = pk_bf16(bbi[4], bbi[5]); w0.w = pk_bf16(bbi[6], bbi[7]);
          w1.x = pk_bf16(bbi[8], bbi[9]); w1.y = pk_bf16(bbi[10], bbi[11]); w1.z = pk_bf16(bbi[12], bbi[13]); w1.w = pk_bf16(bbi[14], bbi[15]);
          *(u32x4*)(tb + nim * 16) = w0; *(u32x4*)(tb + nim * 16 + 8) = w1; }
        { bf16_t* tc = (bf16_t*)(ws + WS_TC) + (size_t)(l * 32 + g) * 16 * 128;
#pragma unroll
          for (int cc = 0; cc < 16; ++cc) { const float cr = ap->in[I_CRE][((size_t)(l * 32 + g) * 16 + cc) * 64 + n], ci = ap->in[I_CIM][((size_t)(l * 32 + g) * 16 + cc) * 64 + n];
              *(unsigned*)(tc + cc * 128 + 2 * n) = pk_bf16(cr, -ci); } }
    }
    }
    if (part == 0) { const float* x = ap->in[I_X]; bf16_t* XG = (bf16_t*)(ws + WS_XG); float* ss = (float*)(ws + WS_SS);
      f32x4 nxv[4];
      const int gwv = c.vb * 8 + wave; const bool g256 = grid_g() == 256; const int row_b = g256 ? gwv * 8 : gw, row_s = g256 ? 1 : ngw, row_e = g256 ? gwv * 8 + 8 : T_;
#pragma unroll
      for (int j = 0; j < 4; ++j) nxv[j] = *(const f32x4*)(x + (size_t)(row_b < T_ ? row_b : 0) * DM + j * 256 + lane * 4);
      for (int row = row_b; row < row_e; row += row_s) { float s = 0.f; f32x4 v[4];
#pragma unroll
          for (int j = 0; j < 4; ++j) v[j] = nxv[j];
          { const int nrow = (row + row_s < row_e) ? row + row_s : row;
#pragma unroll
            for (int j = 0; j < 4; ++j) nxv[j] = *(const f32x4*)(x + (size_t)nrow * DM + j * 256 + lane * 4); }
          SBAR();
#pragma unroll
          for (int j = 0; j < 4; ++j) { const int col = j * 256 + lane * 4;
              s += (v[j][0] * v[j][0] + v[j][1] * v[j][1]) + (v[j][2] * v[j][2] + v[j][3] * v[j][3]);
              u32x2 w; w.x = pk_bf16(v[j][0], v[j][1]); w.y = pk_bf16(v[j][2], v[j][3]);
              *(u32x2*)(XG + ((size_t)(col >> 9) * T_ + row) * 512 + (col & 511)) = w; }
          s = wave_sum(s); if (lane == 0) ss[row] = s; }
      for (long i = gtid; i < T_; i += gthreads) ss[T_ + i] = 0.f;
      for (long i = gtid; i < 2 * NL * T_; i += gthreads) ((float*)(ws + WS_SSQ))[i] = 0.f;
      for (long i = gtid; i < 8 * 3456; i += gthreads) ((unsigned*)(ws + WS_PBAR))[i] = 0u;
      for (long i = gtid; i < (long)NL * 1024 * 16; i += gthreads) *(u32x4*)((bf16_t*)(ws + WS_WKV) + (i >> 4) * 256 + 128 + (i & 15) * 8) = (u32x4){0u, 0u, 0u, 0u}; }
}

struct S5Coef { float a1r, a1i, a2r, a2i, a3r, a3i, a4r, a4i; };
__device__ __forceinline__ S5Coef s5_coef(float ar, float ai) { S5Coef q; q.a1r = ar; q.a1i = ai; q.a2r = ar * ar - ai * ai; q.a2i = 2.f * ar * ai; q.a3r = q.a2r * ar - q.a2i * ai; q.a3i = q.a2r * ai + q.a2i * ar; q.a4r = q.a2r * q.a2r - q.a2i * q.a2i; q.a4i = 2.f * q.a2r * q.a2i; return q; }
__device__ __forceinline__ float other_half(float v, int hi) { auto rr = __builtin_amdgcn_permlane32_swap(__float_as_uint(v), __float_as_uint(v), false, false); return __uint_as_float(hi ? rr[0] : rr[1]); }
template <bool NEEDX>
__device__ __forceinline__ void s5_scan32(f32x16& xr, f32x16& xi, const S5Coef& q, float& sr, float& si, int hi) {
    float er[4], ei[4];
#pragma unroll
    for (int k = 0; k < 4; ++k) {
        const float r0 = xr[4 * k], i0 = xi[4 * k];
        const float r1 = q.a1r * r0 - q.a1i * i0 + xr[4 * k + 1], i1 = q.a1r * i0 + q.a1i * r0 + xi[4 * k + 1];
        const float r2 = q.a1r * r1 - q.a1i * i1 + xr[4 * k + 2], i2 = q.a1r * i1 + q.a1i * r1 + xi[4 * k + 2];
        const float r3 = q.a1r * r2 - q.a1i * i2 + xr[4 * k + 3], i3 = q.a1r * i2 + q.a1i * r2 + xi[4 * k + 3];
        if (NEEDX) { xr[4 * k + 1] = r1; xi[4 * k + 1] = i1; xr[4 * k + 2] = r2; xi[4 * k + 2] = i2; xr[4 * k + 3] = r3; xi[4 * k + 3] = i3; }
        er[k] = r3; ei[k] = i3;
    }
    float pr[4], pi[4];
#pragma unroll
    for (int k = 0; k < 4; ++k) {
        const float orr = other_half(er[k], hi), oii = other_half(ei[k], hi);
        const float e0r = hi ? orr : er[k], e0i = hi ? oii : ei[k], e1r = hi ? er[k] : orr, e1i = hi ? ei[k] : oii;
        const float p0r = sr, p0i = si;
        float nr = q.a4r * sr - q.a4i * si + e0r, ni = q.a4r * si + q.a4i * sr + e0i; sr = nr; si = ni;
        const float p1r = sr, p1i = si;
        nr = q.a4r * sr - q.a4i * si + e1r; ni = q.a4r * si + q.a4i * sr + e1i; sr = nr; si = ni;
        pr[k] = hi ? p1r : p0r; pi[k] = hi ? p1i : p0i;
    }
    if (NEEDX) {
#pragma unroll
        for (int k = 0; k < 4; ++k) {
            xr[4 * k + 0] += q.a1r * pr[k] - q.a1i * pi[k]; xi[4 * k + 0] += q.a1r * pi[k] + q.a1i * pr[k];
            xr[4 * k + 1] += q.a2r * pr[k] - q.a2i * pi[k]; xi[4 * k + 1] += q.a2r * pi[k] + q.a2i * pr[k];
            xr[4 * k + 2] += q.a3r * pr[k] - q.a3i * pi[k]; xi[4 * k + 2] += q.a3r * pi[k] + q.a3i * pr[k];
            xr[4 * k + 3] += q.a4r * pr[k] - q.a4i * pi[k]; xi[4 * k + 3] += q.a4r * pi[k] + q.a4i * pr[k];
        }
    }
}
constexpr int S5_XPITCH = 272, S5_XWAVE = 32 * S5_XPITCH;
template <bool FULL>
__device__ __forceinline__ void s5_pass(const Ctx& c, int l, bool dry) {
    PHASE_IDS(); ArgsP ap = get_args(); unsigned char* ws = ap->ws; bf16_t* P = (bf16_t*)(ws + WS_PROJ); const float* dsk = ap->in[I_S5D] + l * 512;
    const int cl = lane & 31, hi = lane >> 5;
    char* Xl = c.ldsg + wave * S5_XWAVE;
    const int gw = c.vb * 8 + wave, ngw = grid_g() * 8;
    for (int task = gw; task < NB_ * 32 * 8; task += ngw) {
        const int g = task & 31, q8 = (task >> 5) & 7, b = task >> 8;
        const int tb0 = (l * 32 + g) * 64;
        const f32x4 taA = ((const f32x4*)(ws + WS_TA))[tb0 + cl], taB = ((const f32x4*)(ws + WS_TA))[tb0 + 32 + cl];
        const S5Coef qA = s5_coef(taA[0], taA[1]), qB = s5_coef(taB[0], taB[1]);
        bf16x8 bbf[4];
        { const bf16_t* tbb = (const bf16_t*)(ws + WS_TBB) + (size_t)(l * 32 + g) * 128 * 16;
#pragma unroll
          for (int blk = 0; blk < 4; ++blk) bbf[blk] = *(const bf16x8*)(tbb + (blk * 32 + cl) * 16 + 8 * hi); }
        float sAr = 0.f, sAi = 0.f, sBr = 0.f, sBi = 0.f;
        bf16x8 cm[4];
        if (FULL) {
            const bf16_t* tcm = (const bf16_t*)(ws + WS_TC) + (size_t)(l * 32 + g) * 16 * 128;
#pragma unroll
            for (int ks = 0; ks < 4; ++ks) cm[ks] = *(const bf16x8*)(tcm + (lane & 15) * 128 + ks * 32 + 8 * (lane >> 4));
            const f32x2* Ep = (const f32x2*)(ws + WS_E) + ((size_t)(b * 32) * 32 + g) * 64;
            const int nprev = 4 * q8;
            for (int j0 = 0; j0 < nprev; j0 += 8) {
                f32x2 eA[8], eB[8];
#pragma unroll
                for (int i = 0; i < 8; ++i) { const int cp = (j0 + i < nprev) ? j0 + i : 0; eA[i] = Ep[(size_t)cp * 2048 + cl]; eB[i] = Ep[(size_t)cp * 2048 + 32 + cl]; }
#pragma unroll
                for (int i = 0; i < 8; ++i) if (j0 + i < nprev) {
                    float nr = taA[2] * sAr - taA[3] * sAi + eA[i][0], ni = taA[2] * sAi + taA[3] * sAr + eA[i][1]; sAr = nr; sAi = ni;
                    nr = taB[2] * sBr - taB[3] * sBi + eB[i][0]; ni = taB[2] * sBi + taB[3] * sBr + eB[i][1]; sBr = nr; sBi = ni; }
            }
        }
        const f32x4 dv = *(const f32x4*)(dsk + 16 * g + 4 * (lane >> 4));
        const size_t ubase = (size_t)(b * S_ + 4 * q8 * 64 + cl) * NPROJ + 2048 + 16 * g + 8 * hi;
        bf16x8 ua_n = *(const bf16x8*)(P + ubase);
        const size_t uebase = (size_t)(b * S_ + 4 * q8 * 64 + (lane & 15)) * NPROJ + 2048 + 16 * g + 4 * (lane >> 4);
        for (int i8 = 0; i8 < 8; ++i8) {
            const bf16x8 ua = ua_n;
            if (i8 < 7) ua_n = *(const bf16x8*)(P + ubase + (size_t)(i8 + 1) * 32 * NPROJ);
            u32x2 ue0 = (u32x2){0u, 0u}, ue1 = (u32x2){0u, 0u};
            if (FULL) { ue0 = *(const u32x2*)(P + uebase + (size_t)i8 * 32 * NPROJ); ue1 = *(const u32x2*)(P + uebase + (size_t)(i8 * 32 + 16) * NPROJ); }
            const int ch = 4 * q8 + (i8 >> 1), rb = i8 & 1, tok0 = b * S_ + ch * 64;
            if (!FULL && rb == 0) { sAr = 0.f; sAi = 0.f; sBr = 0.f; sBi = 0.f; }
            f32x16 bu0 = __builtin_amdgcn_mfma_f32_32x32x16_bf16(ua, bbf[0], f32x16{}, 0, 0, 0);
            f32x16 bu1 = __builtin_amdgcn_mfma_f32_32x32x16_bf16(ua, bbf[1], f32x16{}, 0, 0, 0);
            f32x16 bu2 = __builtin_amdgcn_mfma_f32_32x32x16_bf16(ua, bbf[2], f32x16{}, 0, 0, 0);
            f32x16 bu3 = __builtin_amdgcn_mfma_f32_32x32x16_bf16(ua, bbf[3], f32x16{}, 0, 0, 0);
            s5_scan32<FULL>(bu0, bu1, qA, sAr, sAi, hi);
            s5_scan32<FULL>(bu2, bu3, qB, sBr, sBi, hi);
            if (FULL) {
#pragma unroll
                for (int r = 0; r < 16; ++r) { const int t = (r & 3) + 8 * (r >> 2) + 4 * hi;
                    *(unsigned*)(Xl + t * S5_XPITCH + 4 * cl) = pk_bf16(bu0[r], bu1[r]);
                    *(unsigned*)(Xl + t * S5_XPITCH + 128 + 4 * cl) = pk_bf16(bu2[r], bu3[r]); }
                asm volatile("s_waitcnt lgkmcnt(0)" ::: "memory");
#pragma unroll
                for (int tb = 0; tb < 2; ++tb) {
                    f32x4 y = (f32x4){0.f, 0.f, 0.f, 0.f};
#pragma unroll
                    for (int ks = 0; ks < 4; ++ks) { const bf16x8 xb = *(const bf16x8*)(Xl + (16 * tb + (lane & 15)) * S5_XPITCH + (ks * 32 + 8 * (lane >> 4)) * 2);
                        y = __builtin_amdgcn_mfma_f32_16x16x32_bf16(cm[ks], xb, y, 0, 0, 0); }
                    const int q4 = lane >> 4;
                    const size_t tokz = (size_t)(tok0 + rb * 32 + tb * 16 + (lane & 15));
                    bf16_t* zp = (bf16_t*)(ws + WS_Z) + tokz * 512 + 16 * g + 4 * q4;
                    const u32x2 uu = tb ? ue1 : ue0;
                    const float y0 = y[0] + dv[0] * bf_lo(uu.x), y1 = y[1] + dv[1] * bf_hi(uu.x), y2 = y[2] + dv[2] * bf_lo(uu.y), y3 = y[3] + dv[3] * bf_hi(uu.y);
                    u32x2 w; w.x = pk_bf16(gelu_tanh(y0), gelu_tanh(y1)); w.y = pk_bf16(gelu_tanh(y2), gelu_tanh(y3));
                    if (!dry) *(u32x2*)zp = w;
                }
                asm volatile("s_waitcnt lgkmcnt(0)" ::: "memory");
            }
            if (!FULL && rb == 1) { if (hi == 0) { f32x2* Eo = (f32x2*)(ws + WS_E) + (size_t)((b * 32 + ch) * 32 + g) * 64; Eo[cl] = (f32x2){sAr, sAi}; Eo[32 + cl] = (f32x2){sBr, sBi}; } }
        }
    }
}

__device__ __forceinline__ void unpack8(const u32x4 w, float (&v)[8]) { v[0] = bf_lo(w.x); v[1] = bf_hi(w.x); v[2] = bf_lo(w.y); v[3] = bf_hi(w.y); v[4] = bf_lo(w.z); v[5] = bf_hi(w.z); v[6] = bf_lo(w.w); v[7] = bf_hi(w.w); }
__device__ __forceinline__ u32x4 pack8(const float (&v)[8]) { u32x4 w; w.x = pk_bf16(v[0], v[1]); w.y = pk_bf16(v[2], v[3]); w.z = pk_bf16(v[4], v[5]); w.w = pk_bf16(v[6], v[7]); return w; }
__device__ __forceinline__ void prep_phase(const Ctx& c, int l, bool dry) {
    PHASE_IDS(); ArgsP ap = get_args(); unsigned char* ws = ap->ws;

    bf16_t* P = (bf16_t*)(ws + WS_PROJ); bf16_t* QUP = (bf16_t*)(ws + WS_QUP); bf16_t* KVUP = (bf16_t*)(ws + WS_KVUP); bf16_t* KM = (bf16_t*)(ws + WS_KM);
    if (wave == 0) for (int bq = (grid_g() == 256) ? ((c.bid >> 3) < 8 ? (c.bid & 7) * 8 + (c.bid >> 3) : 64) : c.bid; bq < 64; bq += grid_g()) {
        const int bh = bq, b = bh >> 3, h = bh & 7; const float bf = ap->in[I_FBF][l * 8 + h];
        const float* ff = (const float*)(ws + WS_FF32) + (size_t)(b * S_) * 8 + h; float* cum = (float*)(ws + WS_CUM) + (size_t)bh * S_;
        float xv[32];
#pragma unroll
        for (int it = 0; it < 32; ++it) xv[it] = ff[(size_t)(it * 64 + lane) * 8];
        float carry = 0.f;
#pragma unroll
        for (int it = 0; it < 32; ++it) { const float xx = xv[it] + bf;
            float v = fminf(xx, 0.f) - log1pf(__expf(-fabsf(xx)));
            v += __builtin_bit_cast(float, __builtin_amdgcn_update_dpp(0, __builtin_bit_cast(int, v), 0x111, 0xF, 0xF, false));
            v += __builtin_bit_cast(float, __builtin_amdgcn_update_dpp(0, __builtin_bit_cast(int, v), 0x112, 0xF, 0xF, false));
            v += __builtin_bit_cast(float, __builtin_amdgcn_update_dpp(0, __builtin_bit_cast(int, v), 0x114, 0xF, 0xF, false));
            v += __builtin_bit_cast(float, __builtin_amdgcn_update_dpp(0, __builtin_bit_cast(int, v), 0x118, 0xF, 0xF, false));
            const int iv = __builtin_bit_cast(int, v);
            const float t0 = __builtin_bit_cast(float, __builtin_amdgcn_readlane(iv, 15)), t1 = __builtin_bit_cast(float, __builtin_amdgcn_readlane(iv, 31));
            const float t2 = __builtin_bit_cast(float, __builtin_amdgcn_readlane(iv, 47)), t3 = __builtin_bit_cast(float, __builtin_amdgcn_readlane(iv, 63));
            const int rw = lane >> 4;
            v += carry + (rw == 1 ? t0 : rw == 2 ? t0 + t1 : rw == 3 ? (t0 + t1) + t2 : 0.f);
            if (!dry) cum[it * 64 + lane] = v * LOG2E;
            carry += ((t0 + t1) + t2) + t3; }
    }
    const float* qn = ap->in[I_MQN] + l * 96; const float* kn = ap->in[I_MKN] + l * 96; const float* fqn = ap->in[I_FQN] + l * 64; const float* fkn = ap->in[I_FKN] + l * 64;
    const int* pos = (const int*)ap->in[I_POS];
    const int hd = lane >> 3, j = lane & 7;
    const float QSC = 0.10206207261596575f * LOG2E, FSC = 0.125f * LOG2E;
    const int gw = c.vb * 8 + wave, ngw = grid_g() * 8;
    const bool g256 = grid_g() == 256;
    const int row_b = g256 ? gw * 8 : gw, row_s = g256 ? 1 : ngw, row_e = g256 ? gw * 8 + 8 : T_;
    float gq[12], gk[12], gfq[8], gfk[8];
#pragma unroll
    for (int e = 0; e < 8; ++e) { gq[e] = qn[8 * j + e]; gk[e] = kn[8 * j + e]; gfq[e] = fqn[8 * j + e]; gfk[e] = fkn[8 * j + e]; }
    gq[8] = qn[64 + 2 * j]; gq[9] = qn[65 + 2 * j]; gq[10] = qn[80 + 2 * j]; gq[11] = qn[81 + 2 * j];
    gk[8] = kn[64 + 2 * j]; gk[9] = kn[65 + 2 * j]; gk[10] = kn[80 + 2 * j]; gk[11] = kn[81 + 2 * j];
    struct PrepIn { float pf; u32x4 q; unsigned q1, q2; u32x4 k; unsigned p1, p2; u32x4 fq, fk; };
    auto prep_load = [&](int row) -> PrepIn { PrepIn r_;
        const bf16_t* pr = P + (size_t)row * NPROJ; const bf16_t* qp = QUP + (size_t)row * 768 + 96 * hd; const bf16_t* kp = KM + (size_t)row * 768 + 96 * hd;
        r_.pf = (float)pos[row];
        r_.q = *(const u32x4*)(qp + 8 * j); r_.q1 = *(const unsigned*)(qp + 64 + 2 * j); r_.q2 = *(const unsigned*)(qp + 80 + 2 * j);
        r_.k = *(const u32x4*)(kp + 8 * j);
        r_.p1 = *(const unsigned*)(pr + 384 + 2 * j); r_.p2 = *(const unsigned*)(pr + 400 + 2 * j);
        r_.fq = *(const u32x4*)(pr + 512 + 64 * hd + 8 * j); r_.fk = *(const u32x4*)(pr + 1024 + 64 * hd + 8 * j); return r_; };
    PrepIn nx_ = prep_load(row_b < T_ ? row_b : 0);
    for (int row = row_b; row < row_e; row += row_s) {
        bf16_t* pr = P + (size_t)row * NPROJ;
        bf16_t* qp = QUP + (size_t)row * 768 + 96 * hd; bf16_t* ko = KM + (size_t)row * 768 + 96 * hd;
        bf16_t* fqp = pr + 512 + 64 * hd + 8 * j; bf16_t* fkp = pr + 1024 + 64 * hd + 8 * j;
        const PrepIn in_ = nx_;
        { const int nrow = row + row_s; nx_ = prep_load(nrow < row_e ? nrow : row); }
        SBAR();
        const float pf = in_.pf;
        const u32x4 l_q = in_.q; const unsigned l_q1 = in_.q1, l_q2 = in_.q2;
        const u32x4 l_k = in_.k; const unsigned l_p1 = in_.p1, l_p2 = in_.p2;
        const u32x4 l_fq = in_.fq, l_fk = in_.fk;
        float cs[2], sn[2];
#pragma unroll
        for (int e = 0; e < 2; ++e) { const int i = 2 * j + e; const float inv = exp2f(-(float)i * (13.287712379549449f / 16.f)); const float ang = pf * inv;
            float rev = ang * 0.15915494309189535f; rev -= floorf(rev); cs[e] = __builtin_amdgcn_cosf(rev); sn[e] = __builtin_amdgcn_sinf(rev); }
        u32x4 o_q, o_k, o_fq, o_fk; unsigned o_q1, o_q2, o_k1, o_k2;
        { float v[8]; unpack8(l_q, v);
          const float x1[2] = {bf_lo(l_q1), bf_hi(l_q1)}, x2[2] = {bf_lo(l_q2), bf_hi(l_q2)};
          float ssq = 0.f;
#pragma unroll
          for (int e = 0; e < 8; ++e) ssq += v[e] * v[e];
          float r1[2], r2[2];
#pragma unroll
          for (int e = 0; e < 2; ++e) { r1[e] = x1[e] * cs[e] - x2[e] * sn[e]; r2[e] = x1[e] * sn[e] + x2[e] * cs[e]; ssq += r1[e] * r1[e] + r2[e] * r2[e]; }
          const float rn = rsqrtf(sum8(ssq) * (1.f / 96) + EPS) * QSC;
#pragma unroll
          for (int e = 0; e < 8; ++e) v[e] *= rn * gq[e];
          o_q = pack8(v);
          o_q1 = pk_bf16(r1[0] * rn * gq[8], r1[1] * rn * gq[9]);
          o_q2 = pk_bf16(r2[0] * rn * gq[10], r2[1] * rn * gq[11]); }
        { float v[8]; unpack8(l_k, v);
          const float x1[2] = {bf_lo(l_p1), bf_hi(l_p1)}, x2[2] = {bf_lo(l_p2), bf_hi(l_p2)};
          float ssq = 0.f;
#pragma unroll
          for (int e = 0; e < 8; ++e) ssq += v[e] * v[e];
          float r1[2], r2[2];
#pragma unroll
          for (int e = 0; e < 2; ++e) { r1[e] = x1[e] * cs[e] - x2[e] * sn[e]; r2[e] = x1[e] * sn[e] + x2[e] * cs[e]; ssq += r1[e] * r1[e] + r2[e] * r2[e]; }
          const float rn = rsqrtf(sum8(ssq) * (1.f / 96) + EPS);
#pragma unroll
          for (int e = 0; e < 8; ++e) v[e] *= rn * gk[e];
          o_k = pack8(v);
          o_k1 = pk_bf16(r1[0] * rn * gk[8], r1[1] * rn * gk[9]);
          o_k2 = pk_bf16(r2[0] * rn * gk[10], r2[1] * rn * gk[11]); }
        { float v[8]; unpack8(l_fq, v); float ssq = 0.f;
#pragma unroll
          for (int e = 0; e < 8; ++e) ssq += v[e] * v[e];
          const float rn = rsqrtf(sum8(ssq) * (1.f / 64) + EPS) * FSC;
#pragma unroll
          for (int e = 0; e < 8; ++e) v[e] *= rn * gfq[e];
          o_fq = pack8(v); }
        { float v[8]; unpack8(l_fk, v); float ssq = 0.f;
#pragma unroll
          for (int e = 0; e < 8; ++e) ssq += v[e] * v[e];
          const float rn = rsqrtf(sum8(ssq) * (1.f / 64) + EPS);
#pragma unroll
          for (int e = 0; e < 8; ++e) v[e] *= rn * gfk[e];
          o_fk = pack8(v); }
        if (!dry) {
            *(u32x4*)(qp + 8 * j) = o_q; *(unsigned*)(qp + 64 + 2 * j) = o_q1; *(unsigned*)(qp + 80 + 2 * j) = o_q2;
            *(u32x4*)(ko + 8 * j) = o_k; *(unsigned*)(ko + 64 + 2 * j) = o_k1; *(unsigned*)(ko + 80 + 2 * j) = o_k2;
            *(u32x4*)fqp = o_fq; *(u32x4*)fkp = o_fk;
        }
    }
}

__device__ __forceinline__ void attn_phase(const Ctx& c, int l, bool dry) {
    PHASE_IDS(); ArgsP ap = get_args(); unsigned char* ws = ap->ws;
    bf16_t* P = (bf16_t*)(ws + WS_PROJ); bf16_t* QUP = (bf16_t*)(ws + WS_QUP); const bf16_t* KVUP = (const bf16_t*)(ws + WS_KVUP); const bf16_t* KM = (const bf16_t*)(ws + WS_KM);
    const float* CUM = (const float*)(ws + WS_CUM);
    float sbound;
    { float mq = fabsf(ap->in[I_FQN][l * 64 + lane]), mk = fabsf(ap->in[I_FKN][l * 64 + lane]);
#pragma unroll
      for (int o = 1; o < 64; o <<= 1) { mq = fmaxf(mq, __shfl_xor(mq, o)); mk = fmaxf(mk, __shfl_xor(mk, o)); }
      sbound = 2.f * 1.05f * 8.f * LOG2E * mq * mk; }
    for (int L = c.vb; L < 256; L += grid_g()) {
        const int bh = (L >> 5) * 8 + (L & 7), p = (L >> 3) & 3, b = bh >> 3, h = bh & 7; const size_t r0 = (size_t)b * S_;
        const float* cum = CUM + (size_t)bh * S_;
        int T0f[2];
#pragma unroll
        for (int e = 0; e < 2; ++e) { const int q0 = (2 * p + e) * 256, nb = q0 >> 6; const float c0 = cum[q0]; bool need = false;
            if (lane < nb) need = (sbound + c0 - cum[64 * lane + 63] >= -40.f);
            const unsigned long long bal = __ballot(need);
            T0f[e] = __builtin_amdgcn_readfirstlane((bal ? (__ffsll((long long)bal) - 1) : nb) & ~1); }
#pragma unroll 1
        for (int e = 0; e < 2; ++e)
            attn::attn_unit<96, false>(QUP + r0 * 768 + 96 * h, 768, KM + r0 * 768 + 96 * h, 768, KVUP + r0 * 512 + 64 * h, 512, nullptr, (e ? p : 7 - p) * 256, c.ldsg, dry, 0.f, 0);
#pragma unroll 1
        for (int e = 0; e < 2; ++e)
            attn::attn_unit<64, true>(P + r0 * NPROJ + 512 + 64 * h, NPROJ, P + r0 * NPROJ + 1024 + 64 * h, NPROJ, P + r0 * NPROJ + 1536 + 64 * h, NPROJ, cum, (2 * p + e) * 256, c.ldsg, dry, sbound, e ? T0f[1] : T0f[0]);
    }
}

#if USE_XCD_BAR
#define XB_TMO      128
#define XB_XCNT(j)  (256  + 64 * (j))
#define XB_XSUB(j)  (1280 + 64 * (j))
#define XB_XGEN(j)  (2304 + 64 * (j))
#define XB_TOP      3328
#define XB_TOPGEN   3392
#define XCD_BAR_WORDS 3456
#define XB_SPIN_CAP (1u << 22)
__device__ __forceinline__ unsigned xb_ld(unsigned* p)              { return __hip_atomic_load(p, __ATOMIC_RELAXED, __HIP_MEMORY_SCOPE_AGENT); }
__device__ __forceinline__ unsigned xb_add(unsigned* p, unsigned v) { return __hip_atomic_fetch_add(p, v, __ATOMIC_RELAXED, __HIP_MEMORY_SCOPE_AGENT); }
__device__ __forceinline__ unsigned xb_xcc_id() { return (unsigned)__builtin_amdgcn_s_getreg((3 << 11) | 20) & 0xFu; }
#define XB_SPIN(cond, bar) do { unsigned _sp = 0; while (cond) { __builtin_amdgcn_s_sleep(1); \
    if ((++_sp & 255u) == 0u) { if (xb_ld(&(bar)[XB_TMO])) break; if (_sp > XB_SPIN_CAP) { atomicAdd(&(bar)[XB_TMO], 1u); break; } } } } while (0)
struct XcdBarrier { unsigned* bar; unsigned x; volatile LAS unsigned* st; unsigned nexp; };
__device__ __forceinline__ XcdBarrier xcd_barrier_post(unsigned* bar, volatile LAS unsigned* st, unsigned nexp) {
    XcdBarrier b; b.bar = bar; b.x = xb_xcc_id(); b.st = st; b.nexp = nexp;
    if (threadIdx.x == 0) (void)xb_add(&bar[XB_XCNT(b.x)], 1u);
    return b;
}
__device__ __forceinline__ void xcd_barrier_complete(unsigned* bar, unsigned x, unsigned G, unsigned& nloc, unsigned& nx) {
    unsigned sum, cnt, mine, sp = 0u;
    for (;;) {
        sum = 0u; cnt = 0u; mine = 0u;
#pragma unroll
        for (unsigned j = 0; j < 16; ++j) { const unsigned c = xb_ld(&bar[XB_XCNT(j)]); sum += c; cnt += (c > 0u) ? 1u : 0u; mine = (j == x) ? c : mine; }
        if (sum == G) break;
        __builtin_amdgcn_s_sleep(1);
        if ((++sp & 255u) == 0u) { if (xb_ld(&bar[XB_TMO])) break; if (sp > XB_SPIN_CAP) { atomicAdd(&bar[XB_TMO], 1u); break; } }
    }
    nloc = mine > 0u ? mine : 1u; nx = cnt > 0u ? cnt : 1u;
}
__device__ __forceinline__ void xcd_barrier(const XcdBarrier& b) {
    asm volatile("s_waitcnt vmcnt(0)" ::: "memory");
    __syncthreads();
    if (threadIdx.x == 0) {
        unsigned* bar = b.bar;
        __builtin_amdgcn_s_waitcnt(0);
        unsigned nloc = b.st[0], nx = b.st[1];
        if (nloc == 0u) { xcd_barrier_complete(bar, b.x, b.nexp, nloc, nx); b.st[0] = nloc; b.st[1] = nx; }
        const unsigned old = xb_add(&bar[XB_XSUB(b.x)], 1u);
        const unsigned gen = old / nloc;
        if (old + 1u == (gen + 1u) * nloc) {
            __builtin_amdgcn_fence(__ATOMIC_RELEASE, "agent");
            asm volatile("s_waitcnt vmcnt(0)" ::: "memory");
            const unsigned og = xb_add(&bar[XB_TOP], 1u);
            const unsigned tg = og / nx;
            if (og + 1u == (tg + 1u) * nx) xb_add(&bar[XB_TOPGEN], 1u);
            else XB_SPIN(xb_ld(&bar[XB_TOPGEN]) == tg, bar);
            __builtin_amdgcn_fence(__ATOMIC_ACQUIRE, "agent");
            xb_add(&bar[XB_XGEN(b.x)], 1u);
            asm volatile("s_waitcnt vmcnt(0)" ::: "memory");
        } else {
            XB_SPIN(xb_ld(&bar[XB_XGEN(b.x)]) == gen, bar);
            __builtin_amdgcn_fence(__ATOMIC_ACQUIRE, "agent");
            asm volatile("s_waitcnt vmcnt(0)" ::: "memory");
        }
    }
    __syncthreads();
}
#endif

constexpr int LDS_MAIN = 131072, LDS_BYTES = LDS_MAIN + 1024;
static_assert(attn::LDS_BYTES <= LDS_MAIN && 8 * S5_XWAVE <= LDS_MAIN && 8 * 8448 <= LDS_MAIN, "LDS map");

__device__ __forceinline__ void ph_inproj(const Ctx& c, int l) {
    ArgsP ap = get_args(); unsigned char* ws = ap->ws;
    SchedIn S{(const char*)(ws + WS_XG), (const char*)(ws + WS_WIN) + (size_t)l * 2 * NIN * 512 * 2, 0, grid_g(), c.bid};
    EpiProj E{(bf16_t*)(ws + WS_PROJ), (const float*)(ws + WS_SS) + (size_t)l * T_, (float*)(ws + WS_FF32), (float*)(ws + WS_SSQ) + (size_t)l * T_};
    pg8::gemm_phase(c.lds, 512, 512, 8, S, E);
}
__device__ __forceinline__ void ph_fv(const Ctx& c, int l) {
    ArgsP ap = get_args(); unsigned char* ws = ap->ws;
    SchedIn S{(const char*)(ws + WS_XG), (const char*)(ws + WS_WIN) + (size_t)l * 2 * NIN * 512 * 2, 1, grid_g(), c.bid};
    EpiProj E{(bf16_t*)(ws + WS_PROJ), (const float*)(ws + WS_SS) + (size_t)l * T_, (float*)(ws + WS_FF32), (float*)(ws + WS_SSQ) + (size_t)l * T_};
    pg8::gemm_phase(c.lds, 512, 512, 8, S, E);
}
__device__ __forceinline__ void ph_up(const Ctx& c, int l) {
    ArgsP ap = get_args(); unsigned char* ws = ap->ws;
    SchedUp S{(const char*)(ws + WS_PROJ), (const char*)(ws + WS_WQ) + (size_t)l * 768 * 256 * 2, (const char*)(ws + WS_WKV) + (size_t)l * 1024 * 256 * 2, grid_g(), c.bid};
    EpiUp E{(bf16_t*)(ws + WS_QUP), (bf16_t*)(ws + WS_KM), (bf16_t*)(ws + WS_KVUP), (const float*)(ws + WS_SSQ) + (size_t)l * T_}; pg8::gemm_phase(c.lds, NPROJ, 256, 4, S, E);
}
__device__ __forceinline__ void ph_gate(const Ctx& c, int l) {
    ArgsP ap = get_args(); unsigned char* ws = ap->ws;
    SchedGate S{(const char*)ws, l, grid_g(), c.bid};
    EpiGate E{ws, ap->in[I_BGLU] + l * 512, l};
    pg8::gemm_phase(c.lds, 512, 512, 8, S, E);
}
__device__ __forceinline__ void ph_merge(const Ctx& c, int l) {
    ArgsP ap = get_args(); unsigned char* ws = ap->ws;
    SchedMerge S{(const char*)ws, l, grid_g(), c.bid};
    EpiMerge E{ws, l, c.bid};
    pg8::gemm_phase(c.lds, 512, 512, 8, S, E);
}
__device__ __forceinline__ void ph_out(const Ctx& c, int l, bool dry) {
    ArgsP ap = get_args(); unsigned char* ws = ap->ws;
    SchedPlain S{(const char*)(ws + WS_PROJ) + (size_t)S_ * 1024 * 2, (size_t)256 * 1024 * 2, (size_t)10 << 20, (const char*)(ws + WS_WOUT) + (size_t)l * DM * DM * 2, (size_t)256 * 1024 * 2, 4, grid_g(), c.bid};
    const bool lastl = (l == NL - 1);
    EpiOut E{l == 0 ? ap->in[I_X] : nullptr, ap->out, (bf16_t*)(ws + WS_XG), lastl ? nullptr : (float*)(ws + WS_SS) + (size_t)(l + 1) * T_, dry};
    pg8::gemm_phase(c.lds, 1024, 1024, 16, S, E);
}

__global__ void __launch_bounds__(512, 2) trunk_fwd(Args args) {
    extern __shared__ __attribute__((aligned(16))) unsigned char lds[];
    Ctx c; c.lds = (LAS unsigned char*)lds; c.ldsg = (char*)lds; c.G = gridDim.x; c.bid = blockIdx.x; c.vb = (gridDim.x == 256) ? (int)((blockIdx.x & 7) * 32 + (blockIdx.x >> 3)) : (int)blockIdx.x;
#if MK_LAUNCHES == 1
#if USE_XCD_BAR
    if (threadIdx.x < 4) ((volatile LAS unsigned*)(c.lds + LDS_MAIN))[threadIdx.x] = 0u;
    __syncthreads();
    XcdBarrier bar = xcd_barrier_post((unsigned*)(args.ws + WS_CTL) + 4096, (volatile LAS unsigned*)(c.lds + LDS_MAIN), gridDim.x);
    XcdBarrier pbar = bar;
#define GRID_BAR() xcd_barrier(bar)
#define PIPE_BAR() xcd_barrier(pbar)
#define HAVE_PIPE_BAR 1
#else
    cg::grid_group grid = cg::this_grid();
#define GRID_BAR() grid.sync()
#endif
#else
#define GRID_BAR() do {} while (0)
#endif
    const int lo = args.ph_lo, hi = args.ph_hi;
#ifndef PH_MASK
#define PH_MASK 0xfff
#endif
#define IN(k) (lo <= (k) && (k) < hi)
#define PHM(j) ((PH_MASK >> (j)) & 1)
#define SEAM(k) do { if (IN(k) && IN((k) + 1)) GRID_BAR(); } while (0)
#ifdef HAVE_PIPE_BAR
#define SEAMP(k) do { if (IN(k) && IN((k) + 1)) PIPE_BAR(); } while (0)
#else
#define SEAMP(k) SEAM(k)
#endif

#ifndef ENABLE_PROBES
#define ENABLE_PROBES 0
#endif
#if ENABLE_PROBES
    const int probe = args.probe;
#define REP(j) for (int rep = (probe == (j)) ? 0 : 1; rep < 2; ++rep)
#else
#define REP(j) for (int rep = 1; rep < 2; ++rep)
#endif
    if (PHM(0) && IN(0)) { REP(1) phase0(c, 0); } SEAM(0);
#ifdef HAVE_PIPE_BAR
    if (gridDim.x == 256 && lo == 0 && hi == NPH)
        pbar = xcd_barrier_post((unsigned*)(args.ws + WS_PBAR) + (blockIdx.x & 7) * XCD_BAR_WORDS, (volatile LAS unsigned*)(c.lds + LDS_MAIN) + 2, 32u);
#endif
    for (int l = 0; l < NL; ++l) {
        const int pb = 1 + 7 * l;
        if (PHM(1) && IN(pb + 0)) {
            if (l == 0 && (c.bid & 1)) { phase0(c, 1); __syncthreads(); }
            REP(2) ph_inproj(c, l);
            if (l == 0 && !(c.bid & 1)) phase0(c, 1); }
        if (l == 0) SEAM(pb + 0); else SEAMP(pb + 0);
        if (IN(pb + 1)) {
            if (c.bid & 1) { if (PHM(9)) REP(5) s5_pass<false>(c, l, false); if (PHM(2)) REP(4) ph_fv(c, l); if (PHM(2)) REP(3) ph_up(c, l); }
            else { if (PHM(2)) REP(4) ph_fv(c, l); if (PHM(2)) REP(3) ph_up(c, l); if (PHM(9)) REP(5) s5_pass<false>(c, l, false); } }
        SEAMP(pb + 1);
        if (IN(pb + 2)) {
            if (c.bid & 1) { if (PHM(10)) REP(7) s5_pass<true>(c, l, rep == 0); if (PHM(3)) REP(6) prep_phase(c, l, rep == 0); }
            else { if (PHM(3)) REP(6) prep_phase(c, l, rep == 0); if (PHM(10)) REP(7) s5_pass<true>(c, l, rep == 0); } }
        SEAMP(pb + 2);
        if (IN(pb + 3)) { if (PHM(4)) REP(8) attn_phase(c, l, rep == 0); }
        SEAMP(pb + 3);
        if (PHM(5) && IN(pb + 4)) REP(10) ph_gate(c, l);
        SEAMP(pb + 4);
        if (PHM(6) && IN(pb + 5)) REP(11) ph_merge(c, l);
        SEAMP(pb + 5);
        if (PHM(7) && IN(pb + 6)) REP(12) ph_out(c, l, rep == 0);
        SEAMP(pb + 6);
    }
#undef IN
#undef SEAM
}

extern "C" void kernel_launch(void* const* d_in, const int* in_sizes, int n_in, void* d_out, int out_size, void* d_ws, size_t ws_size, hipStream_t stream) {
    static int grid = 0;
    if (grid == 0) {
        if (n_in != 25 || in_sizes[0] != T_ * DM || out_size != T_ * DM || ws_size < WS_END) {
            fprintf(stderr, "kernel_launch: shape mismatch n_in %d in0 %d out %d ws %zu (need %zu)\n", n_in, n_in > 0 ? in_sizes[0] : -1, out_size, ws_size, (size_t)WS_END); grid = -1; return; }
        int dev = 0, cus = 0, per_cu = 0;
        hipGetDevice(&dev); hipDeviceGetAttribute(&cus, hipDeviceAttributeMultiprocessorCount, dev);
        if (hipFuncSetAttribute((const void*)trunk_fwd, hipFuncAttributeMaxDynamicSharedMemorySize, LDS_BYTES) != hipSuccess) { fprintf(stderr, "kernel_launch: hipFuncSetAttribute failed\n"); grid = -1; return; }
        if (hipOccupancyMaxActiveBlocksPerMultiprocessor(&per_cu, (const void*)trunk_fwd, 512, LDS_BYTES) != hipSuccess || per_cu < 1) { fprintf(stderr, "kernel_launch: occupancy query says %d\n", per_cu); per_cu = 1; }
        (void)hipGetLastError();
        grid = cus;
    }
    if (grid < 0) return;
    hipMemsetAsync((char*)d_ws + WS_CTL, 0, 64 * KiB, stream);
    Args a{};
    for (int i = 0; i < 25; ++i) a.in[i] = (const float*)d_in[i];
    a.out = (float*)d_out; a.ws = (unsigned char*)d_ws;
#ifdef PROBE_PHASE
    a.probe = PROBE_PHASE;
#endif
#if MK_LAUNCHES == 1
    a.ph_lo = 0; a.ph_hi = NPH;
#ifndef PLAIN_LAUNCH
#define PLAIN_LAUNCH 0
#endif
#if PLAIN_LAUNCH
    hipLaunchKernelGGL(trunk_fwd, dim3(grid), dim3(512), LDS_BYTES, stream, a);
#else
    void* kargs[] = {&a};
    hipError_t e = hipLaunchCooperativeKernel((const void*)trunk_fwd, dim3(grid), dim3(512), kargs, LDS_BYTES, stream);
    if (e != hipSuccess) fprintf(stderr, "cooperative launch failed: %s (grid %d)\n", hipGetErrorString(e), grid);
#endif
#else
    for (int ph = 0; ph < NPH; ++ph) { a.ph_lo = ph; a.ph_hi = ph + 1; hipLaunchKernelGGL(trunk_fwd, dim3(grid), dim3(512), LDS_BYTES, stream, a); }
#endif
}
```

```cpp
#include <hip/hip_runtime.h>
#include <hip/hip_cooperative_groups.h>
#include <cstdint>
#include <cstdio>
namespace cg = cooperative_groups;

#ifndef MK_LAUNCHES
#define MK_LAUNCHES 1
#endif
#ifndef USE_XCD_BAR
#define USE_XCD_BAR 1
#endif

#define LAS __attribute__((address_space(3)))
typedef unsigned short bf16_t;
typedef short bf16x8 __attribute__((ext_vector_type(8)));
typedef short s16x4 __attribute__((ext_vector_type(4)));
typedef float f32x2 __attribute__((ext_vector_type(2)));
typedef float f32x4 __attribute__((ext_vector_type(4)));
typedef float f32x16 __attribute__((ext_vector_type(16)));
typedef unsigned u32x2 __attribute__((ext_vector_type(2)));
typedef unsigned u32x4 __attribute__((ext_vector_type(4)));

constexpr int T_ = 16384, S_ = 2048, NB_ = 8, DM = 1024, NL = 2;
constexpr int NPROJ = 2560;
constexpr int NIN = 7168;
constexpr int IN_SRC = 7080;
constexpr float EPS = 1e-6f;
constexpr float LOG2E = 1.4426950408889634f;
constexpr int NPH = 1 + 7 * NL;

constexpr size_t KiB = 1024, MiB = 1024 * 1024;
constexpr size_t WS_CTL = 0;
constexpr size_t WS_SS = 64 * KiB;
constexpr size_t WS_FF32 = 256 * KiB;
constexpr size_t WS_CUM = 768 * KiB;
constexpr size_t WS_TA = 1280 * KiB;
constexpr size_t WS_TBB = 1344 * KiB;
constexpr size_t WS_TC = 1856 * KiB;
constexpr size_t WS_SSQ = 2432 * KiB;
constexpr size_t WS_SSKV = 2560 * KiB;
constexpr size_t WS_GBAR = 2800 * KiB;
constexpr size_t WS_PBAR = 2688 * KiB;
constexpr size_t WS_E = 3 * MiB;
constexpr size_t WS_WQ = 7 * MiB;
constexpr size_t WS_WKV = WS_WQ + 768 * KiB;
constexpr size_t WS_WGLU = WS_WKV + 1 * MiB;
constexpr size_t WS_WBO = WS_WGLU + 1 * MiB;
constexpr size_t WS_WOUT = WS_WBO + 6 * MiB;
constexpr size_t WS_WIN = 20 * MiB;
constexpr size_t WS_XG = 48 * MiB;
constexpr size_t WS_PROJ = 80 * MiB;
constexpr size_t WS_QUP = 160 * MiB;
constexpr size_t WS_KVUP = 184 * MiB;
constexpr size_t WS_KM = 216 * MiB;
constexpr size_t WS_Z = 240 * MiB;
constexpr size_t WS_END = 256 * MiB;
static_assert(WS_WOUT + 4 * MiB <= WS_WIN && WS_WIN + 28 * MiB <= WS_XG, "ws map");

__device__ __forceinline__ unsigned pk_bf16(float lo, float hi) {
    typedef __bf16 b2 __attribute__((ext_vector_type(2)));
    f32x2 v = {lo, hi}; b2 b = __builtin_convertvector(v, b2); return __builtin_bit_cast(unsigned, b);
}
__device__ __forceinline__ float bf_lo(unsigned w) { return __uint_as_float(w << 16); }
__device__ __forceinline__ float bf_hi(unsigned w) { return __uint_as_float(w & 0xffff0000u); }
__device__ __forceinline__ float bf2f(bf16_t h) { return __uint_as_float(((unsigned)h) << 16); }
__device__ __forceinline__ bf16_t f2bf(float f) { return (bf16_t)(pk_bf16(f, 0.f) & 0xffffu); }
__device__ __forceinline__ float sigmoidf_(float v) { return 1.f / (1.f + __expf(-v)); }
__device__ __forceinline__ float siluf_(float v) { return v / (1.f + __expf(-v)); }
__device__ __forceinline__ float gelu_tanh(float y) {
    const float v = 0.7978845608028654f * (y + 0.044715f * y * y * y);
    const float t = 1.f - 2.f / (1.f + __expf(2.f * v));
    return 0.5f * y * (1.f + t);
}
template <int CTRL> __device__ __forceinline__ float dpp_f(float v) { return __builtin_bit_cast(float, __builtin_amdgcn_update_dpp(0, __builtin_bit_cast(int, v), CTRL, 0xF, 0xF, true)); }
__device__ __forceinline__ float sum8(float v) { v += dpp_f<0xB1>(v); v += dpp_f<0x4E>(v); v += dpp_f<0x141>(v); return v; }
__device__ __forceinline__ float wave_sum(float v) {
    v = sum8(v); v += dpp_f<0x140>(v);
    const int iv = __builtin_bit_cast(int, v);
    const float a = __builtin_bit_cast(float, __builtin_amdgcn_readlane(iv, 0)), b = __builtin_bit_cast(float, __builtin_amdgcn_readlane(iv, 16));
    const float c = __builtin_bit_cast(float, __builtin_amdgcn_readlane(iv, 32)), d = __builtin_bit_cast(float, __builtin_amdgcn_readlane(iv, 48));
    return (a + b) + (c + d);
}
#define SBAR() __builtin_amdgcn_sched_barrier(0)

namespace pg8 {
constexpr int BM = 256, BK = 64, HALF = 128, HTB = HALF * BK * 2, STAGE_BYTES = 8 * HTB;
__device__ __forceinline__ int lds_byte(int r, int c) { const int st = (r >> 4) * 2 + (c >> 5), rr = r & 15, cc = c & 31, ob = rr * 64 + cc * 2; return st * 1024 + (ob ^ (((ob >> 9) & 1) << 5)); }
__device__ __forceinline__ void stage_rc(int b, int& R, int& C) { const int st = b / 1024, sb = b % 1024, swz = sb ^ (((sb >> 9) & 1) << 5); R = (st >> 1) * 16 + swz / 64; C = (st & 1) * 32 + (swz % 64) / 2; }
__device__ __forceinline__ int perm32(int rho) { const int n = rho >> 4, i = rho & 15; return 8 * (i >> 2) + 4 * n + (i & 3); }

struct Unit { const char* A; const char* B; int pm, pn, kind; };

__device__ __forceinline__ bool tile_at(long L, int nM, int nN, int& pm, int& pn) {
    const int nwg = nM * nN; if (L >= nwg) return false;
    int wgid = (int)L; { const int q = nwg / 8, r = nwg % 8, xcd = wgid % 8, off = wgid / 8; wgid = (xcd < r ? xcd * (q + 1) : r * (q + 1) + (xcd - r) * q) + off; }
    const int WGM = 8, nig = WGM * nN, gid = wgid / nig, fm = gid * WGM;
    pm = fm + ((wgid % nig) & (WGM - 1)); pn = (wgid % nig) / WGM; return true;
}

template <class Epi, class Sched>
__device__ __forceinline__ void gemm_phase(LAS unsigned char* lds, const int lda, const int ldb, const int nt, const Sched& S, const Epi& E) {
    int tid = threadIdx.x; asm volatile("" : "+v"(tid));
    const int wid = __builtin_amdgcn_readfirstlane(tid >> 6), lane = tid & 63, wr = wid >> 2, wc = wid & 3, fr = lane & 15, fq = lane >> 4;
    unsigned voffA[2], voffB[2];
#pragma unroll
    for (int i = 0; i < 2; ++i) { int R, C; stage_rc(tid * 16 + i * 8192, R, C); const int Rb = Epi::PERM ? ((R & ~31) + perm32(R & 31)) : R;
        voffA[i] = (unsigned)(R * lda + C) * 2u; voffB[i] = (unsigned)(Rb * ldb + C) * 2u; }
    int ntv = nt; asm volatile("" : "+s"(ntv));
    const size_t kstep = (size_t)(BK * 2);
    const size_t hstepA = (size_t)HALF * lda * 2, hstepB = (size_t)HALF * ldb * 2;
    const unsigned ldsw = (unsigned)wid * 1024u;
    const int aoff = lds_byte(wr * 64 + fr, fq * 8), boff = lds_byte(wc * 32 + fr, fq * 8);
#define PG8_SA(b, h) (((b) * 2 + (h)) * HTB)
#define PG8_SB(b, h) ((4 + (b) * 2 + (h)) * HTB)
#define PG8_STAGE(bufoff, gbase, voff) do { _Pragma("unroll") for (int _i = 0; _i < 2; ++_i) \
        __builtin_amdgcn_global_load_lds((const unsigned*)((const char*)(gbase) + (voff)[_i]), (LAS unsigned*)(lds + (bufoff) + ldsw + _i * 8192), 16, 0, 0); } while (0)
#define PG8_LDA(dst, b, h) do { _Pragma("unroll") for (int m = 0; m < 4; ++m) _Pragma("unroll") for (int k = 0; k < 2; ++k) dst[m][k] = *(const LAS bf16x8*)(lds + PG8_SA(b, h) + aoff + m * 2048 + k * 1024); } while (0)
#define PG8_LDB(dst, b, h) do { _Pragma("unroll") for (int n = 0; n < 2; ++n) _Pragma("unroll") for (int k = 0; k < 2; ++k) dst[n][k] = *(const LAS bf16x8*)(lds + PG8_SB(b, h) + boff + n * 2048 + k * 1024); } while (0)
#define PG8_MMA(ai, bj, At, Bt) do { __builtin_amdgcn_s_setprio(1); _Pragma("unroll") for (int m = 0; m < 4; ++m) _Pragma("unroll") for (int n = 0; n < 2; ++n) _Pragma("unroll") for (int k = 0; k < 2; ++k) \
        acc[ai][bj][m][n] = __builtin_amdgcn_mfma_f32_16x16x32_bf16(Bt[n][k], At[m][k], acc[ai][bj][m][n], 0, 0, 0); __builtin_amdgcn_s_setprio(0); } while (0)
#define PG8_WAIT_V(n) asm volatile("s_waitcnt vmcnt(" #n ")" ::: "memory")
#define PG8_WAIT_L(n) asm volatile("s_waitcnt lgkmcnt(" #n ")" ::: "memory")
#define PG8_BAR __builtin_amdgcn_s_barrier()
#define PG8_SCHED __builtin_amdgcn_sched_barrier(0)
    Unit cur, nxt; int ui = 0;
    if (!S.next(0, cur)) return;
    f32x4 acc[2][2][4][2];
#pragma unroll
    for (int a = 0; a < 2; ++a)
#pragma unroll
        for (int b = 0; b < 2; ++b)
#pragma unroll
            for (int m = 0; m < 4; ++m)
#pragma unroll
                for (int n = 0; n < 2; ++n) acc[a][b][m][n] = (f32x4){0.f, 0.f, 0.f, 0.f};
    bf16x8 At[4][2], B0[2][2], B1[2][2];
    const char* cA = cur.A; const char* cB = cur.B;
    PG8_STAGE(PG8_SB(0, 0), cB, voffB); PG8_STAGE(PG8_SB(0, 1), cB + hstepB, voffB); PG8_STAGE(PG8_SA(0, 0), cA, voffA); PG8_STAGE(PG8_SA(0, 1), cA + hstepA, voffA);
    if (wr == 1) PG8_BAR;
    PG8_WAIT_V(2); PG8_BAR;
    PG8_STAGE(PG8_SB(1, 0), cB + kstep, voffB); PG8_STAGE(PG8_SA(1, 0), cA + kstep, voffA); PG8_STAGE(PG8_SB(1, 1), cB + hstepB + kstep, voffB);
    PG8_WAIT_V(6); PG8_BAR;
    for (;;) {
        const bool has_next = S.next(ui + 1, nxt);
        const char* nA = has_next ? nxt.A : cA; const char* nB = has_next ? nxt.B : cB;
        for (int t = 0; t < ntv; t += 2) {
            const bool last = (t == ntv - 2);
            const char* a1 = cA + (size_t)(t + 1) * kstep;
            const char* a2 = last ? nA : cA + (size_t)(t + 2) * kstep; const char* b2 = last ? nB : cB + (size_t)(t + 2) * kstep;
            const char* a3 = a2 + kstep; const char* b3 = b2 + kstep;
            PG8_LDB(B0, 0, 0); PG8_LDB(B1, 0, 1); PG8_SCHED; PG8_LDA(At, 0, 0); PG8_STAGE(PG8_SA(1, 1), a1 + hstepA, voffA);
            PG8_WAIT_V(8); PG8_WAIT_L(0); PG8_BAR; PG8_MMA(0, 0, At, B0); PG8_MMA(0, 1, At, B1); PG8_BAR; PG8_SCHED;
            PG8_LDA(At, 0, 1); PG8_STAGE(PG8_SB(0, 0), b2, voffB); PG8_STAGE(PG8_SB(0, 1), b2 + hstepB, voffB); PG8_STAGE(PG8_SA(0, 0), a2, voffA);
            PG8_WAIT_V(8); PG8_WAIT_L(0); PG8_BAR; PG8_MMA(1, 0, At, B0); PG8_MMA(1, 1, At, B1); PG8_BAR; PG8_SCHED;
            PG8_LDB(B0, 1, 0); PG8_LDB(B1, 1, 1); PG8_SCHED; PG8_LDA(At, 1, 0); PG8_STAGE(PG8_SA(0, 1), a2 + hstepA, voffA);
            PG8_WAIT_V(8); PG8_WAIT_L(0); PG8_BAR; PG8_MMA(0, 0, At, B0); PG8_MMA(0, 1, At, B1); PG8_BAR; PG8_SCHED;
            PG8_LDA(At, 1, 1); PG8_STAGE(PG8_SB(1, 0), b3, voffB); PG8_STAGE(PG8_SB(1, 1), b3 + hstepB, voffB); PG8_STAGE(PG8_SA(1, 0), a3, voffA);
            PG8_WAIT_V(8); PG8_WAIT_L(0); PG8_BAR; PG8_MMA(1, 0, At, B0); PG8_MMA(1, 1, At, B1); PG8_BAR; PG8_SCHED;
        }
        if (wr == 0) PG8_BAR;
        const bool keep = E(acc, cur, wr, wc, fr, fq);
        if (!has_next) break;
        if (!keep) {
#pragma unroll
            for (int a = 0; a < 2; ++a)
#pragma unroll
                for (int b = 0; b < 2; ++b)
#pragma unroll
                    for (int m = 0; m < 4; ++m)
#pragma unroll
                        for (int n = 0; n < 2; ++n) acc[a][b][m][n] = (f32x4){0.f, 0.f, 0.f, 0.f};
        }
        cur = nxt; cA = nA; cB = nB; ++ui;
        if (wr == 1) PG8_BAR;
    }
    PG8_WAIT_V(0);
    PG8_BAR;
#undef PG8_SA
#undef PG8_SB
#undef PG8_STAGE
#undef PG8_LDA
#undef PG8_LDB
#undef PG8_MMA
#undef PG8_WAIT_V
#undef PG8_WAIT_L
#undef PG8_BAR
#undef PG8_SCHED
}
}

struct Args {
    const float* in[25];
    float* out;
    unsigned char* ws;
    int ph_lo, ph_hi, probe, pad;
};
enum { I_X = 0, I_POS, I_NORMG, I_WIN, I_QAN, I_WQUP, I_KVAN, I_WKVUP, I_MQN, I_MKN, I_FBF, I_FQN, I_FKN,
       I_LRE, I_LIM, I_LDT, I_BRE, I_BIM, I_CRE, I_CIM, I_S5D, I_WGLU, I_BGLU, I_WBO, I_WOUT };

typedef const __attribute__((address_space(4))) Args* ArgsP;
__device__ __forceinline__ ArgsP get_args() { ArgsP p = (ArgsP)__builtin_amdgcn_kernarg_segment_ptr(); asm volatile("" : "+s"(p)); return p; }
__device__ __forceinline__ int grid_g() { int g = (int)gridDim.x; asm volatile("" : "+s"(g)); return g; }
struct Ctx {
    LAS unsigned char* lds;
    char* ldsg;
    int G, bid;
    int vb;
};
#define PHASE_IDS() int tid = threadIdx.x; asm volatile("" : "+v"(tid)); const int lane = tid & 63, wave = __builtin_amdgcn_readfirstlane(tid >> 6); (void)lane; (void)wave

using pg8::Unit;
using pg8::tile_at;

__device__ __forceinline__ float rstd_of(const float* ss, int row) { return rsqrtf(ss[row] * (1.f / DM) + EPS); }

struct SchedIn {
    const char* XG; const char* WIN; int mode, G, c;
    __device__ __forceinline__ bool next(int i, Unit& u) const {
        int pm, pn; if (!tile_at((long)(i >> 1) * G + c, 64, mode ? 2 : 8, pm, pn)) return false;
        pn = mode ? pn + 6 : (pn >= 6 ? pn + 2 : pn);
        const int h = i & 1;
        u.A = XG + ((size_t)h * T_ + (size_t)pm * 256) * 512 * 2;
        u.B = WIN + ((size_t)h * NIN + (size_t)pn * 256) * 512 * 2;
        u.pm = pm; u.pn = pn; u.kind = h; return true;
    }
};
struct EpiProj {
    static constexpr bool PERM = true;
    bf16_t* P; const float* ss; float* ff32; float* ssq;
    __device__ __forceinline__ bool operator()(f32x4 (&acc)[2][2][4][2], const Unit& u, int wr, int wc, int fr, int fq) const {
        if (u.kind == 0) return true;
        const int row0 = u.pm * 256 + wr * 64 + fr, col0 = u.pn * 256 + wc * 32 + 8 * fq;
        float rs[2][4];
#pragma unroll
        for (int ai = 0; ai < 2; ++ai)
#pragma unroll
            for (int m = 0; m < 4; ++m) rs[ai][m] = ss[row0 + ai * 128 + m * 16];
#pragma unroll
        for (int ai = 0; ai < 2; ++ai)
#pragma unroll
            for (int m = 0; m < 4; ++m) { const int row = row0 + ai * 128 + m * 16; const float r_ = rsqrtf(rs[ai][m] * (1.f / DM) + EPS); bf16_t* rp = P + (size_t)row * NPROJ + col0;
#pragma unroll
                for (int bj = 0; bj < 2; ++bj) { const f32x4 v0 = acc[ai][bj][m][0] * r_, v1 = acc[ai][bj][m][1] * r_;
                    u32x4 w; w.x = pk_bf16(v0[0], v0[1]); w.y = pk_bf16(v0[2], v0[3]); w.z = pk_bf16(v1[0], v1[1]); w.w = pk_bf16(v1[2], v1[3]);
                    *(u32x4*)(rp + bj * 128) = w;
                    if (u.pn == 1 && bj == 1 && wc == 1 && fq == 0) { float* f = ff32 + (size_t)row * 8; *(f32x4*)f = v0; *(f32x4*)(f + 4) = v1; } }
                if (u.pn < 2) {
                    const f32x4 a0 = acc[ai][0][m][0] * r_, a1 = acc[ai][0][m][1] * r_; float sq = (a0[0] * a0[0] + a0[1] * a0[1]) + (a0[2] * a0[2] + a0[3] * a0[3]) + (a1[0] * a1[0] + a1[1] * a1[1]) + (a1[2] * a1[2] + a1[3] * a1[3]);
                    if (u.pn == 0) { const f32x4 b0 = acc[ai][1][m][0] * r_, b1 = acc[ai][1][m][1] * r_; sq += (b0[0] * b0[0] + b0[1] * b0[1]) + (b0[2] * b0[2] + b0[3] * b0[3]) + (b1[0] * b1[0] + b1[1] * b1[1]) + (b1[2] * b1[2] + b1[3] * b1[3]); }
                    sq += __shfl_xor(sq, 16); sq += __shfl_xor(sq, 32);
                    if (fq == 0) atomicAdd(ssq + (u.pn == 0 ? 0 : NL * T_) + row, sq); } }
        return false;
    }
};

struct SchedUp { const char* P; const char* WQ; const char* WKV; int G, c;
    __device__ __forceinline__ bool next(int i, Unit& u) const {
        long L = (long)i * G + c; int pm, pn;
        if (G == 256) { if (c < 128 || i >= 4) return false; L = (long)i * 128 + (c - 128); }
        if (L < 256) { tile_at(L, 64, 4, pm, pn); u.A = P + (size_t)pm * 256 * NPROJ * 2 + 256 * 2; u.B = WKV + (size_t)pn * 256 * 256 * 2; u.kind = 1; }
        else { if (!tile_at(L - 256, 64, 3, pm, pn)) return false; u.A = P + (size_t)pm * 256 * NPROJ * 2; u.B = WQ + (size_t)pn * 256 * 256 * 2; u.kind = 0; }
        u.pm = pm; u.pn = pn; return true; }
};
struct SchedPlain { const char* A; size_t a_tile_bytes, a_batch_bytes; const char* B; size_t b_tile_bytes; int nN, G, c;
    __device__ __forceinline__ bool next(int i, Unit& u) const {
        int pm, pn; if (!tile_at((long)i * G + c, 64, nN, pm, pn)) return false;
        u.A = A + (size_t)(pm >> 3) * a_batch_bytes + (size_t)(pm & 7) * a_tile_bytes; u.B = B + (size_t)pn * b_tile_bytes; u.pm = pm; u.pn = pn; u.kind = 0; return true; }
};
struct EpiUp { static constexpr bool PERM = true; bf16_t* QUP; bf16_t* KM; bf16_t* VM; const float* ssq;
    __device__ __forceinline__ bool operator()(f32x4 (&acc)[2][2][4][2], const Unit& u, int wr, int wc, int fr, int fq) const {
        const int row0 = u.pm * 256 + wr * 64 + fr, col0 = u.pn * 256 + wc * 32 + 8 * fq;
        float rs[2][4];
#pragma unroll
        for (int ai = 0; ai < 2; ++ai)
#pragma unroll
            for (int m = 0; m < 4; ++m) rs[ai][m] = ssq[(u.kind ? NL * T_ : 0) + row0 + ai * 128 + m * 16];
        const float inv = u.kind ? (1.f / 128) : (1.f / 256);
        bf16_t* dbase[2]; int dstr[2];
#pragma unroll
        for (int bj = 0; bj < 2; ++bj) { const int col = col0 + bj * 128;
            if (u.kind == 0) { dbase[bj] = QUP + col; dstr[bj] = 768; }
            else { const int hd = col >> 7, d = col & 127; if (d < 64) { dbase[bj] = KM + 96 * hd + d; dstr[bj] = 768; } else { dbase[bj] = VM + 64 * hd + (d - 64); dstr[bj] = 512; } } }
#pragma unroll
        for (int ai = 0; ai < 2; ++ai)
#pragma unroll
            for (int m = 0; m < 4; ++m) { const int row = row0 + ai * 128 + m * 16; const float r_ = rsqrtf(rs[ai][m] * inv + EPS);
#pragma unroll
                for (int bj = 0; bj < 2; ++bj) { const f32x4 v0 = acc[ai][bj][m][0] * r_, v1 = acc[ai][bj][m][1] * r_;
                    u32x4 w; w.x = pk_bf16(v0[0], v0[1]); w.y = pk_bf16(v0[2], v0[3]); w.z = pk_bf16(v1[0], v1[1]); w.w = pk_bf16(v1[2], v1[3]);
                    *(u32x4*)(dbase[bj] + (size_t)row * dstr[bj]) = w; } }
        return false;
    }
};
struct SchedGate { const char* ws; int l, G, c;
    __device__ __forceinline__ bool next(int i, Unit& u) const {
        const char* XG = ws + WS_XG; const char* WIN = ws + WS_WIN + (size_t)l * 2 * NIN * 512 * 2; const char* Z = ws + WS_Z; const char* WGLU = ws + WS_WGLU + (size_t)l * 512 * 512 * 2;
        int pm, pn, j;
        if (G == 256) {
            const int x = c & 7, k = c >> 3;
            if (k < 16) { if (i >= 4) return false; pm = 8 * x + (k & 7); pn = 2 * (k >> 3) + (i >> 1); j = i & 1; }
            else { if (i >= 3) return false; const int kk = k - 16; pm = 8 * x + (kk & 7); pn = 4 + (kk >> 3); j = i - 1; }
        } else {
            int Gv = G; asm volatile("" : "+s"(Gv));
            const int t3 = (128 - c + Gv - 1) / Gv;
            const int ns5 = (c < 128) ? t3 : 0;
            if (i < 3 * ns5) { const int m = c + (i / 3) * G; pm = m >> 1; pn = 4 + (m & 1); j = i % 3 - 1; }
            else { const int i2 = i - 3 * ns5; const long n = (long)(i2 >> 1) * G + c; if (n >= 256) return false; pm = (int)(n >> 2); pn = (int)(n & 3); j = i2 & 1; }
        }
        if (j < 0) { u.A = Z + (size_t)pm * 256 * 512 * 2; u.B = WGLU + (size_t)(pn & 1) * 256 * 512 * 2; u.kind = 2; }
        else { u.A = XG + ((size_t)j * T_ + (size_t)pm * 256) * 512 * 2; u.B = WIN + ((size_t)j * NIN + 2560 + (size_t)pn * 256) * 512 * 2; u.kind = j; }
        u.pm = pm; u.pn = pn; return true;
    }
};
struct EpiGate { static constexpr bool PERM = true; unsigned char* ws; const float* bias; int l;
    __device__ __forceinline__ bool operator()(f32x4 (&acc)[2][2][4][2], const Unit& u, int wr, int wc, int fr, int fq) const {
        if (u.kind == 0) return true;
        bf16_t* P = (bf16_t*)(ws + WS_PROJ); const bf16_t* QUP = (const bf16_t*)(ws + WS_QUP); const bf16_t* Z = (const bf16_t*)(ws + WS_Z); bf16_t* ABO = (bf16_t*)(ws + WS_KVUP); const float* ss = (const float*)(ws + WS_SS) + (size_t)l * T_;
        const int br = u.pn >> 1;
        const int row0 = u.pm * 256 + wr * 64 + fr, c0 = (u.pn & 1) * 256 + wc * 32 + 8 * fq;
        if (u.kind == 2) {
            f32x4 bv[2][2];
#pragma unroll
            for (int bj = 0; bj < 2; ++bj) { bv[bj][0] = *(const f32x4*)(bias + c0 + bj * 128); bv[bj][1] = *(const f32x4*)(bias + c0 + bj * 128 + 4); }
#pragma unroll
            for (int ai = 0; ai < 2; ++ai) {
                u32x4 yv[4][2];
#pragma unroll
                for (int m = 0; m < 4; ++m)
#pragma unroll
                    for (int bj = 0; bj < 2; ++bj) yv[m][bj] = *(const u32x4*)(Z + (size_t)(row0 + ai * 128 + m * 16) * 512 + c0 + bj * 128);
#pragma unroll
                for (int m = 0; m < 4; ++m) { const int row = row0 + ai * 128 + m * 16;
#pragma unroll
                    for (int bj = 0; bj < 2; ++bj) { const int c = c0 + bj * 128; const f32x4 v0 = acc[ai][bj][m][0] + bv[bj][0], v1 = acc[ai][bj][m][1] + bv[bj][1];
                        const u32x4 z = yv[m][bj];
                        u32x4 w;
                        w.x = pk_bf16(bf_lo(z.x) * sigmoidf_(v0[0]), bf_hi(z.x) * sigmoidf_(v0[1]));
                        w.y = pk_bf16(bf_lo(z.y) * sigmoidf_(v0[2]), bf_hi(z.y) * sigmoidf_(v0[3]));
                        w.z = pk_bf16(bf_lo(z.z) * sigmoidf_(v1[0]), bf_hi(z.z) * sigmoidf_(v1[1]));
                        w.w = pk_bf16(bf_lo(z.w) * sigmoidf_(v1[2]), bf_hi(z.w) * sigmoidf_(v1[3]));
                        *(u32x4*)(P + (size_t)row * NPROJ + c) = w; } }
            }
            return false;
        }
        const unsigned abo2 = (br == 2) ? (unsigned)(u.pm >> 3) * (512u << 10) + (unsigned)(u.pm & 7) * (64u << 10) : 0u;
        float rs[2][4];
#pragma unroll
        for (int ai = 0; ai < 2; ++ai)
#pragma unroll
            for (int m = 0; m < 4; ++m) rs[ai][m] = ss[row0 + ai * 128 + m * 16];
#pragma unroll
        for (int ai = 0; ai < 2; ++ai) {
            u32x4 yv[4][2];
#pragma unroll
            for (int m = 0; m < 4; ++m) { const int row = row0 + ai * 128 + m * 16;
#pragma unroll
                for (int bj = 0; bj < 2; ++bj) { const int c = c0 + bj * 128;
                    const bf16_t* ysrc = (br == 0) ? (QUP + (size_t)row * 768 + 96 * (c >> 6) + (c & 63)) : (br == 1) ? (P + (size_t)row * NPROJ + 512 + c) : (P + (size_t)row * NPROJ + c);
                    yv[m][bj] = *(const u32x4*)ysrc; } }
#pragma unroll
            for (int m = 0; m < 4; ++m) { const int row = row0 + ai * 128 + m * 16; const float r_ = rsqrtf(rs[ai][m] * (1.f / DM) + EPS);
#pragma unroll
                for (int bj = 0; bj < 2; ++bj) { const int c = c0 + bj * 128;
                    const u32x4 y = yv[m][bj];
                    const f32x4 v0 = acc[ai][bj][m][0] * r_, v1 = acc[ai][bj][m][1] * r_;
                    u32x4 w;
                    w.x = pk_bf16(bf_lo(y.x) * siluf_(v0[0]), bf_hi(y.x) * siluf_(v0[1]));
                    w.y = pk_bf16(bf_lo(y.y) * siluf_(v0[2]), bf_hi(y.y) * siluf_(v0[3]));
                    w.z = pk_bf16(bf_lo(y.z) * siluf_(v1[0]), bf_hi(y.z) * siluf_(v1[1]));
                    w.w = pk_bf16(bf_lo(y.w) * siluf_(v1[2]), bf_hi(y.w) * siluf_(v1[3]));
                    *(u32x4*)(ABO + ((size_t)br * T_ + row) * 512 + abo2 + c) = w; } }
        }
        return false;
    }
};
enum { MOP_KEEP = 0, MOP_STORE_O = 1, MOP_GATE_RMW = 2, MOP_STORE_S = 3, MOP_O_RMW = 4, MOP_FIRST = 8 };
struct SchedMerge { const char* ws; int l, G, c;
    __device__ __forceinline__ bool next(int i, Unit& u) const {
        const char* ABO = ws + WS_KVUP; const char* WBO = ws + WS_WBO + (size_t)l * 3 * 1024 * 512 * 2; const char* XG = ws + WS_XG; const char* WIN = ws + WS_WIN + (size_t)l * 2 * NIN * 512 * 2;
        int pm, pn; if (!tile_at((long)(i / 9) * G + c, 64, 4, pm, pn)) return false;
        const int j = i % 9; int typ, br, h = 0, op;
        if (G != 256 || !(c & 1)) { br = j / 3; const int s_ = j % 3; typ = s_ != 0; h = s_ - 1; op = s_ == 0 ? MOP_STORE_O : s_ == 1 ? MOP_KEEP : (MOP_GATE_RMW | (br == 0 ? MOP_FIRST : 0)); }
        else if (j < 2) { typ = 1; br = 2; h = j; op = j ? MOP_STORE_S : MOP_KEEP; }
        else { const int jj = j - 2, g = jj / 3, r = jj % 3; br = g;
            if (g == 2) { typ = 0; op = MOP_O_RMW; }
            else if (r == 0) { typ = 0; op = MOP_STORE_O; }
            else { typ = 1; h = r - 1; op = r == 1 ? MOP_KEEP : (MOP_GATE_RMW | (g == 0 ? MOP_FIRST : 0)); } }
        if (typ == 0) { u.A = ABO + ((size_t)br * T_ + (size_t)pm * 256) * 512 * 2 + (br == 2 ? ((size_t)(pm >> 3) << 20) + ((size_t)(pm & 7) << 17) : 0); u.B = WBO + ((size_t)br * 1024 + (size_t)pn * 256) * 512 * 2; }
        else { u.A = XG + ((size_t)h * T_ + (size_t)pm * 256) * 512 * 2; u.B = WIN + ((size_t)h * NIN + 4096 + (size_t)br * 1024 + (size_t)pn * 256) * 512 * 2; }
        u.pm = pm; u.pn = pn; u.kind = op; return true;
    }
};
struct EpiMerge { static constexpr bool PERM = true; unsigned char* ws; int l, bid;
    __device__ __forceinline__ bf16_t* scr2() const { unsigned b_ = (unsigned)bid; asm volatile("" : "+s"(b_)); const unsigned sb = b_ & 7u, sj = (b_ >> 3) & 7u, sm = (b_ >> 6) & 3u;
        return (bf16_t*)(ws + (sm < 2u ? (unsigned)WS_Z + sb * (2u << 20) + sj * (256u << 10) + sm * 131072u : (unsigned)WS_PROJ + sb * (10u << 20) + sj * (1280u << 10) + (1u << 20) + (sm - 2u) * 131072u)); }
    __device__ __forceinline__ bool operator()(f32x4 (&acc)[2][2][4][2], const Unit& u, int wr, int wc, int fr, int fq) const {
        const int op = u.kind & 7; const bool first = (u.kind & MOP_FIRST) != 0;
        if (op == MOP_KEEP) return true;
        bf16_t* OSCR = (bf16_t*)(ws + WS_PROJ) + (unsigned)(u.pm >> 3) * (3u << 20) + (unsigned)(u.pm & 7) * (384u << 10); bf16_t* MERGED = OSCR + (256u << 10); const float* ss = (const float*)(ws + WS_SS) + (size_t)l * T_;
        const int rt0 = wr * 64 + fr, ct0 = wc * 32 + 8 * fq;
        const int row0 = u.pm * 256 + rt0, col0 = u.pn * 256 + ct0;
        if (op == MOP_STORE_O) {
#pragma unroll
            for (int ai = 0; ai < 2; ++ai)
#pragma unroll
                for (int m = 0; m < 4; ++m) { const size_t off = (size_t)(row0 + ai * 128 + m * 16) * 1024 + col0;
#pragma unroll
                    for (int bj = 0; bj < 2; ++bj) { const f32x4 v0 = acc[ai][bj][m][0], v1 = acc[ai][bj][m][1];
                        u32x4 w; w.x = pk_bf16(v0[0], v0[1]); w.y = pk_bf16(v0[2], v0[3]); w.z = pk_bf16(v1[0], v1[1]); w.w = pk_bf16(v1[2], v1[3]);
                        *(u32x4*)(OSCR + off + bj * 128) = w; } }
            return false;
        }
        if (op == MOP_O_RMW) {
            bf16_t* SCR2 = scr2();
#pragma unroll
            for (int qd = 0; qd < 4; ++qd) { const int ai = qd >> 1, m0 = (qd & 1) * 2;
                u32x4 sv[2][2], pv[2][2];
#pragma unroll
                for (int mm = 0; mm < 2; ++mm) { const int rr = ai * 128 + (m0 + mm) * 16; const size_t off = (size_t)(row0 + rr) * 1024 + col0;
#pragma unroll
                    for (int bj = 0; bj < 2; ++bj) { sv[mm][bj] = *(const u32x4*)(SCR2 + (size_t)(rt0 + rr) * 256 + ct0 + bj * 128); pv[mm][bj] = *(const u32x4*)(MERGED + off + bj * 128); } }
#pragma unroll
                for (int mm = 0; mm < 2; ++mm) { const int m = m0 + mm; const size_t off = (size_t)(row0 + ai * 128 + m * 16) * 1024 + col0;
#pragma unroll
                    for (int bj = 0; bj < 2; ++bj) { const f32x4 v0 = acc[ai][bj][m][0], v1 = acc[ai][bj][m][1]; const u32x4 g = sv[mm][bj], p = pv[mm][bj];
                        u32x4 w;
                        w.x = pk_bf16(bf_lo(p.x) + bf_lo(g.x) * v0[0], bf_hi(p.x) + bf_hi(g.x) * v0[1]); w.y = pk_bf16(bf_lo(p.y) + bf_lo(g.y) * v0[2], bf_hi(p.y) + bf_hi(g.y) * v0[3]);
                        w.z = pk_bf16(bf_lo(p.z) + bf_lo(g.z) * v1[0], bf_hi(p.z) + bf_hi(g.z) * v1[1]); w.w = pk_bf16(bf_lo(p.w) + bf_lo(g.w) * v1[2], bf_hi(p.w) + bf_hi(g.w) * v1[3]);
                        *(u32x4*)(MERGED + off + bj * 128) = w; } }
            }
            return false;
        }
        if (op == MOP_STORE_S) {
            bf16_t* SCR2 = scr2();
            float rs[2][4];
#pragma unroll
            for (int ai = 0; ai < 2; ++ai)
#pragma unroll
                for (int m = 0; m < 4; ++m) rs[ai][m] = ss[row0 + ai * 128 + m * 16];
#pragma unroll
            for (int ai = 0; ai < 2; ++ai)
#pragma unroll
                for (int m = 0; m < 4; ++m) { const int rr = ai * 128 + m * 16; const float r_ = rsqrtf(rs[ai][m] * (1.f / DM) + EPS);
#pragma unroll
                    for (int bj = 0; bj < 2; ++bj) { const f32x4 v0 = acc[ai][bj][m][0] * r_, v1 = acc[ai][bj][m][1] * r_;
                        u32x4 w; w.x = pk_bf16(sigmoidf_(v0[0]), sigmoidf_(v0[1])); w.y = pk_bf16(sigmoidf_(v0[2]), sigmoidf_(v0[3])); w.z = pk_bf16(sigmoidf_(v1[0]), sigmoidf_(v1[1])); w.w = pk_bf16(sigmoidf_(v1[2]), sigmoidf_(v1[3]));
                        *(u32x4*)(SCR2 + (size_t)(rt0 + rr) * 256 + ct0 + bj * 128) = w; } }
            return false;
        }
        float rq[8];
#pragma unroll
        for (int g = 0; g < 8; ++g) rq[g] = ss[row0 + (g >> 2) * 128 + (g & 3) * 16];
        u32x4 ov[2][2], pv[2][2];
#define RMW_LOAD(g, b) do { const size_t off_ = (size_t)(row0 + ((g) >> 2) * 128 + ((g) & 3) * 16) * 1024 + col0; \
            _Pragma("unroll") for (int bj = 0; bj < 2; ++bj) { ov[b][bj] = *(const u32x4*)(OSCR + off_ + bj * 128); pv[b][bj] = (u32x4){0u, 0u, 0u, 0u}; if (!first) pv[b][bj] = *(const u32x4*)(MERGED + off_ + bj * 128); } } while (0)
        RMW_LOAD(0, 0);
#pragma unroll
        for (int g = 0; g < 8; ++g) { const int ai = g >> 2, m = g & 3, b = g & 1; const size_t off = (size_t)(row0 + ai * 128 + m * 16) * 1024 + col0;
            if (g + 1 < 8) RMW_LOAD(g + 1, (g + 1) & 1);
            const float r_ = rsqrtf(rq[g] * (1.f / DM) + EPS);
#pragma unroll
            for (int bj = 0; bj < 2; ++bj) { const f32x4 v0 = acc[ai][bj][m][0] * r_, v1 = acc[ai][bj][m][1] * r_;
                const u32x4 o = ov[b][bj], p = pv[b][bj];
                u32x4 w;
                w.x = pk_bf16(bf_lo(p.x) + bf_lo(o.x) * sigmoidf_(v0[0]), bf_hi(p.x) + bf_hi(o.x) * sigmoidf_(v0[1]));
                w.y = pk_bf16(bf_lo(p.y) + bf_lo(o.y) * sigmoidf_(v0[2]), bf_hi(p.y) + bf_hi(o.y) * sigmoidf_(v0[3]));
                w.z = pk_bf16(bf_lo(p.z) + bf_lo(o.z) * sigmoidf_(v1[0]), bf_hi(p.z) + bf_hi(o.z) * sigmoidf_(v1[1]));
                w.w = pk_bf16(bf_lo(p.w) + bf_lo(o.w) * sigmoidf_(v1[2]), bf_hi(p.w) + bf_hi(o.w) * sigmoidf_(v1[3]));
                *(u32x4*)(MERGED + off + bj * 128) = w; } }
#undef RMW_LOAD
        return false;
    }
};
struct EpiOut { static constexpr bool PERM = false; const float* xres; float* out; bf16_t* XG; float* ssn; bool dry;
    __device__ __forceinline__ bool operator()(f32x4 (&acc)[2][2][4][2], const Unit& u, int wr, int wc, int fr, int fq) const {
        const int row0 = u.pm * 256 + wr * 64 + fr, col0 = u.pn * 256 + wc * 32 + 4 * fq;
#pragma unroll
        for (int qd = 0; qd < 4; ++qd) { const int ai = qd >> 1, m0 = (qd & 1) * 2;
            f32x4 xr[2][2][2];
            if (xres) {
#pragma unroll
                for (int mm = 0; mm < 2; ++mm) { const size_t off = (size_t)(row0 + ai * 128 + (m0 + mm) * 16) * DM + col0;
#pragma unroll
                    for (int bj = 0; bj < 2; ++bj)
#pragma unroll
                        for (int n = 0; n < 2; ++n) xr[mm][bj][n] = *(const f32x4*)(xres + off + bj * 128 + n * 16); }
            } else {
                u32x2 xb[2][2][2];
#pragma unroll
                for (int mm = 0; mm < 2; ++mm) { const int row = row0 + ai * 128 + (m0 + mm) * 16;
#pragma unroll
                    for (int bj = 0; bj < 2; ++bj)
#pragma unroll
                        for (int n = 0; n < 2; ++n) { const int col = col0 + bj * 128 + n * 16; xb[mm][bj][n] = *(const u32x2*)(XG + ((size_t)(col >> 9) * T_ + row) * 512 + (col & 511)); } }
#pragma unroll
                for (int mm = 0; mm < 2; ++mm)
#pragma unroll
                    for (int bj = 0; bj < 2; ++bj)
#pragma unroll
                        for (int n = 0; n < 2; ++n) { const u32x2 b = xb[mm][bj][n]; xr[mm][bj][n] = (f32x4){bf_lo(b.x), bf_hi(b.x), bf_lo(b.y), bf_hi(b.y)}; }
            }
#pragma unroll
            for (int mm = 0; mm < 2; ++mm) { const int m = m0 + mm; const int row = row0 + ai * 128 + m * 16; const size_t off = (size_t)row * DM + col0; float sq = 0.f;
#pragma unroll
                for (int bj = 0; bj < 2; ++bj)
#pragma unroll
                    for (int n = 0; n < 2; ++n) { const int cc = bj * 128 + n * 16; const f32x4 o = xr[mm][bj][n] + acc[ai][bj][m][n];
                        if (!ssn && !dry) *(f32x4*)(out + off + cc) = o;
                        if (ssn && !dry) { const int col = col0 + cc; sq += (o[0] * o[0] + o[1] * o[1]) + (o[2] * o[2] + o[3] * o[3]);
                            u32x2 w; w.x = pk_bf16(o[0], o[1]); w.y = pk_bf16(o[2], o[3]);
                            *(u32x2*)(XG + ((size_t)(col >> 9) * T_ + row) * 512 + (col & 511)) = w; } }
                if (ssn && !dry) { sq += __shfl_xor(sq, 16); sq += __shfl_xor(sq, 32); if (fq == 0) atomicAdd(ssn + row, sq); } }
        }
        return false;
    }
};

namespace attn {
constexpr int QBLK = 32, KVBLK = 64;
constexpr int SHM_K = KVBLK * 256, SHM_V = KVBLK * 64 * 2;
constexpr int NBUF = 3;
constexpr int LDS_V = 0, LDS_K = NBUF * SHM_V, LDS_CK = LDS_K + NBUF * SHM_K, LDS_WS = LDS_CK + NBUF * 256, LDS_OST = LDS_WS + 8 * 256, LDS_BYTES = LDS_OST + 8 * 4096;
constexpr float THR2 = 8.f;
#define KSWZ(row, colB) ((row) * 256 + ((colB) ^ (((row) & 15) << 4)))
__device__ __forceinline__ int crow(int r, int hi) { return (r & 3) + 8 * (r >> 2) + 4 * hi; }
__device__ __forceinline__ void partialSM(f32x16& p0, f32x16& p1, float& m_reg, float& alpha) {
    float pmax = p0[0];
#pragma unroll
    for (int r = 1; r < 16; ++r) pmax = fmaxf(pmax, p0[r]);
#pragma unroll
    for (int r = 0; r < 16; ++r) pmax = fmaxf(pmax, p1[r]);
    { auto rr = __builtin_amdgcn_permlane32_swap(__float_as_uint(pmax), __float_as_uint(pmax), false, false);
      pmax = fmaxf(__uint_as_float(rr[0]), __uint_as_float(rr[1])); }
    if (__builtin_expect(__all(pmax <= THR2), 1)) { alpha = 1.f; }
    else { const float dl = fmaxf(pmax, 0.f); m_reg += dl; alpha = __builtin_amdgcn_exp2f(-dl);
#pragma unroll
        for (int r = 0; r < 16; ++r) { p0[r] -= dl; p1[r] -= dl; } }
#pragma unroll
    for (int r = 0; r < 16; ++r) p0[r] = __builtin_amdgcn_exp2f(p0[r]);
}
__device__ __forceinline__ void finishSM(f32x16& p0, f32x16& p1, float alpha, float& l_reg, bf16x8& pa0, bf16x8& pa1, bf16x8& pa2, bf16x8& pa3) {
#pragma unroll
    for (int r = 0; r < 16; ++r) p1[r] = __builtin_amdgcn_exp2f(p1[r]);
    float ps = 0;
#pragma unroll
    for (int r = 0; r < 16; ++r) ps += p0[r];
#pragma unroll
    for (int r = 0; r < 16; ++r) ps += p1[r];
    { auto rr = __builtin_amdgcn_permlane32_swap(__float_as_uint(ps), __float_as_uint(ps), false, false);
      ps = __uint_as_float(rr[0]) + __uint_as_float(rr[1]); }
    l_reg = l_reg * alpha + ps;
#define PK4(P, BASE, OUT) do { unsigned a0 = pk_bf16(P[BASE + 0], P[BASE + 1]), a1 = pk_bf16(P[BASE + 2], P[BASE + 3]);   \
    unsigned b0 = pk_bf16(P[BASE + 4], P[BASE + 5]), b1 = pk_bf16(P[BASE + 6], P[BASE + 7]);                              \
    auto r0 = __builtin_amdgcn_permlane32_swap(a0, b0, false, false); auto r1 = __builtin_amdgcn_permlane32_swap(a1, b1, false, false); \
    u32x4 w = {r0[0], r1[0], r0[1], r1[1]}; OUT = __builtin_bit_cast(bf16x8, w); } while (0)
    PK4(p0, 0, pa0); PK4(p0, 8, pa1); PK4(p1, 0, pa2); PK4(p1, 8, pa3);
#undef PK4
}
__device__ __forceinline__ void expHalf(f32x16& p) {
#pragma unroll
    for (int r = 0; r < 16; ++r) p[r] = __builtin_amdgcn_exp2f(p[r]);
}
__device__ __forceinline__ void packP(const f32x16& p0, const f32x16& p1, bf16x8& pa0, bf16x8& pa1, bf16x8& pa2, bf16x8& pa3) {
#define PK4(P, BASE, OUT) do { unsigned a0 = pk_bf16(P[BASE + 0], P[BASE + 1]), a1 = pk_bf16(P[BASE + 2], P[BASE + 3]);   \
    unsigned b0 = pk_bf16(P[BASE + 4], P[BASE + 5]), b1 = pk_bf16(P[BASE + 6], P[BASE + 7]);                              \
    auto r0 = __builtin_amdgcn_permlane32_swap(a0, b0, false, false); auto r1 = __builtin_amdgcn_permlane32_swap(a1, b1, false, false); \
    u32x4 w = {r0[0], r1[0], r0[1], r1[1]}; OUT = __builtin_bit_cast(bf16x8, w); } while (0)
    PK4(p0, 0, pa0); PK4(p0, 8, pa1); PK4(p1, 0, pa2); PK4(p1, 8, pa3);
#undef PK4
}
__device__ __forceinline__ void sumP(const f32x16& p0, const f32x16& p1, float& l_reg) {
    float s0 = p0[0] + p0[1], s1 = p0[2] + p0[3], s2 = p1[0] + p1[1], s3 = p1[2] + p1[3];
#pragma unroll
    for (int r = 4; r < 16; r += 4) { s0 += p0[r] + p0[r + 1]; s1 += p0[r + 2] + p0[r + 3]; s2 += p1[r] + p1[r + 1]; s3 += p1[r + 2] + p1[r + 3]; }
    float ps = (s0 + s1) + (s2 + s3);
    { auto rr = __builtin_amdgcn_permlane32_swap(__float_as_uint(ps), __float_as_uint(ps), false, false); ps = __uint_as_float(rr[0]) + __uint_as_float(rr[1]); }
    l_reg += ps;
}
__device__ __forceinline__ void pv_sum(f32x16& la, bf16x8 pa0, bf16x8 pa1, bf16x8 pa2, bf16x8 pa3) {
    const u32x4 ow = {0x3F803F80u, 0x3F803F80u, 0x3F803F80u, 0x3F803F80u}; const bf16x8 ones = __builtin_bit_cast(bf16x8, ow);
    la = __builtin_amdgcn_mfma_f32_32x32x16_bf16(pa0, ones, la, 0, 0, 0);
    la = __builtin_amdgcn_mfma_f32_32x32x16_bf16(pa1, ones, la, 0, 0, 0);
    la = __builtin_amdgcn_mfma_f32_32x32x16_bf16(pa2, ones, la, 0, 0, 0);
    la = __builtin_amdgcn_mfma_f32_32x32x16_bf16(pa3, ones, la, 0, 0, 0);
}
__device__ __forceinline__ int v_st(int k, int c) { const int kk = (k & ~0xC) | ((k & 4) << 1) | ((k & 8) >> 1); return ((kk >> 3) * 2 + (c >> 5)) * 512 + ((kk & 7) * 32 + (c & 31)) * 2; }
__device__ __forceinline__ int v_rd_base(int lane) { return ((lane & 3) << 3) | (((lane >> 2) & 3) << 6) | (((lane >> 4) & 1) << 5) | (((lane >> 5) & 1) << 8); }
constexpr int v_rd_off(int d0, int ks, int half) { return d0 * 512 + ks * 2048 + half * 1024; }
template <int OFF> __device__ __forceinline__ s16x4 tr_read(int vb) {
    s16x4 r; asm volatile("ds_read_b64_tr_b16 %0, %1 offset:%2" : "=&v"(r) : "v"(vb), "i"(OFF) : "memory"); return r;
}
template <int OFF> __device__ __forceinline__ s16x4 trb(int vb) {
    return __builtin_amdgcn_ds_read_tr16_b64_v4i16((LAS s16x4*)(size_t)(unsigned)(vb + OFF));
}
#define SG(mask, n) __builtin_amdgcn_sched_group_barrier(mask, n, 0)
#define SGI(mask, n, id) __builtin_amdgcn_sched_group_barrier(mask, n, id)
#define SG_MFMA 0x008
#define SG_VALU 0x002
#define SG_DSR  0x100
template <int D0> __device__ __forceinline__ void pv_one(f32x16& od, int vb, bf16x8 pa0, bf16x8 pa1, bf16x8 pa2, bf16x8 pa3) {
    const s16x4 l0 = tr_read<v_rd_off(D0, 0, 0)>(vb), h0 = tr_read<v_rd_off(D0, 0, 1)>(vb), l1 = tr_read<v_rd_off(D0, 1, 0)>(vb), h1 = tr_read<v_rd_off(D0, 1, 1)>(vb);
    const s16x4 l2 = tr_read<v_rd_off(D0, 2, 0)>(vb), h2 = tr_read<v_rd_off(D0, 2, 1)>(vb), l3 = tr_read<v_rd_off(D0, 3, 0)>(vb), h3 = tr_read<v_rd_off(D0, 3, 1)>(vb);
    asm volatile("s_waitcnt lgkmcnt(0)" ::: "memory"); SBAR();
#define PKV(L, H) (bf16x8){L[0], L[1], L[2], L[3], H[0], H[1], H[2], H[3]}
    od = __builtin_amdgcn_mfma_f32_32x32x16_bf16(pa0, PKV(l0, h0), od, 0, 0, 0);
    od = __builtin_amdgcn_mfma_f32_32x32x16_bf16(pa1, PKV(l1, h1), od, 0, 0, 0);
    od = __builtin_amdgcn_mfma_f32_32x32x16_bf16(pa2, PKV(l2, h2), od, 0, 0, 0);
    od = __builtin_amdgcn_mfma_f32_32x32x16_bf16(pa3, PKV(l3, h3), od, 0, 0, 0);
#undef PKV
}

template <int DQK, bool FOX, bool TRACK>
__device__ __forceinline__ void attn_unit(bf16_t* Qh, int ldq, const bf16_t* Kh, int ldk, const bf16_t* Vh, int ldv, const float* cum, int q0, char* lds, bool dry, float sbound, int T0) {
    constexpr int ND = DQK / 16, KCH = DQK / 8;
    int tid = threadIdx.x; asm volatile("" : "+v"(tid));
    const int wid = __builtin_amdgcn_readfirstlane(tid >> 6), lane = tid & 63, r32 = lane & 31, hi = lane >> 5;
    char* V_lds = lds + LDS_V; char* K_lds = lds + LDS_K; float* CK_lds = (float*)(lds + LDS_CK);
    float* ws = (float*)(lds + LDS_WS) + wid * 64; float* li_l = ws; float* al_l = ws + 32;
    float m_reg = 0.f, l_reg = 0; f32x16 o[2]; o[0] = f32x16{}; o[1] = f32x16{}; bf16x8 qr[ND];
    const int qrow = q0 + wid * QBLK + r32;
    { const bf16_t* Qw = Qh + (size_t)qrow * ldq + hi * 8;
#pragma unroll
      for (int d0 = 0; d0 < ND; ++d0) qr[d0] = *reinterpret_cast<const bf16x8*>(Qw + d0 * 16); }
    float cq = 0.f; if (FOX) cq = cum[qrow];
    const int kr0 = tid / KCH, kc0 = tid % KCH;
    const int kr1 = (tid + 512) / KCH, kc1 = (tid + 512) % KCH;
    const bool k2 = (KCH * 64 > 512) && (tid + 512 < KCH * 64);
    const int vr = tid >> 3, vc = (tid & 7) * 8, vst = v_st(vr, vc);
    const int vb0 = (int)(uintptr_t)V_lds + v_rd_base(lane);
    struct Stg { bf16x8 k0, k1, v; f32x4 ck; } st[2];
    const int kr1c = (kr1 < 64) ? kr1 : 63;
    const int ckc = (tid & 15) * 4;
#define SLOAD(i, k0_) do { st[i].k0 = *reinterpret_cast<const bf16x8*>(Kh + (size_t)((k0_) + kr0) * ldk + kc0 * 8); \
      if (KCH * 64 > 512) st[i].k1 = *reinterpret_cast<const bf16x8*>(Kh + (size_t)((k0_) + kr1c) * ldk + kc1 * 8); \
      st[i].v = *reinterpret_cast<const bf16x8*>(Vh + (size_t)((k0_) + vr) * ldv + vc); \
      if (FOX) st[i].ck = *reinterpret_cast<const f32x4*>(cum + (k0_) + ckc); } while (0)
#define SWRITE(b, i) do { *(bf16x8*)(K_lds + (b) * SHM_K + KSWZ(kr0, kc0 * 16)) = st[i].k0; \
      if (k2) *(bf16x8*)(K_lds + (b) * SHM_K + KSWZ(kr1, kc1 * 16)) = st[i].k1; \
      *(bf16x8*)(V_lds + (b) * SHM_V + vst) = st[i].v; \
      if (FOX && tid < 16) *(f32x4*)(CK_lds + (b) * 64 + tid * 4) = st[i].ck; } while (0)
#define RESC(a) do { if (TRACK && __any((a) < 1.f)) { if (hi == 0) al_l[r32] = (a); asm volatile("s_waitcnt lgkmcnt(0)" ::: "memory"); \
      _Pragma("unroll") for (int d = 0; d < 2; ++d) _Pragma("unroll") for (int r = 0; r < 16; ++r) o[d][r] *= al_l[crow(r, hi)]; } } while (0)
    const int NT = (q0 + 256) / KVBLK;
    const int tlast = __builtin_amdgcn_readfirstlane((q0 + wid * QBLK + (FOX ? 31 : 0)) >> 6);
    int tfirst = 0;
    if (FOX && TRACK) { const float c0w = cum[q0 + wid * QBLK]; bool need = false; const int nbw = (q0 + wid * QBLK) >> 6;
        if (lane < nbw) need = (sbound + c0w - cum[64 * lane + 63] >= -40.f);
        const unsigned long long bal = __ballot(need);
        tfirst = __builtin_amdgcn_readfirstlane(bal ? (__ffsll((long long)bal) - 1) : nbw); }
    auto qkt = [&](f32x16& p0, f32x16& p1, int b, int t) {
        if (t > tlast || t < tfirst) return;
        const char* Ks = K_lds + b * SHM_K;
        if (FOX) { const float* ck = CK_lds + b * 64; const float cqm = TRACK ? cq - m_reg : cq;
#pragma unroll
            for (int g = 0; g < 4; ++g) { const f32x4 c0 = *(const f32x4*)(ck + 8 * g + 4 * hi), c1 = *(const f32x4*)(ck + 32 + 8 * g + 4 * hi);
#pragma unroll
                for (int i = 0; i < 4; ++i) { p0[4 * g + i] = cqm - c0[i]; p1[4 * g + i] = cqm - c1[i]; } }
        } else if (TRACK) { const float nm = -m_reg;
#pragma unroll
            for (int r = 0; r < 16; ++r) { p0[r] = nm; p1[r] = nm; } }
        else { p0 = f32x16{}; p1 = f32x16{}; }
#pragma unroll
        for (int d0 = 0; d0 < ND; ++d0) { const int cb = (d0 * 16 + hi * 8) * 2;
            const bf16x8 b0 = *reinterpret_cast<const bf16x8*>(Ks + KSWZ(r32, cb));
            const bf16x8 b1 = *reinterpret_cast<const bf16x8*>(Ks + KSWZ(32 + r32, cb));
            p0 = __builtin_amdgcn_mfma_f32_32x32x16_bf16(b0, qr[d0], p0, 0, 0, 0);
            p1 = __builtin_amdgcn_mfma_f32_32x32x16_bf16(b1, qr[d0], p1, 0, 0, 0); }
        if (FOX && t >= NT - 4) {
            asm volatile("" ::: "memory");
            const int kb = t * KVBLK + 4 * hi;
#pragma unroll
            for (int r = 0; r < 16; ++r) { const int kv = kb + (r & 3) + 8 * (r >> 2);
                if (kv > qrow) p0[r] = -INFINITY; if (kv + 32 > qrow) p1[r] = -INFINITY; }
        }
    };
#define PSM(P0, P1, AL, t) do { if (TRACK) { if ((t) <= tlast && (t) >= tfirst) partialSM(P0, P1, m_reg, AL); else AL = 1.f; } else if ((t) <= tlast && (t) >= tfirst) expHalf(P0); } while (0)
#define FSM(P0, P1, AL, t) do { if ((t) <= tlast && (t) >= tfirst) { if (TRACK) finishSM(P0, P1, AL, l_reg, pa0, pa1, pa2, pa3); else { expHalf(P1); sumP(P0, P1, l_reg); packP(P0, P1, pa0, pa1, pa2, pa3); } } } while (0)
#define PV(vb, t) do { if ((t) <= tlast && (t) >= tfirst) { pv_one<0>(o[0], vb, pa0, pa1, pa2, pa3); pv_one<1>(o[1], vb, pa0, pa1, pa2, pa3); } } while (0)
    f32x16 pA0, pA1, pB0, pB1; float alA, alB; bf16x8 pa0, pa1, pa2, pa3;
#define PKV(L, H) (bf16x8){L[0], L[1], L[2], L[3], H[0], H[1], H[2], H[3]}
#define SG_R1_STEP(nr) SG(SG_MFMA, 1); SG(SG_VALU, FOX ? 10 : 7); SG(SG_DSR, nr)
#define TRA(OFF) tr_read<OFF>(vbp_)
#define FAST_HALF(X0, X1, Y0, Y1, LOADSTMT, WRITESTMT) do { \
        SBAR(); \
        { const char* Ks = K_lds + bc * SHM_K; \
          if (FOX) { const float* ck = CK_lds + bc * 64; \
              _Pragma("unroll") for (int g = 0; g < 4; ++g) { const f32x4 c0 = *(const f32x4*)(ck + 8 * g + 4 * hi), c1 = *(const f32x4*)(ck + 32 + 8 * g + 4 * hi); \
                  _Pragma("unroll") for (int i = 0; i < 4; ++i) { X0[4 * g + i] = cq - c0[i]; X1[4 * g + i] = cq - c1[i]; } } } \
          else { X0 = f32x16{}; X1 = f32x16{}; } \
          _Pragma("unroll") for (int d0 = 0; d0 < ND; ++d0) { const int cb = (d0 * 16 + hi * 8) * 2; \
              const bf16x8 b0 = *reinterpret_cast<const bf16x8*>(Ks + KSWZ(r32, cb)); \
              const bf16x8 b1 = *reinterpret_cast<const bf16x8*>(Ks + KSWZ(32 + r32, cb)); \
              X0 = __builtin_amdgcn_mfma_f32_32x32x16_bf16(b0, qr[d0], X0, 0, 0, 0); \
              X1 = __builtin_amdgcn_mfma_f32_32x32x16_bf16(b1, qr[d0], X1, 0, 0, 0); } } \
        expHalf(Y1); sumP(Y0, Y1, l_reg); packP(Y0, Y1, pa0, pa1, pa2, pa3); \
        if (FOX) { SG(SG_DSR, 12); SG(SG_VALU, 32); SG_R1_STEP(1); SG_R1_STEP(1); SG_R1_STEP(1); SG_R1_STEP(1); SG_R1_STEP(0); SG_R1_STEP(0); SG_R1_STEP(0); SG_R1_STEP(0); } \
        else { SG(SG_DSR, 4); SG_R1_STEP(1); SG_R1_STEP(1); SG_R1_STEP(1); SG_R1_STEP(1); SG_R1_STEP(1); SG_R1_STEP(1); SG_R1_STEP(1); SG_R1_STEP(1); SG_R1_STEP(0); SG_R1_STEP(0); SG_R1_STEP(0); SG_R1_STEP(0); } \
        asm volatile("" : "+v"(X0), "+v"(X1), "+v"(pa0), "+v"(pa1), "+v"(pa2), "+v"(pa3), "+v"(l_reg));     \
        const int vbp_ = vb0 + bp * SHM_V; \
        const s16x4 va0 = TRA(v_rd_off(0, 0, 0)), va1 = TRA(v_rd_off(0, 0, 1)), va2 = TRA(v_rd_off(0, 1, 0)), va3 = TRA(v_rd_off(0, 1, 1)); \
        const s16x4 va4 = TRA(v_rd_off(0, 2, 0)), va5 = TRA(v_rd_off(0, 2, 1)), va6 = TRA(v_rd_off(0, 3, 0)), va7 = TRA(v_rd_off(0, 3, 1)); \
        SBAR(); \
        LOADSTMT; \
        asm volatile("s_waitcnt lgkmcnt(0)" ::: "memory"); SBAR(); \
        const s16x4 vc0 = TRA(v_rd_off(1, 0, 0)), vc1 = TRA(v_rd_off(1, 0, 1)), vc2 = TRA(v_rd_off(1, 1, 0)), vc3 = TRA(v_rd_off(1, 1, 1)); \
        const s16x4 vc4 = TRA(v_rd_off(1, 2, 0)), vc5 = TRA(v_rd_off(1, 2, 1)), vc6 = TRA(v_rd_off(1, 3, 0)), vc7 = TRA(v_rd_off(1, 3, 1)); \
        o[0] = __builtin_amdgcn_mfma_f32_32x32x16_bf16(pa0, PKV(va0, va1), o[0], 0, 0, 0); \
        o[0] = __builtin_amdgcn_mfma_f32_32x32x16_bf16(pa1, PKV(va2, va3), o[0], 0, 0, 0); \
        o[0] = __builtin_amdgcn_mfma_f32_32x32x16_bf16(pa2, PKV(va4, va5), o[0], 0, 0, 0); \
        o[0] = __builtin_amdgcn_mfma_f32_32x32x16_bf16(pa3, PKV(va6, va7), o[0], 0, 0, 0); \
        _Pragma("unroll") for (int r = 0; r < 8; ++r) X0[r] = __builtin_amdgcn_exp2f(X0[r]); \
        SGI(SG_MFMA, 1, 1); SGI(SG_VALU, 2, 1); SGI(SG_MFMA, 1, 1); SGI(SG_VALU, 2, 1); SGI(SG_MFMA, 1, 1); SGI(SG_VALU, 2, 1); SGI(SG_MFMA, 1, 1); SGI(SG_VALU, 2, 1); \
        asm volatile("" : "+v"(X0), "+v"(o[0])); \
        asm volatile("s_waitcnt lgkmcnt(0)" ::: "memory"); SBAR(); \
        o[1] = __builtin_amdgcn_mfma_f32_32x32x16_bf16(pa0, PKV(vc0, vc1), o[1], 0, 0, 0); \
        o[1] = __builtin_amdgcn_mfma_f32_32x32x16_bf16(pa1, PKV(vc2, vc3), o[1], 0, 0, 0); \
        o[1] = __builtin_amdgcn_mfma_f32_32x32x16_bf16(pa2, PKV(vc4, vc5), o[1], 0, 0, 0); \
        o[1] = __builtin_amdgcn_mfma_f32_32x32x16_bf16(pa3, PKV(vc6, vc7), o[1], 0, 0, 0); \
        _Pragma("unroll") for (int r = 8; r < 16; ++r) X0[r] = __builtin_amdgcn_exp2f(X0[r]); \
        SGI(SG_MFMA, 1, 2); SGI(SG_VALU, 2, 2); SGI(SG_MFMA, 1, 2); SGI(SG_VALU, 2, 2); SGI(SG_MFMA, 1, 2); SGI(SG_VALU, 2, 2); SGI(SG_MFMA, 1, 2); SGI(SG_VALU, 2, 2); \
        asm volatile("" : "+v"(X0), "+v"(o[1])); \
        SBAR(); \
        WRITESTMT; __syncthreads(); } while (0)
    SLOAD(0, T0 * KVBLK); SLOAD(1, (T0 + 1) * KVBLK); SBAR();
    SWRITE(0, 0); __syncthreads();
    qkt(pA0, pA1, 0, T0); PSM(pA0, pA1, alA, T0);
    SLOAD(0, (T0 + 2) * KVBLK); SBAR();
    SWRITE(1, 1); __syncthreads();
    int bp = 0, bc = 1, bn = 2;
    int j = T0 + 1;
    if (!TRACK) {
        const int JF = FOX ? NT - 5 : NT - 4;
        for (; j + 1 <= JF; j += 2) {
            FAST_HALF(pB0, pB1, pA0, pA1, SLOAD(1, (j + 2) * KVBLK), SWRITE(bn, 0));
            { const int t_ = bp; bp = bc; bc = bn; bn = t_; }
            FAST_HALF(pA0, pA1, pB0, pB1, SLOAD(0, (j + 3) * KVBLK), SWRITE(bn, 1));
            { const int t_ = bp; bp = bc; bc = bn; bn = t_; }
        }
    }
    for (; j + 1 < NT; j += 2) {
        SBAR(); qkt(pB0, pB1, bc, j);
        FSM(pA0, pA1, alA, j - 1); SBAR();
        SLOAD(1, (j + 2) * KVBLK); SBAR();
        PV(vb0 + bp * SHM_V, j - 1); PSM(pB0, pB1, alB, j);
        SWRITE(bn, 0);
        RESC(alB); __syncthreads();
        { const int t_ = bp; bp = bc; bc = bn; bn = t_; }
        SBAR(); qkt(pA0, pA1, bc, j + 1);
        FSM(pB0, pB1, alB, j); SBAR();
        if (j + 3 < NT) SLOAD(0, (j + 3) * KVBLK); SBAR();
        PV(vb0 + bp * SHM_V, j); PSM(pA0, pA1, alA, j + 1);
        SWRITE(bn, 1);
        RESC(alA); __syncthreads();
        { const int t_ = bp; bp = bc; bc = bn; bn = t_; }
    }
    SBAR(); qkt(pB0, pB1, bc, NT - 1);
    FSM(pA0, pA1, alA, NT - 2); SBAR();
    PV(vb0 + bp * SHM_V, NT - 2); PSM(pB0, pB1, alB, NT - 1);
    RESC(alB);
    FSM(pB0, pB1, alB, NT - 1); SBAR();
    PV(vb0 + bc * SHM_V, NT - 1);
#undef PSM
#undef FSM
#undef PV
#undef FAST_HALF
#undef TRA
#undef SG_R1_STEP
#undef PKV
    if (hi == 0) li_l[r32] = l_reg; asm volatile("s_waitcnt lgkmcnt(0)" ::: "memory");
    float rli[16];
#pragma unroll
    for (int r = 0; r < 16; ++r) rli[r] = __builtin_amdgcn_rcpf(li_l[crow(r, hi)]);
    { bf16_t* stg = (bf16_t*)(lds + LDS_OST) + wid * 2048;
#pragma unroll
      for (int r = 0; r < 16; ++r) { const int orow = crow(r, hi);
#pragma unroll
          for (int d0 = 0; d0 < 2; ++d0) stg[orow * 64 + d0 * 32 + r32] = f2bf(o[d0][r] * rli[r]); }
      asm volatile("s_waitcnt lgkmcnt(0)" ::: "memory");
      bf16_t* Ow = Qh + (size_t)(q0 + wid * QBLK) * ldq;
#pragma unroll
      for (int i = 0; i < 4; ++i) { const int row = i * 8 + (lane >> 3), ch = lane & 7; const u32x4 v = *(const u32x4*)(stg + row * 64 + ch * 8); if (!dry) *(u32x4*)(Ow + (size_t)row * ldq + ch * 8) = v; } }
    __syncthreads();
#undef SLOAD
#undef SWRITE
#undef RESC
}
}

__device__ __forceinline__ int map_in(int n) {
    if (n < 416) return n;
    if (n < 424) return 1952 + (n - 416);
    if (n < 512) return -1;
    if (n < 2048) return n - 512 + 416;
    if (n < 2560) return n - 2048 + 1960;
    if (n < 4096) return n - 2560 + 2472;
    return n - 4096 + 4008;
}
struct ConvD { const float* src; const float* kscale; bf16_t* dst; int ldsrc, K, N, dld, item; bool split512, mapped; };
__device__ __forceinline__ void conv_load(const ConvD& d, int lane, float (&x)[32], float& ks) {
    const int nblk = d.N / 32, kb = d.item / nblk, nb = d.item % nblk, k0 = 64 * kb, n0 = 32 * nb;
    const int sn = d.mapped ? map_in(n0 + (lane & 31)) : n0 + (lane & 31);
#pragma unroll
    for (int i = 0; i < 32; ++i) { const int kk = 2 * i + (lane >> 5); float v = 0.f; if (sn >= 0) v = d.src[(size_t)(k0 + kk) * d.ldsrc + sn]; x[i] = v; }
    ks = d.kscale ? d.kscale[k0 + lane] : 1.f;
}
__device__ __forceinline__ void conv_finish(const ConvD& d, LAS float* scr, int lane, const float (&x)[32], const float ks) {
    const int nblk = d.N / 32, kb = d.item / nblk, nb = d.item % nblk, k0 = 64 * kb, n0 = 32 * nb;
#pragma unroll
    for (int i = 0; i < 32; ++i) { const float s0 = __uint_as_float(__builtin_amdgcn_readlane(__float_as_uint(ks), 2 * i)), s1 = __uint_as_float(__builtin_amdgcn_readlane(__float_as_uint(ks), 2 * i + 1));
        scr[(2 * i + (lane >> 5)) * 33 + (lane & 31)] = x[i] * ((lane >> 5) ? s1 : s0); }
    asm volatile("s_waitcnt lgkmcnt(0)" ::: "memory");
    const int cch = lane & 7;
#pragma unroll
    for (int j = 0; j < 4; ++j) { const int n = (lane >> 3) + 8 * j; const LAS float* sp = scr + (8 * cch) * 33 + n;
        u32x4 o; o.x = pk_bf16(sp[0 * 33], sp[1 * 33]); o.y = pk_bf16(sp[2 * 33], sp[3 * 33]); o.z = pk_bf16(sp[4 * 33], sp[5 * 33]); o.w = pk_bf16(sp[6 * 33], sp[7 * 33]);
        bf16_t* dp = d.split512 ? (d.dst + ((size_t)(k0 >> 9) * d.N + n0 + n) * 512 + (k0 & 511) + 8 * cch) : (d.dst + (size_t)(n0 + n) * d.dld + k0 + 8 * cch);
        *(u32x4*)dp = o; }
    asm volatile("s_waitcnt lgkmcnt(0)" ::: "memory");
}
__device__ __forceinline__ void phase0(const Ctx& c, const int part) {
    PHASE_IDS(); ArgsP ap = get_args(); unsigned char* ws = ap->ws;
    const long gtid = (long)c.bid * 512 + tid, gthreads = (long)grid_g() * 512;
    const int gw = c.bid * 8 + wave, ngw = grid_g() * 8;
    LAS float* scr = (LAS float*)(c.lds + wave * 8448);
    constexpr int I_IN_ = 16 * 224, I_Q_ = 4 * 24, I_KV_ = 2 * 32, I_GLU_ = 8 * 16, I_BO_ = 8 * 32, I_OUT_ = 16 * 32, I_L = I_IN_ + I_Q_ + I_KV_ + I_GLU_ + 3 * I_BO_ + I_OUT_;
    auto conv_desc = [&](int it) -> ConvD { ConvD d; const int l = it / I_L; int r = it % I_L; d.kscale = nullptr; d.split512 = false; d.mapped = false;
        if (r < I_IN_) { d.src = ap->in[I_WIN] + (size_t)l * DM * IN_SRC; d.ldsrc = IN_SRC; d.K = DM; d.N = NIN; d.dst = (bf16_t*)(ws + WS_WIN) + (size_t)l * 2 * NIN * 512; d.dld = 512; d.split512 = true; d.mapped = true; d.kscale = ap->in[I_NORMG] + l * DM; d.item = r; return d; } r -= I_IN_;
        if (r < I_Q_) { d.src = ap->in[I_WQUP] + (size_t)l * 256 * 768; d.ldsrc = 768; d.K = 256; d.N = 768; d.dst = (bf16_t*)(ws + WS_WQ) + (size_t)l * 768 * 256; d.dld = 256; d.kscale = ap->in[I_QAN] + l * 256; d.item = r; return d; } r -= I_Q_;
        if (r < I_KV_) { d.src = ap->in[I_WKVUP] + (size_t)l * 128 * 1024; d.ldsrc = 1024; d.K = 128; d.N = 1024; d.dst = (bf16_t*)(ws + WS_WKV) + (size_t)l * 1024 * 256; d.dld = 256; d.kscale = ap->in[I_KVAN] + l * 128; d.item = r; return d; } r -= I_KV_;
        if (r < I_GLU_) { d.src = ap->in[I_WGLU] + (size_t)l * 512 * 512; d.ldsrc = 512; d.K = 512; d.N = 512; d.dst = (bf16_t*)(ws + WS_WGLU) + (size_t)l * 512 * 512; d.dld = 512; d.item = r; return d; } r -= I_GLU_;
        if (r < 3 * I_BO_) { const int br = r / I_BO_; d.src = ap->in[I_WBO] + ((size_t)l * 1536 + br * 512) * 1024; d.ldsrc = 1024; d.K = 512; d.N = 1024; d.dst = (bf16_t*)(ws + WS_WBO) + ((size_t)l * 3 + br) * 1024 * 512; d.dld = 512; d.item = r % I_BO_; return d; } r -= 3 * I_BO_;
        d.src = ap->in[I_WOUT] + (size_t)l * DM * DM; d.ldsrc = DM; d.K = DM; d.N = DM; d.dst = (bf16_t*)(ws + WS_WOUT) + (size_t)l * DM * DM; d.dld = DM; d.item = r; return d; };
    constexpr int N_A = 16 * 80, N_B = NL * I_L - N_A;
    auto item_of = [&](int idx) -> int { if (part == 0) return (idx / 80) * 224 + (idx % 80);
        return idx < 16 * 144 ? (idx / 144) * 224 + 80 + (idx % 144) : I_IN_ + (idx - 16 * 144); };
    const int n_items = part == 0 ? N_A : N_B;
    if (gw < n_items) {
        ConvD dc = conv_desc(item_of(gw)); float xc[32], kc; conv_load(dc, lane, xc, kc);
        for (int it = gw; it < n_items; it += ngw) {
            const int nit = it + ngw; const bool hn = nit < n_items;
            ConvD dn = dc; float xn[32], kn = 1.f;
#pragma unroll
            for (int i = 0; i < 32; ++i) xn[i] = 0.f;
            if (hn) { dn = conv_desc(item_of(nit)); conv_load(dn, lane, xn, kn); }
            SBAR();
            conv_finish(dc, scr, lane, xc, kc);
            dc = dn; kc = kn;
#pragma unroll
            for (int i = 0; i < 32; ++i) xc[i] = xn[i];
        }
    }
    if (part == 1) {
    for (long it = (wave == 1 ? (long)c.bid * 64 + lane : (long)NL * 32 * 64); it < NL * 32 * 64; it += (long)grid_g() * 64) {
        const int n = (int)(it & 63), g = (int)((it >> 6) & 31), l = (int)(it >> 11);
        const float dt = expf(ap->in[I_LDT][l * 32 + g]);
        const float lr = ap->in[I_LRE][(l * 32 + g) * 64 + n], li = ap->in[I_LIM][(l * 32 + g) * 64 + n];
        const float mag = expf(lr * dt), ang = li * dt;
        float rev = ang * 0.15915494309189535f; rev -= floorf(rev);
        const float are = mag * __builtin_amdgcn_cosf(rev), aim = mag * __builtin_amdgcn_sinf(rev);
        float pr = are, pi = aim;
#pragma unroll
        for (int s = 0; s < 6; ++s) { const float nr = pr * pr - pi * pi, ni = 2.f * pr * pi; pr = nr; pi = ni; }
        ((f32x4*)(ws + WS_TA))[it] = (f32x4){are, aim, pr, pi};
        const float den = lr * lr + li * li;
        const float fre = ((are - 1.f) * lr + aim * li) / den, fim = (aim * lr - (are - 1.f) * li) / den;
        const float* bre = ap->in[I_BRE] + it * 16; const float* bim = ap->in[I_BIM] + it * 16;
        float bbr[16], bbi[16];
#pragma unroll
        for (int cc = 0; cc < 16; ++cc) { const float br = bre[cc], bi = bim[cc]; bbr[cc] = fre * br - fim * bi; bbi[cc] = fre * bi + fim * br; }
        { const int nre = (n < 32) ? n : 64 + (n - 32), nim = nre + 32; bf16_t* tb = (bf16_t*)(ws + WS_TBB) + (size_t)(l * 32 + g) * 128 * 16;
          u32x4 w0, w1;
          w0.x = pk_bf16(bbr[0], bbr[1]); w0.y = pk_bf16(bbr[2], bbr[3]); w0.z = pk_bf16(bbr[4], bbr[5]); w0.w = pk_bf16(bbr[6], bbr[7]);
          w1.x = pk_bf16(bbr[8], bbr[9]); w1.y = pk_bf16(bbr[10], bbr[11]); w1.z = pk_bf16(bbr[12], bbr[13]); w1.w = pk_bf16(bbr[14], bbr[15]);
          *(u32x4*)(tb + nre * 16) = w0; *(u32x4*)(tb + nre * 16 + 8) = w1;
          w0.x = pk_bf16(bbi[0], bbi[1]); w0.y = pk_bf16(bbi[2], bbi[3]); w0.z = pk_bf16(bbi[4], bbi[5]); w0.w = pk_bf16(bbi[6], bbi[7]);
          w1.x = pk_bf16(bbi[8], bbi[9]); w1.y = pk_bf16(bbi[10], bbi[11]); w1.z = pk_bf16(bbi[12], bbi[13]); w1.w = pk_bf16(bbi[14], bbi[15]);
          *(u32x4*)(tb + nim * 16) = w0; *(u32x4*)(tb + nim * 16 + 8) = w1; }
        { bf16_t* tc = (bf16_t*)(ws + WS_TC) + (size_t)(l * 32 + g) * 16 * 128;
#pragma unroll
          for (int cc = 0; cc < 16; ++cc) { const float cr = ap->in[I_CRE][((size_t)(l * 32 + g) * 16 + cc) * 64 + n], ci = ap->in[I_CIM][((size_t)(l * 32 + g) * 16 + cc) * 64 + n];
              *(unsigned*)(tc + cc * 128 + 2 * n) = pk_bf16(cr, -ci); } }
    }
    }
    if (part == 0) { const float* x = ap->in[I_X]; bf16_t* XG = (bf16_t*)(ws + WS_XG); float* ss = (float*)(ws + WS_SS);
      f32x4 nxv[4];
      const int gwv = c.vb * 8 + wave; const bool g256 = grid_g() == 256; const int row_b = g256 ? gwv * 8 : gw, row_s = g256 ? 1 : ngw, row_e = g256 ? gwv * 8 + 8 : T_;
#pragma unroll
      for (int j = 0; j < 4; ++j) nxv[j] = *(const f32x4*)(x + (size_t)(row_b < T_ ? row_b : 0) * DM + j * 256 + lane * 4);
      for (int row = row_b; row < row_e; row += row_s) { float s = 0.f; f32x4 v[4];
#pragma unroll
          for (int j = 0; j < 4; ++j) v[j] = nxv[j];
          { const int nrow = (row + row_s < row_e) ? row + row_s : row;
#pragma unroll
            for (int j = 0; j < 4; ++j) nxv[j] = *(const f32x4*)(x + (size_t)nrow * DM + j * 256 + lane * 4); }
          SBAR();
#pragma unroll
          for (int j = 0; j < 4; ++j) { const int col = j * 256 + lane * 4;
              s += (v[j][0] * v[j][0] + v[j][1] * v[j][1]) + (v[j][2] * v[j][2] + v[j][3] * v[j][3]);
              u32x2 w; w.x = pk_bf16(v[j][0], v[j][1]); w.y = pk_bf16(v[j][2], v[j][3]);
              *(u32x2*)(XG + ((size_t)(col >> 9) * T_ + row) * 512 + (col & 511)) = w; }
          s = wave_sum(s); if (lane == 0) ss[row] = s; }
      for (long i = gtid; i < T_; i += gthreads) ss[T_ + i] = 0.f;
      for (long i = gtid; i < 2 * NL * T_; i += gthreads) ((float*)(ws + WS_SSQ))[i] = 0.f;
      for (long i = gtid; i < 8 * 3456; i += gthreads) ((unsigned*)(ws + WS_PBAR))[i] = 0u;
      for (long i = gtid; i < 64 * 1024; i += gthreads) ((unsigned*)(ws + WS_GBAR))[i] = 0u;
      for (long i = gtid; i < (long)NL * 1024 * 16; i += gthreads) *(u32x4*)((bf16_t*)(ws + WS_WKV) + (i >> 4) * 256 + 128 + (i & 15) * 8) = (u32x4){0u, 0u, 0u, 0u}; }
}

struct S5Coef { float a1r, a1i, a2r, a2i, a3r, a3i, a4r, a4i; };
__device__ __forceinline__ S5Coef s5_coef(float ar, float ai) { S5Coef q; q.a1r = ar; q.a1i = ai; q.a2r = ar * ar - ai * ai; q.a2i = 2.f * ar * ai; q.a3r = q.a2r * ar - q.a2i * ai; q.a3i = q.a2r * ai + q.a2i * ar; q.a4r = q.a2r * q.a2r - q.a2i * q.a2i; q.a4i = 2.f * q.a2r * q.a2i; return q; }
__device__ __forceinline__ float other_half(float v, int hi) { auto rr = __builtin_amdgcn_permlane32_swap(__float_as_uint(v), __float_as_uint(v), false, false); return __uint_as_float(hi ? rr[0] : rr[1]); }
template <bool NEEDX>
__device__ __forceinline__ void s5_scan32(f32x16& xr, f32x16& xi, const S5Coef& q, float& sr, float& si, int hi) {
    float er[4], ei[4];
#pragma unroll
    for (int k = 0; k < 4; ++k) {
        const float r0 = xr[4 * k], i0 = xi[4 * k];
        const float r1 = q.a1r * r0 - q.a1i * i0 + xr[4 * k + 1], i1 = q.a1r * i0 + q.a1i * r0 + xi[4 * k + 1];
        const float r2 = q.a1r * r1 - q.a1i * i1 + xr[4 * k + 2], i2 = q.a1r * i1 + q.a1i * r1 + xi[4 * k + 2];
        const float r3 = q.a1r * r2 - q.a1i * i2 + xr[4 * k + 3], i3 = q.a1r * i2 + q.a1i * r2 + xi[4 * k + 3];
        if (NEEDX) { xr[4 * k + 1] = r1; xi[4 * k + 1] = i1; xr[4 * k + 2] = r2; xi[4 * k + 2] = i2; xr[4 * k + 3] = r3; xi[4 * k + 3] = i3; }
        er[k] = r3; ei[k] = i3;
    }
    float pr[4], pi[4];
#pragma unroll
    for (int k = 0; k < 4; ++k) {
        const float orr = other_half(er[k], hi), oii = other_half(ei[k], hi);
        const float e0r = hi ? orr : er[k], e0i = hi ? oii : ei[k], e1r = hi ? er[k] : orr, e1i = hi ? ei[k] : oii;
        const float p0r = sr, p0i = si;
        float nr = q.a4r * sr - q.a4i * si + e0r, ni = q.a4r * si + q.a4i * sr + e0i; sr = nr; si = ni;
        const float p1r = sr, p1i = si;
        nr = q.a4r * sr - q.a4i * si + e1r; ni = q.a4r * si + q.a4i * sr + e1i; sr = nr; si = ni;
        pr[k] = hi ? p1r : p0r; pi[k] = hi ? p1i : p0i;
    }
    if (NEEDX) {
#pragma unroll
        for (int k = 0; k < 4; ++k) {
            xr[4 * k + 0] += q.a1r * pr[k] - q.a1i * pi[k]; xi[4 * k + 0] += q.a1r * pi[k] + q.a1i * pr[k];
            xr[4 * k + 1] += q.a2r * pr[k] - q.a2i * pi[k]; xi[4 * k + 1] += q.a2r * pi[k] + q.a2i * pr[k];
            xr[4 * k + 2] += q.a3r * pr[k] - q.a3i * pi[k]; xi[4 * k + 2] += q.a3r * pi[k] + q.a3i * pr[k];
            xr[4 * k + 3] += q.a4r * pr[k] - q.a4i * pi[k]; xi[4 * k + 3] += q.a4r * pi[k] + q.a4i * pr[k];
        }
    }
}
constexpr int S5_XPITCH = 272, S5_XWAVE = 32 * S5_XPITCH;
template <bool FULL>
__device__ __forceinline__ void s5_pass(const Ctx& c, int l, bool dry) {
    PHASE_IDS(); ArgsP ap = get_args(); unsigned char* ws = ap->ws; bf16_t* P = (bf16_t*)(ws + WS_PROJ); const float* dsk = ap->in[I_S5D] + l * 512;
    const int cl = lane & 31, hi = lane >> 5;
    char* Xl = c.ldsg + wave * S5_XWAVE;
    const int gw = (grid_g() == 256) ? (c.bid & 7) * 256 + ((c.bid >> 3) & 7) * 32 + ((c.bid >> 6) & 3) * 8 + wave : c.vb * 8 + wave, ngw = grid_g() * 8;
    for (int task = gw; task < NB_ * 32 * 8; task += ngw) {
        const int g = task & 31, q8 = (task >> 5) & 7, b = task >> 8;
        const int tb0 = (l * 32 + g) * 64;
        const f32x4 taA = ((const f32x4*)(ws + WS_TA))[tb0 + cl], taB = ((const f32x4*)(ws + WS_TA))[tb0 + 32 + cl];
        const S5Coef qA = s5_coef(taA[0], taA[1]), qB = s5_coef(taB[0], taB[1]);
        bf16x8 bbf[4];
        { const bf16_t* tbb = (const bf16_t*)(ws + WS_TBB) + (size_t)(l * 32 + g) * 128 * 16;
#pragma unroll
          for (int blk = 0; blk < 4; ++blk) bbf[blk] = *(const bf16x8*)(tbb + (blk * 32 + cl) * 16 + 8 * hi); }
        float sAr = 0.f, sAi = 0.f, sBr = 0.f, sBi = 0.f;
        bf16x8 cm[4];
        if (FULL) {
            const bf16_t* tcm = (const bf16_t*)(ws + WS_TC) + (size_t)(l * 32 + g) * 16 * 128;
#pragma unroll
            for (int ks = 0; ks < 4; ++ks) cm[ks] = *(const bf16x8*)(tcm + (lane & 15) * 128 + ks * 32 + 8 * (lane >> 4));
            const f32x2* Ep = (const f32x2*)(ws + WS_E) + ((size_t)(b * 32) * 32 + g) * 64;
            const int nprev = 4 * q8;
            for (int j0 = 0; j0 < nprev; j0 += 8) {
                f32x2 eA[8], eB[8];
#pragma unroll
                for (int i = 0; i < 8; ++i) { const int cp = (j0 + i < nprev) ? j0 + i : 0; eA[i] = Ep[(size_t)cp * 2048 + cl]; eB[i] = Ep[(size_t)cp * 2048 + 32 + cl]; }
#pragma unroll
                for (int i = 0; i < 8; ++i) if (j0 + i < nprev) {
                    float nr = taA[2] * sAr - taA[3] * sAi + eA[i][0], ni = taA[2] * sAi + taA[3] * sAr + eA[i][1]; sAr = nr; sAi = ni;
                    nr = taB[2] * sBr - taB[3] * sBi + eB[i][0]; ni = taB[2] * sBi + taB[3] * sBr + eB[i][1]; sBr = nr; sBi = ni; }
            }
        }
        const f32x4 dv = *(const f32x4*)(dsk + 16 * g + 4 * (lane >> 4));
        const size_t ubase = (size_t)(b * S_ + 4 * q8 * 64 + cl) * NPROJ + 2048 + 16 * g + 8 * hi;
        bf16x8 ua_n = *(const bf16x8*)(P + ubase);
        const size_t uebase = (size_t)(b * S_ + 4 * q8 * 64 + (lane & 15)) * NPROJ + 2048 + 16 * g + 4 * (lane >> 4);
        for (int i8 = 0; i8 < 8; ++i8) {
            const bf16x8 ua = ua_n;
            if (i8 < 7) ua_n = *(const bf16x8*)(P + ubase + (size_t)(i8 + 1) * 32 * NPROJ);
            u32x2 ue0 = (u32x2){0u, 0u}, ue1 = (u32x2){0u, 0u};
            if (FULL) { ue0 = *(const u32x2*)(P + uebase + (size_t)i8 * 32 * NPROJ); ue1 = *(const u32x2*)(P + uebase + (size_t)(i8 * 32 + 16) * NPROJ); }
            const int ch = 4 * q8 + (i8 >> 1), rb = i8 & 1, tok0 = b * S_ + ch * 64;
            if (!FULL && rb == 0) { sAr = 0.f; sAi = 0.f; sBr = 0.f; sBi = 0.f; }
            f32x16 bu0 = __builtin_amdgcn_mfma_f32_32x32x16_bf16(ua, bbf[0], f32x16{}, 0, 0, 0);
            f32x16 bu1 = __builtin_amdgcn_mfma_f32_32x32x16_bf16(ua, bbf[1], f32x16{}, 0, 0, 0);
            f32x16 bu2 = __builtin_amdgcn_mfma_f32_32x32x16_bf16(ua, bbf[2], f32x16{}, 0, 0, 0);
            f32x16 bu3 = __builtin_amdgcn_mfma_f32_32x32x16_bf16(ua, bbf[3], f32x16{}, 0, 0, 0);
            s5_scan32<FULL>(bu0, bu1, qA, sAr, sAi, hi);
            s5_scan32<FULL>(bu2, bu3, qB, sBr, sBi, hi);
            if (FULL) {
#pragma unroll
                for (int r = 0; r < 16; ++r) { const int t = (r & 3) + 8 * (r >> 2) + 4 * hi;
                    *(unsigned*)(Xl + t * S5_XPITCH + 4 * cl) = pk_bf16(bu0[r], bu1[r]);
                    *(unsigned*)(Xl + t * S5_XPITCH + 128 + 4 * cl) = pk_bf16(bu2[r], bu3[r]); }
                asm volatile("s_waitcnt lgkmcnt(0)" ::: "memory");
#pragma unroll
                for (int tb = 0; tb < 2; ++tb) {
                    f32x4 y = (f32x4){0.f, 0.f, 0.f, 0.f};
#pragma unroll
                    for (int ks = 0; ks < 4; ++ks) { const bf16x8 xb = *(const bf16x8*)(Xl + (16 * tb + (lane & 15)) * S5_XPITCH + (ks * 32 + 8 * (lane >> 4)) * 2);
                        y = __builtin_amdgcn_mfma_f32_16x16x32_bf16(cm[ks], xb, y, 0, 0, 0); }
                    const int q4 = lane >> 4;
                    const size_t tokz = (size_t)(tok0 + rb * 32 + tb * 16 + (lane & 15));
                    bf16_t* zp = (bf16_t*)(ws + WS_Z) + tokz * 512 + 16 * g + 4 * q4;
                    const u32x2 uu = tb ? ue1 : ue0;
                    const float y0 = y[0] + dv[0] * bf_lo(uu.x), y1 = y[1] + dv[1] * bf_hi(uu.x), y2 = y[2] + dv[2] * bf_lo(uu.y), y3 = y[3] + dv[3] * bf_hi(uu.y);
                    u32x2 w; w.x = pk_bf16(gelu_tanh(y0), gelu_tanh(y1)); w.y = pk_bf16(gelu_tanh(y2), gelu_tanh(y3));
                    if (!dry) *(u32x2*)zp = w;
                }
                asm volatile("s_waitcnt lgkmcnt(0)" ::: "memory");
            }
            if (!FULL && rb == 1) { if (hi == 0) { f32x2* Eo = (f32x2*)(ws + WS_E) + (size_t)((b * 32 + ch) * 32 + g) * 64; Eo[cl] = (f32x2){sAr, sAi}; Eo[32 + cl] = (f32x2){sBr, sBi}; } }
        }
    }
}

__device__ __forceinline__ void unpack8(const u32x4 w, float (&v)[8]) { v[0] = bf_lo(w.x); v[1] = bf_hi(w.x); v[2] = bf_lo(w.y); v[3] = bf_hi(w.y); v[4] = bf_lo(w.z); v[5] = bf_hi(w.z); v[6] = bf_lo(w.w); v[7] = bf_hi(w.w); }
__device__ __forceinline__ u32x4 pack8(const float (&v)[8]) { u32x4 w; w.x = pk_bf16(v[0], v[1]); w.y = pk_bf16(v[2], v[3]); w.z = pk_bf16(v[4], v[5]); w.w = pk_bf16(v[6], v[7]); return w; }
__device__ __forceinline__ void prep_phase(const Ctx& c, int l, bool dry) {
    PHASE_IDS(); ArgsP ap = get_args(); unsigned char* ws = ap->ws;

    bf16_t* P = (bf16_t*)(ws + WS_PROJ); bf16_t* QUP = (bf16_t*)(ws + WS_QUP); bf16_t* KVUP = (bf16_t*)(ws + WS_KVUP); bf16_t* KM = (bf16_t*)(ws + WS_KM);
    if (wave == 0) for (int bq = (grid_g() == 256) ? ((c.bid >> 3) < 8 ? (c.bid & 7) * 8 + (c.bid >> 3) : 64) : c.bid; bq < 64; bq += grid_g()) {
        const int bh = bq, b = bh >> 3, h = bh & 7; const float bf = ap->in[I_FBF][l * 8 + h];
        const float* ff = (const float*)(ws + WS_FF32) + (size_t)(b * S_) * 8 + h; float* cum = (float*)(ws + WS_CUM) + (size_t)bh * S_;
        float xv[32];
#pragma unroll
        for (int it = 0; it < 32; ++it) xv[it] = ff[(size_t)(it * 64 + lane) * 8];
        float carry = 0.f;
#pragma unroll
        for (int it = 0; it < 32; ++it) { const float xx = xv[it] + bf;
            float v = fminf(xx, 0.f) - log1pf(__expf(-fabsf(xx)));
            v += __builtin_bit_cast(float, __builtin_amdgcn_update_dpp(0, __builtin_bit_cast(int, v), 0x111, 0xF, 0xF, false));
            v += __builtin_bit_cast(float, __builtin_amdgcn_update_dpp(0, __builtin_bit_cast(int, v), 0x112, 0xF, 0xF, false));
            v += __builtin_bit_cast(float, __builtin_amdgcn_update_dpp(0, __builtin_bit_cast(int, v), 0x114, 0xF, 0xF, false));
            v += __builtin_bit_cast(float, __builtin_amdgcn_update_dpp(0, __builtin_bit_cast(int, v), 0x118, 0xF, 0xF, false));
            const int iv = __builtin_bit_cast(int, v);
            const float t0 = __builtin_bit_cast(float, __builtin_amdgcn_readlane(iv, 15)), t1 = __builtin_bit_cast(float, __builtin_amdgcn_readlane(iv, 31));
            const float t2 = __builtin_bit_cast(float, __builtin_amdgcn_readlane(iv, 47)), t3 = __builtin_bit_cast(float, __builtin_amdgcn_readlane(iv, 63));
            const int rw = lane >> 4;
            v += carry + (rw == 1 ? t0 : rw == 2 ? t0 + t1 : rw == 3 ? (t0 + t1) + t2 : 0.f);
            if (!dry) cum[it * 64 + lane] = v * LOG2E;
            carry += ((t0 + t1) + t2) + t3; }
    }
    const float* qn = ap->in[I_MQN] + l * 96; const float* kn = ap->in[I_MKN] + l * 96; const float* fqn = ap->in[I_FQN] + l * 64; const float* fkn = ap->in[I_FKN] + l * 64;
    const int* pos = (const int*)ap->in[I_POS];
    const int hd = lane >> 3, j = lane & 7;
    const float QSC = 0.10206207261596575f * LOG2E, FSC = 0.125f * LOG2E;
    const int gw = c.vb * 8 + wave, ngw = grid_g() * 8;
    const bool g256 = grid_g() == 256;
    const int row_b = g256 ? gw * 8 : gw, row_s = g256 ? 1 : ngw, row_e = g256 ? gw * 8 + 8 : T_;
    float gq[12], gk[12], gfq[8], gfk[8];
#pragma unroll
    for (int e = 0; e < 8; ++e) { gq[e] = qn[8 * j + e]; gk[e] = kn[8 * j + e]; gfq[e] = fqn[8 * j + e]; gfk[e] = fkn[8 * j + e]; }
    gq[8] = qn[64 + 2 * j]; gq[9] = qn[65 + 2 * j]; gq[10] = qn[80 + 2 * j]; gq[11] = qn[81 + 2 * j];
    gk[8] = kn[64 + 2 * j]; gk[9] = kn[65 + 2 * j]; gk[10] = kn[80 + 2 * j]; gk[11] = kn[81 + 2 * j];
    struct PrepIn { float pf; u32x4 q; unsigned q1, q2; u32x4 k; unsigned p1, p2; u32x4 fq, fk; };
    auto prep_load = [&](int row) -> PrepIn { PrepIn r_;
        const bf16_t* pr = P + (size_t)row * NPROJ; const bf16_t* qp = QUP + (size_t)row * 768 + 96 * hd; const bf16_t* kp = KM + (size_t)row * 768 + 96 * hd;
        r_.pf = (float)pos[row];
        r_.q = *(const u32x4*)(qp + 8 * j); r_.q1 = *(const unsigned*)(qp + 64 + 2 * j); r_.q2 = *(const unsigned*)(qp + 80 + 2 * j);
        r_.k = *(const u32x4*)(kp + 8 * j);
        r_.p1 = *(const unsigned*)(pr + 384 + 2 * j); r_.p2 = *(const unsigned*)(pr + 400 + 2 * j);
        r_.fq = *(const u32x4*)(pr + 512 + 64 * hd + 8 * j); r_.fk = *(const u32x4*)(pr + 1024 + 64 * hd + 8 * j); return r_; };
    PrepIn nx_ = prep_load(row_b < T_ ? row_b : 0);
    for (int row = row_b; row < row_e; row += row_s) {
        bf16_t* pr = P + (size_t)row * NPROJ;
        bf16_t* qp = QUP + (size_t)row * 768 + 96 * hd; bf16_t* ko = KM + (size_t)row * 768 + 96 * hd;
        bf16_t* fqp = pr + 512 + 64 * hd + 8 * j; bf16_t* fkp = pr + 1024 + 64 * hd + 8 * j;
        const PrepIn in_ = nx_;
        { const int nrow = row + row_s; nx_ = prep_load(nrow < row_e ? nrow : row); }
        SBAR();
        const float pf = in_.pf;
        const u32x4 l_q = in_.q; const unsigned l_q1 = in_.q1, l_q2 = in_.q2;
        const u32x4 l_k = in_.k; const unsigned l_p1 = in_.p1, l_p2 = in_.p2;
        const u32x4 l_fq = in_.fq, l_fk = in_.fk;
        float cs[2], sn[2];
#pragma unroll
        for (int e = 0; e < 2; ++e) { const int i = 2 * j + e; const float inv = exp2f(-(float)i * (13.287712379549449f / 16.f)); const float ang = pf * inv;
            float rev = ang * 0.15915494309189535f; rev -= floorf(rev); cs[e] = __builtin_amdgcn_cosf(rev); sn[e] = __builtin_amdgcn_sinf(rev); }
        u32x4 o_q, o_k, o_fq, o_fk; unsigned o_q1, o_q2, o_k1, o_k2;
        { float v[8]; unpack8(l_q, v);
          const float x1[2] = {bf_lo(l_q1), bf_hi(l_q1)}, x2[2] = {bf_lo(l_q2), bf_hi(l_q2)};
          float ssq = 0.f;
#pragma unroll
          for (int e = 0; e < 8; ++e) ssq += v[e] * v[e];
          float r1[2], r2[2];
#pragma unroll
          for (int e = 0; e < 2; ++e) { r1[e] = x1[e] * cs[e] - x2[e] * sn[e]; r2[e] = x1[e] * sn[e] + x2[e] * cs[e]; ssq += r1[e] * r1[e] + r2[e] * r2[e]; }
          const float rn = rsqrtf(sum8(ssq) * (1.f / 96) + EPS) * QSC;
#pragma unroll
          for (int e = 0; e < 8; ++e) v[e] *= rn * gq[e];
          o_q = pack8(v);
          o_q1 = pk_bf16(r1[0] * rn * gq[8], r1[1] * rn * gq[9]);
          o_q2 = pk_bf16(r2[0] * rn * gq[10], r2[1] * rn * gq[11]); }
        { float v[8]; unpack8(l_k, v);
          const float x1[2] = {bf_lo(l_p1), bf_hi(l_p1)}, x2[2] = {bf_lo(l_p2), bf_hi(l_p2)};
          float ssq = 0.f;
#pragma unroll
          for (int e = 0; e < 8; ++e) ssq += v[e] * v[e];
          float r1[2], r2[2];
#pragma unroll
          for (int e = 0; e < 2; ++e) { r1[e] = x1[e] * cs[e] - x2[e] * sn[e]; r2[e] = x1[e] * sn[e] + x2[e] * cs[e]; ssq += r1[e] * r1[e] + r2[e] * r2[e]; }
          const float rn = rsqrtf(sum8(ssq) * (1.f / 96) + EPS);
#pragma unroll
          for (int e = 0; e < 8; ++e) v[e] *= rn * gk[e];
          o_k = pack8(v);
          o_k1 = pk_bf16(r1[0] * rn * gk[8], r1[1] * rn * gk[9]);
          o_k2 = pk_bf16(r2[0] * rn * gk[10], r2[1] * rn * gk[11]); }
        { float v[8]; unpack8(l_fq, v); float ssq = 0.f;
#pragma unroll
          for (int e = 0; e < 8; ++e) ssq += v[e] * v[e];
          const float rn = rsqrtf(sum8(ssq) * (1.f / 64) + EPS) * FSC;
#pragma unroll
          for (int e = 0; e < 8; ++e) v[e] *= rn * gfq[e];
          o_fq = pack8(v); }
        { float v[8]; unpack8(l_fk, v); float ssq = 0.f;
#pragma unroll
          for (int e = 0; e < 8; ++e) ssq += v[e] * v[e];
          const float rn = rsqrtf(sum8(ssq) * (1.f / 64) + EPS);
#pragma unroll
          for (int e = 0; e < 8; ++e) v[e] *= rn * gfk[e];
          o_fk = pack8(v); }
        if (!dry) {
            *(u32x4*)(qp + 8 * j) = o_q; *(unsigned*)(qp + 64 + 2 * j) = o_q1; *(unsigned*)(qp + 80 + 2 * j) = o_q2;
            *(u32x4*)(ko + 8 * j) = o_k; *(unsigned*)(ko + 64 + 2 * j) = o_k1; *(unsigned*)(ko + 80 + 2 * j) = o_k2;
            *(u32x4*)fqp = o_fq; *(u32x4*)fkp = o_fk;
        }
    }
}

__device__ __forceinline__ void attn_phase(const Ctx& c, int l, bool dry) {
    PHASE_IDS(); ArgsP ap = get_args(); unsigned char* ws = ap->ws;
    bf16_t* P = (bf16_t*)(ws + WS_PROJ); bf16_t* QUP = (bf16_t*)(ws + WS_QUP); const bf16_t* KVUP = (const bf16_t*)(ws + WS_KVUP); const bf16_t* KM = (const bf16_t*)(ws + WS_KM);
    const float* CUM = (const float*)(ws + WS_CUM);
    float sbound;
    { float mq = fabsf(ap->in[I_FQN][l * 64 + lane]), mk = fabsf(ap->in[I_FKN][l * 64 + lane]);
#pragma unroll
      for (int o = 1; o < 64; o <<= 1) { mq = fmaxf(mq, __shfl_xor(mq, o)); mk = fmaxf(mk, __shfl_xor(mk, o)); }
      sbound = 2.f * 1.05f * 8.f * LOG2E * mq * mk; }
    bool trackM, trackF = !(sbound <= 120.f);
    { float mq = lane < 48 ? fmaxf(fabsf(ap->in[I_MQN][l * 96 + lane]), fabsf(ap->in[I_MQN][l * 96 + 48 + lane])) : 0.f, mk = lane < 48 ? fmaxf(fabsf(ap->in[I_MKN][l * 96 + lane]), fabsf(ap->in[I_MKN][l * 96 + 48 + lane])) : 0.f;
#pragma unroll
      for (int o = 1; o < 64; o <<= 1) { mq = fmaxf(mq, __shfl_xor(mq, o)); mk = fmaxf(mk, __shfl_xor(mk, o)); }
      trackM = !(1.05f * 9.7979590f * LOG2E * mq * mk <= 60.f); }
    for (int L = c.vb; L < 256; L += grid_g()) {
        const int bh = (L >> 5) * 8 + (L & 7), p = (L >> 3) & 3, b = bh >> 3, h = bh & 7; const size_t r0 = (size_t)b * S_;
        const float* cum = CUM + (size_t)bh * S_;
        int T0f[2];
#pragma unroll
        for (int e = 0; e < 2; ++e) { const int q0 = (2 * p + e) * 256, nb = q0 >> 6; const float c0 = cum[q0]; bool need = false;
            if (lane < nb) need = (sbound + c0 - cum[64 * lane + 63] >= -40.f);
            const unsigned long long bal = __ballot(need);
            T0f[e] = __builtin_amdgcn_readfirstlane((bal ? (__ffsll((long long)bal) - 1) : nb) & ~1); }
        if (!trackM) {
#pragma unroll 1
            for (int e = 0; e < 2; ++e)
                attn::attn_unit<96, false, false>(QUP + r0 * 768 + 96 * h, 768, KM + r0 * 768 + 96 * h, 768, KVUP + r0 * 512 + 64 * h, 512, nullptr, (e ? p : 7 - p) * 256, c.ldsg, dry, 0.f, 0);
        } else {
#pragma unroll 1
            for (int e = 0; e < 2; ++e)
                attn::attn_unit<96, false, true>(QUP + r0 * 768 + 96 * h, 768, KM + r0 * 768 + 96 * h, 768, KVUP + r0 * 512 + 64 * h, 512, nullptr, (e ? p : 7 - p) * 256, c.ldsg, dry, 0.f, 0);
        }
        if (!trackF) {
#pragma unroll 1
            for (int e = 0; e < 2; ++e)
                attn::attn_unit<64, true, false>(P + r0 * NPROJ + 512 + 64 * h, NPROJ, P + r0 * NPROJ + 1024 + 64 * h, NPROJ, P + r0 * NPROJ + 1536 + 64 * h, NPROJ, cum, (2 * p + e) * 256, c.ldsg, dry, sbound, e ? T0f[1] : T0f[0]);
        } else {
#pragma unroll 1
            for (int e = 0; e < 2; ++e)
                attn::attn_unit<64, true, true>(P + r0 * NPROJ + 512 + 64 * h, NPROJ, P + r0 * NPROJ + 1024 + 64 * h, NPROJ, P + r0 * NPROJ + 1536 + 64 * h, NPROJ, cum, (2 * p + e) * 256, c.ldsg, dry, sbound, e ? T0f[1] : T0f[0]);
        }
    }
}

#if USE_XCD_BAR
#define XB_TMO      (2u * S)
#define XB_XCNT(j)  ((4u + (j)) * S)
#define XB_XSUB(j)  ((20u + (j)) * S)
#define XB_XGEN(j)  ((36u + (j)) * S)
#define XB_TOP      (52u * S)
#define XB_TOPGEN   (53u * S)
#define XCD_BAR_WORDS 3456
#define GRP_BAR_WORDS 1024
#define XB_SPIN_CAP (1u << 22)
__device__ __forceinline__ unsigned xb_ld(unsigned* p)              { return __hip_atomic_load(p, __ATOMIC_RELAXED, __HIP_MEMORY_SCOPE_AGENT); }
__device__ __forceinline__ unsigned xb_add(unsigned* p, unsigned v) { return __hip_atomic_fetch_add(p, v, __ATOMIC_RELAXED, __HIP_MEMORY_SCOPE_AGENT); }
__device__ __forceinline__ unsigned xb_xcc_id() { return (unsigned)__builtin_amdgcn_s_getreg((3 << 11) | 20) & 0xFu; }
#define XB_SPIN(cond, bar) do { unsigned _sp = 0; while (cond) { __builtin_amdgcn_s_sleep(1); \
    if ((++_sp & 255u) == 0u) { if (xb_ld(&(bar)[XB_TMO])) break; if (_sp > XB_SPIN_CAP) { atomicAdd(&(bar)[XB_TMO], 1u); break; } } } } while (0)
struct XcdBarrier { unsigned* bar; unsigned x; volatile LAS unsigned* st; unsigned nexp, S; };
__device__ __forceinline__ XcdBarrier xcd_barrier_post(unsigned* bar, volatile LAS unsigned* st, unsigned nexp, unsigned S) {
    XcdBarrier b; b.bar = bar; b.x = xb_xcc_id(); b.st = st; b.nexp = nexp; b.S = S;
    if (threadIdx.x == 0) (void)xb_add(&bar[XB_XCNT(b.x)], 1u);
    return b;
}
__device__ __forceinline__ void xcd_barrier_complete(unsigned* bar, unsigned x, unsigned G, unsigned S, unsigned& nloc, unsigned& nx) {
    unsigned sum, cnt, mine, sp = 0u;
    for (;;) {
        sum = 0u; cnt = 0u; mine = 0u;
#pragma unroll
        for (unsigned j = 0; j < 16; ++j) { const unsigned c = xb_ld(&bar[XB_XCNT(j)]); sum += c; cnt += (c > 0u) ? 1u : 0u; mine = (j == x) ? c : mine; }
        if (sum == G) break;
        __builtin_amdgcn_s_sleep(1);
        if ((++sp & 255u) == 0u) { if (xb_ld(&bar[XB_TMO])) break; if (sp > XB_SPIN_CAP) { atomicAdd(&bar[XB_TMO], 1u); break; } }
    }
    nloc = mine > 0u ? mine : 1u; nx = cnt > 0u ? cnt : 1u;
}
__device__ __forceinline__ void xcd_barrier(const XcdBarrier& b) {
    asm volatile("s_waitcnt vmcnt(0)" ::: "memory");
    __syncthreads();
    if (threadIdx.x == 0) {
        unsigned* bar = b.bar; const unsigned S = b.S;
        __builtin_amdgcn_s_waitcnt(0);
        unsigned nloc = b.st[0], nx = b.st[1];
        if (nloc == 0u) { xcd_barrier_complete(bar, b.x, b.nexp, S, nloc, nx); b.st[0] = nloc; b.st[1] = nx; }
        const bool one_xcd = (nx == 1u) && (nloc == b.nexp);
        if (one_xcd) {
            const unsigned k = b.st[2]; b.st[2] = k + 1u;
            (void)__hip_atomic_fetch_add(&bar[XB_XSUB(b.x)], 1u, __ATOMIC_RELAXED, __HIP_MEMORY_SCOPE_AGENT);
            const unsigned target = (k + 1u) * nloc;
            XB_SPIN(xb_ld(&bar[XB_XSUB(b.x)]) < target, bar);
            asm volatile("s_waitcnt vmcnt(0)" ::: "memory");
        } else if (const unsigned old = xb_add(&bar[XB_XSUB(b.x)], 1u), gen = old / nloc; old + 1u == (gen + 1u) * nloc) {
            if (!one_xcd) __builtin_amdgcn_fence(__ATOMIC_RELEASE, "agent");
            asm volatile("s_waitcnt vmcnt(0)" ::: "memory");
            const unsigned og = xb_add(&bar[XB_TOP], 1u);
            const unsigned tg = og / nx;
            if (og + 1u == (tg + 1u) * nx) xb_add(&bar[XB_TOPGEN], 1u);
            else XB_SPIN(xb_ld(&bar[XB_TOPGEN]) == tg, bar);
            if (!one_xcd) __builtin_amdgcn_fence(__ATOMIC_ACQUIRE, "agent");
            xb_add(&bar[XB_XGEN(b.x)], 1u);
            asm volatile("s_waitcnt vmcnt(0)" ::: "memory");
        } else {
            XB_SPIN(xb_ld(&bar[XB_XGEN(b.x)]) == gen, bar);
            if (!one_xcd) __builtin_amdgcn_fence(__ATOMIC_ACQUIRE, "agent");
            asm volatile("s_waitcnt vmcnt(0)" ::: "memory");
        }
        if (one_xcd) asm volatile("buffer_inv sc0\n\ts_waitcnt vmcnt(0)" ::: "memory");
    }
    __syncthreads();
}
#endif

constexpr int LDS_MAIN = 131072, LDS_BYTES = LDS_MAIN + 1024;
static_assert(attn::LDS_BYTES <= LDS_MAIN && 8 * S5_XWAVE <= LDS_MAIN && 8 * 8448 <= LDS_MAIN, "LDS map");

__device__ __forceinline__ void ph_inproj(const Ctx& c, int l) {
    ArgsP ap = get_args(); unsigned char* ws = ap->ws;
    SchedIn S{(const char*)(ws + WS_XG), (const char*)(ws + WS_WIN) + (size_t)l * 2 * NIN * 512 * 2, 0, grid_g(), c.bid};
    EpiProj E{(bf16_t*)(ws + WS_PROJ), (const float*)(ws + WS_SS) + (size_t)l * T_, (float*)(ws + WS_FF32), (float*)(ws + WS_SSQ) + (size_t)l * T_};
    pg8::gemm_phase(c.lds, 512, 512, 8, S, E);
}
__device__ __forceinline__ void ph_fv(const Ctx& c, int l) {
    ArgsP ap = get_args(); unsigned char* ws = ap->ws;
    SchedIn S{(const char*)(ws + WS_XG), (const char*)(ws + WS_WIN) + (size_t)l * 2 * NIN * 512 * 2, 1, grid_g(), c.bid};
    EpiProj E{(bf16_t*)(ws + WS_PROJ), (const float*)(ws + WS_SS) + (size_t)l * T_, (float*)(ws + WS_FF32), (float*)(ws + WS_SSQ) + (size_t)l * T_};
    pg8::gemm_phase(c.lds, 512, 512, 8, S, E);
}
__device__ __forceinline__ void ph_up(const Ctx& c, int l) {
    ArgsP ap = get_args(); unsigned char* ws = ap->ws;
    SchedUp S{(const char*)(ws + WS_PROJ), (const char*)(ws + WS_WQ) + (size_t)l * 768 * 256 * 2, (const char*)(ws + WS_WKV) + (size_t)l * 1024 * 256 * 2, grid_g(), c.bid};
    EpiUp E{(bf16_t*)(ws + WS_QUP), (bf16_t*)(ws + WS_KM), (bf16_t*)(ws + WS_KVUP), (const float*)(ws + WS_SSQ) + (size_t)l * T_}; pg8::gemm_phase(c.lds, NPROJ, 256, 4, S, E);
}
__device__ __forceinline__ void ph_gate(const Ctx& c, int l) {
    ArgsP ap = get_args(); unsigned char* ws = ap->ws;
    SchedGate S{(const char*)ws, l, grid_g(), c.bid};
    EpiGate E{ws, ap->in[I_BGLU] + l * 512, l};
    pg8::gemm_phase(c.lds, 512, 512, 8, S, E);
}
__device__ __forceinline__ void ph_merge(const Ctx& c, int l) {
    ArgsP ap = get_args(); unsigned char* ws = ap->ws;
    SchedMerge S{(const char*)ws, l, grid_g(), c.bid};
    EpiMerge E{ws, l, c.bid};
    pg8::gemm_phase(c.lds, 512, 512, 8, S, E);
}
__device__ __forceinline__ void ph_out(const Ctx& c, int l, bool dry) {
    ArgsP ap = get_args(); unsigned char* ws = ap->ws;
    SchedPlain S{(const char*)(ws + WS_PROJ) + ((size_t)512 << 10), (size_t)1280 << 10, (size_t)10 << 20, (const char*)(ws + WS_WOUT) + (size_t)l * DM * DM * 2, (size_t)256 * 1024 * 2, 4, grid_g(), c.bid};
    const bool lastl = (l == NL - 1);
    EpiOut E{l == 0 ? ap->in[I_X] : nullptr, ap->out, (bf16_t*)(ws + WS_XG), lastl ? nullptr : (float*)(ws + WS_SS) + (size_t)(l + 1) * T_, dry};
    pg8::gemm_phase(c.lds, 1024, 1024, 16, S, E);
}

__global__ void __launch_bounds__(512, 2) trunk_fwd(Args args) {
    extern __shared__ __attribute__((aligned(16))) unsigned char lds[];
    Ctx c; c.lds = (LAS unsigned char*)lds; c.ldsg = (char*)lds; c.G = gridDim.x; c.bid = blockIdx.x; c.vb = (gridDim.x == 256) ? (int)((blockIdx.x & 7) * 32 + (blockIdx.x >> 3)) : (int)blockIdx.x;
#if MK_LAUNCHES == 1
#if USE_XCD_BAR
    if (threadIdx.x < 16) ((volatile LAS unsigned*)(c.lds + LDS_MAIN))[threadIdx.x] = 0u;
    __syncthreads();
    XcdBarrier bar = xcd_barrier_post((unsigned*)(args.ws + WS_CTL) + 4096, (volatile LAS unsigned*)(c.lds + LDS_MAIN), gridDim.x, 64u);
#define GRID_BAR() xcd_barrier(bar)
    const bool sub_bars = (gridDim.x == 256) && args.ph_lo == 0 && args.ph_hi == NPH;
#define PIPE_BAR() do { if (sub_bars) { ArgsP ap_ = get_args(); XcdBarrier b_; b_.bar = (unsigned*)(ap_->ws + WS_PBAR) + (blockIdx.x & 7) * XCD_BAR_WORDS; b_.x = xb_xcc_id(); b_.st = (volatile LAS unsigned*)(c.lds + LDS_MAIN) + 4; b_.nexp = 32u; b_.S = 64u; xcd_barrier(b_); } else xcd_barrier(bar); } while (0)
#define GROUP_BAR() do { if (sub_bars) { ArgsP ap_ = get_args(); XcdBarrier b_; b_.bar = (unsigned*)(ap_->ws + WS_GBAR) + ((blockIdx.x & 7) * 8 + ((blockIdx.x >> 3) & 7)) * GRP_BAR_WORDS; b_.x = xb_xcc_id(); b_.st = (volatile LAS unsigned*)(c.lds + LDS_MAIN) + 8; b_.nexp = 4u; b_.S = 16u; xcd_barrier(b_); } else xcd_barrier(bar); } while (0)
#define HAVE_PIPE_BAR 1
#else
    cg::grid_group grid = cg::this_grid();
#define GRID_BAR() grid.sync()
#endif
#else
#define GRID_BAR() do {} while (0)
#endif
    const int lo = args.ph_lo, hi = args.ph_hi;
#ifndef PH_MASK
#define PH_MASK 0xfff
#endif
#define IN(k) (lo <= (k) && (k) < hi)
#define PHM(j) ((PH_MASK >> (j)) & 1)
#define SEAM(k) do { if (IN(k) && IN((k) + 1)) GRID_BAR(); } while (0)
#ifdef HAVE_PIPE_BAR
#define SEAMP(k) do { if (IN(k) && IN((k) + 1)) PIPE_BAR(); } while (0)
#define SEAMG(k) do { if (IN(k) && IN((k) + 1)) GROUP_BAR(); } while (0)
#else
#define SEAMP(k) SEAM(k)
#define SEAMG(k) SEAM(k)
#endif

#ifndef ENABLE_PROBES
#define ENABLE_PROBES 0
#endif
#if ENABLE_PROBES
    const int probe = args.probe;
#define REP(j) for (int rep = (probe == (j)) ? 0 : 1; rep < 2; ++rep)
#else
#define REP(j) for (int rep = 1; rep < 2; ++rep)
#endif
    if (PHM(0) && IN(0)) { REP(1) phase0(c, 0); } SEAM(0);
#ifdef HAVE_PIPE_BAR
    if (sub_bars) {
        (void)xcd_barrier_post((unsigned*)(args.ws + WS_PBAR) + (blockIdx.x & 7) * XCD_BAR_WORDS, (volatile LAS unsigned*)(c.lds + LDS_MAIN) + 4, 32u, 64u);
        (void)xcd_barrier_post((unsigned*)(args.ws + WS_GBAR) + ((blockIdx.x & 7) * 8 + ((blockIdx.x >> 3) & 7)) * GRP_BAR_WORDS, (volatile LAS unsigned*)(c.lds + LDS_MAIN) + 8, 4u, 16u);
    }
#endif
    for (int l = 0; l < NL; ++l) {
        const int pb = 1 + 7 * l;
        if (PHM(1) && IN(pb + 0)) {
            if (l == 0 && (c.bid & 1)) { phase0(c, 1); __syncthreads(); }
            REP(2) ph_inproj(c, l);
            if (l == 0 && !(c.bid & 1)) phase0(c, 1); }
        if (l == 0) SEAM(pb + 0); else SEAMG(pb + 0);
#ifdef PIPE_SKEW_TICKS
        if (l == 0 && gridDim.x == 256) {
            const unsigned t0 = (unsigned)__builtin_amdgcn_s_memrealtime(), dt = (unsigned)__builtin_amdgcn_readfirstlane((int)(PIPE_SKEW_TICKS));
            while ((unsigned)__builtin_amdgcn_s_memrealtime() - t0 < dt) __builtin_amdgcn_s_sleep(8);
        }
#endif
        if (IN(pb + 1)) {
            if (c.bid & 1) { if (PHM(9)) REP(5) s5_pass<false>(c, l, false); if (PHM(2)) REP(4) ph_fv(c, l); if (PHM(2)) REP(3) ph_up(c, l); }
            else { if (PHM(2)) REP(4) ph_fv(c, l); if (PHM(2)) REP(3) ph_up(c, l); if (PHM(9)) REP(5) s5_pass<false>(c, l, false); } }
        SEAMP(pb + 1);
        if (IN(pb + 2)) {
            if (c.bid & 1) { if (PHM(10)) REP(7) s5_pass<true>(c, l, rep == 0); if (PHM(3)) REP(6) prep_phase(c, l, rep == 0); }
            else { if (PHM(3)) REP(6) prep_phase(c, l, rep == 0); if (PHM(10)) REP(7) s5_pass<true>(c, l, rep == 0); } }
        SEAMP(pb + 2);
        if (IN(pb + 3)) { if (PHM(4)) REP(8) attn_phase(c, l, rep == 0); }
        SEAMP(pb + 3);
        if (PHM(5) && IN(pb + 4)) REP(10) ph_gate(c, l);
        SEAMG(pb + 4);
        if (PHM(6) && IN(pb + 5)) REP(11) ph_merge(c, l);
        SEAMG(pb + 5);
        if (PHM(7) && IN(pb + 6)) REP(12) ph_out(c, l, rep == 0);
        SEAMG(pb + 6);
    }
#undef IN
#undef SEAM
}

extern "C" void kernel_launch(void* const* d_in, const int* in_sizes, int n_in, void* d_out, int out_size, void* d_ws, size_t ws_size, hipStream_t stream) {
    static int grid = 0;
    if (grid == 0) {
        if (n_in != 25 || in_sizes[0] != T_ * DM || out_size != T_ * DM || ws_size < WS_END) {
            fprintf(stderr, "kernel_launch: shape mismatch n_in %d in0 %d out %d ws %zu (need %zu)\n", n_in, n_in > 0 ? in_sizes[0] : -1, out_size, ws_size, (size_t)WS_END); grid = -1; return; }
        int dev = 0, cus = 0, per_cu = 0;
        hipGetDevice(&dev); hipDeviceGetAttribute(&cus, hipDeviceAttributeMultiprocessorCount, dev);
        if (hipFuncSetAttribute((const void*)trunk_fwd, hipFuncAttributeMaxDynamicSharedMemorySize, LDS_BYTES) != hipSuccess) { fprintf(stderr, "kernel_launch: hipFuncSetAttribute failed\n"); grid = -1; return; }
        if (hipOccupancyMaxActiveBlocksPerMultiprocessor(&per_cu, (const void*)trunk_fwd, 512, LDS_BYTES) != hipSuccess || per_cu < 1) { fprintf(stderr, "kernel_launch: occupancy query says %d\n", per_cu); per_cu = 1; }
        (void)hipGetLastError();
        grid = cus;
    }
    if (grid < 0) return;
    hipMemsetAsync((char*)d_ws + WS_CTL, 0, 64 * KiB, stream);
    Args a{};
    for (int i = 0; i < 25; ++i) a.in[i] = (const float*)d_in[i];
    a.out = (float*)d_out; a.ws = (unsigned char*)d_ws;
#ifdef PROBE_PHASE
    a.probe = PROBE_PHASE;
#endif
#if MK_LAUNCHES == 1
    a.ph_lo = 0; a.ph_hi = NPH;
#ifndef PLAIN_LAUNCH
#define PLAIN_LAUNCH 0
#endif
#if PLAIN_LAUNCH
    hipLaunchKernelGGL(trunk_fwd, dim3(grid), dim3(512), LDS_BYTES, stream, a);
#else
    void* kargs[] = {&a};
    hipError_t e = hipLaunchCooperativeKernel((const void*)trunk_fwd, dim3(grid), dim3(512), kargs, LDS_BYTES, stream);
    if (e != hipSuccess) fprintf(stderr, "cooperative launch failed: %s (grid %d)\n", hipGetErrorString(e), grid);
#endif
#else
    for (int ph = 0; ph < NPH; ++ph) { a.ph_lo = ph; a.ph_hi = ph + 1; hipLaunchKernelGGL(trunk_fwd, dim3(grid), dim3(512), LDS_BYTES, stream, a); }
#endif
}
```

```cpp
#include <hip/hip_runtime.h>
#include <hip/hip_cooperative_groups.h>
#include <cstdint>
#include <cstdio>
namespace cg = cooperative_groups;

#ifndef MK_LAUNCHES
#define MK_LAUNCHES 1
#endif
#ifndef USE_XCD_BAR
#define USE_XCD_BAR 1
#endif

#define LAS __attribute__((address_space(3)))
typedef unsigned short bf16_t;
typedef short bf16x8 __attribute__((ext_vector_type(8)));
typedef short s16x4 __attribute__((ext_vector_type(4)));
typedef float f32x2 __attribute__((ext_vector_type(2)));
typedef float f32x4 __attribute__((ext_vector_type(4)));
typedef float f32x16 __attribute__((ext_vector_type(16)));
typedef unsigned u32x2 __attribute__((ext_vector_type(2)));
typedef unsigned u32x4 __attribute__((ext_vector_type(4)));

constexpr int T_ = 16384, S_ = 2048, NB_ = 8, DM = 1024, NL = 2;
constexpr int NPROJ = 2560;
constexpr int NIN = 7168;
constexpr int IN_SRC = 7080;
constexpr float EPS = 1e-6f;
constexpr float LOG2E = 1.4426950408889634f;
constexpr int NPH = 1 + 7 * NL;

constexpr size_t KiB = 1024, MiB = 1024 * 1024;
constexpr size_t WS_CTL = 0;
constexpr size_t WS_SS = 64 * KiB;
constexpr size_t WS_FF32 = 256 * KiB;
constexpr size_t WS_CUM = 768 * KiB;
constexpr size_t WS_TA = 1280 * KiB;
constexpr size_t WS_TBB = 1344 * KiB;
constexpr size_t WS_TC = 1856 * KiB;
constexpr size_t WS_SSQ = 2432 * KiB;
constexpr size_t WS_SSKV = 2560 * KiB;
constexpr size_t WS_PBAR = 2688 * KiB;
constexpr size_t WS_E = 3 * MiB;
constexpr size_t WS_WQ = 7 * MiB;
constexpr size_t WS_WKV = WS_WQ + 768 * KiB;
constexpr size_t WS_WGLU = WS_WKV + 1 * MiB;
constexpr size_t WS_WBO = WS_WGLU + 1 * MiB;
constexpr size_t WS_WOUT = WS_WBO + 6 * MiB;
constexpr size_t WS_WIN = 20 * MiB;
constexpr size_t WS_XG = 48 * MiB;
constexpr size_t WS_PROJ = 80 * MiB;
constexpr size_t WS_QUP = 160 * MiB;
constexpr size_t WS_KVUP = 184 * MiB;
constexpr size_t WS_KM = 216 * MiB;
constexpr size_t WS_Z = 240 * MiB;
constexpr size_t WS_END = 256 * MiB;
static_assert(WS_WOUT + 4 * MiB <= WS_WIN && WS_WIN + 28 * MiB <= WS_XG, "ws map");

__device__ __forceinline__ unsigned pk_bf16(float lo, float hi) {
    typedef __bf16 b2 __attribute__((ext_vector_type(2)));
    f32x2 v = {lo, hi}; b2 b = __builtin_convertvector(v, b2); return __builtin_bit_cast(unsigned, b);
}
__device__ __forceinline__ float bf_lo(unsigned w) { return __uint_as_float(w << 16); }
__device__ __forceinline__ float bf_hi(unsigned w) { return __uint_as_float(w & 0xffff0000u); }
__device__ __forceinline__ float bf2f(bf16_t h) { return __uint_as_float(((unsigned)h) << 16); }
__device__ __forceinline__ bf16_t f2bf(float f) { return (bf16_t)(pk_bf16(f, 0.f) & 0xffffu); }
__device__ __forceinline__ float sigmoidf_(float v) { return 1.f / (1.f + __expf(-v)); }
__device__ __forceinline__ float siluf_(float v) { return v / (1.f + __expf(-v)); }
__device__ __forceinline__ float gelu_tanh(float y) {
    const float v = 0.7978845608028654f * (y + 0.044715f * y * y * y);
    const float t = 1.f - 2.f / (1.f + __expf(2.f * v));
    return 0.5f * y * (1.f + t);
}
template <int CTRL> __device__ __forceinline__ float dpp_f(float v) { return __builtin_bit_cast(float, __builtin_amdgcn_update_dpp(0, __builtin_bit_cast(int, v), CTRL, 0xF, 0xF, true)); }
__device__ __forceinline__ float sum8(float v) { v += dpp_f<0xB1>(v); v += dpp_f<0x4E>(v); v += dpp_f<0x141>(v); return v; }
__device__ __forceinline__ float wave_sum(float v) {
    v = sum8(v); v += dpp_f<0x140>(v);
    const int iv = __builtin_bit_cast(int, v);
    const float a = __builtin_bit_cast(float, __builtin_amdgcn_readlane(iv, 0)), b = __builtin_bit_cast(float, __builtin_amdgcn_readlane(iv, 16));
    const float c = __builtin_bit_cast(float, __builtin_amdgcn_readlane(iv, 32)), d = __builtin_bit_cast(float, __builtin_amdgcn_readlane(iv, 48));
    return (a + b) + (c + d);
}
#define SBAR() __builtin_amdgcn_sched_barrier(0)

namespace pg8 {
constexpr int BM = 256, BK = 64, HALF = 128, HTB = HALF * BK * 2, STAGE_BYTES = 8 * HTB;
__device__ __forceinline__ int lds_byte(int r, int c) { const int st = (r >> 4) * 2 + (c >> 5), rr = r & 15, cc = c & 31, ob = rr * 64 + cc * 2; return st * 1024 + (ob ^ (((ob >> 9) & 1) << 5)); }
__device__ __forceinline__ void stage_rc(int b, int& R, int& C) { const int st = b / 1024, sb = b % 1024, swz = sb ^ (((sb >> 9) & 1) << 5); R = (st >> 1) * 16 + swz / 64; C = (st & 1) * 32 + (swz % 64) / 2; }
__device__ __forceinline__ int perm32(int rho) { const int n = rho >> 4, i = rho & 15; return 8 * (i >> 2) + 4 * n + (i & 3); }

struct Unit { const char* A; const char* B; int pm, pn, kind; };

__device__ __forceinline__ bool tile_at(long L, int nM, int nN, int& pm, int& pn) {
    const int nwg = nM * nN; if (L >= nwg) return false;
    int wgid = (int)L; { const int q = nwg / 8, r = nwg % 8, xcd = wgid % 8, off = wgid / 8; wgid = (xcd < r ? xcd * (q + 1) : r * (q + 1) + (xcd - r) * q) + off; }
    const int WGM = 8, nig = WGM * nN, gid = wgid / nig, fm = gid * WGM;
    pm = fm + ((wgid % nig) & (WGM - 1)); pn = (wgid % nig) / WGM; return true;
}

template <class Epi, class Sched>
__device__ __forceinline__ void gemm_phase(LAS unsigned char* lds, const int lda, const int ldb, const int nt, const Sched& S, const Epi& E) {
    int tid = threadIdx.x; asm volatile("" : "+v"(tid));
    const int wid = __builtin_amdgcn_readfirstlane(tid >> 6), lane = tid & 63, wr = wid >> 2, wc = wid & 3, fr = lane & 15, fq = lane >> 4;
    unsigned voffA[2], voffB[2];
#pragma unroll
    for (int i = 0; i < 2; ++i) { int R, C; stage_rc(tid * 16 + i * 8192, R, C); const int Rb = Epi::PERM ? ((R & ~31) + perm32(R & 31)) : R;
        voffA[i] = (unsigned)(R * lda + C) * 2u; voffB[i] = (unsigned)(Rb * ldb + C) * 2u; }
    int ntv = nt; asm volatile("" : "+s"(ntv));
    const size_t kstep = (size_t)(BK * 2);
    const size_t hstepA = (size_t)HALF * lda * 2, hstepB = (size_t)HALF * ldb * 2;
    const unsigned ldsw = (unsigned)wid * 1024u;
    const int aoff = lds_byte(wr * 64 + fr, fq * 8), boff = lds_byte(wc * 32 + fr, fq * 8);
#define PG8_SA(b, h) (((b) * 2 + (h)) * HTB)
#define PG8_SB(b, h) ((4 + (b) * 2 + (h)) * HTB)
#define PG8_STAGE(bufoff, gbase, voff) do { _Pragma("unroll") for (int _i = 0; _i < 2; ++_i) \
        __builtin_amdgcn_global_load_lds((const unsigned*)((const char*)(gbase) + (voff)[_i]), (LAS unsigned*)(lds + (bufoff) + ldsw + _i * 8192), 16, 0, 0); } while (0)
#define PG8_LDA(dst, b, h) do { _Pragma("unroll") for (int m = 0; m < 4; ++m) _Pragma("unroll") for (int k = 0; k < 2; ++k) dst[m][k] = *(const LAS bf16x8*)(lds + PG8_SA(b, h) + aoff + m * 2048 + k * 1024); } while (0)
#define PG8_LDB(dst, b, h) do { _Pragma("unroll") for (int n = 0; n < 2; ++n) _Pragma("unroll") for (int k = 0; k < 2; ++k) dst[n][k] = *(const LAS bf16x8*)(lds + PG8_SB(b, h) + boff + n * 2048 + k * 1024); } while (0)
#define PG8_MMA(ai, bj, At, Bt) do { __builtin_amdgcn_s_setprio(1); _Pragma("unroll") for (int m = 0; m < 4; ++m) _Pragma("unroll") for (int n = 0; n < 2; ++n) _Pragma("unroll") for (int k = 0; k < 2; ++k) \
        acc[ai][bj][m][n] = __builtin_amdgcn_mfma_f32_16x16x32_bf16(Bt[n][k], At[m][k], acc[ai][bj][m][n], 0, 0, 0); __builtin_amdgcn_s_setprio(0); } while (0)
#define PG8_WAIT_V(n) asm volatile("s_waitcnt vmcnt(" #n ")" ::: "memory")
#define PG8_WAIT_L(n) asm volatile("s_waitcnt lgkmcnt(" #n ")" ::: "memory")
#define PG8_BAR __builtin_amdgcn_s_barrier()
#define PG8_SCHED __builtin_amdgcn_sched_barrier(0)
    Unit cur, nxt; int ui = 0;
    if (!S.next(0, cur)) return;
    f32x4 acc[2][2][4][2];
#pragma unroll
    for (int a = 0; a < 2; ++a)
#pragma unroll
        for (int b = 0; b < 2; ++b)
#pragma unroll
            for (int m = 0; m < 4; ++m)
#pragma unroll
                for (int n = 0; n < 2; ++n) acc[a][b][m][n] = (f32x4){0.f, 0.f, 0.f, 0.f};
    bf16x8 At[4][2], B0[2][2], B1[2][2];
    const char* cA = cur.A; const char* cB = cur.B;
    PG8_STAGE(PG8_SB(0, 0), cB, voffB); PG8_STAGE(PG8_SB(0, 1), cB + hstepB, voffB); PG8_STAGE(PG8_SA(0, 0), cA, voffA); PG8_STAGE(PG8_SA(0, 1), cA + hstepA, voffA);
    if (wr == 1) PG8_BAR;
    PG8_WAIT_V(2); PG8_BAR;
    PG8_STAGE(PG8_SB(1, 0), cB + kstep, voffB); PG8_STAGE(PG8_SA(1, 0), cA + kstep, voffA); PG8_STAGE(PG8_SB(1, 1), cB + hstepB + kstep, voffB);
    PG8_WAIT_V(6); PG8_BAR;
    for (;;) {
        const bool has_next = S.next(ui + 1, nxt);
        const char* nA = has_next ? nxt.A : cA; const char* nB = has_next ? nxt.B : cB;
        for (int t = 0; t < ntv; t += 2) {
            const bool last = (t == ntv - 2);
            const char* a1 = cA + (size_t)(t + 1) * kstep;
            const char* a2 = last ? nA : cA + (size_t)(t + 2) * kstep; const char* b2 = last ? nB : cB + (size_t)(t + 2) * kstep;
            const char* a3 = a2 + kstep; const char* b3 = b2 + kstep;
            PG8_LDB(B0, 0, 0); PG8_LDB(B1, 0, 1); PG8_SCHED; PG8_LDA(At, 0, 0); PG8_STAGE(PG8_SA(1, 1), a1 + hstepA, voffA);
            PG8_WAIT_V(8); PG8_WAIT_L(0); PG8_BAR; PG8_MMA(0, 0, At, B0); PG8_MMA(0, 1, At, B1); PG8_BAR; PG8_SCHED;
            PG8_LDA(At, 0, 1); PG8_STAGE(PG8_SB(0, 0), b2, voffB); PG8_STAGE(PG8_SB(0, 1), b2 + hstepB, voffB); PG8_STAGE(PG8_SA(0, 0), a2, voffA);
            PG8_WAIT_V(8); PG8_WAIT_L(0); PG8_BAR; PG8_MMA(1, 0, At, B0); PG8_MMA(1, 1, At, B1); PG8_BAR; PG8_SCHED;
            PG8_LDB(B0, 1, 0); PG8_LDB(B1, 1, 1); PG8_SCHED; PG8_LDA(At, 1, 0); PG8_STAGE(PG8_SA(0, 1), a2 + hstepA, voffA);
            PG8_WAIT_V(8); PG8_WAIT_L(0); PG8_BAR; PG8_MMA(0, 0, At, B0); PG8_MMA(0, 1, At, B1); PG8_BAR; PG8_SCHED;
            PG8_LDA(At, 1, 1); PG8_STAGE(PG8_SB(1, 0), b3, voffB); PG8_STAGE(PG8_SB(1, 1), b3 + hstepB, voffB); PG8_STAGE(PG8_SA(1, 0), a3, voffA);
            PG8_WAIT_V(8); PG8_WAIT_L(0); PG8_BAR; PG8_MMA(1, 0, At, B0); PG8_MMA(1, 1, At, B1); PG8_BAR; PG8_SCHED;
        }
        if (wr == 0) PG8_BAR;
        const bool keep = E(acc, cur, wr, wc, fr, fq);
        if (!has_next) break;
        if (!keep) {
#pragma unroll
            for (int a = 0; a < 2; ++a)
#pragma unroll
                for (int b = 0; b < 2; ++b)
#pragma unroll
                    for (int m = 0; m < 4; ++m)
#pragma unroll
                        for (int n = 0; n < 2; ++n) acc[a][b][m][n] = (f32x4){0.f, 0.f, 0.f, 0.f};
        }
        cur = nxt; cA = nA; cB = nB; ++ui;
        if (wr == 1) PG8_BAR;
    }
    PG8_WAIT_V(0);
    PG8_BAR;
#undef PG8_SA
#undef PG8_SB
#undef PG8_STAGE
#undef PG8_LDA
#undef PG8_LDB
#undef PG8_MMA
#undef PG8_WAIT_V
#undef PG8_WAIT_L
#undef PG8_BAR
#undef PG8_SCHED
}
}

struct Args {
    const float* in[25];
    float* out;
    unsigned char* ws;
    int ph_lo, ph_hi, probe, pad;
};
enum { I_X = 0, I_POS, I_NORMG, I_WIN, I_QAN, I_WQUP, I_KVAN, I_WKVUP, I_MQN, I_MKN, I_FBF, I_FQN, I_FKN,
       I_LRE, I_LIM, I_LDT, I_BRE, I_BIM, I_CRE, I_CIM, I_S5D, I_WGLU, I_BGLU, I_WBO, I_WOUT };

typedef const __attribute__((address_space(4))) Args* ArgsP;
__device__ __forceinline__ ArgsP get_args() { ArgsP p = (ArgsP)__builtin_amdgcn_kernarg_segment_ptr(); asm volatile("" : "+s"(p)); return p; }
__device__ __forceinline__ int grid_g() { int g = (int)gridDim.x; asm volatile("" : "+s"(g)); return g; }
struct Ctx {
    LAS unsigned char* lds;
    char* ldsg;
    int G, bid;
    int vb;
};
#define PHASE_IDS() int tid = threadIdx.x; asm volatile("" : "+v"(tid)); const int lane = tid & 63, wave = __builtin_amdgcn_readfirstlane(tid >> 6); (void)lane; (void)wave

using pg8::Unit;
using pg8::tile_at;

__device__ __forceinline__ float rstd_of(const float* ss, int row) { return rsqrtf(ss[row] * (1.f / DM) + EPS); }

struct SchedIn {
    const char* XG; const char* WIN; int mode, G, c;
    __device__ __forceinline__ bool next(int i, Unit& u) const {
        int pm, pn; if (!tile_at((long)(i >> 1) * G + c, 64, mode ? 2 : 8, pm, pn)) return false;
        pn = mode ? pn + 6 : (pn >= 6 ? pn + 2 : pn);
        const int h = i & 1;
        u.A = XG + ((size_t)h * T_ + (size_t)pm * 256) * 512 * 2;
        u.B = WIN + ((size_t)h * NIN + (size_t)pn * 256) * 512 * 2;
        u.pm = pm; u.pn = pn; u.kind = h; return true;
    }
};
struct EpiProj {
    static constexpr bool PERM = true;
    bf16_t* P; const float* ss; float* ff32; float* ssq;
    __device__ __forceinline__ bool operator()(f32x4 (&acc)[2][2][4][2], const Unit& u, int wr, int wc, int fr, int fq) const {
        if (u.kind == 0) return true;
        const int row0 = u.pm * 256 + wr * 64 + fr, col0 = u.pn * 256 + wc * 32 + 8 * fq;
        float rs[2][4];
#pragma unroll
        for (int ai = 0; ai < 2; ++ai)
#pragma unroll
            for (int m = 0; m < 4; ++m) rs[ai][m] = ss[row0 + ai * 128 + m * 16];
#pragma unroll
        for (int ai = 0; ai < 2; ++ai)
#pragma unroll
            for (int m = 0; m < 4; ++m) { const int row = row0 + ai * 128 + m * 16; const float r_ = rsqrtf(rs[ai][m] * (1.f / DM) + EPS); bf16_t* rp = P + (size_t)row * NPROJ + col0;
#pragma unroll
                for (int bj = 0; bj < 2; ++bj) { const f32x4 v0 = acc[ai][bj][m][0] * r_, v1 = acc[ai][bj][m][1] * r_;
                    u32x4 w; w.x = pk_bf16(v0[0], v0[1]); w.y = pk_bf16(v0[2], v0[3]); w.z = pk_bf16(v1[0], v1[1]); w.w = pk_bf16(v1[2], v1[3]);
                    *(u32x4*)(rp + bj * 128) = w;
                    if (u.pn == 1 && bj == 1 && wc == 1 && fq == 0) { float* f = ff32 + (size_t)row * 8; *(f32x4*)f = v0; *(f32x4*)(f + 4) = v1; } }
                if (u.pn < 2) {
                    const f32x4 a0 = acc[ai][0][m][0] * r_, a1 = acc[ai][0][m][1] * r_; float sq = (a0[0] * a0[0] + a0[1] * a0[1]) + (a0[2] * a0[2] + a0[3] * a0[3]) + (a1[0] * a1[0] + a1[1] * a1[1]) + (a1[2] * a1[2] + a1[3] * a1[3]);
                    if (u.pn == 0) { const f32x4 b0 = acc[ai][1][m][0] * r_, b1 = acc[ai][1][m][1] * r_; sq += (b0[0] * b0[0] + b0[1] * b0[1]) + (b0[2] * b0[2] + b0[3] * b0[3]) + (b1[0] * b1[0] + b1[1] * b1[1]) + (b1[2] * b1[2] + b1[3] * b1[3]); }
                    sq += __shfl_xor(sq, 16); sq += __shfl_xor(sq, 32);
                    if (fq == 0) atomicAdd(ssq + (u.pn == 0 ? 0 : NL * T_) + row, sq); } }
        return false;
    }
};

struct SchedUp { const char* P; const char* WQ; const char* WKV; int G, c;
    __device__ __forceinline__ bool next(int i, Unit& u) const {
        long L = (long)i * G + c; int pm, pn;
        if (G == 256) { if (c < 128 || i >= 4) return false; L = (long)i * 128 + (c - 128); }
        if (L < 256) { tile_at(L, 64, 4, pm, pn); u.A = P + (size_t)pm * 256 * NPROJ * 2 + 256 * 2; u.B = WKV + (size_t)pn * 256 * 256 * 2; u.kind = 1; }
        else { if (!tile_at(L - 256, 64, 3, pm, pn)) return false; u.A = P + (size_t)pm * 256 * NPROJ * 2; u.B = WQ + (size_t)pn * 256 * 256 * 2; u.kind = 0; }
        u.pm = pm; u.pn = pn; return true; }
};
struct SchedPlain { const char* A; size_t a_tile_bytes, a_batch_bytes; const char* B; size_t b_tile_bytes; int nN, G, c;
    __device__ __forceinline__ bool next(int i, Unit& u) const {
        int pm, pn; if (!tile_at((long)i * G + c, 64, nN, pm, pn)) return false;
        u.A = A + (size_t)(pm >> 3) * a_batch_bytes + (size_t)(pm & 7) * a_tile_bytes; u.B = B + (size_t)pn * b_tile_bytes; u.pm = pm; u.pn = pn; u.kind = 0; return true; }
};
struct EpiUp { static constexpr bool PERM = true; bf16_t* QUP; bf16_t* KM; bf16_t* VM; const float* ssq;
    __device__ __forceinline__ bool operator()(f32x4 (&acc)[2][2][4][2], const Unit& u, int wr, int wc, int fr, int fq) const {
        const int row0 = u.pm * 256 + wr * 64 + fr, col0 = u.pn * 256 + wc * 32 + 8 * fq;
        float rs[2][4];
#pragma unroll
        for (int ai = 0; ai < 2; ++ai)
#pragma unroll
            for (int m = 0; m < 4; ++m) rs[ai][m] = ssq[(u.kind ? NL * T_ : 0) + row0 + ai * 128 + m * 16];
        const float inv = u.kind ? (1.f / 128) : (1.f / 256);
        bf16_t* dbase[2]; int dstr[2];
#pragma unroll
        for (int bj = 0; bj < 2; ++bj) { const int col = col0 + bj * 128;
            if (u.kind == 0) { dbase[bj] = QUP + col; dstr[bj] = 768; }
            else { const int hd = col >> 7, d = col & 127; if (d < 64) { dbase[bj] = KM + 96 * hd + d; dstr[bj] = 768; } else { dbase[bj] = VM + 64 * hd + (d - 64); dstr[bj] = 512; } } }
#pragma unroll
        for (int ai = 0; ai < 2; ++ai)
#pragma unroll
            for (int m = 0; m < 4; ++m) { const int row = row0 + ai * 128 + m * 16; const float r_ = rsqrtf(rs[ai][m] * inv + EPS);
#pragma unroll
                for (int bj = 0; bj < 2; ++bj) { const f32x4 v0 = acc[ai][bj][m][0] * r_, v1 = acc[ai][bj][m][1] * r_;
                    u32x4 w; w.x = pk_bf16(v0[0], v0[1]); w.y = pk_bf16(v0[2], v0[3]); w.z = pk_bf16(v1[0], v1[1]); w.w = pk_bf16(v1[2], v1[3]);
                    *(u32x4*)(dbase[bj] + (size_t)row * dstr[bj]) = w; } }
        return false;
    }
};
struct SchedGate { const char* ws; int l, G, c;
    __device__ __forceinline__ bool next(int i, Unit& u) const {
        const char* XG = ws + WS_XG; const char* WIN = ws + WS_WIN + (size_t)l * 2 * NIN * 512 * 2; const char* Z = ws + WS_Z; const char* WGLU = ws + WS_WGLU + (size_t)l * 512 * 512 * 2;
        int pm, pn, j;
        if (G == 256) {
            const int x = c & 7, k = c >> 3;
            if (k < 16) { if (i >= 4) return false; pm = 8 * x + (k >> 1); pn = 2 * (k & 1) + (i >> 1); j = i & 1; }
            else { if (i >= 3) return false; const int kk = k - 16; pm = 8 * x + (kk >> 1); pn = 4 + (kk & 1); j = i - 1; }
        } else {
            int Gv = G; asm volatile("" : "+s"(Gv));
            const int t3 = (128 - c + Gv - 1) / Gv;
            const int ns5 = (c < 128) ? t3 : 0;
            if (i < 3 * ns5) { const int m = c + (i / 3) * G; pm = m >> 1; pn = 4 + (m & 1); j = i % 3 - 1; }
            else { const int i2 = i - 3 * ns5; const long n = (long)(i2 >> 1) * G + c; if (n >= 256) return false; pm = (int)(n >> 2); pn = (int)(n & 3); j = i2 & 1; }
        }
        if (j < 0) { u.A = Z + (size_t)pm * 256 * 512 * 2; u.B = WGLU + (size_t)(pn & 1) * 256 * 512 * 2; u.kind = 2; }
        else { u.A = XG + ((size_t)j * T_ + (size_t)pm * 256) * 512 * 2; u.B = WIN + ((size_t)j * NIN + 2560 + (size_t)pn * 256) * 512 * 2; u.kind = j; }
        u.pm = pm; u.pn = pn; return true;
    }
};
struct EpiGate { static constexpr bool PERM = true; unsigned char* ws; const float* bias; int l;
    __device__ __forceinline__ bool operator()(f32x4 (&acc)[2][2][4][2], const Unit& u, int wr, int wc, int fr, int fq) const {
        if (u.kind == 0) return true;
        bf16_t* P = (bf16_t*)(ws + WS_PROJ); const bf16_t* QUP = (const bf16_t*)(ws + WS_QUP); const bf16_t* Z = (const bf16_t*)(ws + WS_Z); bf16_t* ABO = (bf16_t*)(ws + WS_KVUP); const float* ss = (const float*)(ws + WS_SS) + (size_t)l * T_;
        const int br = u.pn >> 1;
        const int row0 = u.pm * 256 + wr * 64 + fr, c0 = (u.pn & 1) * 256 + wc * 32 + 8 * fq;
        if (u.kind == 2) {
            f32x4 bv[2][2];
#pragma unroll
            for (int bj = 0; bj < 2; ++bj) { bv[bj][0] = *(const f32x4*)(bias + c0 + bj * 128); bv[bj][1] = *(const f32x4*)(bias + c0 + bj * 128 + 4); }
#pragma unroll
            for (int ai = 0; ai < 2; ++ai) {
                u32x4 yv[4][2];
#pragma unroll
                for (int m = 0; m < 4; ++m)
#pragma unroll
                    for (int bj = 0; bj < 2; ++bj) yv[m][bj] = *(const u32x4*)(Z + (size_t)(row0 + ai * 128 + m * 16) * 512 + c0 + bj * 128);
#pragma unroll
                for (int m = 0; m < 4; ++m) { const int row = row0 + ai * 128 + m * 16;
#pragma unroll
                    for (int bj = 0; bj < 2; ++bj) { const int c = c0 + bj * 128; const f32x4 v0 = acc[ai][bj][m][0] + bv[bj][0], v1 = acc[ai][bj][m][1] + bv[bj][1];
                        const u32x4 z = yv[m][bj];
                        u32x4 w;
                        w.x = pk_bf16(bf_lo(z.x) * sigmoidf_(v0[0]), bf_hi(z.x) * sigmoidf_(v0[1]));
                        w.y = pk_bf16(bf_lo(z.y) * sigmoidf_(v0[2]), bf_hi(z.y) * sigmoidf_(v0[3]));
                        w.z = pk_bf16(bf_lo(z.z) * sigmoidf_(v1[0]), bf_hi(z.z) * sigmoidf_(v1[1]));
                        w.w = pk_bf16(bf_lo(z.w) * sigmoidf_(v1[2]), bf_hi(z.w) * sigmoidf_(v1[3]));
                        *(u32x4*)(P + (size_t)row * NPROJ + c) = w; } }
            }
            return false;
        }
        const unsigned abo2 = (br == 2) ? (unsigned)(u.pm >> 3) * (512u << 10) : 0u;
        float rs[2][4];
#pragma unroll
        for (int ai = 0; ai < 2; ++ai)
#pragma unroll
            for (int m = 0; m < 4; ++m) rs[ai][m] = ss[row0 + ai * 128 + m * 16];
#pragma unroll
        for (int ai = 0; ai < 2; ++ai) {
            u32x4 yv[4][2];
#pragma unroll
            for (int m = 0; m < 4; ++m) { const int row = row0 + ai * 128 + m * 16;
#pragma unroll
                for (int bj = 0; bj < 2; ++bj) { const int c = c0 + bj * 128;
                    const bf16_t* ysrc = (br == 0) ? (QUP + (size_t)row * 768 + 96 * (c >> 6) + (c & 63)) : (br == 1) ? (P + (size_t)row * NPROJ + 512 + c) : (P + (size_t)row * NPROJ + c);
                    yv[m][bj] = *(const u32x4*)ysrc; } }
#pragma unroll
            for (int m = 0; m < 4; ++m) { const int row = row0 + ai * 128 + m * 16; const float r_ = rsqrtf(rs[ai][m] * (1.f / DM) + EPS);
#pragma unroll
                for (int bj = 0; bj < 2; ++bj) { const int c = c0 + bj * 128;
                    const u32x4 y = yv[m][bj];
                    const f32x4 v0 = acc[ai][bj][m][0] * r_, v1 = acc[ai][bj][m][1] * r_;
                    u32x4 w;
                    w.x = pk_bf16(bf_lo(y.x) * siluf_(v0[0]), bf_hi(y.x) * siluf_(v0[1]));
                    w.y = pk_bf16(bf_lo(y.y) * siluf_(v0[2]), bf_hi(y.y) * siluf_(v0[3]));
                    w.z = pk_bf16(bf_lo(y.z) * siluf_(v1[0]), bf_hi(y.z) * siluf_(v1[1]));
                    w.w = pk_bf16(bf_lo(y.w) * siluf_(v1[2]), bf_hi(y.w) * siluf_(v1[3]));
                    *(u32x4*)(ABO + ((size_t)br * T_ + row) * 512 + abo2 + c) = w; } }
        }
        return false;
    }
};
enum { MOP_KEEP = 0, MOP_STORE_O = 1, MOP_GATE_RMW = 2, MOP_STORE_S = 3, MOP_O_RMW = 4, MOP_FIRST = 8 };
struct SchedMerge { const char* ws; int l, G, c;
    __device__ __forceinline__ bool next(int i, Unit& u) const {
        const char* ABO = ws + WS_KVUP; const char* WBO = ws + WS_WBO + (size_t)l * 3 * 1024 * 512 * 2; const char* XG = ws + WS_XG; const char* WIN = ws + WS_WIN + (size_t)l * 2 * NIN * 512 * 2;
        int pm, pn; if (!tile_at((long)(i / 9) * G + c, 64, 4, pm, pn)) return false;
        const int j = i % 9; int typ, br, h = 0, op;
        if (G != 256 || !(c & 1)) { br = j / 3; const int s_ = j % 3; typ = s_ != 0; h = s_ - 1; op = s_ == 0 ? MOP_STORE_O : s_ == 1 ? MOP_KEEP : (MOP_GATE_RMW | (br == 0 ? MOP_FIRST : 0)); }
        else if (j < 2) { typ = 1; br = 2; h = j; op = j ? MOP_STORE_S : MOP_KEEP; }
        else { const int jj = j - 2, g = jj / 3, r = jj % 3; br = g;
            if (g == 2) { typ = 0; op = MOP_O_RMW; }
            else if (r == 0) { typ = 0; op = MOP_STORE_O; }
            else { typ = 1; h = r - 1; op = r == 1 ? MOP_KEEP : (MOP_GATE_RMW | (g == 0 ? MOP_FIRST : 0)); } }
        if (typ == 0) { u.A = ABO + ((size_t)br * T_ + (size_t)pm * 256) * 512 * 2 + (br == 2 ? (size_t)(pm >> 3) << 20 : 0); u.B = WBO + ((size_t)br * 1024 + (size_t)pn * 256) * 512 * 2; }
        else { u.A = XG + ((size_t)h * T_ + (size_t)pm * 256) * 512 * 2; u.B = WIN + ((size_t)h * NIN + 4096 + (size_t)br * 1024 + (size_t)pn * 256) * 512 * 2; }
        u.pm = pm; u.pn = pn; u.kind = op; return true;
    }
};
struct EpiMerge { static constexpr bool PERM = true; unsigned char* ws; int l, bid;
    __device__ __forceinline__ bf16_t* scr2() const { unsigned b_ = (unsigned)bid; asm volatile("" : "+s"(b_)); const unsigned sb = b_ & 7u, sk = (b_ >> 3) & 31u;
        return (bf16_t*)(ws + (sk < 16u ? (unsigned)WS_Z + sb * (2u << 20) + sk * 131072u : (unsigned)WS_PROJ + sb * (10u << 20) + (8u << 20) + (sk - 16u) * 131072u)); }
    __device__ __forceinline__ bool operator()(f32x4 (&acc)[2][2][4][2], const Unit& u, int wr, int wc, int fr, int fq) const {
        const int op = u.kind & 7; const bool first = (u.kind & MOP_FIRST) != 0;
        if (op == MOP_KEEP) return true;
        bf16_t* OSCR = (bf16_t*)(ws + WS_PROJ) + (unsigned)(u.pm >> 3) * (3u << 20); bf16_t* MERGED = OSCR + (size_t)S_ * 1024; const float* ss = (const float*)(ws + WS_SS) + (size_t)l * T_;
        const int rt0 = wr * 64 + fr, ct0 = wc * 32 + 8 * fq;
        const int row0 = u.pm * 256 + rt0, col0 = u.pn * 256 + ct0;
        if (op == MOP_STORE_O) {
#pragma unroll
            for (int ai = 0; ai < 2; ++ai)
#pragma unroll
                for (int m = 0; m < 4; ++m) { const size_t off = (size_t)(row0 + ai * 128 + m * 16) * 1024 + col0;
#pragma unroll
                    for (int bj = 0; bj < 2; ++bj) { const f32x4 v0 = acc[ai][bj][m][0], v1 = acc[ai][bj][m][1];
                        u32x4 w; w.x = pk_bf16(v0[0], v0[1]); w.y = pk_bf16(v0[2], v0[3]); w.z = pk_bf16(v1[0], v1[1]); w.w = pk_bf16(v1[2], v1[3]);
                        *(u32x4*)(OSCR + off + bj * 128) = w; } }
            return false;
        }
        if (op == MOP_O_RMW) {
            bf16_t* SCR2 = scr2();
#pragma unroll
            for (int qd = 0; qd < 4; ++qd) { const int ai = qd >> 1, m0 = (qd & 1) * 2;
                u32x4 sv[2][2], pv[2][2];
#pragma unroll
                for (int mm = 0; mm < 2; ++mm) { const int rr = ai * 128 + (m0 + mm) * 16; const size_t off = (size_t)(row0 + rr) * 1024 + col0;
#pragma unroll
                    for (int bj = 0; bj < 2; ++bj) { sv[mm][bj] = *(const u32x4*)(SCR2 + (size_t)(rt0 + rr) * 256 + ct0 + bj * 128); pv[mm][bj] = *(const u32x4*)(MERGED + off + bj * 128); } }
#pragma unroll
                for (int mm = 0; mm < 2; ++mm) { const int m = m0 + mm; const size_t off = (size_t)(row0 + ai * 128 + m * 16) * 1024 + col0;
#pragma unroll
                    for (int bj = 0; bj < 2; ++bj) { const f32x4 v0 = acc[ai][bj][m][0], v1 = acc[ai][bj][m][1]; const u32x4 g = sv[mm][bj], p = pv[mm][bj];
                        u32x4 w;
                        w.x = pk_bf16(bf_lo(p.x) + bf_lo(g.x) * v0[0], bf_hi(p.x) + bf_hi(g.x) * v0[1]); w.y = pk_bf16(bf_lo(p.y) + bf_lo(g.y) * v0[2], bf_hi(p.y) + bf_hi(g.y) * v0[3]);
                        w.z = pk_bf16(bf_lo(p.z) + bf_lo(g.z) * v1[0], bf_hi(p.z) + bf_hi(g.z) * v1[1]); w.w = pk_bf16(bf_lo(p.w) + bf_lo(g.w) * v1[2], bf_hi(p.w) + bf_hi(g.w) * v1[3]);
                        *(u32x4*)(MERGED + off + bj * 128) = w; } }
            }
            return false;
        }
        if (op == MOP_STORE_S) {
            bf16_t* SCR2 = scr2();
            float rs[2][4];
#pragma unroll
            for (int ai = 0; ai < 2; ++ai)
#pragma unroll
                for (int m = 0; m < 4; ++m) rs[ai][m] = ss[row0 + ai * 128 + m * 16];
#pragma unroll
            for (int ai = 0; ai < 2; ++ai)
#pragma unroll
                for (int m = 0; m < 4; ++m) { const int rr = ai * 128 + m * 16; const float r_ = rsqrtf(rs[ai][m] * (1.f / DM) + EPS);
#pragma unroll
                    for (int bj = 0; bj < 2; ++bj) { const f32x4 v0 = acc[ai][bj][m][0] * r_, v1 = acc[ai][bj][m][1] * r_;
                        u32x4 w; w.x = pk_bf16(sigmoidf_(v0[0]), sigmoidf_(v0[1])); w.y = pk_bf16(sigmoidf_(v0[2]), sigmoidf_(v0[3])); w.z = pk_bf16(sigmoidf_(v1[0]), sigmoidf_(v1[1])); w.w = pk_bf16(sigmoidf_(v1[2]), sigmoidf_(v1[3]));
                        *(u32x4*)(SCR2 + (size_t)(rt0 + rr) * 256 + ct0 + bj * 128) = w; } }
            return false;
        }
        float rq[8];
#pragma unroll
        for (int g = 0; g < 8; ++g) rq[g] = ss[row0 + (g >> 2) * 128 + (g & 3) * 16];
        u32x4 ov[2][2], pv[2][2];
#define RMW_LOAD(g, b) do { const size_t off_ = (size_t)(row0 + ((g) >> 2) * 128 + ((g) & 3) * 16) * 1024 + col0; \
            _Pragma("unroll") for (int bj = 0; bj < 2; ++bj) { ov[b][bj] = *(const u32x4*)(OSCR + off_ + bj * 128); pv[b][bj] = (u32x4){0u, 0u, 0u, 0u}; if (!first) pv[b][bj] = *(const u32x4*)(MERGED + off_ + bj * 128); } } while (0)
        RMW_LOAD(0, 0);
#pragma unroll
        for (int g = 0; g < 8; ++g) { const int ai = g >> 2, m = g & 3, b = g & 1; const size_t off = (size_t)(row0 + ai * 128 + m * 16) * 1024 + col0;
            if (g + 1 < 8) RMW_LOAD(g + 1, (g + 1) & 1);
            const float r_ = rsqrtf(rq[g] * (1.f / DM) + EPS);
#pragma unroll
            for (int bj = 0; bj < 2; ++bj) { const f32x4 v0 = acc[ai][bj][m][0] * r_, v1 = acc[ai][bj][m][1] * r_;
                const u32x4 o = ov[b][bj], p = pv[b][bj];
                u32x4 w;
                w.x = pk_bf16(bf_lo(p.x) + bf_lo(o.x) * sigmoidf_(v0[0]), bf_hi(p.x) + bf_hi(o.x) * sigmoidf_(v0[1]));
                w.y = pk_bf16(bf_lo(p.y) + bf_lo(o.y) * sigmoidf_(v0[2]), bf_hi(p.y) + bf_hi(o.y) * sigmoidf_(v0[3]));
                w.z = pk_bf16(bf_lo(p.z) + bf_lo(o.z) * sigmoidf_(v1[0]), bf_hi(p.z) + bf_hi(o.z) * sigmoidf_(v1[1]));
                w.w = pk_bf16(bf_lo(p.w) + bf_lo(o.w) * sigmoidf_(v1[2]), bf_hi(p.w) + bf_hi(o.w) * sigmoidf_(v1[3]));
                *(u32x4*)(MERGED + off + bj * 128) = w; } }
#undef RMW_LOAD
        return false;
    }
};
struct EpiOut { static constexpr bool PERM = false; const float* xres; float* out; bf16_t* XG; float* ssn; bool dry;
    __device__ __forceinline__ bool operator()(f32x4 (&acc)[2][2][4][2], const Unit& u, int wr, int wc, int fr, int fq) const {
        const int row0 = u.pm * 256 + wr * 64 + fr, col0 = u.pn * 256 + wc * 32 + 4 * fq;
#pragma unroll
        for (int qd = 0; qd < 4; ++qd) { const int ai = qd >> 1, m0 = (qd & 1) * 2;
            f32x4 xr[2][2][2];
            if (xres) {
#pragma unroll
                for (int mm = 0; mm < 2; ++mm) { const size_t off = (size_t)(row0 + ai * 128 + (m0 + mm) * 16) * DM + col0;
#pragma unroll
                    for (int bj = 0; bj < 2; ++bj)
#pragma unroll
                        for (int n = 0; n < 2; ++n) xr[mm][bj][n] = __builtin_nontemporal_load((const f32x4*)(xres + off + bj * 128 + n * 16)); }
            } else {
                u32x2 xb[2][2][2];
#pragma unroll
                for (int mm = 0; mm < 2; ++mm) { const int row = row0 + ai * 128 + (m0 + mm) * 16;
#pragma unroll
                    for (int bj = 0; bj < 2; ++bj)
#pragma unroll
                        for (int n = 0; n < 2; ++n) { const int col = col0 + bj * 128 + n * 16; xb[mm][bj][n] = *(const u32x2*)(XG + ((size_t)(col >> 9) * T_ + row) * 512 + (col & 511)); } }
#pragma unroll
                for (int mm = 0; mm < 2; ++mm)
#pragma unroll
                    for (int bj = 0; bj < 2; ++bj)
#pragma unroll
                        for (int n = 0; n < 2; ++n) { const u32x2 b = xb[mm][bj][n]; xr[mm][bj][n] = (f32x4){bf_lo(b.x), bf_hi(b.x), bf_lo(b.y), bf_hi(b.y)}; }
            }
#pragma unroll
            for (int mm = 0; mm < 2; ++mm) { const int m = m0 + mm; const int row = row0 + ai * 128 + m * 16; const size_t off = (size_t)row * DM + col0; float sq = 0.f;
#pragma unroll
                for (int bj = 0; bj < 2; ++bj)
#pragma unroll
                    for (int n = 0; n < 2; ++n) { const int cc = bj * 128 + n * 16; const f32x4 o = xr[mm][bj][n] + acc[ai][bj][m][n];
                        if (!ssn && !dry) __builtin_nontemporal_store(o, (f32x4*)(out + off + cc));
                        if (ssn && !dry) { const int col = col0 + cc; sq += (o[0] * o[0] + o[1] * o[1]) + (o[2] * o[2] + o[3] * o[3]);
                            u32x2 w; w.x = pk_bf16(o[0], o[1]); w.y = pk_bf16(o[2], o[3]);
                            *(u32x2*)(XG + ((size_t)(col >> 9) * T_ + row) * 512 + (col & 511)) = w; } }
                if (ssn && !dry) { sq += __shfl_xor(sq, 16); sq += __shfl_xor(sq, 32); if (fq == 0) atomicAdd(ssn + row, sq); } }
        }
        return false;
    }
};

namespace attn {
constexpr int QBLK = 32, KVBLK = 64;
constexpr int SHM_K = KVBLK * 256, SHM_V = KVBLK * 64 * 2;
constexpr int NBUF = 3;
constexpr int LDS_V = 0, LDS_K = NBUF * SHM_V, LDS_CK = LDS_K + NBUF * SHM_K, LDS_WS = LDS_CK + NBUF * 256, LDS_OST = LDS_WS + 8 * 256, LDS_BYTES = LDS_OST + 8 * 4096;
constexpr float THR2 = 8.f;
#define KSWZ(row, colB) ((row) * 256 + ((colB) ^ (((row) & 15) << 4)))
__device__ __forceinline__ int crow(int r, int hi) { return (r & 3) + 8 * (r >> 2) + 4 * hi; }
__device__ __forceinline__ void partialSM(f32x16& p0, f32x16& p1, float& m_reg, float& alpha) {
    float pmax = p0[0];
#pragma unroll
    for (int r = 1; r < 16; ++r) pmax = fmaxf(pmax, p0[r]);
#pragma unroll
    for (int r = 0; r < 16; ++r) pmax = fmaxf(pmax, p1[r]);
    { auto rr = __builtin_amdgcn_permlane32_swap(__float_as_uint(pmax), __float_as_uint(pmax), false, false);
      pmax = fmaxf(__uint_as_float(rr[0]), __uint_as_float(rr[1])); }
    if (__builtin_expect(__all(pmax <= THR2), 1)) { alpha = 1.f; }
    else { const float dl = fmaxf(pmax, 0.f); m_reg += dl; alpha = __builtin_amdgcn_exp2f(-dl);
#pragma unroll
        for (int r = 0; r < 16; ++r) { p0[r] -= dl; p1[r] -= dl; } }
#pragma unroll
    for (int r = 0; r < 16; ++r) p0[r] = __builtin_amdgcn_exp2f(p0[r]);
}
__device__ __forceinline__ void finishSM(f32x16& p0, f32x16& p1, float alpha, float& l_reg, bf16x8& pa0, bf16x8& pa1, bf16x8& pa2, bf16x8& pa3) {
#pragma unroll
    for (int r = 0; r < 16; ++r) p1[r] = __builtin_amdgcn_exp2f(p1[r]);
    float ps = 0;
#pragma unroll
    for (int r = 0; r < 16; ++r) ps += p0[r];
#pragma unroll
    for (int r = 0; r < 16; ++r) ps += p1[r];
    { auto rr = __builtin_amdgcn_permlane32_swap(__float_as_uint(ps), __float_as_uint(ps), false, false);
      ps = __uint_as_float(rr[0]) + __uint_as_float(rr[1]); }
    l_reg = l_reg * alpha + ps;
#define PK4(P, BASE, OUT) do { unsigned a0 = pk_bf16(P[BASE + 0], P[BASE + 1]), a1 = pk_bf16(P[BASE + 2], P[BASE + 3]);   \
    unsigned b0 = pk_bf16(P[BASE + 4], P[BASE + 5]), b1 = pk_bf16(P[BASE + 6], P[BASE + 7]);                              \
    auto r0 = __builtin_amdgcn_permlane32_swap(a0, b0, false, false); auto r1 = __builtin_amdgcn_permlane32_swap(a1, b1, false, false); \
    u32x4 w = {r0[0], r1[0], r0[1], r1[1]}; OUT = __builtin_bit_cast(bf16x8, w); } while (0)
    PK4(p0, 0, pa0); PK4(p0, 8, pa1); PK4(p1, 0, pa2); PK4(p1, 8, pa3);
#undef PK4
}
__device__ __forceinline__ void expHalf(f32x16& p) {
#pragma unroll
    for (int r = 0; r < 16; ++r) p[r] = __builtin_amdgcn_exp2f(p[r]);
}
__device__ __forceinline__ void packP(const f32x16& p0, const f32x16& p1, bf16x8& pa0, bf16x8& pa1, bf16x8& pa2, bf16x8& pa3) {
#define PK4(P, BASE, OUT) do { unsigned a0 = pk_bf16(P[BASE + 0], P[BASE + 1]), a1 = pk_bf16(P[BASE + 2], P[BASE + 3]);   \
    unsigned b0 = pk_bf16(P[BASE + 4], P[BASE + 5]), b1 = pk_bf16(P[BASE + 6], P[BASE + 7]);                              \
    auto r0 = __builtin_amdgcn_permlane32_swap(a0, b0, false, false); auto r1 = __builtin_amdgcn_permlane32_swap(a1, b1, false, false); \
    u32x4 w = {r0[0], r1[0], r0[1], r1[1]}; OUT = __builtin_bit_cast(bf16x8, w); } while (0)
    PK4(p0, 0, pa0); PK4(p0, 8, pa1); PK4(p1, 0, pa2); PK4(p1, 8, pa3);
#undef PK4
}
__device__ __forceinline__ void sumP(const f32x16& p0, const f32x16& p1, float& l_reg) {
    float s0 = p0[0] + p0[1], s1 = p0[2] + p0[3], s2 = p1[0] + p1[1], s3 = p1[2] + p1[3];
#pragma unroll
    for (int r = 4; r < 16; r += 4) { s0 += p0[r] + p0[r + 1]; s1 += p0[r + 2] + p0[r + 3]; s2 += p1[r] + p1[r + 1]; s3 += p1[r + 2] + p1[r + 3]; }
    float ps = (s0 + s1) + (s2 + s3);
    { auto rr = __builtin_amdgcn_permlane32_swap(__float_as_uint(ps), __float_as_uint(ps), false, false); ps = __uint_as_float(rr[0]) + __uint_as_float(rr[1]); }
    l_reg += ps;
}
__device__ __forceinline__ void pv_sum(f32x16& la, bf16x8 pa0, bf16x8 pa1, bf16x8 pa2, bf16x8 pa3) {
    const u32x4 ow = {0x3F803F80u, 0x3F803F80u, 0x3F803F80u, 0x3F803F80u}; const bf16x8 ones = __builtin_bit_cast(bf16x8, ow);
    la = __builtin_amdgcn_mfma_f32_32x32x16_bf16(pa0, ones, la, 0, 0, 0);
    la = __builtin_amdgcn_mfma_f32_32x32x16_bf16(pa1, ones, la, 0, 0, 0);
    la = __builtin_amdgcn_mfma_f32_32x32x16_bf16(pa2, ones, la, 0, 0, 0);
    la = __builtin_amdgcn_mfma_f32_32x32x16_bf16(pa3, ones, la, 0, 0, 0);
}
__device__ __forceinline__ int v_st(int k, int c) { const int kk = (k & ~0xC) | ((k & 4) << 1) | ((k & 8) >> 1); return ((kk >> 3) * 2 + (c >> 5)) * 512 + ((kk & 7) * 32 + (c & 31)) * 2; }
__device__ __forceinline__ int v_rd_base(int lane) { return ((lane & 3) << 3) | (((lane >> 2) & 3) << 6) | (((lane >> 4) & 1) << 5) | (((lane >> 5) & 1) << 8); }
constexpr int v_rd_off(int d0, int ks, int half) { return d0 * 512 + ks * 2048 + half * 1024; }
template <int OFF> __device__ __forceinline__ s16x4 tr_read(int vb) {
    s16x4 r; asm volatile("ds_read_b64_tr_b16 %0, %1 offset:%2" : "=&v"(r) : "v"(vb), "i"(OFF) : "memory"); return r;
}
template <int OFF> __device__ __forceinline__ s16x4 trb(int vb) {
    return __builtin_amdgcn_ds_read_tr16_b64_v4i16((LAS s16x4*)(size_t)(unsigned)(vb + OFF));
}
#define SG(mask, n) __builtin_amdgcn_sched_group_barrier(mask, n, 0)
#define SGI(mask, n, id) __builtin_amdgcn_sched_group_barrier(mask, n, id)
#define SG_MFMA 0x008
#define SG_VALU 0x002
#define SG_DSR  0x100
template <int D0> __device__ __forceinline__ void pv_one(f32x16& od, int vb, bf16x8 pa0, bf16x8 pa1, bf16x8 pa2, bf16x8 pa3) {
    const s16x4 l0 = tr_read<v_rd_off(D0, 0, 0)>(vb), h0 = tr_read<v_rd_off(D0, 0, 1)>(vb), l1 = tr_read<v_rd_off(D0, 1, 0)>(vb), h1 = tr_read<v_rd_off(D0, 1, 1)>(vb);
    const s16x4 l2 = tr_read<v_rd_off(D0, 2, 0)>(vb), h2 = tr_read<v_rd_off(D0, 2, 1)>(vb), l3 = tr_read<v_rd_off(D0, 3, 0)>(vb), h3 = tr_read<v_rd_off(D0, 3, 1)>(vb);
    asm volatile("s_waitcnt lgkmcnt(0)" ::: "memory"); SBAR();
#define PKV(L, H) (bf16x8){L[0], L[1], L[2], L[3], H[0], H[1], H[2], H[3]}
    od = __builtin_amdgcn_mfma_f32_32x32x16_bf16(pa0, PKV(l0, h0), od, 0, 0, 0);
    od = __builtin_amdgcn_mfma_f32_32x32x16_bf16(pa1, PKV(l1, h1), od, 0, 0, 0);
    od = __builtin_amdgcn_mfma_f32_32x32x16_bf16(pa2, PKV(l2, h2), od, 0, 0, 0);
    od = __builtin_amdgcn_mfma_f32_32x32x16_bf16(pa3, PKV(l3, h3), od, 0, 0, 0);
#undef PKV
}

template <int DQK, bool FOX, bool TRACK>
__device__ __forceinline__ void attn_unit(bf16_t* Qh, int ldq, const bf16_t* Kh, int ldk, const bf16_t* Vh, int ldv, const float* cum, int q0, char* lds, bool dry, float sbound, int T0) {
    constexpr int ND = DQK / 16, KCH = DQK / 8;
    int tid = threadIdx.x; asm volatile("" : "+v"(tid));
    const int wid = __builtin_amdgcn_readfirstlane(tid >> 6), lane = tid & 63, r32 = lane & 31, hi = lane >> 5;
    char* V_lds = lds + LDS_V; char* K_lds = lds + LDS_K; float* CK_lds = (float*)(lds + LDS_CK);
    float* ws = (float*)(lds + LDS_WS) + wid * 64; float* li_l = ws; float* al_l = ws + 32;
    float m_reg = 0.f, l_reg = 0; f32x16 o[2]; o[0] = f32x16{}; o[1] = f32x16{}; bf16x8 qr[ND];
    const int qrow = q0 + wid * QBLK + r32;
    { const bf16_t* Qw = Qh + (size_t)qrow * ldq + hi * 8;
#pragma unroll
      for (int d0 = 0; d0 < ND; ++d0) qr[d0] = *reinterpret_cast<const bf16x8*>(Qw + d0 * 16); }
    float cq = 0.f; if (FOX) cq = cum[qrow];
    const int kr0 = tid / KCH, kc0 = tid % KCH;
    const int kr1 = (tid + 512) / KCH, kc1 = (tid + 512) % KCH;
    const bool k2 = (KCH * 64 > 512) && (tid + 512 < KCH * 64);
    const int vr = tid >> 3, vc = (tid & 7) * 8, vst = v_st(vr, vc);
    const int vb0 = (int)(uintptr_t)V_lds + v_rd_base(lane);
    struct Stg { bf16x8 k0, k1, v; f32x4 ck; } st[2];
    const int kr1c = (kr1 < 64) ? kr1 : 63;
    const int ckc = (tid & 15) * 4;
#define SLOAD(i, k0_) do { st[i].k0 = *reinterpret_cast<const bf16x8*>(Kh + (size_t)((k0_) + kr0) * ldk + kc0 * 8); \
      if (KCH * 64 > 512) st[i].k1 = *reinterpret_cast<const bf16x8*>(Kh + (size_t)((k0_) + kr1c) * ldk + kc1 * 8); \
      st[i].v = *reinterpret_cast<const bf16x8*>(Vh + (size_t)((k0_) + vr) * ldv + vc); \
      if (FOX) st[i].ck = *reinterpret_cast<const f32x4*>(cum + (k0_) + ckc); } while (0)
#define SWRITE(b, i) do { *(bf16x8*)(K_lds + (b) * SHM_K + KSWZ(kr0, kc0 * 16)) = st[i].k0; \
      if (k2) *(bf16x8*)(K_lds + (b) * SHM_K + KSWZ(kr1, kc1 * 16)) = st[i].k1; \
      *(bf16x8*)(V_lds + (b) * SHM_V + vst) = st[i].v; \
      if (FOX && tid < 16) *(f32x4*)(CK_lds + (b) * 64 + tid * 4) = st[i].ck; } while (0)
#define RESC(a) do { if (TRACK && __any((a) < 1.f)) { if (hi == 0) al_l[r32] = (a); asm volatile("s_waitcnt lgkmcnt(0)" ::: "memory"); \
      _Pragma("unroll") for (int d = 0; d < 2; ++d) _Pragma("unroll") for (int r = 0; r < 16; ++r) o[d][r] *= al_l[crow(r, hi)]; } } while (0)
    const int NT = (q0 + 256) / KVBLK;
    const int tlast = __builtin_amdgcn_readfirstlane((q0 + wid * QBLK + (FOX ? 31 : 0)) >> 6);
    int tfirst = 0;
    if (FOX && TRACK) { const float c0w = cum[q0 + wid * QBLK]; bool need = false; const int nbw = (q0 + wid * QBLK) >> 6;
        if (lane < nbw) need = (sbound + c0w - cum[64 * lane + 63] >= -40.f);
        const unsigned long long bal = __ballot(need);
        tfirst = __builtin_amdgcn_readfirstlane(bal ? (__ffsll((long long)bal) - 1) : nbw); }
    auto qkt = [&](f32x16& p0, f32x16& p1, int b, int t) {
        if (t > tlast || t < tfirst) return;
        const char* Ks = K_lds + b * SHM_K;
        if (FOX) { const float* ck = CK_lds + b * 64; const float cqm = TRACK ? cq - m_reg : cq;
#pragma unroll
            for (int g = 0; g < 4; ++g) { const f32x4 c0 = *(const f32x4*)(ck + 8 * g + 4 * hi), c1 = *(const f32x4*)(ck + 32 + 8 * g + 4 * hi);
#pragma unroll
                for (int i = 0; i < 4; ++i) { p0[4 * g + i] = cqm - c0[i]; p1[4 * g + i] = cqm - c1[i]; } }
        } else if (TRACK) { const float nm = -m_reg;
#pragma unroll
            for (int r = 0; r < 16; ++r) { p0[r] = nm; p1[r] = nm; } }
        else { p0 = f32x16{}; p1 = f32x16{}; }
#pragma unroll
        for (int d0 = 0; d0 < ND; ++d0) { const int cb = (d0 * 16 + hi * 8) * 2;
            const bf16x8 b0 = *reinterpret_cast<const bf16x8*>(Ks + KSWZ(r32, cb));
            const bf16x8 b1 = *reinterpret_cast<const bf16x8*>(Ks + KSWZ(32 + r32, cb));
            p0 = __builtin_amdgcn_mfma_f32_32x32x16_bf16(b0, qr[d0], p0, 0, 0, 0);
            p1 = __builtin_amdgcn_mfma_f32_32x32x16_bf16(b1, qr[d0], p1, 0, 0, 0); }
        if (FOX && t >= NT - 4) {
            asm volatile("" ::: "memory");
            const int kb = t * KVBLK + 4 * hi;
#pragma unroll
            for (int r = 0; r < 16; ++r) { const int kv = kb + (r & 3) + 8 * (r >> 2);
                if (kv > qrow) p0[r] = -INFINITY; if (kv + 32 > qrow) p1[r] = -INFINITY; }
        }
    };
#define PSM(P0, P1, AL, t) do { if (TRACK) { if ((t) <= tlast && (t) >= tfirst) partialSM(P0, P1, m_reg, AL); else AL = 1.f; } else if ((t) <= tlast && (t) >= tfirst) expHalf(P0); } while (0)
#define FSM(P0, P1, AL, t) do { if ((t) <= tlast && (t) >= tfirst) { if (TRACK) finishSM(P0, P1, AL, l_reg, pa0, pa1, pa2, pa3); else { expHalf(P1); sumP(P0, P1, l_reg); packP(P0, P1, pa0, pa1, pa2, pa3); } } } while (0)
#define PV(vb, t) do { if ((t) <= tlast && (t) >= tfirst) { pv_one<0>(o[0], vb, pa0, pa1, pa2, pa3); pv_one<1>(o[1], vb, pa0, pa1, pa2, pa3); } } while (0)
    f32x16 pA0, pA1, pB0, pB1; float alA, alB; bf16x8 pa0, pa1, pa2, pa3;
#define PKV(L, H) (bf16x8){L[0], L[1], L[2], L[3], H[0], H[1], H[2], H[3]}
#define SG_R1_STEP(nr) SG(SG_MFMA, 1); SG(SG_VALU, FOX ? 10 : 7); SG(SG_DSR, nr)
#define TRA(OFF) tr_read<OFF>(vbp_)
#define FAST_HALF(X0, X1, Y0, Y1, LOADSTMT, WRITESTMT) do { \
        SBAR(); \
        { const char* Ks = K_lds + bc * SHM_K; \
          if (FOX) { const float* ck = CK_lds + bc * 64; \
              _Pragma("unroll") for (int g = 0; g < 4; ++g) { const f32x4 c0 = *(const f32x4*)(ck + 8 * g + 4 * hi), c1 = *(const f32x4*)(ck + 32 + 8 * g + 4 * hi); \
                  _Pragma("unroll") for (int i = 0; i < 4; ++i) { X0[4 * g + i] = cq - c0[i]; X1[4 * g + i] = cq - c1[i]; } } } \
          else { X0 = f32x16{}; X1 = f32x16{}; } \
          _Pragma("unroll") for (int d0 = 0; d0 < ND; ++d0) { const int cb = (d0 * 16 + hi * 8) * 2; \
              const bf16x8 b0 = *reinterpret_cast<const bf16x8*>(Ks + KSWZ(r32, cb)); \
              const bf16x8 b1 = *reinterpret_cast<const bf16x8*>(Ks + KSWZ(32 + r32, cb)); \
              X0 = __builtin_amdgcn_mfma_f32_32x32x16_bf16(b0, qr[d0], X0, 0, 0, 0); \
              X1 = __builtin_amdgcn_mfma_f32_32x32x16_bf16(b1, qr[d0], X1, 0, 0, 0); } } \
        expHalf(Y1); sumP(Y0, Y1, l_reg); packP(Y0, Y1, pa0, pa1, pa2, pa3); \
        if (FOX) { SG(SG_DSR, 12); SG(SG_VALU, 32); SG_R1_STEP(1); SG_R1_STEP(1); SG_R1_STEP(1); SG_R1_STEP(1); SG_R1_STEP(0); SG_R1_STEP(0); SG_R1_STEP(0); SG_R1_STEP(0); } \
        else { SG(SG_DSR, 4); SG_R1_STEP(1); SG_R1_STEP(1); SG_R1_STEP(1); SG_R1_STEP(1); SG_R1_STEP(1); SG_R1_STEP(1); SG_R1_STEP(1); SG_R1_STEP(1); SG_R1_STEP(0); SG_R1_STEP(0); SG_R1_STEP(0); SG_R1_STEP(0); } \
        asm volatile("" : "+v"(X0), "+v"(X1), "+v"(pa0), "+v"(pa1), "+v"(pa2), "+v"(pa3), "+v"(l_reg));     \
        const int vbp_ = vb0 + bp * SHM_V; \
        const s16x4 va0 = TRA(v_rd_off(0, 0, 0)), va1 = TRA(v_rd_off(0, 0, 1)), va2 = TRA(v_rd_off(0, 1, 0)), va3 = TRA(v_rd_off(0, 1, 1)); \
        const s16x4 va4 = TRA(v_rd_off(0, 2, 0)), va5 = TRA(v_rd_off(0, 2, 1)), va6 = TRA(v_rd_off(0, 3, 0)), va7 = TRA(v_rd_off(0, 3, 1)); \
        SBAR(); \
        LOADSTMT; \
        asm volatile("s_waitcnt lgkmcnt(0)" ::: "memory"); SBAR(); \
        const s16x4 vc0 = TRA(v_rd_off(1, 0, 0)), vc1 = TRA(v_rd_off(1, 0, 1)), vc2 = TRA(v_rd_off(1, 1, 0)), vc3 = TRA(v_rd_off(1, 1, 1)); \
        const s16x4 vc4 = TRA(v_rd_off(1, 2, 0)), vc5 = TRA(v_rd_off(1, 2, 1)), vc6 = TRA(v_rd_off(1, 3, 0)), vc7 = TRA(v_rd_off(1, 3, 1)); \
        o[0] = __builtin_amdgcn_mfma_f32_32x32x16_bf16(pa0, PKV(va0, va1), o[0], 0, 0, 0); \
        o[0] = __builtin_amdgcn_mfma_f32_32x32x16_bf16(pa1, PKV(va2, va3), o[0], 0, 0, 0); \
        o[0] = __builtin_amdgcn_mfma_f32_32x32x16_bf16(pa2, PKV(va4, va5), o[0], 0, 0, 0); \
        o[0] = __builtin_amdgcn_mfma_f32_32x32x16_bf16(pa3, PKV(va6, va7), o[0], 0, 0, 0); \
        _Pragma("unroll") for (int r = 0; r < 8; ++r) X0[r] = __builtin_amdgcn_exp2f(X0[r]); \
        SGI(SG_MFMA, 1, 1); SGI(SG_VALU, 2, 1); SGI(SG_MFMA, 1, 1); SGI(SG_VALU, 2, 1); SGI(SG_MFMA, 1, 1); SGI(SG_VALU, 2, 1); SGI(SG_MFMA, 1, 1); SGI(SG_VALU, 2, 1); \
        asm volatile("" : "+v"(X0), "+v"(o[0])); \
        asm volatile("s_waitcnt lgkmcnt(0)" ::: "memory"); SBAR(); \
        o[1] = __builtin_amdgcn_mfma_f32_32x32x16_bf16(pa0, PKV(vc0, vc1), o[1], 0, 0, 0); \
        o[1] = __builtin_amdgcn_mfma_f32_32x32x16_bf16(pa1, PKV(vc2, vc3), o[1], 0, 0, 0); \
        o[1] = __builtin_amdgcn_mfma_f32_32x32x16_bf16(pa2, PKV(vc4, vc5), o[1], 0, 0, 0); \
        o[1] = __builtin_amdgcn_mfma_f32_32x32x16_bf16(pa3, PKV(vc6, vc7), o[1], 0, 0, 0); \
        _Pragma("unroll") for (int r = 8; r < 16; ++r) X0[r] = __builtin_amdgcn_exp2f(X0[r]); \
        SGI(SG_MFMA, 1, 2); SGI(SG_VALU, 2, 2); SGI(SG_MFMA, 1, 2); SGI(SG_VALU, 2, 2); SGI(SG_MFMA, 1, 2); SGI(SG_VALU, 2, 2); SGI(SG_MFMA, 1, 2); SGI(SG_VALU, 2, 2); \
        asm volatile("" : "+v"(X0), "+v"(o[1])); \
        SBAR(); \
        WRITESTMT; __syncthreads(); } while (0)
    SLOAD(0, T0 * KVBLK); SLOAD(1, (T0 + 1) * KVBLK); SBAR();
    SWRITE(0, 0); __syncthreads();
    qkt(pA0, pA1, 0, T0); PSM(pA0, pA1, alA, T0);
    SLOAD(0, (T0 + 2) * KVBLK); SBAR();
    SWRITE(1, 1); __syncthreads();
    int bp = 0, bc = 1, bn = 2;
    int j = T0 + 1;
    if (!TRACK) {
        const int JF = FOX ? NT - 5 : NT - 4;
        for (; j + 1 <= JF; j += 2) {
            FAST_HALF(pB0, pB1, pA0, pA1, SLOAD(1, (j + 2) * KVBLK), SWRITE(bn, 0));
            { const int t_ = bp; bp = bc; bc = bn; bn = t_; }
            FAST_HALF(pA0, pA1, pB0, pB1, SLOAD(0, (j + 3) * KVBLK), SWRITE(bn, 1));
            { const int t_ = bp; bp = bc; bc = bn; bn = t_; }
        }
    }
    for (; j + 1 < NT; j += 2) {
        SBAR(); qkt(pB0, pB1, bc, j);
        FSM(pA0, pA1, alA, j - 1); SBAR();
        SLOAD(1, (j + 2) * KVBLK); SBAR();
        PV(vb0 + bp * SHM_V, j - 1); PSM(pB0, pB1, alB, j);
        SWRITE(bn, 0);
        RESC(alB); __syncthreads();
        { const int t_ = bp; bp = bc; bc = bn; bn = t_; }
        SBAR(); qkt(pA0, pA1, bc, j + 1);
        FSM(pB0, pB1, alB, j); SBAR();
        if (j + 3 < NT) SLOAD(0, (j + 3) * KVBLK); SBAR();
        PV(vb0 + bp * SHM_V, j); PSM(pA0, pA1, alA, j + 1);
        SWRITE(bn, 1);
        RESC(alA); __syncthreads();
        { const int t_ = bp; bp = bc; bc = bn; bn = t_; }
    }
    SBAR(); qkt(pB0, pB1, bc, NT - 1);
    FSM(pA0, pA1, alA, NT - 2); SBAR();
    PV(vb0 + bp * SHM_V, NT - 2); PSM(pB0, pB1, alB, NT - 1);
    RESC(alB);
    FSM(pB0, pB1, alB, NT - 1); SBAR();
    PV(vb0 + bc * SHM_V, NT - 1);
#undef PSM
#undef FSM
#undef PV
#undef FAST_HALF
#undef TRA
#undef SG_R1_STEP
#undef PKV
    if (hi == 0) li_l[r32] = l_reg; asm volatile("s_waitcnt lgkmcnt(0)" ::: "memory");
    float rli[16];
#pragma unroll
    for (int r = 0; r < 16; ++r) rli[r] = __builtin_amdgcn_rcpf(li_l[crow(r, hi)]);
    { bf16_t* stg = (bf16_t*)(lds + LDS_OST) + wid * 2048;
#pragma unroll
      for (int r = 0; r < 16; ++r) { const int orow = crow(r, hi);
#pragma unroll
          for (int d0 = 0; d0 < 2; ++d0) stg[orow * 64 + d0 * 32 + r32] = f2bf(o[d0][r] * rli[r]); }
      asm volatile("s_waitcnt lgkmcnt(0)" ::: "memory");
      bf16_t* Ow = Qh + (size_t)(q0 + wid * QBLK) * ldq;
#pragma unroll
      for (int i = 0; i < 4; ++i) { const int row = i * 8 + (lane >> 3), ch = lane & 7; const u32x4 v = *(const u32x4*)(stg + row * 64 + ch * 8); if (!dry) *(u32x4*)(Ow + (size_t)row * ldq + ch * 8) = v; } }
    __syncthreads();
#undef SLOAD
#undef SWRITE
#undef RESC
}
}

__device__ __forceinline__ int map_in(int n) {
    if (n < 416) return n;
    if (n < 424) return 1952 + (n - 416);
    if (n < 512) return -1;
    if (n < 2048) return n - 512 + 416;
    if (n < 2560) return n - 2048 + 1960;
    if (n < 4096) return n - 2560 + 2472;
    return n - 4096 + 4008;
}
struct ConvD { const float* src; const float* kscale; bf16_t* dst; int ldsrc, K, N, dld, item; bool split512, mapped; };
__device__ __forceinline__ void conv_load(const ConvD& d, int lane, float (&x)[32], float& ks) {
    const int nblk = d.N / 32, kb = d.item / nblk, nb = d.item % nblk, k0 = 64 * kb, n0 = 32 * nb;
    const int sn = d.mapped ? map_in(n0 + (lane & 31)) : n0 + (lane & 31);
#pragma unroll
    for (int i = 0; i < 32; ++i) { const int kk = 2 * i + (lane >> 5); float v = 0.f; if (sn >= 0) v = __builtin_nontemporal_load(d.src + (size_t)(k0 + kk) * d.ldsrc + sn); x[i] = v; }
    ks = d.kscale ? d.kscale[k0 + lane] : 1.f;
}
__device__ __forceinline__ void conv_finish(const ConvD& d, LAS float* scr, int lane, const float (&x)[32], const float ks) {
    const int nblk = d.N / 32, kb = d.item / nblk, nb = d.item % nblk, k0 = 64 * kb, n0 = 32 * nb;
#pragma unroll
    for (int i = 0; i < 32; ++i) { const float s0 = __uint_as_float(__builtin_amdgcn_readlane(__float_as_uint(ks), 2 * i)), s1 = __uint_as_float(__builtin_amdgcn_readlane(__float_as_uint(ks), 2 * i + 1));
        scr[(2 * i + (lane >> 5)) * 33 + (lane & 31)] = x[i] * ((lane >> 5) ? s1 : s0); }
    asm volatile("s_waitcnt lgkmcnt(0)" ::: "memory");
    const int cch = lane & 7;
#pragma unroll
    for (int j = 0; j < 4; ++j) { const int n = (lane >> 3) + 8 * j; const LAS float* sp = scr + (8 * cch) * 33 + n;
        u32x4 o; o.x = pk_bf16(sp[0 * 33], sp[1 * 33]); o.y = pk_bf16(sp[2 * 33], sp[3 * 33]); o.z = pk_bf16(sp[4 * 33], sp[5 * 33]); o.w = pk_bf16(sp[6 * 33], sp[7 * 33]);
        bf16_t* dp = d.split512 ? (d.dst + ((size_t)(k0 >> 9) * d.N + n0 + n) * 512 + (k0 & 511) + 8 * cch) : (d.dst + (size_t)(n0 + n) * d.dld + k0 + 8 * cch);
        *(u32x4*)dp = o; }
    asm volatile("s_waitcnt lgkmcnt(0)" ::: "memory");
}
__device__ __forceinline__ void phase0(const Ctx& c, const int part) {
    PHASE_IDS(); ArgsP ap = get_args(); unsigned char* ws = ap->ws;
    const long gtid = (long)c.bid * 512 + tid, gthreads = (long)grid_g() * 512;
    const int gw = c.bid * 8 + wave, ngw = grid_g() * 8;
    LAS float* scr = (LAS float*)(c.lds + wave * 8448);
    constexpr int I_IN_ = 16 * 224, I_Q_ = 4 * 24, I_KV_ = 2 * 32, I_GLU_ = 8 * 16, I_BO_ = 8 * 32, I_OUT_ = 16 * 32, I_L = I_IN_ + I_Q_ + I_KV_ + I_GLU_ + 3 * I_BO_ + I_OUT_;
    auto conv_desc = [&](int it) -> ConvD { ConvD d; const int l = it / I_L; int r = it % I_L; d.kscale = nullptr; d.split512 = false; d.mapped = false;
        if (r < I_IN_) { d.src = ap->in[I_WIN] + (size_t)l * DM * IN_SRC; d.ldsrc = IN_SRC; d.K = DM; d.N = NIN; d.dst = (bf16_t*)(ws + WS_WIN) + (size_t)l * 2 * NIN * 512; d.dld = 512; d.split512 = true; d.mapped = true; d.kscale = ap->in[I_NORMG] + l * DM; d.item = r; return d; } r -= I_IN_;
        if (r < I_Q_) { d.src = ap->in[I_WQUP] + (size_t)l * 256 * 768; d.ldsrc = 768; d.K = 256; d.N = 768; d.dst = (bf16_t*)(ws + WS_WQ) + (size_t)l * 768 * 256; d.dld = 256; d.kscale = ap->in[I_QAN] + l * 256; d.item = r; return d; } r -= I_Q_;
        if (r < I_KV_) { d.src = ap->in[I_WKVUP] + (size_t)l * 128 * 1024; d.ldsrc = 1024; d.K = 128; d.N = 1024; d.dst = (bf16_t*)(ws + WS_WKV) + (size_t)l * 1024 * 256; d.dld = 256; d.kscale = ap->in[I_KVAN] + l * 128; d.item = r; return d; } r -= I_KV_;
        if (r < I_GLU_) { d.src = ap->in[I_WGLU] + (size_t)l * 512 * 512; d.ldsrc = 512; d.K = 512; d.N = 512; d.dst = (bf16_t*)(ws + WS_WGLU) + (size_t)l * 512 * 512; d.dld = 512; d.item = r; return d; } r -= I_GLU_;
        if (r < 3 * I_BO_) { const int br = r / I_BO_; d.src = ap->in[I_WBO] + ((size_t)l * 1536 + br * 512) * 1024; d.ldsrc = 1024; d.K = 512; d.N = 1024; d.dst = (bf16_t*)(ws + WS_WBO) + ((size_t)l * 3 + br) * 1024 * 512; d.dld = 512; d.item = r % I_BO_; return d; } r -= 3 * I_BO_;
        d.src = ap->in[I_WOUT] + (size_t)l * DM * DM; d.ldsrc = DM; d.K = DM; d.N = DM; d.dst = (bf16_t*)(ws + WS_WOUT) + (size_t)l * DM * DM; d.dld = DM; d.item = r; return d; };
    constexpr int N_A = 16 * 80, N_B = NL * I_L - N_A;
    auto item_of = [&](int idx) -> int { if (part == 0) return (idx / 80) * 224 + (idx % 80);
        return idx < 16 * 144 ? (idx / 144) * 224 + 80 + (idx % 144) : I_IN_ + (idx - 16 * 144); };
    const int n_items = part == 0 ? N_A : N_B;
    if (gw < n_items) {
        ConvD dc = conv_desc(item_of(gw)); float xc[32], kc; conv_load(dc, lane, xc, kc);
        for (int it = gw; it < n_items; it += ngw) {
            const int nit = it + ngw; const bool hn = nit < n_items;
            ConvD dn = dc; float xn[32], kn = 1.f;
#pragma unroll
            for (int i = 0; i < 32; ++i) xn[i] = 0.f;
            if (hn) { dn = conv_desc(item_of(nit)); conv_load(dn, lane, xn, kn); }
            SBAR();
            conv_finish(dc, scr, lane, xc, kc);
            dc = dn; kc = kn;
#pragma unroll
            for (int i = 0; i < 32; ++i) xc[i] = xn[i];
        }
    }
    if (part == 1) {
    for (long it = (wave == 1 ? (long)c.bid * 64 + lane : (long)NL * 32 * 64); it < NL * 32 * 64; it += (long)grid_g() * 64) {
        const int n = (int)(it & 63), g = (int)((it >> 6) & 31), l = (int)(it >> 11);
        const float dt = expf(ap->in[I_LDT][l * 32 + g]);
        const float lr = ap->in[I_LRE][(l * 32 + g) * 64 + n], li = ap->in[I_LIM][(l * 32 + g) * 64 + n];
        const float mag = expf(lr * dt), ang = li * dt;
        float rev = ang * 0.15915494309189535f; rev -= floorf(rev);
        const float are = mag * __builtin_amdgcn_cosf(rev), aim = mag * __builtin_amdgcn_sinf(rev);
        float pr = are, pi = aim;
#pragma unroll
        for (int s = 0; s < 6; ++s) { const float nr = pr * pr - pi * pi, ni = 2.f * pr * pi; pr = nr; pi = ni; }
        ((f32x4*)(ws + WS_TA))[it] = (f32x4){are, aim, pr, pi};
        const float den = lr * lr + li * li;
        const float fre = ((are - 1.f) * lr + aim * li) / den, fim = (aim * lr - (are - 1.f) * li) / den;
        const float* bre = ap->in[I_BRE] + it * 16; const float* bim = ap->in[I_BIM] + it * 16;
        float bbr[16], bbi[16];
#pragma unroll
        for (int cc = 0; cc < 16; ++cc) { const float br = bre[cc], bi = bim[cc]; bbr[cc] = fre * br - fim * bi; bbi[cc] = fre * bi + fim * br; }
        { const int nre = (n < 32) ? n : 64 + (n - 32), nim = nre + 32; bf16_t* tb = (bf16_t*)(ws + WS_TBB) + (size_t)(l * 32 + g) * 128 * 16;
          u32x4 w0, w1;
          w0.x = pk_bf16(bbr[0], bbr[1]); w0.y = pk_bf16(bbr[2], bbr[3]); w0.z = pk_bf16(bbr[4], bbr[5]); w0.w = pk_bf16(bbr[6], bbr[7]);
          w1.x = pk_bf16(bbr[8], bbr[9]); w1.y = pk_bf16(bbr[10], bbr[11]); w1.z = pk_bf16(bbr[12], bbr[13]); w1.w = pk_bf16(bbr[14], bbr[15]);
          *(u32x4*)(tb + nre * 16) = w0; *(u32x4*)(tb + nre * 16 + 8) = w1;
          w0.x = pk_bf16(bbi[0], bbi[1]); w0.y = pk_bf16(bbi[2], bbi[3]); w0.z = pk_bf16(bbi[4], bbi[5]); w0.w = pk_bf16(bbi[6], bbi[7]);
          w1.x = pk_bf16(bbi[8], bbi[9]); w1.y = pk_bf16(bbi[10], bbi[11]); w1.z = pk_bf16(bbi[12], bbi[13]); w1.w = pk_bf16(bbi[14], bbi[15]);
          *(u32x4*)(tb + nim * 16) = w0; *(u32x4*)(tb + nim * 16 + 8) = w1; }
        { bf16_t* tc = (bf16_t*)(ws + WS_TC) + (size_t)(l * 32 + g) * 16 * 128;
#pragma unroll
          for (int cc = 0; cc < 16; ++cc) { const float cr = ap->in[I_CRE][((size_t)(l * 32 + g) * 16 + cc) * 64 + n], ci = ap->in[I_CIM][((size_t)(l * 32 + g) * 16 + cc) * 64 + n];
              *(unsigned*)(tc + cc * 128 + 2 * n) = pk_bf16(cr, -ci); } }
    }
    }
    if (part == 0) { const float* x = ap->in[I_X]; bf16_t* XG = (bf16_t*)(ws + WS_XG); float* ss = (float*)(ws + WS_SS);
      f32x4 nxv[4];
      const int gwv = c.vb * 8 + wave; const bool g256 = grid_g() == 256; const int row_b = g256 ? gwv * 8 : gw, row_s = g256 ? 1 : ngw, row_e = g256 ? gwv * 8 + 8 : T_;
#pragma unroll
      for (int j = 0; j < 4; ++j) nxv[j] = __builtin_nontemporal_load((const f32x4*)(x + (size_t)(row_b < T_ ? row_b : 0) * DM + j * 256 + lane * 4));
      for (int row = row_b; row < row_e; row += row_s) { float s = 0.f; f32x4 v[4];
#pragma unroll
          for (int j = 0; j < 4; ++j) v[j] = nxv[j];
          { const int nrow = (row + row_s < row_e) ? row + row_s : row;
#pragma unroll
            for (int j = 0; j < 4; ++j) nxv[j] = __builtin_nontemporal_load((const f32x4*)(x + (size_t)nrow * DM + j * 256 + lane * 4)); }
          SBAR();
#pragma unroll
          for (int j = 0; j < 4; ++j) { const int col = j * 256 + lane * 4;
              s += (v[j][0] * v[j][0] + v[j][1] * v[j][1]) + (v[j][2] * v[j][2] + v[j][3] * v[j][3]);
              u32x2 w; w.x = pk_bf16(v[j][0], v[j][1]); w.y = pk_bf16(v[j][2], v[j][3]);
              *(u32x2*)(XG + ((size_t)(col >> 9) * T_ + row) * 512 + (col & 511)) = w; }
          s = wave_sum(s); if (lane == 0) ss[row] = s; }
      for (long i = gtid; i < T_; i += gthreads) ss[T_ + i] = 0.f;
      for (long i = gtid; i < 2 * NL * T_; i += gthreads) ((float*)(ws + WS_SSQ))[i] = 0.f;
      for (long i = gtid; i < 8 * 3456; i += gthreads) ((unsigned*)(ws + WS_PBAR))[i] = 0u;
      for (long i = gtid; i < (long)NL * 1024 * 16; i += gthreads) *(u32x4*)((bf16_t*)(ws + WS_WKV) + (i >> 4) * 256 + 128 + (i & 15) * 8) = (u32x4){0u, 0u, 0u, 0u}; }
}

struct S5Coef { float a1r, a1i, a2r, a2i, a3r, a3i, a4r, a4i; };
__device__ __forceinline__ S5Coef s5_coef(float ar, float ai) { S5Coef q; q.a1r = ar; q.a1i = ai; q.a2r = ar * ar - ai * ai; q.a2i = 2.f * ar * ai; q.a3r = q.a2r * ar - q.a2i * ai; q.a3i = q.a2r * ai + q.a2i * ar; q.a4r = q.a2r * q.a2r - q.a2i * q.a2i; q.a4i = 2.f * q.a2r * q.a2i; return q; }
__device__ __forceinline__ float other_half(float v, int hi) { auto rr = __builtin_amdgcn_permlane32_swap(__float_as_uint(v), __float_as_uint(v), false, false); return __uint_as_float(hi ? rr[0] : rr[1]); }
template <bool NEEDX>
__device__ __forceinline__ void s5_scan32(f32x16& xr, f32x16& xi, const S5Coef& q, float& sr, float& si, int hi) {
    float er[4], ei[4];
#pragma unroll
    for (int k = 0; k < 4; ++k) {
        const float r0 = xr[4 * k], i0 = xi[4 * k];
        const float r1 = q.a1r * r0 - q.a1i * i0 + xr[4 * k + 1], i1 = q.a1r * i0 + q.a1i * r0 + xi[4 * k + 1];
        const float r2 = q.a1r * r1 - q.a1i * i1 + xr[4 * k + 2], i2 = q.a1r * i1 + q.a1i * r1 + xi[4 * k + 2];
        const float r3 = q.a1r * r2 - q.a1i * i2 + xr[4 * k + 3], i3 = q.a1r * i2 + q.a1i * r2 + xi[4 * k + 3];
        if (NEEDX) { xr[4 * k + 1] = r1; xi[4 * k + 1] = i1; xr[4 * k + 2] = r2; xi[4 * k + 2] = i2; xr[4 * k + 3] = r3; xi[4 * k + 3] = i3; }
        er[k] = r3; ei[k] = i3;
    }
    float pr[4], pi[4];
#pragma unroll
    for (int k = 0; k < 4; ++k) {
        const float orr = other_half(er[k], hi), oii = other_half(ei[k], hi);
        const float e0r = hi ? orr : er[k], e0i = hi ? oii : ei[k], e1r = hi ? er[k] : orr, e1i = hi ? ei[k] : oii;
        const float p0r = sr, p0i = si;
        float nr = q.a4r * sr - q.a4i * si + e0r, ni = q.a4r * si + q.a4i * sr + e0i; sr = nr; si = ni;
        const float p1r = sr, p1i = si;
        nr = q.a4r * sr - q.a4i * si + e1r; ni = q.a4r * si + q.a4i * sr + e1i; sr = nr; si = ni;
        pr[k] = hi ? p1r : p0r; pi[k] = hi ? p1i : p0i;
    }
    if (NEEDX) {
#pragma unroll
        for (int k = 0; k < 4; ++k) {
            xr[4 * k + 0] += q.a1r * pr[k] - q.a1i * pi[k]; xi[4 * k + 0] += q.a1r * pi[k] + q.a1i * pr[k];
            xr[4 * k + 1] += q.a2r * pr[k] - q.a2i * pi[k]; xi[4 * k + 1] += q.a2r * pi[k] + q.a2i * pr[k];
            xr[4 * k + 2] += q.a3r * pr[k] - q.a3i * pi[k]; xi[4 * k + 2] += q.a3r * pi[k] + q.a3i * pr[k];
            xr[4 * k + 3] += q.a4r * pr[k] - q.a4i * pi[k]; xi[4 * k + 3] += q.a4r * pi[k] + q.a4i * pr[k];
        }
    }
}
constexpr int S5_XPITCH = 272, S5_XWAVE = 32 * S5_XPITCH;
template <bool FULL>
__device__ __forceinline__ void s5_pass(const Ctx& c, int l, bool dry) {
    PHASE_IDS(); ArgsP ap = get_args(); unsigned char* ws = ap->ws; bf16_t* P = (bf16_t*)(ws + WS_PROJ); const float* dsk = ap->in[I_S5D] + l * 512;
    const int cl = lane & 31, hi = lane >> 5;
    char* Xl = c.ldsg + wave * S5_XWAVE;
    const int gw = c.vb * 8 + wave, ngw = grid_g() * 8;
    for (int task = gw; task < NB_ * 32 * 8; task += ngw) {
        const int g = task & 31, q8 = (task >> 5) & 7, b = task >> 8;
        const int tb0 = (l * 32 + g) * 64;
        const f32x4 taA = ((const f32x4*)(ws + WS_TA))[tb0 + cl], taB = ((const f32x4*)(ws + WS_TA))[tb0 + 32 + cl];
        const S5Coef qA = s5_coef(taA[0], taA[1]), qB = s5_coef(taB[0], taB[1]);
        bf16x8 bbf[4];
        { const bf16_t* tbb = (const bf16_t*)(ws + WS_TBB) + (size_t)(l * 32 + g) * 128 * 16;
#pragma unroll
          for (int blk = 0; blk < 4; ++blk) bbf[blk] = *(const bf16x8*)(tbb + (blk * 32 + cl) * 16 + 8 * hi); }
        float sAr = 0.f, sAi = 0.f, sBr = 0.f, sBi = 0.f;
        bf16x8 cm[4];
        if (FULL) {
            const bf16_t* tcm = (const bf16_t*)(ws + WS_TC) + (size_t)(l * 32 + g) * 16 * 128;
#pragma unroll
            for (int ks = 0; ks < 4; ++ks) cm[ks] = *(const bf16x8*)(tcm + (lane & 15) * 128 + ks * 32 + 8 * (lane >> 4));
            const f32x2* Ep = (const f32x2*)(ws + WS_E) + ((size_t)(b * 32) * 32 + g) * 64;
            const int nprev = 4 * q8;
            for (int j0 = 0; j0 < nprev; j0 += 8) {
                f32x2 eA[8], eB[8];
#pragma unroll
                for (int i = 0; i < 8; ++i) { const int cp = (j0 + i < nprev) ? j0 + i : 0; eA[i] = Ep[(size_t)cp * 2048 + cl]; eB[i] = Ep[(size_t)cp * 2048 + 32 + cl]; }
#pragma unroll
                for (int i = 0; i < 8; ++i) if (j0 + i < nprev) {
                    float nr = taA[2] * sAr - taA[3] * sAi + eA[i][0], ni = taA[2] * sAi + taA[3] * sAr + eA[i][1]; sAr = nr; sAi = ni;
                    nr = taB[2] * sBr - taB[3] * sBi + eB[i][0]; ni = taB[2] * sBi + taB[3] * sBr + eB[i][1]; sBr = nr; sBi = ni; }
            }
        }
        const f32x4 dv = *(const f32x4*)(dsk + 16 * g + 4 * (lane >> 4));
        const size_t ubase = (size_t)(b * S_ + 4 * q8 * 64 + cl) * NPROJ + 2048 + 16 * g + 8 * hi;
        bf16x8 ua_n = *(const bf16x8*)(P + ubase);
        const size_t uebase = (size_t)(b * S_ + 4 * q8 * 64 + (lane & 15)) * NPROJ + 2048 + 16 * g + 4 * (lane >> 4);
        for (int i8 = 0; i8 < 8; ++i8) {
            const bf16x8 ua = ua_n;
            if (i8 < 7) ua_n = *(const bf16x8*)(P + ubase + (size_t)(i8 + 1) * 32 * NPROJ);
            u32x2 ue0 = (u32x2){0u, 0u}, ue1 = (u32x2){0u, 0u};
            if (FULL) { ue0 = *(const u32x2*)(P + uebase + (size_t)i8 * 32 * NPROJ); ue1 = *(const u32x2*)(P + uebase + (size_t)(i8 * 32 + 16) * NPROJ); }
            const int ch = 4 * q8 + (i8 >> 1), rb = i8 & 1, tok0 = b * S_ + ch * 64;
            if (!FULL && rb == 0) { sAr = 0.f; sAi = 0.f; sBr = 0.f; sBi = 0.f; }
            f32x16 bu0 = __builtin_amdgcn_mfma_f32_32x32x16_bf16(ua, bbf[0], f32x16{}, 0, 0, 0);
            f32x16 bu1 = __builtin_amdgcn_mfma_f32_32x32x16_bf16(ua, bbf[1], f32x16{}, 0, 0, 0);
            f32x16 bu2 = __builtin_amdgcn_mfma_f32_32x32x16_bf16(ua, bbf[2], f32x16{}, 0, 0, 0);
            f32x16 bu3 = __builtin_amdgcn_mfma_f32_32x32x16_bf16(ua, bbf[3], f32x16{}, 0, 0, 0);
            s5_scan32<FULL>(bu0, bu1, qA, sAr, sAi, hi);
            s5_scan32<FULL>(bu2, bu3, qB, sBr, sBi, hi);
            if (FULL) {
#pragma unroll
                for (int r = 0; r < 16; ++r) { const int t = (r & 3) + 8 * (r >> 2) + 4 * hi;
                    *(unsigned*)(Xl + t * S5_XPITCH + 4 * cl) = pk_bf16(bu0[r], bu1[r]);
                    *(unsigned*)(Xl + t * S5_XPITCH + 128 + 4 * cl) = pk_bf16(bu2[r], bu3[r]); }
                asm volatile("s_waitcnt lgkmcnt(0)" ::: "memory");
#pragma unroll
                for (int tb = 0; tb < 2; ++tb) {
                    f32x4 y = (f32x4){0.f, 0.f, 0.f, 0.f};
#pragma unroll
                    for (int ks = 0; ks < 4; ++ks) { const bf16x8 xb = *(const bf16x8*)(Xl + (16 * tb + (lane & 15)) * S5_XPITCH + (ks * 32 + 8 * (lane >> 4)) * 2);
                        y = __builtin_amdgcn_mfma_f32_16x16x32_bf16(cm[ks], xb, y, 0, 0, 0); }
                    const int q4 = lane >> 4;
                    const size_t tokz = (size_t)(tok0 + rb * 32 + tb * 16 + (lane & 15));
                    bf16_t* zp = (bf16_t*)(ws + WS_Z) + tokz * 512 + 16 * g + 4 * q4;
                    const u32x2 uu = tb ? ue1 : ue0;
                    const float y0 = y[0] + dv[0] * bf_lo(uu.x), y1 = y[1] + dv[1] * bf_hi(uu.x), y2 = y[2] + dv[2] * bf_lo(uu.y), y3 = y[3] + dv[3] * bf_hi(uu.y);
                    u32x2 w; w.x = pk_bf16(gelu_tanh(y0), gelu_tanh(y1)); w.y = pk_bf16(gelu_tanh(y2), gelu_tanh(y3));
                    if (!dry) *(u32x2*)zp = w;
                }
                asm volatile("s_waitcnt lgkmcnt(0)" ::: "memory");
            }
            if (!FULL && rb == 1) { if (hi == 0) { f32x2* Eo = (f32x2*)(ws + WS_E) + (size_t)((b * 32 + ch) * 32 + g) * 64; Eo[cl] = (f32x2){sAr, sAi}; Eo[32 + cl] = (f32x2){sBr, sBi}; } }
        }
    }
}

__device__ __forceinline__ void unpack8(const u32x4 w, float (&v)[8]) { v[0] = bf_lo(w.x); v[1] = bf_hi(w.x); v[2] = bf_lo(w.y); v[3] = bf_hi(w.y); v[4] = bf_lo(w.z); v[5] = bf_hi(w.z); v[6] = bf_lo(w.w); v[7] = bf_hi(w.w); }
__device__ __forceinline__ u32x4 pack8(const float (&v)[8]) { u32x4 w; w.x = pk_bf16(v[0], v[1]); w.y = pk_bf16(v[2], v[3]); w.z = pk_bf16(v[4], v[5]); w.w = pk_bf16(v[6], v[7]); return w; }
__device__ __forceinline__ void prep_phase(const Ctx& c, int l, bool dry) {
    PHASE_IDS(); ArgsP ap = get_args(); unsigned char* ws = ap->ws;

    bf16_t* P = (bf16_t*)(ws + WS_PROJ); bf16_t* QUP = (bf16_t*)(ws + WS_QUP); bf16_t* KVUP = (bf16_t*)(ws + WS_KVUP); bf16_t* KM = (bf16_t*)(ws + WS_KM);
    if (wave == 0) for (int bq = (grid_g() == 256) ? ((c.bid >> 3) < 8 ? (c.bid & 7) * 8 + (c.bid >> 3) : 64) : c.bid; bq < 64; bq += grid_g()) {
        const int bh = bq, b = bh >> 3, h = bh & 7; const float bf = ap->in[I_FBF][l * 8 + h];
        const float* ff = (const float*)(ws + WS_FF32) + (size_t)(b * S_) * 8 + h; float* cum = (float*)(ws + WS_CUM) + (size_t)bh * S_;
        float xv[32];
#pragma unroll
        for (int it = 0; it < 32; ++it) xv[it] = ff[(size_t)(it * 64 + lane) * 8];
        float carry = 0.f;
#pragma unroll
        for (int it = 0; it < 32; ++it) { const float xx = xv[it] + bf;
            float v = fminf(xx, 0.f) - log1pf(__expf(-fabsf(xx)));
            v += __builtin_bit_cast(float, __builtin_amdgcn_update_dpp(0, __builtin_bit_cast(int, v), 0x111, 0xF, 0xF, false));
            v += __builtin_bit_cast(float, __builtin_amdgcn_update_dpp(0, __builtin_bit_cast(int, v), 0x112, 0xF, 0xF, false));
            v += __builtin_bit_cast(float, __builtin_amdgcn_update_dpp(0, __builtin_bit_cast(int, v), 0x114, 0xF, 0xF, false));
            v += __builtin_bit_cast(float, __builtin_amdgcn_update_dpp(0, __builtin_bit_cast(int, v), 0x118, 0xF, 0xF, false));
            const int iv = __builtin_bit_cast(int, v);
            const float t0 = __builtin_bit_cast(float, __builtin_amdgcn_readlane(iv, 15)), t1 = __builtin_bit_cast(float, __builtin_amdgcn_readlane(iv, 31));
            const float t2 = __builtin_bit_cast(float, __builtin_amdgcn_readlane(iv, 47)), t3 = __builtin_bit_cast(float, __builtin_amdgcn_readlane(iv, 63));
            const int rw = lane >> 4;
            v += carry + (rw == 1 ? t0 : rw == 2 ? t0 + t1 : rw == 3 ? (t0 + t1) + t2 : 0.f);
            if (!dry) cum[it * 64 + lane] = v * LOG2E;
            carry += ((t0 + t1) + t2) + t3; }
    }
    const float* qn = ap->in[I_MQN] + l * 96; const float* kn = ap->in[I_MKN] + l * 96; const float* fqn = ap->in[I_FQN] + l * 64; const float* fkn = ap->in[I_FKN] + l * 64;
    const int* pos = (const int*)ap->in[I_POS];
    const int hd = lane >> 3, j = lane & 7;
    const float QSC = 0.10206207261596575f * LOG2E, FSC = 0.125f * LOG2E;
    const int gw = c.vb * 8 + wave, ngw = grid_g() * 8;
    const bool g256 = grid_g() == 256;
    const int row_b = g256 ? gw * 8 : gw, row_s = g256 ? 1 : ngw, row_e = g256 ? gw * 8 + 8 : T_;
    float gq[12], gk[12], gfq[8], gfk[8];
#pragma unroll
    for (int e = 0; e < 8; ++e) { gq[e] = qn[8 * j + e]; gk[e] = kn[8 * j + e]; gfq[e] = fqn[8 * j + e]; gfk[e] = fkn[8 * j + e]; }
    gq[8] = qn[64 + 2 * j]; gq[9] = qn[65 + 2 * j]; gq[10] = qn[80 + 2 * j]; gq[11] = qn[81 + 2 * j];
    gk[8] = kn[64 + 2 * j]; gk[9] = kn[65 + 2 * j]; gk[10] = kn[80 + 2 * j]; gk[11] = kn[81 + 2 * j];
    struct PrepIn { float pf; u32x4 q; unsigned q1, q2; u32x4 k; unsigned p1, p2; u32x4 fq, fk; };
    auto prep_load = [&](int row) -> PrepIn { PrepIn r_;
        const bf16_t* pr = P + (size_t)row * NPROJ; const bf16_t* qp = QUP + (size_t)row * 768 + 96 * hd; const bf16_t* kp = KM + (size_t)row * 768 + 96 * hd;
        r_.pf = (float)pos[row];
        r_.q = *(const u32x4*)(qp + 8 * j); r_.q1 = *(const unsigned*)(qp + 64 + 2 * j); r_.q2 = *(const unsigned*)(qp + 80 + 2 * j);
        r_.k = *(const u32x4*)(kp + 8 * j);
        r_.p1 = *(const unsigned*)(pr + 384 + 2 * j); r_.p2 = *(const unsigned*)(pr + 400 + 2 * j);
        r_.fq = *(const u32x4*)(pr + 512 + 64 * hd + 8 * j); r_.fk = *(const u32x4*)(pr + 1024 + 64 * hd + 8 * j); return r_; };
    PrepIn nx_ = prep_load(row_b < T_ ? row_b : 0);
    for (int row = row_b; row < row_e; row += row_s) {
        bf16_t* pr = P + (size_t)row * NPROJ;
        bf16_t* qp = QUP + (size_t)row * 768 + 96 * hd; bf16_t* ko = KM + (size_t)row * 768 + 96 * hd;
        bf16_t* fqp = pr + 512 + 64 * hd + 8 * j; bf16_t* fkp = pr + 1024 + 64 * hd + 8 * j;
        const PrepIn in_ = nx_;
        { const int nrow = row + row_s; nx_ = prep_load(nrow < row_e ? nrow : row); }
        SBAR();
        const float pf = in_.pf;
        const u32x4 l_q = in_.q; const unsigned l_q1 = in_.q1, l_q2 = in_.q2;
        const u32x4 l_k = in_.k; const unsigned l_p1 = in_.p1, l_p2 = in_.p2;
        const u32x4 l_fq = in_.fq, l_fk = in_.fk;
        float cs[2], sn[2];
#pragma unroll
        for (int e = 0; e < 2; ++e) { const int i = 2 * j + e; const float inv = exp2f(-(float)i * (13.287712379549449f / 16.f)); const float ang = pf * inv;
            float rev = ang * 0.15915494309189535f; rev -= floorf(rev); cs[e] = __builtin_amdgcn_cosf(rev); sn[e] = __builtin_amdgcn_sinf(rev); }
        u32x4 o_q, o_k, o_fq, o_fk; unsigned o_q1, o_q2, o_k1, o_k2;
        { float v[8]; unpack8(l_q, v);
          const float x1[2] = {bf_lo(l_q1), bf_hi(l_q1)}, x2[2] = {bf_lo(l_q2), bf_hi(l_q2)};
          float ssq = 0.f;
#pragma unroll
          for (int e = 0; e < 8; ++e) ssq += v[e] * v[e];
          float r1[2], r2[2];
#pragma unroll
          for (int e = 0; e < 2; ++e) { r1[e] = x1[e] * cs[e] - x2[e] * sn[e]; r2[e] = x1[e] * sn[e] + x2[e] * cs[e]; ssq += r1[e] * r1[e] + r2[e] * r2[e]; }
          const float rn = rsqrtf(sum8(ssq) * (1.f / 96) + EPS) * QSC;
#pragma unroll
          for (int e = 0; e < 8; ++e) v[e] *= rn * gq[e];
          o_q = pack8(v);
          o_q1 = pk_bf16(r1[0] * rn * gq[8], r1[1] * rn * gq[9]);
          o_q2 = pk_bf16(r2[0] * rn * gq[10], r2[1] * rn * gq[11]); }
        { float v[8]; unpack8(l_k, v);
          const float x1[2] = {bf_lo(l_p1), bf_hi(l_p1)}, x2[2] = {bf_lo(l_p2), bf_hi(l_p2)};
          float ssq = 0.f;
#pragma unroll
          for (int e = 0; e < 8; ++e) ssq += v[e] * v[e];
          float r1[2], r2[2];
#pragma unroll
          for (int e = 0; e < 2; ++e) { r1[e] = x1[e] * cs[e] - x2[e] * sn[e]; r2[e] = x1[e] * sn[e] + x2[e] * cs[e]; ssq += r1[e] * r1[e] + r2[e] * r2[e]; }
          const float rn = rsqrtf(sum8(ssq) * (1.f / 96) + EPS);
#pragma unroll
          for (int e = 0; e < 8; ++e) v[e] *= rn * gk[e];
          o_k = pack8(v);
          o_k1 = pk_bf16(r1[0] * rn * gk[8], r1[1] * rn * gk[9]);
          o_k2 = pk_bf16(r2[0] * rn * gk[10], r2[1] * rn * gk[11]); }
        { float v[8]; unpack8(l_fq, v); float ssq = 0.f;
#pragma unroll
          for (int e = 0; e < 8; ++e) ssq += v[e] * v[e];
          const float rn = rsqrtf(sum8(ssq) * (1.f / 64) + EPS) * FSC;
#pragma unroll
          for (int e = 0; e < 8; ++e) v[e] *= rn * gfq[e];
          o_fq = pack8(v); }
        { float v[8]; unpack8(l_fk, v); float ssq = 0.f;
#pragma unroll
          for (int e = 0; e < 8; ++e) ssq += v[e] * v[e];
          const float rn = rsqrtf(sum8(ssq) * (1.f / 64) + EPS);
#pragma unroll
          for (int e = 0; e < 8; ++e) v[e] *= rn * gfk[e];
          o_fk = pack8(v); }
        if (!dry) {
            *(u32x4*)(qp + 8 * j) = o_q; *(unsigned*)(qp + 64 + 2 * j) = o_q1; *(unsigned*)(qp + 80 + 2 * j) = o_q2;
            *(u32x4*)(ko + 8 * j) = o_k; *(unsigned*)(ko + 64 + 2 * j) = o_k1; *(unsigned*)(ko + 80 + 2 * j) = o_k2;
            *(u32x4*)fqp = o_fq; *(u32x4*)fkp = o_fk;
        }
    }
}

__device__ __forceinline__ void attn_phase(const Ctx& c, int l, bool dry) {
    PHASE_IDS(); ArgsP ap = get_args(); unsigned char* ws = ap->ws;
    bf16_t* P = (bf16_t*)(ws + WS_PROJ); bf16_t* QUP = (bf16_t*)(ws + WS_QUP); const bf16_t* KVUP = (const bf16_t*)(ws + WS_KVUP); const bf16_t* KM = (const bf16_t*)(ws + WS_KM);
    const float* CUM = (const float*)(ws + WS_CUM);
    float sbound;
    { float mq = fabsf(ap->in[I_FQN][l * 64 + lane]), mk = fabsf(ap->in[I_FKN][l * 64 + lane]);
#pragma unroll
      for (int o = 1; o < 64; o <<= 1) { mq = fmaxf(mq, __shfl_xor(mq, o)); mk = fmaxf(mk, __shfl_xor(mk, o)); }
      sbound = 2.f * 1.05f * 8.f * LOG2E * mq * mk; }
    bool trackM, trackF = !(sbound <= 120.f);
    { float mq = lane < 48 ? fmaxf(fabsf(ap->in[I_MQN][l * 96 + lane]), fabsf(ap->in[I_MQN][l * 96 + 48 + lane])) : 0.f, mk = lane < 48 ? fmaxf(fabsf(ap->in[I_MKN][l * 96 + lane]), fabsf(ap->in[I_MKN][l * 96 + 48 + lane])) : 0.f;
#pragma unroll
      for (int o = 1; o < 64; o <<= 1) { mq = fmaxf(mq, __shfl_xor(mq, o)); mk = fmaxf(mk, __shfl_xor(mk, o)); }
      trackM = !(1.05f * 9.7979590f * LOG2E * mq * mk <= 60.f); }
    for (int L = c.vb; L < 256; L += grid_g()) {
        const int bh = (L >> 5) * 8 + (L & 7), p = (L >> 3) & 3, b = bh >> 3, h = bh & 7; const size_t r0 = (size_t)b * S_;
        const float* cum = CUM + (size_t)bh * S_;
        int T0f[2];
#pragma unroll
        for (int e = 0; e < 2; ++e) { const int q0 = (2 * p + e) * 256, nb = q0 >> 6; const float c0 = cum[q0]; bool need = false;
            if (lane < nb) need = (sbound + c0 - cum[64 * lane + 63] >= -40.f);
            const unsigned long long bal = __ballot(need);
            T0f[e] = __builtin_amdgcn_readfirstlane((bal ? (__ffsll((long long)bal) - 1) : nb) & ~1); }
        if (!trackM) {
#pragma unroll 1
            for (int e = 0; e < 2; ++e)
                attn::attn_unit<96, false, false>(QUP + r0 * 768 + 96 * h, 768, KM + r0 * 768 + 96 * h, 768, KVUP + r0 * 512 + 64 * h, 512, nullptr, (e ? p : 7 - p) * 256, c.ldsg, dry, 0.f, 0);
        } else {
#pragma unroll 1
            for (int e = 0; e < 2; ++e)
                attn::attn_unit<96, false, true>(QUP + r0 * 768 + 96 * h, 768, KM + r0 * 768 + 96 * h, 768, KVUP + r0 * 512 + 64 * h, 512, nullptr, (e ? p : 7 - p) * 256, c.ldsg, dry, 0.f, 0);
        }
        if (!trackF) {
#pragma unroll 1
            for (int e = 0; e < 2; ++e)
                attn::attn_unit<64, true, false>(P + r0 * NPROJ + 512 + 64 * h, NPROJ, P + r0 * NPROJ + 1024 + 64 * h, NPROJ, P + r0 * NPROJ + 1536 + 64 * h, NPROJ, cum, (2 * p + e) * 256, c.ldsg, dry, sbound, e ? T0f[1] : T0f[0]);
        } else {
#pragma unroll 1
            for (int e = 0; e < 2; ++e)
                attn::attn_unit<64, true, true>(P + r0 * NPROJ + 512 + 64 * h, NPROJ, P + r0 * NPROJ + 1024 + 64 * h, NPROJ, P + r0 * NPROJ + 1536 + 64 * h, NPROJ, cum, (2 * p + e) * 256, c.ldsg, dry, sbound, e ? T0f[1] : T0f[0]);
        }
    }
}

#if USE_XCD_BAR
#define XB_TMO      128
#define XB_XCNT(j)  (256  + 64 * (j))
#define XB_XSUB(j)  (1280 + 64 * (j))
#define XB_XGEN(j)  (2304 + 64 * (j))
#define XB_TOP      3328
#define XB_TOPGEN   3392
#define XCD_BAR_WORDS 3456
#define XB_SPIN_CAP (1u << 22)
__device__ __forceinline__ unsigned xb_ld(unsigned* p)              { return __hip_atomic_load(p, __ATOMIC_RELAXED, __HIP_MEMORY_SCOPE_AGENT); }
__device__ __forceinline__ unsigned xb_add(unsigned* p, unsigned v) { return __hip_atomic_fetch_add(p, v, __ATOMIC_RELAXED, __HIP_MEMORY_SCOPE_AGENT); }
__device__ __forceinline__ unsigned xb_xcc_id() { return (unsigned)__builtin_amdgcn_s_getreg((3 << 11) | 20) & 0xFu; }
#define XB_SPIN(cond, bar) do { unsigned _sp = 0; while (cond) { __builtin_amdgcn_s_sleep(1); \
    if ((++_sp & 255u) == 0u) { if (xb_ld(&(bar)[XB_TMO])) break; if (_sp > XB_SPIN_CAP) { atomicAdd(&(bar)[XB_TMO], 1u); break; } } } } while (0)
struct XcdBarrier { unsigned* bar; unsigned x; volatile LAS unsigned* st; unsigned nexp; };
__device__ __forceinline__ XcdBarrier xcd_barrier_post(unsigned* bar, volatile LAS unsigned* st, unsigned nexp) {
    XcdBarrier b; b.bar = bar; b.x = xb_xcc_id(); b.st = st; b.nexp = nexp;
    if (threadIdx.x == 0) (void)xb_add(&bar[XB_XCNT(b.x)], 1u);
    return b;
}
__device__ __forceinline__ void xcd_barrier_complete(unsigned* bar, unsigned x, unsigned G, unsigned& nloc, unsigned& nx) {
    unsigned sum, cnt, mine, sp = 0u;
    for (;;) {
        sum = 0u; cnt = 0u; mine = 0u;
#pragma unroll
        for (unsigned j = 0; j < 16; ++j) { const unsigned c = xb_ld(&bar[XB_XCNT(j)]); sum += c; cnt += (c > 0u) ? 1u : 0u; mine = (j == x) ? c : mine; }
        if (sum == G) break;
        __builtin_amdgcn_s_sleep(1);
        if ((++sp & 255u) == 0u) { if (xb_ld(&bar[XB_TMO])) break; if (sp > XB_SPIN_CAP) { atomicAdd(&bar[XB_TMO], 1u); break; } }
    }
    nloc = mine > 0u ? mine : 1u; nx = cnt > 0u ? cnt : 1u;
}
__device__ __forceinline__ void xcd_barrier(const XcdBarrier& b) {
    asm volatile("s_waitcnt vmcnt(0)" ::: "memory");
    __syncthreads();
    if (threadIdx.x == 0) {
        unsigned* bar = b.bar;
        __builtin_amdgcn_s_waitcnt(0);
        unsigned nloc = b.st[0], nx = b.st[1];
        if (nloc == 0u) { xcd_barrier_complete(bar, b.x, b.nexp, nloc, nx); b.st[0] = nloc; b.st[1] = nx; }
        const bool one_xcd = (nx == 1u) && (nloc == b.nexp);
        if (one_xcd) {
            const unsigned k = b.st[2]; b.st[2] = k + 1u;
            (void)__hip_atomic_fetch_add(&bar[XB_XSUB(b.x)], 1u, __ATOMIC_RELAXED, __HIP_MEMORY_SCOPE_AGENT);
            const unsigned target = (k + 1u) * nloc;
            XB_SPIN(xb_ld(&bar[XB_XSUB(b.x)]) < target, bar);
            asm volatile("s_waitcnt vmcnt(0)" ::: "memory");
        } else if (const unsigned old = xb_add(&bar[XB_XSUB(b.x)], 1u), gen = old / nloc; old + 1u == (gen + 1u) * nloc) {
            if (!one_xcd) __builtin_amdgcn_fence(__ATOMIC_RELEASE, "agent");
            asm volatile("s_waitcnt vmcnt(0)" ::: "memory");
            const unsigned og = xb_add(&bar[XB_TOP], 1u);
            const unsigned tg = og / nx;
            if (og + 1u == (tg + 1u) * nx) xb_add(&bar[XB_TOPGEN], 1u);
            else XB_SPIN(xb_ld(&bar[XB_TOPGEN]) == tg, bar);
            if (!one_xcd) __builtin_amdgcn_fence(__ATOMIC_ACQUIRE, "agent");
            xb_add(&bar[XB_XGEN(b.x)], 1u);
            asm volatile("s_waitcnt vmcnt(0)" ::: "memory");
        } else {
            XB_SPIN(xb_ld(&bar[XB_XGEN(b.x)]) == gen, bar);
            if (!one_xcd) __builtin_amdgcn_fence(__ATOMIC_ACQUIRE, "agent");
            asm volatile("s_waitcnt vmcnt(0)" ::: "memory");
        }
        if (one_xcd) asm volatile("buffer_inv sc0\n\ts_waitcnt vmcnt(0)" ::: "memory");
    }
    __syncthreads();
}
#endif

constexpr int LDS_MAIN = 131072, LDS_BYTES = LDS_MAIN + 1024;
static_assert(attn::LDS_BYTES <= LDS_MAIN && 8 * S5_XWAVE <= LDS_MAIN && 8 * 8448 <= LDS_MAIN, "LDS map");

__device__ __forceinline__ void ph_inproj(const Ctx& c, int l) {
    ArgsP ap = get_args(); unsigned char* ws = ap->ws;
    SchedIn S{(const char*)(ws + WS_XG), (const char*)(ws + WS_WIN) + (size_t)l * 2 * NIN * 512 * 2, 0, grid_g(), c.bid};
    EpiProj E{(bf16_t*)(ws + WS_PROJ), (const float*)(ws + WS_SS) + (size_t)l * T_, (float*)(ws + WS_FF32), (float*)(ws + WS_SSQ) + (size_t)l * T_};
    pg8::gemm_phase(c.lds, 512, 512, 8, S, E);
}
__device__ __forceinline__ void ph_fv(const Ctx& c, int l) {
    ArgsP ap = get_args(); unsigned char* ws = ap->ws;
    SchedIn S{(const char*)(ws + WS_XG), (const char*)(ws + WS_WIN) + (size_t)l * 2 * NIN * 512 * 2, 1, grid_g(), c.bid};
    EpiProj E{(bf16_t*)(ws + WS_PROJ), (const float*)(ws + WS_SS) + (size_t)l * T_, (float*)(ws + WS_FF32), (float*)(ws + WS_SSQ) + (size_t)l * T_};
    pg8::gemm_phase(c.lds, 512, 512, 8, S, E);
}
__device__ __forceinline__ void ph_up(const Ctx& c, int l) {
    ArgsP ap = get_args(); unsigned char* ws = ap->ws;
    SchedUp S{(const char*)(ws + WS_PROJ), (const char*)(ws + WS_WQ) + (size_t)l * 768 * 256 * 2, (const char*)(ws + WS_WKV) + (size_t)l * 1024 * 256 * 2, grid_g(), c.bid};
    EpiUp E{(bf16_t*)(ws + WS_QUP), (bf16_t*)(ws + WS_KM), (bf16_t*)(ws + WS_KVUP), (const float*)(ws + WS_SSQ) + (size_t)l * T_}; pg8::gemm_phase(c.lds, NPROJ, 256, 4, S, E);
}
__device__ __forceinline__ void ph_gate(const Ctx& c, int l) {
    ArgsP ap = get_args(); unsigned char* ws = ap->ws;
    SchedGate S{(const char*)ws, l, grid_g(), c.bid};
    EpiGate E{ws, ap->in[I_BGLU] + l * 512, l};
    pg8::gemm_phase(c.lds, 512, 512, 8, S, E);
}
__device__ __forceinline__ void ph_merge(const Ctx& c, int l) {
    ArgsP ap = get_args(); unsigned char* ws = ap->ws;
    SchedMerge S{(const char*)ws, l, grid_g(), c.bid};
    EpiMerge E{ws, l, c.bid};
    pg8::gemm_phase(c.lds, 512, 512, 8, S, E);
}
__device__ __forceinline__ void ph_out(const Ctx& c, int l, bool dry) {
    ArgsP ap = get_args(); unsigned char* ws = ap->ws;
    SchedPlain S{(const char*)(ws + WS_PROJ) + (size_t)S_ * 1024 * 2, (size_t)256 * 1024 * 2, (size_t)10 << 20, (const char*)(ws + WS_WOUT) + (size_t)l * DM * DM * 2, (size_t)256 * 1024 * 2, 4, grid_g(), c.bid};
    const bool lastl = (l == NL - 1);
    EpiOut E{l == 0 ? ap->in[I_X] : nullptr, ap->out, (bf16_t*)(ws + WS_XG), lastl ? nullptr : (float*)(ws + WS_SS) + (size_t)(l + 1) * T_, dry};
    pg8::gemm_phase(c.lds, 1024, 1024, 16, S, E);
}

__global__ void __launch_bounds__(512, 2) trunk_fwd(Args args) {
    extern __shared__ __attribute__((aligned(16))) unsigned char lds[];
    Ctx c; c.lds = (LAS unsigned char*)lds; c.ldsg = (char*)lds; c.G = gridDim.x; c.bid = blockIdx.x; c.vb = (gridDim.x == 256) ? (int)((blockIdx.x & 7) * 32 + (blockIdx.x >> 3)) : (int)blockIdx.x;
#if MK_LAUNCHES == 1
#if USE_XCD_BAR
    if (threadIdx.x < 8) ((volatile LAS unsigned*)(c.lds + LDS_MAIN))[threadIdx.x] = 0u;
    __syncthreads();
    XcdBarrier bar = xcd_barrier_post((unsigned*)(args.ws + WS_CTL) + 4096, (volatile LAS unsigned*)(c.lds + LDS_MAIN), gridDim.x);
    XcdBarrier pbar = bar;
#define GRID_BAR() xcd_barrier(bar)
#define PIPE_BAR() xcd_barrier(pbar)
#define HAVE_PIPE_BAR 1
#else
    cg::grid_group grid = cg::this_grid();
#define GRID_BAR() grid.sync()
#endif
#else
#define GRID_BAR() do {} while (0)
#endif
    const int lo = args.ph_lo, hi = args.ph_hi;
#ifndef PH_MASK
#define PH_MASK 0xfff
#endif
#define IN(k) (lo <= (k) && (k) < hi)
#define PHM(j) ((PH_MASK >> (j)) & 1)
#define SEAM(k) do { if (IN(k) && IN((k) + 1)) GRID_BAR(); } while (0)
#ifdef HAVE_PIPE_BAR
#define SEAMP(k) do { if (IN(k) && IN((k) + 1)) PIPE_BAR(); } while (0)
#else
#define SEAMP(k) SEAM(k)
#endif

#ifndef ENABLE_PROBES
#define ENABLE_PROBES 0
#endif
#if ENABLE_PROBES
    const int probe = args.probe;
#define REP(j) for (int rep = (probe == (j)) ? 0 : 1; rep < 2; ++rep)
#else
#define REP(j) for (int rep = 1; rep < 2; ++rep)
#endif
    if (PHM(0) && IN(0)) { REP(1) phase0(c, 0); } SEAM(0);
#ifdef HAVE_PIPE_BAR
    if (gridDim.x == 256 && lo == 0 && hi == NPH)
        pbar = xcd_barrier_post((unsigned*)(args.ws + WS_PBAR) + (blockIdx.x & 7) * XCD_BAR_WORDS, (volatile LAS unsigned*)(c.lds + LDS_MAIN) + 4, 32u);
#endif
    for (int l = 0; l < NL; ++l) {
        const int pb = 1 + 7 * l;
        if (PHM(1) && IN(pb + 0)) {
            if (l == 0 && (c.bid & 1)) { phase0(c, 1); __syncthreads(); }
            REP(2) ph_inproj(c, l);
            if (l == 0 && !(c.bid & 1)) phase0(c, 1); }
        if (l == 0) SEAM(pb + 0); else SEAMP(pb + 0);
#ifdef PIPE_SKEW_TICKS
        if (l == 0 && gridDim.x == 256) {
            const unsigned t0 = (unsigned)__builtin_amdgcn_s_memrealtime(), dt = (unsigned)__builtin_amdgcn_readfirstlane((int)(PIPE_SKEW_TICKS));
            while ((unsigned)__builtin_amdgcn_s_memrealtime() - t0 < dt) __builtin_amdgcn_s_sleep(8);
        }
#endif
        if (IN(pb + 1)) {
            if (c.bid & 1) { if (PHM(9)) REP(5) s5_pass<false>(c, l, false); if (PHM(2)) REP(4) ph_fv(c, l); if (PHM(2)) REP(3) ph_up(c, l); }
            else { if (PHM(2)) REP(4) ph_fv(c, l); if (PHM(2)) REP(3) ph_up(c, l); if (PHM(9)) REP(5) s5_pass<false>(c, l, false); } }
        SEAMP(pb + 1);
        if (IN(pb + 2)) {
            if (c.bid & 1) { if (PHM(10)) REP(7) s5_pass<true>(c, l, rep == 0); if (PHM(3)) REP(6) prep_phase(c, l, rep == 0); }
            else { if (PHM(3)) REP(6) prep_phase(c, l, rep == 0); if (PHM(10)) REP(7) s5_pass<true>(c, l, rep == 0); } }
        SEAMP(pb + 2);
        if (IN(pb + 3)) { if (PHM(4)) REP(8) attn_phase(c, l, rep == 0); }
        SEAMP(pb + 3);
        if (PHM(5) && IN(pb + 4)) REP(10) ph_gate(c, l);
        SEAMP(pb + 4);
        if (PHM(6) && IN(pb + 5)) REP(11) ph_merge(c, l);
        SEAMP(pb + 5);
        if (PHM(7) && IN(pb + 6)) REP(12) ph_out(c, l, rep == 0);
        SEAMP(pb + 6);
    }
#undef IN
#undef SEAM
}

extern "C" void kernel_launch(void* const* d_in, const int* in_sizes, int n_in, void* d_out, int out_size, void* d_ws, size_t ws_size, hipStream_t stream) {
    static int grid = 0;
    if (grid == 0) {
        if (n_in != 25 || in_sizes[0] != T_ * DM || out_size != T_ * DM || ws_size < WS_END) {
            fprintf(stderr, "kernel_launch: shape mismatch n_in %d in0 %d out %d ws %zu (need %zu)\n", n_in, n_in > 0 ? in_sizes[0] : -1, out_size, ws_size, (size_t)WS_END); grid = -1; return; }
        int dev = 0, cus = 0, per_cu = 0;
        hipGetDevice(&dev); hipDeviceGetAttribute(&cus, hipDeviceAttributeMultiprocessorCount, dev);
        if (hipFuncSetAttribute((const void*)trunk_fwd, hipFuncAttributeMaxDynamicSharedMemorySize, LDS_BYTES) != hipSuccess) { fprintf(stderr, "kernel_launch: hipFuncSetAttribute failed\n"); grid = -1; return; }
        if (hipOccupancyMaxActiveBlocksPerMultiprocessor(&per_cu, (const void*)trunk_fwd, 512, LDS_BYTES) != hipSuccess || per_cu < 1) { fprintf(stderr, "kernel_launch: occupancy query says %d\n", per_cu); per_cu = 1; }
        (void)hipGetLastError();
        grid = cus;
    }
    if (grid < 0) return;
    hipMemsetAsync((char*)d_ws + WS_CTL, 0, 64 * KiB, stream);
    Args a{};
    for (int i = 0; i < 25; ++i) a.in[i] = (const float*)d_in[i];
    a.out = (float*)d_out; a.ws = (unsigned char*)d_ws;
#ifdef PROBE_PHASE
    a.probe = PROBE_PHASE;
#endif
#if MK_LAUNCHES == 1
    a.ph_lo = 0; a.ph_hi = NPH;
#ifndef PLAIN_LAUNCH
#define PLAIN_LAUNCH 0
#endif
#if PLAIN_LAUNCH
    hipLaunchKernelGGL(trunk_fwd, dim3(grid), dim3(512), LDS_BYTES, stream, a);
#else
    void* kargs[] = {&a};
    hipError_t e = hipLaunchCooperativeKernel((const void*)trunk_fwd, dim3(grid), dim3(512), kargs, LDS_BYTES, stream);
    if (e != hipSuccess) fprintf(stderr, "cooperative launch failed: %s (grid %d)\n", hipGetErrorString(e), grid);
#endif
#else
    for (int ph = 0; ph < NPH; ++ph) { a.ph_lo = ph; a.ph_hi = ph + 1; hipLaunchKernelGGL(trunk_fwd, dim3(grid), dim3(512), LDS_BYTES, stream, a); }
#endif
}
```

```cpp
#include <hip/hip_runtime.h>
#include <hip/hip_cooperative_groups.h>
#include <cstdint>
#include <cstdio>
namespace cg = cooperative_groups;

#ifndef MK_LAUNCHES
#define MK_LAUNCHES 1
#endif
#ifndef USE_XCD_BAR
#define USE_XCD_BAR 1
#endif

#define LAS __attribute__((address_space(3)))
typedef unsigned short bf16_t;
typedef short bf16x8 __attribute__((ext_vector_type(8)));
typedef short s16x4 __attribute__((ext_vector_type(4)));
typedef float f32x2 __attribute__((ext_vector_type(2)));
typedef float f32x4 __attribute__((ext_vector_type(4)));
typedef float f32x16 __attribute__((ext_vector_type(16)));
typedef unsigned u32x2 __attribute__((ext_vector_type(2)));
typedef unsigned u32x4 __attribute__((ext_vector_type(4)));

constexpr int T_ = 16384, S_ = 2048, NB_ = 8, DM = 1024, NL = 2;
constexpr int NPROJ = 2560;
constexpr int NIN = 7168;
constexpr int IN_SRC = 7080;
constexpr float EPS = 1e-6f;
constexpr float LOG2E = 1.4426950408889634f;
constexpr int NPH = 1 + 7 * NL;

constexpr size_t KiB = 1024, MiB = 1024 * 1024;
constexpr size_t WS_CTL = 0;
constexpr size_t WS_SS = 64 * KiB;
constexpr size_t WS_FF32 = 256 * KiB;
constexpr size_t WS_CUM = 768 * KiB;
constexpr size_t WS_TA = 1280 * KiB;
constexpr size_t WS_TBB = 1344 * KiB;
constexpr size_t WS_TC = 1856 * KiB;
constexpr size_t WS_SSQ = 2432 * KiB;
constexpr size_t WS_SSKV = 2560 * KiB;
constexpr size_t WS_PBAR = 2688 * KiB;
constexpr size_t WS_E = 3 * MiB;
constexpr size_t WS_WQ = 7 * MiB;
constexpr size_t WS_WKV = WS_WQ + 768 * KiB;
constexpr size_t WS_WGLU = WS_WKV + 1 * MiB;
constexpr size_t WS_WBO = WS_WGLU + 1 * MiB;
constexpr size_t WS_WOUT = WS_WBO + 6 * MiB;
constexpr size_t WS_WIN = 20 * MiB;
constexpr size_t WS_XG = 48 * MiB;
constexpr size_t WS_PROJ = 80 * MiB;
constexpr size_t WS_QUP = 160 * MiB;
constexpr size_t WS_KVUP = 184 * MiB;
constexpr size_t WS_KM = 216 * MiB;
constexpr size_t WS_Z = 240 * MiB;
constexpr size_t WS_END = 256 * MiB;
static_assert(WS_WOUT + 4 * MiB <= WS_WIN && WS_WIN + 28 * MiB <= WS_XG, "ws map");

__device__ __forceinline__ unsigned pk_bf16(float lo, float hi) {
    typedef __bf16 b2 __attribute__((ext_vector_type(2)));
    f32x2 v = {lo, hi}; b2 b = __builtin_convertvector(v, b2); return __builtin_bit_cast(unsigned, b);
}
__device__ __forceinline__ float bf_lo(unsigned w) { return __uint_as_float(w << 16); }
__device__ __forceinline__ float bf_hi(unsigned w) { return __uint_as_float(w & 0xffff0000u); }
__device__ __forceinline__ float bf2f(bf16_t h) { return __uint_as_float(((unsigned)h) << 16); }
__device__ __forceinline__ bf16_t f2bf(float f) { return (bf16_t)(pk_bf16(f, 0.f) & 0xffffu); }
__device__ __forceinline__ float sigmoidf_(float v) { return 1.f / (1.f + __expf(-v)); }
__device__ __forceinline__ float siluf_(float v) { return v / (1.f + __expf(-v)); }
__device__ __forceinline__ float gelu_tanh(float y) {
    const float v = 0.7978845608028654f * (y + 0.044715f * y * y * y);
    const float t = 1.f - 2.f / (1.f + __expf(2.f * v));
    return 0.5f * y * (1.f + t);
}
template <int CTRL> __device__ __forceinline__ float dpp_f(float v) { return __builtin_bit_cast(float, __builtin_amdgcn_update_dpp(0, __builtin_bit_cast(int, v), CTRL, 0xF, 0xF, true)); }
__device__ __forceinline__ float sum8(float v) { v += dpp_f<0xB1>(v); v += dpp_f<0x4E>(v); v += dpp_f<0x141>(v); return v; }
__device__ __forceinline__ float wave_sum(float v) {
    v = sum8(v); v += dpp_f<0x140>(v);
    const int iv = __builtin_bit_cast(int, v);
    const float a = __builtin_bit_cast(float, __builtin_amdgcn_readlane(iv, 0)), b = __builtin_bit_cast(float, __builtin_amdgcn_readlane(iv, 16));
    const float c = __builtin_bit_cast(float, __builtin_amdgcn_readlane(iv, 32)), d = __builtin_bit_cast(float, __builtin_amdgcn_readlane(iv, 48));
    return (a + b) + (c + d);
}
#define SBAR() __builtin_amdgcn_sched_barrier(0)

namespace pg8 {
constexpr int BM = 256, BK = 64, HALF = 128, HTB = HALF * BK * 2, STAGE_BYTES = 8 * HTB;
__device__ __forceinline__ int lds_byte(int r, int c) { const int st = (r >> 4) * 2 + (c >> 5), rr = r & 15, cc = c & 31, ob = rr * 64 + cc * 2; return st * 1024 + (ob ^ (((ob >> 9) & 1) << 5)); }
__device__ __forceinline__ void stage_rc(int b, int& R, int& C) { const int st = b / 1024, sb = b % 1024, swz = sb ^ (((sb >> 9) & 1) << 5); R = (st >> 1) * 16 + swz / 64; C = (st & 1) * 32 + (swz % 64) / 2; }
__device__ __forceinline__ int perm32(int rho) { const int n = rho >> 4, i = rho & 15; return 8 * (i >> 2) + 4 * n + (i & 3); }

struct Unit { const char* A; const char* B; int pm, pn, kind; };

__device__ __forceinline__ bool tile_at(long L, int nM, int nN, int& pm, int& pn) {
    const int nwg = nM * nN; if (L >= nwg) return false;
    int wgid = (int)L; { const int q = nwg / 8, r = nwg % 8, xcd = wgid % 8, off = wgid / 8; wgid = (xcd < r ? xcd * (q + 1) : r * (q + 1) + (xcd - r) * q) + off; }
    const int WGM = 8, nig = WGM * nN, gid = wgid / nig, fm = gid * WGM;
    pm = fm + ((wgid % nig) & (WGM - 1)); pn = (wgid % nig) / WGM; return true;
}

template <class Epi, class Sched>
__device__ __forceinline__ void gemm_phase(LAS unsigned char* lds, const int lda, const int ldb, const int nt, const Sched& S, const Epi& E) {
    int tid = threadIdx.x; asm volatile("" : "+v"(tid));
    const int wid = __builtin_amdgcn_readfirstlane(tid >> 6), lane = tid & 63, wr = wid >> 2, wc = wid & 3, fr = lane & 15, fq = lane >> 4;
    unsigned voffA[2], voffB[2];
#pragma unroll
    for (int i = 0; i < 2; ++i) { int R, C; stage_rc(tid * 16 + i * 8192, R, C); const int Rb = Epi::PERM ? ((R & ~31) + perm32(R & 31)) : R;
        voffA[i] = (unsigned)(R * lda + C) * 2u; voffB[i] = (unsigned)(Rb * ldb + C) * 2u; }
    int ntv = nt; asm volatile("" : "+s"(ntv));
    const size_t kstep = (size_t)(BK * 2);
    const size_t hstepA = (size_t)HALF * lda * 2, hstepB = (size_t)HALF * ldb * 2;
    const unsigned ldsw = (unsigned)wid * 1024u;
    const int aoff = lds_byte(wr * 64 + fr, fq * 8), boff = lds_byte(wc * 32 + fr, fq * 8);
#define PG8_SA(b, h) (((b) * 2 + (h)) * HTB)
#define PG8_SB(b, h) ((4 + (b) * 2 + (h)) * HTB)
#define PG8_STAGE(bufoff, gbase, voff) do { _Pragma("unroll") for (int _i = 0; _i < 2; ++_i) \
        __builtin_amdgcn_global_load_lds((const unsigned*)((const char*)(gbase) + (voff)[_i]), (LAS unsigned*)(lds + (bufoff) + ldsw + _i * 8192), 16, 0, 0); } while (0)
#define PG8_LDA(dst, b, h) do { _Pragma("unroll") for (int m = 0; m < 4; ++m) _Pragma("unroll") for (int k = 0; k < 2; ++k) dst[m][k] = *(const LAS bf16x8*)(lds + PG8_SA(b, h) + aoff + m * 2048 + k * 1024); } while (0)
#define PG8_LDB(dst, b, h) do { _Pragma("unroll") for (int n = 0; n < 2; ++n) _Pragma("unroll") for (int k = 0; k < 2; ++k) dst[n][k] = *(const LAS bf16x8*)(lds + PG8_SB(b, h) + boff + n * 2048 + k * 1024); } while (0)
#define PG8_MMA(ai, bj, At, Bt) do { __builtin_amdgcn_s_setprio(1); _Pragma("unroll") for (int m = 0; m < 4; ++m) _Pragma("unroll") for (int n = 0; n < 2; ++n) _Pragma("unroll") for (int k = 0; k < 2; ++k) \
        acc[ai][bj][m][n] = __builtin_amdgcn_mfma_f32_16x16x32_bf16(Bt[n][k], At[m][k], acc[ai][bj][m][n], 0, 0, 0); __builtin_amdgcn_s_setprio(0); } while (0)
#define PG8_WAIT_V(n) asm volatile("s_waitcnt vmcnt(" #n ")" ::: "memory")
#define PG8_WAIT_L(n) asm volatile("s_waitcnt lgkmcnt(" #n ")" ::: "memory")
#define PG8_BAR __builtin_amdgcn_s_barrier()
#define PG8_SCHED __builtin_amdgcn_sched_barrier(0)
    Unit cur, nxt; int ui = 0;
    if (!S.next(0, cur)) return;
    f32x4 acc[2][2][4][2];
#pragma unroll
    for (int a = 0; a < 2; ++a)
#pragma unroll
        for (int b = 0; b < 2; ++b)
#pragma unroll
            for (int m = 0; m < 4; ++m)
#pragma unroll
                for (int n = 0; n < 2; ++n) acc[a][b][m][n] = (f32x4){0.f, 0.f, 0.f, 0.f};
    bf16x8 At[4][2], B0[2][2], B1[2][2];
    const char* cA = cur.A; const char* cB = cur.B;
    PG8_STAGE(PG8_SB(0, 0), cB, voffB); PG8_STAGE(PG8_SB(0, 1), cB + hstepB, voffB); PG8_STAGE(PG8_SA(0, 0), cA, voffA); PG8_STAGE(PG8_SA(0, 1), cA + hstepA, voffA);
    if (wr == 1) PG8_BAR;
    PG8_WAIT_V(2); PG8_BAR;
    PG8_STAGE(PG8_SB(1, 0), cB + kstep, voffB); PG8_STAGE(PG8_SA(1, 0), cA + kstep, voffA); PG8_STAGE(PG8_SB(1, 1), cB + hstepB + kstep, voffB);
    PG8_WAIT_V(6); PG8_BAR;
    for (;;) {
        const bool has_next = S.next(ui + 1, nxt);
        const char* nA = has_next ? nxt.A : cA; const char* nB = has_next ? nxt.B : cB;
        for (int t = 0; t < ntv; t += 2) {
            const bool last = (t == ntv - 2);
            const char* a1 = cA + (size_t)(t + 1) * kstep;
            const char* a2 = last ? nA : cA + (size_t)(t + 2) * kstep; const char* b2 = last ? nB : cB + (size_t)(t + 2) * kstep;
            const char* a3 = a2 + kstep; const char* b3 = b2 + kstep;
            PG8_LDB(B0, 0, 0); PG8_LDB(B1, 0, 1); PG8_SCHED; PG8_LDA(At, 0, 0); PG8_STAGE(PG8_SA(1, 1), a1 + hstepA, voffA);
            PG8_WAIT_V(8); PG8_WAIT_L(0); PG8_BAR; PG8_MMA(0, 0, At, B0); PG8_MMA(0, 1, At, B1); PG8_BAR; PG8_SCHED;
            PG8_LDA(At, 0, 1); PG8_STAGE(PG8_SB(0, 0), b2, voffB); PG8_STAGE(PG8_SB(0, 1), b2 + hstepB, voffB); PG8_STAGE(PG8_SA(0, 0), a2, voffA);
            PG8_WAIT_V(8); PG8_WAIT_L(0); PG8_BAR; PG8_MMA(1, 0, At, B0); PG8_MMA(1, 1, At, B1); PG8_BAR; PG8_SCHED;
            PG8_LDB(B0, 1, 0); PG8_LDB(B1, 1, 1); PG8_SCHED; PG8_LDA(At, 1, 0); PG8_STAGE(PG8_SA(0, 1), a2 + hstepA, voffA);
            PG8_WAIT_V(8); PG8_WAIT_L(0); PG8_BAR; PG8_MMA(0, 0, At, B0); PG8_MMA(0, 1, At, B1); PG8_BAR; PG8_SCHED;
            PG8_LDA(At, 1, 1); PG8_STAGE(PG8_SB(1, 0), b3, voffB); PG8_STAGE(PG8_SB(1, 1), b3 + hstepB, voffB); PG8_STAGE(PG8_SA(1, 0), a3, voffA);
            PG8_WAIT_V(8); PG8_WAIT_L(0); PG8_BAR; PG8_MMA(1, 0, At, B0); PG8_MMA(1, 1, At, B1); PG8_BAR; PG8_SCHED;
        }
        if (wr == 0) PG8_BAR;
        const bool keep = E(acc, cur, wr, wc, fr, fq);
        if (!has_next) break;
        if (!keep) {
#pragma unroll
            for (int a = 0; a < 2; ++a)
#pragma unroll
                for (int b = 0; b < 2; ++b)
#pragma unroll
                    for (int m = 0; m < 4; ++m)
#pragma unroll
                        for (int n = 0; n < 2; ++n) acc[a][b][m][n] = (f32x4){0.f, 0.f, 0.f, 0.f};
        }
        cur = nxt; cA = nA; cB = nB; ++ui;
        if (wr == 1) PG8_BAR;
    }
    PG8_WAIT_V(0);
    PG8_BAR;
#undef PG8_SA
#undef PG8_SB
#undef PG8_STAGE
#undef PG8_LDA
#undef PG8_LDB
#undef PG8_MMA
#undef PG8_WAIT_V
#undef PG8_WAIT_L
#undef PG8_BAR
#undef PG8_SCHED
}
}

struct Args {
    const float* in[25];
    float* out;
    unsigned char* ws;
    int ph_lo, ph_hi, probe, pad;
};
enum { I_X = 0, I_POS, I_NORMG, I_WIN, I_QAN, I_WQUP, I_KVAN, I_WKVUP, I_MQN, I_MKN, I_FBF, I_FQN, I_FKN,
       I_LRE, I_LIM, I_LDT, I_BRE, I_BIM, I_CRE, I_CIM, I_S5D, I_WGLU, I_BGLU, I_WBO, I_WOUT };

typedef const __attribute__((address_space(4))) Args* ArgsP;
__device__ __forceinline__ ArgsP get_args() { ArgsP p = (ArgsP)__builtin_amdgcn_kernarg_segment_ptr(); asm volatile("" : "+s"(p)); return p; }
__device__ __forceinline__ int grid_g() { int g = (int)gridDim.x; asm volatile("" : "+s"(g)); return g; }
struct Ctx {
    LAS unsigned char* lds;
    char* ldsg;
    int G, bid;
    int vb;
};
#define PHASE_IDS() int tid = threadIdx.x; asm volatile("" : "+v"(tid)); const int lane = tid & 63, wave = __builtin_amdgcn_readfirstlane(tid >> 6); (void)lane; (void)wave

using pg8::Unit;
using pg8::tile_at;

__device__ __forceinline__ float rstd_of(const float* ss, int row) { return rsqrtf(ss[row] * (1.f / DM) + EPS); }

struct SchedIn {
    const char* XG; const char* WIN; int mode, G, c;
    __device__ __forceinline__ bool next(int i, Unit& u) const {
        int pm, pn; if (!tile_at((long)(i >> 1) * G + c, 64, mode ? 2 : 8, pm, pn)) return false;
        pn = mode ? pn + 6 : (pn >= 6 ? pn + 2 : pn);
        const int h = i & 1;
        u.A = XG + ((size_t)h * T_ + (size_t)pm * 256) * 512 * 2;
        u.B = WIN + ((size_t)h * NIN + (size_t)pn * 256) * 512 * 2;
        u.pm = pm; u.pn = pn; u.kind = h; return true;
    }
};
struct EpiProj {
    static constexpr bool PERM = true;
    bf16_t* P; const float* ss; float* ff32; float* ssq;
    __device__ __forceinline__ bool operator()(f32x4 (&acc)[2][2][4][2], const Unit& u, int wr, int wc, int fr, int fq) const {
        if (u.kind == 0) return true;
        const int row0 = u.pm * 256 + wr * 64 + fr, col0 = u.pn * 256 + wc * 32 + 8 * fq;
        float rs[2][4];
#pragma unroll
        for (int ai = 0; ai < 2; ++ai)
#pragma unroll
            for (int m = 0; m < 4; ++m) rs[ai][m] = ss[row0 + ai * 128 + m * 16];
#pragma unroll
        for (int ai = 0; ai < 2; ++ai)
#pragma unroll
            for (int m = 0; m < 4; ++m) { const int row = row0 + ai * 128 + m * 16; const float r_ = rsqrtf(rs[ai][m] * (1.f / DM) + EPS); bf16_t* rp = P + (size_t)row * NPROJ + col0;
#pragma unroll
                for (int bj = 0; bj < 2; ++bj) { const f32x4 v0 = acc[ai][bj][m][0] * r_, v1 = acc[ai][bj][m][1] * r_;
                    u32x4 w; w.x = pk_bf16(v0[0], v0[1]); w.y = pk_bf16(v0[2], v0[3]); w.z = pk_bf16(v1[0], v1[1]); w.w = pk_bf16(v1[2], v1[3]);
                    *(u32x4*)(rp + bj * 128) = w;
                    if (u.pn == 1 && bj == 1 && wc == 1 && fq == 0) { float* f = ff32 + (size_t)row * 8; *(f32x4*)f = v0; *(f32x4*)(f + 4) = v1; } }
                if (u.pn < 2) {
                    const f32x4 a0 = acc[ai][0][m][0] * r_, a1 = acc[ai][0][m][1] * r_; float sq = (a0[0] * a0[0] + a0[1] * a0[1]) + (a0[2] * a0[2] + a0[3] * a0[3]) + (a1[0] * a1[0] + a1[1] * a1[1]) + (a1[2] * a1[2] + a1[3] * a1[3]);
                    if (u.pn == 0) { const f32x4 b0 = acc[ai][1][m][0] * r_, b1 = acc[ai][1][m][1] * r_; sq += (b0[0] * b0[0] + b0[1] * b0[1]) + (b0[2] * b0[2] + b0[3] * b0[3]) + (b1[0] * b1[0] + b1[1] * b1[1]) + (b1[2] * b1[2] + b1[3] * b1[3]); }
                    sq += __shfl_xor(sq, 16); sq += __shfl_xor(sq, 32);
                    if (fq == 0) atomicAdd(ssq + (u.pn == 0 ? 0 : NL * T_) + row, sq); } }
        return false;
    }
};

struct SchedUp { const char* P; const char* WQ; const char* WKV; int G, c;
    __device__ __forceinline__ bool next(int i, Unit& u) const {
        long L = (long)i * G + c; int pm, pn;
        if (G == 256) { if (c < 128 || i >= 4) return false; L = (long)i * 128 + (c - 128); }
        if (L < 256) { tile_at(L, 64, 4, pm, pn); u.A = P + (size_t)pm * 256 * NPROJ * 2 + 256 * 2; u.B = WKV + (size_t)pn * 256 * 256 * 2; u.kind = 1; }
        else { if (!tile_at(L - 256, 64, 3, pm, pn)) return false; u.A = P + (size_t)pm * 256 * NPROJ * 2; u.B = WQ + (size_t)pn * 256 * 256 * 2; u.kind = 0; }
        u.pm = pm; u.pn = pn; return true; }
};
struct SchedPlain { const char* A; size_t a_tile_bytes, a_batch_bytes; const char* B; size_t b_tile_bytes; int nN, G, c;
    __device__ __forceinline__ bool next(int i, Unit& u) const {
        int pm, pn; if (!tile_at((long)i * G + c, 64, nN, pm, pn)) return false;
        u.A = A + (size_t)(pm >> 3) * a_batch_bytes + (size_t)(pm & 7) * a_tile_bytes; u.B = B + (size_t)pn * b_tile_bytes; u.pm = pm; u.pn = pn; u.kind = 0; return true; }
};
struct EpiUp { static constexpr bool PERM = true; bf16_t* QUP; bf16_t* KM; bf16_t* VM; const float* ssq;
    __device__ __forceinline__ bool operator()(f32x4 (&acc)[2][2][4][2], const Unit& u, int wr, int wc, int fr, int fq) const {
        const int row0 = u.pm * 256 + wr * 64 + fr, col0 = u.pn * 256 + wc * 32 + 8 * fq;
        float rs[2][4];
#pragma unroll
        for (int ai = 0; ai < 2; ++ai)
#pragma unroll
            for (int m = 0; m < 4; ++m) rs[ai][m] = ssq[(u.kind ? NL * T_ : 0) + row0 + ai * 128 + m * 16];
        const float inv = u.kind ? (1.f / 128) : (1.f / 256);
        bf16_t* dbase[2]; int dstr[2];
#pragma unroll
        for (int bj = 0; bj < 2; ++bj) { const int col = col0 + bj * 128;
            if (u.kind == 0) { dbase[bj] = QUP + col; dstr[bj] = 768; }
            else { const int hd = col >> 7, d = col & 127; if (d < 64) { dbase[bj] = KM + 96 * hd + d; dstr[bj] = 768; } else { dbase[bj] = VM + 64 * hd + (d - 64); dstr[bj] = 512; } } }
#pragma unroll
        for (int ai = 0; ai < 2; ++ai)
#pragma unroll
            for (int m = 0; m < 4; ++m) { const int row = row0 + ai * 128 + m * 16; const float r_ = rsqrtf(rs[ai][m] * inv + EPS);
#pragma unroll
                for (int bj = 0; bj < 2; ++bj) { const f32x4 v0 = acc[ai][bj][m][0] * r_, v1 = acc[ai][bj][m][1] * r_;
                    u32x4 w; w.x = pk_bf16(v0[0], v0[1]); w.y = pk_bf16(v0[2], v0[3]); w.z = pk_bf16(v1[0], v1[1]); w.w = pk_bf16(v1[2], v1[3]);
                    *(u32x4*)(dbase[bj] + (size_t)row * dstr[bj]) = w; } }
        return false;
    }
};
struct SchedGate { const char* ws; int l, G, c;
    __device__ __forceinline__ bool next(int i, Unit& u) const {
        const char* XG = ws + WS_XG; const char* WIN = ws + WS_WIN + (size_t)l * 2 * NIN * 512 * 2; const char* Z = ws + WS_Z; const char* WGLU = ws + WS_WGLU + (size_t)l * 512 * 512 * 2;
        int pm, pn, j;
        if (G == 256) {
            const int x = c & 7, k = c >> 3;
            if (k < 16) { if (i >= 4) return false; pm = 8 * x + (k >> 1); pn = 2 * (k & 1) + (i >> 1); j = i & 1; }
            else { if (i >= 3) return false; const int kk = k - 16; pm = 8 * x + (kk >> 1); pn = 4 + (kk & 1); j = i - 1; }
        } else {
            int Gv = G; asm volatile("" : "+s"(Gv));
            const int t3 = (128 - c + Gv - 1) / Gv;
            const int ns5 = (c < 128) ? t3 : 0;
            if (i < 3 * ns5) { const int m = c + (i / 3) * G; pm = m >> 1; pn = 4 + (m & 1); j = i % 3 - 1; }
            else { const int i2 = i - 3 * ns5; const long n = (long)(i2 >> 1) * G + c; if (n >= 256) return false; pm = (int)(n >> 2); pn = (int)(n & 3); j = i2 & 1; }
        }
        if (j < 0) { u.A = Z + (size_t)pm * 256 * 512 * 2; u.B = WGLU + (size_t)(pn & 1) * 256 * 512 * 2; u.kind = 2; }
        else { u.A = XG + ((size_t)j * T_ + (size_t)pm * 256) * 512 * 2; u.B = WIN + ((size_t)j * NIN + 2560 + (size_t)pn * 256) * 512 * 2; u.kind = j; }
        u.pm = pm; u.pn = pn; return true;
    }
};
struct EpiGate { static constexpr bool PERM = true; unsigned char* ws; const float* bias; int l;
    __device__ __forceinline__ bool operator()(f32x4 (&acc)[2][2][4][2], const Unit& u, int wr, int wc, int fr, int fq) const {
        if (u.kind == 0) return true;
        bf16_t* P = (bf16_t*)(ws + WS_PROJ); const bf16_t* QUP = (const bf16_t*)(ws + WS_QUP); const bf16_t* Z = (const bf16_t*)(ws + WS_Z); bf16_t* ABO = (bf16_t*)(ws + WS_KVUP); const float* ss = (const float*)(ws + WS_SS) + (size_t)l * T_;
        const int br = u.pn >> 1;
        const int row0 = u.pm * 256 + wr * 64 + fr, c0 = (u.pn & 1) * 256 + wc * 32 + 8 * fq;
        if (u.kind == 2) {
            f32x4 bv[2][2];
#pragma unroll
            for (int bj = 0; bj < 2; ++bj) { bv[bj][0] = *(const f32x4*)(bias + c0 + bj * 128); bv[bj][1] = *(const f32x4*)(bias + c0 + bj * 128 + 4); }
#pragma unroll
            for (int ai = 0; ai < 2; ++ai) {
                u32x4 yv[4][2];
#pragma unroll
                for (int m = 0; m < 4; ++m)
#pragma unroll
                    for (int bj = 0; bj < 2; ++bj) yv[m][bj] = *(const u32x4*)(Z + (size_t)(row0 + ai * 128 + m * 16) * 512 + c0 + bj * 128);
#pragma unroll
                for (int m = 0; m < 4; ++m) { const int row = row0 + ai * 128 + m * 16;
#pragma unroll
                    for (int bj = 0; bj < 2; ++bj) { const int c = c0 + bj * 128; const f32x4 v0 = acc[ai][bj][m][0] + bv[bj][0], v1 = acc[ai][bj][m][1] + bv[bj][1];
                        const u32x4 z = yv[m][bj];
                        u32x4 w;
                        w.x = pk_bf16(bf_lo(z.x) * sigmoidf_(v0[0]), bf_hi(z.x) * sigmoidf_(v0[1]));
                        w.y = pk_bf16(bf_lo(z.y) * sigmoidf_(v0[2]), bf_hi(z.y) * sigmoidf_(v0[3]));
                        w.z = pk_bf16(bf_lo(z.z) * sigmoidf_(v1[0]), bf_hi(z.z) * sigmoidf_(v1[1]));
                        w.w = pk_bf16(bf_lo(z.w) * sigmoidf_(v1[2]), bf_hi(z.w) * sigmoidf_(v1[3]));
                        *(u32x4*)(P + (size_t)row * NPROJ + c) = w; } }
            }
            return false;
        }
        const unsigned abo2 = (br == 2) ? (unsigned)(u.pm >> 3) * (512u << 10) : 0u;
        float rs[2][4];
#pragma unroll
        for (int ai = 0; ai < 2; ++ai)
#pragma unroll
            for (int m = 0; m < 4; ++m) rs[ai][m] = ss[row0 + ai * 128 + m * 16];
#pragma unroll
        for (int ai = 0; ai < 2; ++ai) {
            u32x4 yv[4][2];
#pragma unroll
            for (int m = 0; m < 4; ++m) { const int row = row0 + ai * 128 + m * 16;
#pragma unroll
                for (int bj = 0; bj < 2; ++bj) { const int c = c0 + bj * 128;
                    const bf16_t* ysrc = (br == 0) ? (QUP + (size_t)row * 768 + 96 * (c >> 6) + (c & 63)) : (br == 1) ? (P + (size_t)row * NPROJ + 512 + c) : (P + (size_t)row * NPROJ + c);
                    yv[m][bj] = *(const u32x4*)ysrc; } }
#pragma unroll
            for (int m = 0; m < 4; ++m) { const int row = row0 + ai * 128 + m * 16; const float r_ = rsqrtf(rs[ai][m] * (1.f / DM) + EPS);
#pragma unroll
                for (int bj = 0; bj < 2; ++bj) { const int c = c0 + bj * 128;
                    const u32x4 y = yv[m][bj];
                    const f32x4 v0 = acc[ai][bj][m][0] * r_, v1 = acc[ai][bj][m][1] * r_;
                    u32x4 w;
                    w.x = pk_bf16(bf_lo(y.x) * siluf_(v0[0]), bf_hi(y.x) * siluf_(v0[1]));
                    w.y = pk_bf16(bf_lo(y.y) * siluf_(v0[2]), bf_hi(y.y) * siluf_(v0[3]));
                    w.z = pk_bf16(bf_lo(y.z) * siluf_(v1[0]), bf_hi(y.z) * siluf_(v1[1]));
                    w.w = pk_bf16(bf_lo(y.w) * siluf_(v1[2]), bf_hi(y.w) * siluf_(v1[3]));
                    *(u32x4*)(ABO + ((size_t)br * T_ + row) * 512 + abo2 + c) = w; } }
        }
        return false;
    }
};
enum { MOP_KEEP = 0, MOP_STORE_O = 1, MOP_GATE_RMW = 2, MOP_STORE_S = 3, MOP_O_RMW = 4, MOP_FIRST = 8 };
struct SchedMerge { const char* ws; int l, G, c;
    __device__ __forceinline__ bool next(int i, Unit& u) const {
        const char* ABO = ws + WS_KVUP; const char* WBO = ws + WS_WBO + (size_t)l * 3 * 1024 * 512 * 2; const char* XG = ws + WS_XG; const char* WIN = ws + WS_WIN + (size_t)l * 2 * NIN * 512 * 2;
        int pm, pn; if (!tile_at((long)(i / 9) * G + c, 64, 4, pm, pn)) return false;
        const int j = i % 9; int typ, br, h = 0, op;
        if (G != 256 || !(c & 1)) { br = j / 3; const int s_ = j % 3; typ = s_ != 0; h = s_ - 1; op = s_ == 0 ? MOP_STORE_O : s_ == 1 ? MOP_KEEP : (MOP_GATE_RMW | (br == 0 ? MOP_FIRST : 0)); }
        else if (j < 2) { typ = 1; br = 2; h = j; op = j ? MOP_STORE_S : MOP_KEEP; }
        else { const int jj = j - 2, g = jj / 3, r = jj % 3; br = g;
            if (g == 2) { typ = 0; op = MOP_O_RMW; }
            else if (r == 0) { typ = 0; op = MOP_STORE_O; }
            else { typ = 1; h = r - 1; op = r == 1 ? MOP_KEEP : (MOP_GATE_RMW | (g == 0 ? MOP_FIRST : 0)); } }
        if (typ == 0) { u.A = ABO + ((size_t)br * T_ + (size_t)pm * 256) * 512 * 2 + (br == 2 ? (size_t)(pm >> 3) << 20 : 0); u.B = WBO + ((size_t)br * 1024 + (size_t)pn * 256) * 512 * 2; }
        else { u.A = XG + ((size_t)h * T_ + (size_t)pm * 256) * 512 * 2; u.B = WIN + ((size_t)h * NIN + 4096 + (size_t)br * 1024 + (size_t)pn * 256) * 512 * 2; }
        u.pm = pm; u.pn = pn; u.kind = op; return true;
    }
};
struct EpiMerge { static constexpr bool PERM = true; unsigned char* ws; int l, bid;
    __device__ __forceinline__ bf16_t* scr2() const { unsigned b_ = (unsigned)bid; asm volatile("" : "+s"(b_)); const unsigned sb = b_ & 7u, sk = (b_ >> 3) & 31u;
        return (bf16_t*)(ws + (sk < 16u ? (unsigned)WS_Z + sb * (2u << 20) + sk * 131072u : (unsigned)WS_PROJ + sb * (10u << 20) + (8u << 20) + (sk - 16u) * 131072u)); }
    __device__ __forceinline__ bool operator()(f32x4 (&acc)[2][2][4][2], const Unit& u, int wr, int wc, int fr, int fq) const {
        const int op = u.kind & 7; const bool first = (u.kind & MOP_FIRST) != 0;
        if (op == MOP_KEEP) return true;
        bf16_t* OSCR = (bf16_t*)(ws + WS_PROJ) + (unsigned)(u.pm >> 3) * (3u << 20); bf16_t* MERGED = OSCR + (size_t)S_ * 1024; const float* ss = (const float*)(ws + WS_SS) + (size_t)l * T_;
        const int rt0 = wr * 64 + fr, ct0 = wc * 32 + 8 * fq;
        const int row0 = u.pm * 256 + rt0, col0 = u.pn * 256 + ct0;
        if (op == MOP_STORE_O) {
#pragma unroll
            for (int ai = 0; ai < 2; ++ai)
#pragma unroll
                for (int m = 0; m < 4; ++m) { const size_t off = (size_t)(row0 + ai * 128 + m * 16) * 1024 + col0;
#pragma unroll
                    for (int bj = 0; bj < 2; ++bj) { const f32x4 v0 = acc[ai][bj][m][0], v1 = acc[ai][bj][m][1];
                        u32x4 w; w.x = pk_bf16(v0[0], v0[1]); w.y = pk_bf16(v0[2], v0[3]); w.z = pk_bf16(v1[0], v1[1]); w.w = pk_bf16(v1[2], v1[3]);
                        *(u32x4*)(OSCR + off + bj * 128) = w; } }
            return false;
        }
        if (op == MOP_O_RMW) {
            bf16_t* SCR2 = scr2();
#pragma unroll
            for (int qd = 0; qd < 4; ++qd) { const int ai = qd >> 1, m0 = (qd & 1) * 2;
                u32x4 sv[2][2], pv[2][2];
#pragma unroll
                for (int mm = 0; mm < 2; ++mm) { const int rr = ai * 128 + (m0 + mm) * 16; const size_t off = (size_t)(row0 + rr) * 1024 + col0;
#pragma unroll
                    for (int bj = 0; bj < 2; ++bj) { sv[mm][bj] = *(const u32x4*)(SCR2 + (size_t)(rt0 + rr) * 256 + ct0 + bj * 128); pv[mm][bj] = *(const u32x4*)(MERGED + off + bj * 128); } }
#pragma unroll
                for (int mm = 0; mm < 2; ++mm) { const int m = m0 + mm; const size_t off = (size_t)(row0 + ai * 128 + m * 16) * 1024 + col0;
#pragma unroll
                    for (int bj = 0; bj < 2; ++bj) { const f32x4 v0 = acc[ai][bj][m][0], v1 = acc[ai][bj][m][1]; const u32x4 g = sv[mm][bj], p = pv[mm][bj];
                        u32x4 w;
                        w.x = pk_bf16(bf_lo(p.x) + bf_lo(g.x) * v0[0], bf_hi(p.x) + bf_hi(g.x) * v0[1]); w.y = pk_bf16(bf_lo(p.y) + bf_lo(g.y) * v0[2], bf_hi(p.y) + bf_hi(g.y) * v0[3]);
                        w.z = pk_bf16(bf_lo(p.z) + bf_lo(g.z) * v1[0], bf_hi(p.z) + bf_hi(g.z) * v1[1]); w.w = pk_bf16(bf_lo(p.w) + bf_lo(g.w) * v1[2], bf_hi(p.w) + bf_hi(g.w) * v1[3]);
                        *(u32x4*)(MERGED + off + bj * 128) = w; } }
            }
            return false;
        }
        if (op == MOP_STORE_S) {
            bf16_t* SCR2 = scr2();
            float rs[2][4];
#pragma unroll
            for (int ai = 0; ai < 2; ++ai)
#pragma unroll
                for (int m = 0; m < 4; ++m) rs[ai][m] = ss[row0 + ai * 128 + m * 16];
#pragma unroll
            for (int ai = 0; ai < 2; ++ai)
#pragma unroll
                for (int m = 0; m < 4; ++m) { const int rr = ai * 128 + m * 16; const float r_ = rsqrtf(rs[ai][m] * (1.f / DM) + EPS);
#pragma unroll
                    for (int bj = 0; bj < 2; ++bj) { const f32x4 v0 = acc[ai][bj][m][0] * r_, v1 = acc[ai][bj][m][1] * r_;
                        u32x4 w; w.x = pk_bf16(sigmoidf_(v0[0]), sigmoidf_(v0[1])); w.y = pk_bf16(sigmoidf_(v0[2]), sigmoidf_(v0[3])); w.z = pk_bf16(sigmoidf_(v1[0]), sigmoidf_(v1[1])); w.w = pk_bf16(sigmoidf_(v1[2]), sigmoidf_(v1[3]));
                        *(u32x4*)(SCR2 + (size_t)(rt0 + rr) * 256 + ct0 + bj * 128) = w; } }
            return false;
        }
        float rq[8];
#pragma unroll
        for (int g = 0; g < 8; ++g) rq[g] = ss[row0 + (g >> 2) * 128 + (g & 3) * 16];
        u32x4 ov[2][2], pv[2][2];
#define RMW_LOAD(g, b) do { const size_t off_ = (size_t)(row0 + ((g) >> 2) * 128 + ((g) & 3) * 16) * 1024 + col0; \
            _Pragma("unroll") for (int bj = 0; bj < 2; ++bj) { ov[b][bj] = *(const u32x4*)(OSCR + off_ + bj * 128); pv[b][bj] = (u32x4){0u, 0u, 0u, 0u}; if (!first) pv[b][bj] = *(const u32x4*)(MERGED + off_ + bj * 128); } } while (0)
        RMW_LOAD(0, 0);
#pragma unroll
        for (int g = 0; g < 8; ++g) { const int ai = g >> 2, m = g & 3, b = g & 1; const size_t off = (size_t)(row0 + ai * 128 + m * 16) * 1024 + col0;
            if (g + 1 < 8) RMW_LOAD(g + 1, (g + 1) & 1);
            const float r_ = rsqrtf(rq[g] * (1.f / DM) + EPS);
#pragma unroll
            for (int bj = 0; bj < 2; ++bj) { const f32x4 v0 = acc[ai][bj][m][0] * r_, v1 = acc[ai][bj][m][1] * r_;
                const u32x4 o = ov[b][bj], p = pv[b][bj];
                u32x4 w;
                w.x = pk_bf16(bf_lo(p.x) + bf_lo(o.x) * sigmoidf_(v0[0]), bf_hi(p.x) + bf_hi(o.x) * sigmoidf_(v0[1]));
                w.y = pk_bf16(bf_lo(p.y) + bf_lo(o.y) * sigmoidf_(v0[2]), bf_hi(p.y) + bf_hi(o.y) * sigmoidf_(v0[3]));
                w.z = pk_bf16(bf_lo(p.z) + bf_lo(o.z) * sigmoidf_(v1[0]), bf_hi(p.z) + bf_hi(o.z) * sigmoidf_(v1[1]));
                w.w = pk_bf16(bf_lo(p.w) + bf_lo(o.w) * sigmoidf_(v1[2]), bf_hi(p.w) + bf_hi(o.w) * sigmoidf_(v1[3]));
                *(u32x4*)(MERGED + off + bj * 128) = w; } }
#undef RMW_LOAD
        return false;
    }
};
struct EpiOut { static constexpr bool PERM = false; const float* xres; float* out; bf16_t* XG; float* ssn; bool dry;
    __device__ __forceinline__ bool operator()(f32x4 (&acc)[2][2][4][2], const Unit& u, int wr, int wc, int fr, int fq) const {
        const int row0 = u.pm * 256 + wr * 64 + fr, col0 = u.pn * 256 + wc * 32 + 4 * fq;
#pragma unroll
        for (int qd = 0; qd < 4; ++qd) { const int ai = qd >> 1, m0 = (qd & 1) * 2;
            f32x4 xr[2][2][2];
            if (xres) {
#pragma unroll
                for (int mm = 0; mm < 2; ++mm) { const size_t off = (size_t)(row0 + ai * 128 + (m0 + mm) * 16) * DM + col0;
#pragma unroll
                    for (int bj = 0; bj < 2; ++bj)
#pragma unroll
                        for (int n = 0; n < 2; ++n) xr[mm][bj][n] = __builtin_nontemporal_load((const f32x4*)(xres + off + bj * 128 + n * 16)); }
            } else {
                u32x2 xb[2][2][2];
#pragma unroll
                for (int mm = 0; mm < 2; ++mm) { const int row = row0 + ai * 128 + (m0 + mm) * 16;
#pragma unroll
                    for (int bj = 0; bj < 2; ++bj)
#pragma unroll
                        for (int n = 0; n < 2; ++n) { const int col = col0 + bj * 128 + n * 16; xb[mm][bj][n] = *(const u32x2*)(XG + ((size_t)(col >> 9) * T_ + row) * 512 + (col & 511)); } }
#pragma unroll
                for (int mm = 0; mm < 2; ++mm)
#pragma unroll
                    for (int bj = 0; bj < 2; ++bj)
#pragma unroll
                        for (int n = 0; n < 2; ++n) { const u32x2 b = xb[mm][bj][n]; xr[mm][bj][n] = (f32x4){bf_lo(b.x), bf_hi(b.x), bf_lo(b.y), bf_hi(b.y)}; }
            }
#pragma unroll
            for (int mm = 0; mm < 2; ++mm) { const int m = m0 + mm; const int row = row0 + ai * 128 + m * 16; const size_t off = (size_t)row * DM + col0; float sq = 0.f;
#pragma unroll
                for (int bj = 0; bj < 2; ++bj)
#pragma unroll
                    for (int n = 0; n < 2; ++n) { const int cc = bj * 128 + n * 16; const f32x4 o = xr[mm][bj][n] + acc[ai][bj][m][n];
                        if (!ssn && !dry) __builtin_nontemporal_store(o, (f32x4*)(out + off + cc));
                        if (ssn && !dry) { const int col = col0 + cc; sq += (o[0] * o[0] + o[1] * o[1]) + (o[2] * o[2] + o[3] * o[3]);
                            u32x2 w; w.x = pk_bf16(o[0], o[1]); w.y = pk_bf16(o[2], o[3]);
                            *(u32x2*)(XG + ((size_t)(col >> 9) * T_ + row) * 512 + (col & 511)) = w; } }
                if (ssn && !dry) { sq += __shfl_xor(sq, 16); sq += __shfl_xor(sq, 32); if (fq == 0) atomicAdd(ssn + row, sq); } }
        }
        return false;
    }
};

namespace attn {
constexpr int QBLK = 32, KVBLK = 64;
constexpr int SHM_K = KVBLK * 256, SHM_V = KVBLK * 64 * 2;
constexpr int NBUF = 3;
constexpr int LDS_V = 0, LDS_K = NBUF * SHM_V, LDS_CK = LDS_K + NBUF * SHM_K, LDS_WS = LDS_CK + NBUF * 256, LDS_OST = LDS_WS + 8 * 256, LDS_BYTES = LDS_OST + 8 * 4096;
constexpr float THR2 = 8.f;
#define KSWZ(row, colB) ((row) * 256 + ((colB) ^ (((row) & 15) << 4)))
__device__ __forceinline__ int crow(int r, int hi) { return (r & 3) + 8 * (r >> 2) + 4 * hi; }
__device__ __forceinline__ void partialSM(f32x16& p0, f32x16& p1, float& m_reg, float& alpha) {
    float pmax = p0[0];
#pragma unroll
    for (int r = 1; r < 16; ++r) pmax = fmaxf(pmax, p0[r]);
#pragma unroll
    for (int r = 0; r < 16; ++r) pmax = fmaxf(pmax, p1[r]);
    { auto rr = __builtin_amdgcn_permlane32_swap(__float_as_uint(pmax), __float_as_uint(pmax), false, false);
      pmax = fmaxf(__uint_as_float(rr[0]), __uint_as_float(rr[1])); }
    if (__builtin_expect(__all(pmax <= THR2), 1)) { alpha = 1.f; }
    else { const float dl = fmaxf(pmax, 0.f); m_reg += dl; alpha = __builtin_amdgcn_exp2f(-dl);
#pragma unroll
        for (int r = 0; r < 16; ++r) { p0[r] -= dl; p1[r] -= dl; } }
#pragma unroll
    for (int r = 0; r < 16; ++r) p0[r] = __builtin_amdgcn_exp2f(p0[r]);
}
__device__ __forceinline__ void finishSM(f32x16& p0, f32x16& p1, float alpha, float& l_reg, bf16x8& pa0, bf16x8& pa1, bf16x8& pa2, bf16x8& pa3) {
#pragma unroll
    for (int r = 0; r < 16; ++r) p1[r] = __builtin_amdgcn_exp2f(p1[r]);
    float ps = 0;
#pragma unroll
    for (int r = 0; r < 16; ++r) ps += p0[r];
#pragma unroll
    for (int r = 0; r < 16; ++r) ps += p1[r];
    { auto rr = __builtin_amdgcn_permlane32_swap(__float_as_uint(ps), __float_as_uint(ps), false, false);
      ps = __uint_as_float(rr[0]) + __uint_as_float(rr[1]); }
    l_reg = l_reg * alpha + ps;
#define PK4(P, BASE, OUT) do { unsigned a0 = pk_bf16(P[BASE + 0], P[BASE + 1]), a1 = pk_bf16(P[BASE + 2], P[BASE + 3]);   \
    unsigned b0 = pk_bf16(P[BASE + 4], P[BASE + 5]), b1 = pk_bf16(P[BASE + 6], P[BASE + 7]);                              \
    auto r0 = __builtin_amdgcn_permlane32_swap(a0, b0, false, false); auto r1 = __builtin_amdgcn_permlane32_swap(a1, b1, false, false); \
    u32x4 w = {r0[0], r1[0], r0[1], r1[1]}; OUT = __builtin_bit_cast(bf16x8, w); } while (0)
    PK4(p0, 0, pa0); PK4(p0, 8, pa1); PK4(p1, 0, pa2); PK4(p1, 8, pa3);
#undef PK4
}
__device__ __forceinline__ void expHalf(f32x16& p) {
#pragma unroll
    for (int r = 0; r < 16; ++r) p[r] = __builtin_amdgcn_exp2f(p[r]);
}
__device__ __forceinline__ void packP(const f32x16& p0, const f32x16& p1, bf16x8& pa0, bf16x8& pa1, bf16x8& pa2, bf16x8& pa3) {
#define PK4(P, BASE, OUT) do { unsigned a0 = pk_bf16(P[BASE + 0], P[BASE + 1]), a1 = pk_bf16(P[BASE + 2], P[BASE + 3]);   \
    unsigned b0 = pk_bf16(P[BASE + 4], P[BASE + 5]), b1 = pk_bf16(P[BASE + 6], P[BASE + 7]);                              \
    auto r0 = __builtin_amdgcn_permlane32_swap(a0, b0, false, false); auto r1 = __builtin_amdgcn_permlane32_swap(a1, b1, false, false); \
    u32x4 w = {r0[0], r1[0], r0[1], r1[1]}; OUT = __builtin_bit_cast(bf16x8, w); } while (0)
    PK4(p0, 0, pa0); PK4(p0, 8, pa1); PK4(p1, 0, pa2); PK4(p1, 8, pa3);
#undef PK4
}
__device__ __forceinline__ void sumP(const f32x16& p0, const f32x16& p1, float& l_reg) {
    float s0 = p0[0] + p0[1], s1 = p0[2] + p0[3], s2 = p1[0] + p1[1], s3 = p1[2] + p1[3];
#pragma unroll
    for (int r = 4; r < 16; r += 4) { s0 += p0[r] + p0[r + 1]; s1 += p0[r + 2] + p0[r + 3]; s2 += p1[r] + p1[r + 1]; s3 += p1[r + 2] + p1[r + 3]; }
    float ps = (s0 + s1) + (s2 + s3);
    { auto rr = __builtin_amdgcn_permlane32_swap(__float_as_uint(ps), __float_as_uint(ps), false, false); ps = __uint_as_float(rr[0]) + __uint_as_float(rr[1]); }
    l_reg += ps;
}
__device__ __forceinline__ void pv_sum(f32x16& la, bf16x8 pa0, bf16x8 pa1, bf16x8 pa2, bf16x8 pa3) {
    const u32x4 ow = {0x3F803F80u, 0x3F803F80u, 0x3F803F80u, 0x3F803F80u}; const bf16x8 ones = __builtin_bit_cast(bf16x8, ow);
    la = __builtin_amdgcn_mfma_f32_32x32x16_bf16(pa0, ones, la, 0, 0, 0);
    la = __builtin_amdgcn_mfma_f32_32x32x16_bf16(pa1, ones, la, 0, 0, 0);
    la = __builtin_amdgcn_mfma_f32_32x32x16_bf16(pa2, ones, la, 0, 0, 0);
    la = __builtin_amdgcn_mfma_f32_32x32x16_bf16(pa3, ones, la, 0, 0, 0);
}
__device__ __forceinline__ int v_st(int k, int c) { const int kk = (k & ~0xC) | ((k & 4) << 1) | ((k & 8) >> 1); return ((kk >> 3) * 2 + (c >> 5)) * 512 + ((kk & 7) * 32 + (c & 31)) * 2; }
__device__ __forceinline__ int v_rd_base(int lane) { return ((lane & 3) << 3) | (((lane >> 2) & 3) << 6) | (((lane >> 4) & 1) << 5) | (((lane >> 5) & 1) << 8); }
constexpr int v_rd_off(int d0, int ks, int half) { return d0 * 512 + ks * 2048 + half * 1024; }
template <int OFF> __device__ __forceinline__ s16x4 tr_read(int vb) {
    s16x4 r; asm volatile("ds_read_b64_tr_b16 %0, %1 offset:%2" : "=&v"(r) : "v"(vb), "i"(OFF) : "memory"); return r;
}
template <int OFF> __device__ __forceinline__ s16x4 trb(int vb) {
    return __builtin_amdgcn_ds_read_tr16_b64_v4i16((LAS s16x4*)(size_t)(unsigned)(vb + OFF));
}
#define SG(mask, n) __builtin_amdgcn_sched_group_barrier(mask, n, 0)
#define SGI(mask, n, id) __builtin_amdgcn_sched_group_barrier(mask, n, id)
#define SG_MFMA 0x008
#define SG_VALU 0x002
#define SG_DSR  0x100
template <int D0> __device__ __forceinline__ void pv_one(f32x16& od, int vb, bf16x8 pa0, bf16x8 pa1, bf16x8 pa2, bf16x8 pa3) {
    const s16x4 l0 = tr_read<v_rd_off(D0, 0, 0)>(vb), h0 = tr_read<v_rd_off(D0, 0, 1)>(vb), l1 = tr_read<v_rd_off(D0, 1, 0)>(vb), h1 = tr_read<v_rd_off(D0, 1, 1)>(vb);
    const s16x4 l2 = tr_read<v_rd_off(D0, 2, 0)>(vb), h2 = tr_read<v_rd_off(D0, 2, 1)>(vb), l3 = tr_read<v_rd_off(D0, 3, 0)>(vb), h3 = tr_read<v_rd_off(D0, 3, 1)>(vb);
    asm volatile("s_waitcnt lgkmcnt(0)" ::: "memory"); SBAR();
#define PKV(L, H) (bf16x8){L[0], L[1], L[2], L[3], H[0], H[1], H[2], H[3]}
    od = __builtin_amdgcn_mfma_f32_32x32x16_bf16(pa0, PKV(l0, h0), od, 0, 0, 0);
    od = __builtin_amdgcn_mfma_f32_32x32x16_bf16(pa1, PKV(l1, h1), od, 0, 0, 0);
    od = __builtin_amdgcn_mfma_f32_32x32x16_bf16(pa2, PKV(l2, h2), od, 0, 0, 0);
    od = __builtin_amdgcn_mfma_f32_32x32x16_bf16(pa3, PKV(l3, h3), od, 0, 0, 0);
#undef PKV
}

template <int DQK, bool FOX, bool TRACK>
__device__ __forceinline__ void attn_unit(bf16_t* Qh, int ldq, const bf16_t* Kh, int ldk, const bf16_t* Vh, int ldv, const float* cum, int q0, char* lds, bool dry, float sbound, int T0) {
    constexpr int ND = DQK / 16, KCH = DQK / 8;
    int tid = threadIdx.x; asm volatile("" : "+v"(tid));
    const int wid = __builtin_amdgcn_readfirstlane(tid >> 6), lane = tid & 63, r32 = lane & 31, hi = lane >> 5;
    char* V_lds = lds + LDS_V; char* K_lds = lds + LDS_K; float* CK_lds = (float*)(lds + LDS_CK);
    float* ws = (float*)(lds + LDS_WS) + wid * 64; float* li_l = ws; float* al_l = ws + 32;
    float m_reg = 0.f, l_reg = 0; f32x16 o[2]; o[0] = f32x16{}; o[1] = f32x16{}; bf16x8 qr[ND];
    const int qrow = q0 + wid * QBLK + r32;
    { const bf16_t* Qw = Qh + (size_t)qrow * ldq + hi * 8;
#pragma unroll
      for (int d0 = 0; d0 < ND; ++d0) qr[d0] = *reinterpret_cast<const bf16x8*>(Qw + d0 * 16); }
    float cq = 0.f; if (FOX) cq = cum[qrow];
    const int kr0 = tid / KCH, kc0 = tid % KCH;
    const int kr1 = (tid + 512) / KCH, kc1 = (tid + 512) % KCH;
    const bool k2 = (KCH * 64 > 512) && (tid + 512 < KCH * 64);
    const int vr = tid >> 3, vc = (tid & 7) * 8, vst = v_st(vr, vc);
    const int vb0 = (int)(uintptr_t)V_lds + v_rd_base(lane);
    struct Stg { bf16x8 k0, k1, v; f32x4 ck; } st[2];
    const int kr1c = (kr1 < 64) ? kr1 : 63;
    const int ckc = (tid & 15) * 4;
#define SLOAD(i, k0_) do { st[i].k0 = *reinterpret_cast<const bf16x8*>(Kh + (size_t)((k0_) + kr0) * ldk + kc0 * 8); \
      if (KCH * 64 > 512) st[i].k1 = *reinterpret_cast<const bf16x8*>(Kh + (size_t)((k0_) + kr1c) * ldk + kc1 * 8); \
      st[i].v = *reinterpret_cast<const bf16x8*>(Vh + (size_t)((k0_) + vr) * ldv + vc); \
      if (FOX) st[i].ck = *reinterpret_cast<const f32x4*>(cum + (k0_) + ckc); } while (0)
#define SWRITE(b, i) do { *(bf16x8*)(K_lds + (b) * SHM_K + KSWZ(kr0, kc0 * 16)) = st[i].k0; \
      if (k2) *(bf16x8*)(K_lds + (b) * SHM_K + KSWZ(kr1, kc1 * 16)) = st[i].k1; \
      *(bf16x8*)(V_lds + (b) * SHM_V + vst) = st[i].v; \
      if (FOX && tid < 16) *(f32x4*)(CK_lds + (b) * 64 + tid * 4) = st[i].ck; } while (0)
#define RESC(a) do { if (TRACK && __any((a) < 1.f)) { if (hi == 0) al_l[r32] = (a); asm volatile("s_waitcnt lgkmcnt(0)" ::: "memory"); \
      _Pragma("unroll") for (int d = 0; d < 2; ++d) _Pragma("unroll") for (int r = 0; r < 16; ++r) o[d][r] *= al_l[crow(r, hi)]; } } while (0)
    const int NT = (q0 + 256) / KVBLK;
    const int tlast = __builtin_amdgcn_readfirstlane((q0 + wid * QBLK + (FOX ? 31 : 0)) >> 6);
    int tfirst = 0;
    if (FOX && TRACK) { const float c0w = cum[q0 + wid * QBLK]; bool need = false; const int nbw = (q0 + wid * QBLK) >> 6;
        if (lane < nbw) need = (sbound + c0w - cum[64 * lane + 63] >= -40.f);
        const unsigned long long bal = __ballot(need);
        tfirst = __builtin_amdgcn_readfirstlane(bal ? (__ffsll((long long)bal) - 1) : nbw); }
    auto qkt = [&](f32x16& p0, f32x16& p1, int b, int t) {
        if (t > tlast || t < tfirst) return;
        const char* Ks = K_lds + b * SHM_K;
        if (FOX) { const float* ck = CK_lds + b * 64; const float cqm = TRACK ? cq - m_reg : cq;
#pragma unroll
            for (int g = 0; g < 4; ++g) { const f32x4 c0 = *(const f32x4*)(ck + 8 * g + 4 * hi), c1 = *(const f32x4*)(ck + 32 + 8 * g + 4 * hi);
#pragma unroll
                for (int i = 0; i < 4; ++i) { p0[4 * g + i] = cqm - c0[i]; p1[4 * g + i] = cqm - c1[i]; } }
        } else if (TRACK) { const float nm = -m_reg;
#pragma unroll
            for (int r = 0; r < 16; ++r) { p0[r] = nm; p1[r] = nm; } }
        else { p0 = f32x16{}; p1 = f32x16{}; }
#pragma unroll
        for (int d0 = 0; d0 < ND; ++d0) { const int cb = (d0 * 16 + hi * 8) * 2;
            const bf16x8 b0 = *reinterpret_cast<const bf16x8*>(Ks + KSWZ(r32, cb));
            const bf16x8 b1 = *reinterpret_cast<const bf16x8*>(Ks + KSWZ(32 + r32, cb));
            p0 = __builtin_amdgcn_mfma_f32_32x32x16_bf16(b0, qr[d0], p0, 0, 0, 0);
            p1 = __builtin_amdgcn_mfma_f32_32x32x16_bf16(b1, qr[d0], p1, 0, 0, 0); }
        if (FOX && t >= NT - 4) {
            asm volatile("" ::: "memory");
            const int kb = t * KVBLK + 4 * hi;
#pragma unroll
            for (int r = 0; r < 16; ++r) { const int kv = kb + (r & 3) + 8 * (r >> 2);
                if (kv > qrow) p0[r] = -INFINITY; if (kv + 32 > qrow) p1[r] = -INFINITY; }
        }
    };
#define PSM(P0, P1, AL, t) do { if (TRACK) { if ((t) <= tlast && (t) >= tfirst) partialSM(P0, P1, m_reg, AL); else AL = 1.f; } else if ((t) <= tlast && (t) >= tfirst) expHalf(P0); } while (0)
#define FSM(P0, P1, AL, t) do { if ((t) <= tlast && (t) >= tfirst) { if (TRACK) finishSM(P0, P1, AL, l_reg, pa0, pa1, pa2, pa3); else { expHalf(P1); sumP(P0, P1, l_reg); packP(P0, P1, pa0, pa1, pa2, pa3); } } } while (0)
#define PV(vb, t) do { if ((t) <= tlast && (t) >= tfirst) { pv_one<0>(o[0], vb, pa0, pa1, pa2, pa3); pv_one<1>(o[1], vb, pa0, pa1, pa2, pa3); } } while (0)
    f32x16 pA0, pA1, pB0, pB1; float alA, alB; bf16x8 pa0, pa1, pa2, pa3;
#define PKV(L, H) (bf16x8){L[0], L[1], L[2], L[3], H[0], H[1], H[2], H[3]}
#define SG_R1_STEP(nr) SG(SG_MFMA, 1); SG(SG_VALU, FOX ? 10 : 7); SG(SG_DSR, nr)
#define TRA(OFF) tr_read<OFF>(vbp_)
#define FAST_HALF(X0, X1, Y0, Y1, LOADSTMT, WRITESTMT) do { \
        SBAR(); \
        { const char* Ks = K_lds + bc * SHM_K; \
          if (FOX) { const float* ck = CK_lds + bc * 64; \
              _Pragma("unroll") for (int g = 0; g < 4; ++g) { const f32x4 c0 = *(const f32x4*)(ck + 8 * g + 4 * hi), c1 = *(const f32x4*)(ck + 32 + 8 * g + 4 * hi); \
                  _Pragma("unroll") for (int i = 0; i < 4; ++i) { X0[4 * g + i] = cq - c0[i]; X1[4 * g + i] = cq - c1[i]; } } } \
          else { X0 = f32x16{}; X1 = f32x16{}; } \
          _Pragma("unroll") for (int d0 = 0; d0 < ND; ++d0) { const int cb = (d0 * 16 + hi * 8) * 2; \
              const bf16x8 b0 = *reinterpret_cast<const bf16x8*>(Ks + KSWZ(r32, cb)); \
              const bf16x8 b1 = *reinterpret_cast<const bf16x8*>(Ks + KSWZ(32 + r32, cb)); \
              X0 = __builtin_amdgcn_mfma_f32_32x32x16_bf16(b0, qr[d0], X0, 0, 0, 0); \
              X1 = __builtin_amdgcn_mfma_f32_32x32x16_bf16(b1, qr[d0], X1, 0, 0, 0); } } \
        expHalf(Y1); sumP(Y0, Y1, l_reg); packP(Y0, Y1, pa0, pa1, pa2, pa3); \
        if (FOX) { SG(SG_DSR, 12); SG(SG_VALU, 32); SG_R1_STEP(1); SG_R1_STEP(1); SG_R1_STEP(1); SG_R1_STEP(1); SG_R1_STEP(0); SG_R1_STEP(0); SG_R1_STEP(0); SG_R1_STEP(0); } \
        else { SG(SG_DSR, 4); SG_R1_STEP(1); SG_R1_STEP(1); SG_R1_STEP(1); SG_R1_STEP(1); SG_R1_STEP(1); SG_R1_STEP(1); SG_R1_STEP(1); SG_R1_STEP(1); SG_R1_STEP(0); SG_R1_STEP(0); SG_R1_STEP(0); SG_R1_STEP(0); } \
        asm volatile("" : "+v"(X0), "+v"(X1), "+v"(pa0), "+v"(pa1), "+v"(pa2), "+v"(pa3), "+v"(l_reg));     \
        const int vbp_ = vb0 + bp * SHM_V; \
        const s16x4 va0 = TRA(v_rd_off(0, 0, 0)), va1 = TRA(v_rd_off(0, 0, 1)), va2 = TRA(v_rd_off(0, 1, 0)), va3 = TRA(v_rd_off(0, 1, 1)); \
        const s16x4 va4 = TRA(v_rd_off(0, 2, 0)), va5 = TRA(v_rd_off(0, 2, 1)), va6 = TRA(v_rd_off(0, 3, 0)), va7 = TRA(v_rd_off(0, 3, 1)); \
        SBAR(); \
        LOADSTMT; \
        asm volatile("s_waitcnt lgkmcnt(0)" ::: "memory"); SBAR(); \
        const s16x4 vc0 = TRA(v_rd_off(1, 0, 0)), vc1 = TRA(v_rd_off(1, 0, 1)), vc2 = TRA(v_rd_off(1, 1, 0)), vc3 = TRA(v_rd_off(1, 1, 1)); \
        const s16x4 vc4 = TRA(v_rd_off(1, 2, 0)), vc5 = TRA(v_rd_off(1, 2, 1)), vc6 = TRA(v_rd_off(1, 3, 0)), vc7 = TRA(v_rd_off(1, 3, 1)); \
        o[0] = __builtin_amdgcn_mfma_f32_32x32x16_bf16(pa0, PKV(va0, va1), o[0], 0, 0, 0); \
        o[0] = __builtin_amdgcn_mfma_f32_32x32x16_bf16(pa1, PKV(va2, va3), o[0], 0, 0, 0); \
        o[0] = __builtin_amdgcn_mfma_f32_32x32x16_bf16(pa2, PKV(va4, va5), o[0], 0, 0, 0); \
        o[0] = __builtin_amdgcn_mfma_f32_32x32x16_bf16(pa3, PKV(va6, va7), o[0], 0, 0, 0); \
        _Pragma("unroll") for (int r = 0; r < 8; ++r) X0[r] = __builtin_amdgcn_exp2f(X0[r]); \
        SGI(SG_MFMA, 1, 1); SGI(SG_VALU, 2, 1); SGI(SG_MFMA, 1, 1); SGI(SG_VALU, 2, 1); SGI(SG_MFMA, 1, 1); SGI(SG_VALU, 2, 1); SGI(SG_MFMA, 1, 1); SGI(SG_VALU, 2, 1); \
        asm volatile("" : "+v"(X0), "+v"(o[0])); \
        asm volatile("s_waitcnt lgkmcnt(0)" ::: "memory"); SBAR(); \
        o[1] = __builtin_amdgcn_mfma_f32_32x32x16_bf16(pa0, PKV(vc0, vc1), o[1], 0, 0, 0); \
        o[1] = __builtin_amdgcn_mfma_f32_32x32x16_bf16(pa1, PKV(vc2, vc3), o[1], 0, 0, 0); \
        o[1] = __builtin_amdgcn_mfma_f32_32x32x16_bf16(pa2, PKV(vc4, vc5), o[1], 0, 0, 0); \
        o[1] = __builtin_amdgcn_mfma_f32_32x32x16_bf16(pa3, PKV(vc6, vc7), o[1], 0, 0, 0); \
        _Pragma("unroll") for (int r = 8; r < 16; ++r) X0[r] = __builtin_amdgcn_exp2f(X0[r]); \
        SGI(SG_MFMA, 1, 2); SGI(SG_VALU, 2, 2); SGI(SG_MFMA, 1, 2); SGI(SG_VALU, 2, 2); SGI(SG_MFMA, 1, 2); SGI(SG_VALU, 2, 2); SGI(SG_MFMA, 1, 2); SGI(SG_VALU, 2, 2); \
        asm volatile("" : "+v"(X0), "+v"(o[1])); \
        SBAR(); \
        WRITESTMT; __syncthreads(); } while (0)
    SLOAD(0, T0 * KVBLK); SLOAD(1, (T0 + 1) * KVBLK); SBAR();
    SWRITE(0, 0); __syncthreads();
    qkt(pA0, pA1, 0, T0); PSM(pA0, pA1, alA, T0);
    SLOAD(0, (T0 + 2) * KVBLK); SBAR();
    SWRITE(1, 1); __syncthreads();
    int bp = 0, bc = 1, bn = 2;
    int j = T0 + 1;
    if (!TRACK) {
        const int JF = FOX ? NT - 5 : NT - 4;
        for (; j + 1 <= JF; j += 2) {
            FAST_HALF(pB0, pB1, pA0, pA1, SLOAD(1, (j + 2) * KVBLK), SWRITE(bn, 0));
            { const int t_ = bp; bp = bc; bc = bn; bn = t_; }
            FAST_HALF(pA0, pA1, pB0, pB1, SLOAD(0, (j + 3) * KVBLK), SWRITE(bn, 1));
            { const int t_ = bp; bp = bc; bc = bn; bn = t_; }
        }
    }
    for (; j + 1 < NT; j += 2) {
        SBAR(); qkt(pB0, pB1, bc, j);
        FSM(pA0, pA1, alA, j - 1); SBAR();
        SLOAD(1, (j + 2) * KVBLK); SBAR();
        PV(vb0 + bp * SHM_V, j - 1); PSM(pB0, pB1, alB, j);
        SWRITE(bn, 0);
        RESC(alB); __syncthreads();
        { const int t_ = bp; bp = bc; bc = bn; bn = t_; }
        SBAR(); qkt(pA0, pA1, bc, j + 1);
        FSM(pB0, pB1, alB, j); SBAR();
        if (j + 3 < NT) SLOAD(0, (j + 3) * KVBLK); SBAR();
        PV(vb0 + bp * SHM_V, j); PSM(pA0, pA1, alA, j + 1);
        SWRITE(bn, 1);
        RESC(alA); __syncthreads();
        { const int t_ = bp; bp = bc; bc = bn; bn = t_; }
    }
    SBAR(); qkt(pB0, pB1, bc, NT - 1);
    FSM(pA0, pA1, alA, NT - 2); SBAR();
    PV(vb0 + bp * SHM_V, NT - 2); PSM(pB0, pB1, alB, NT - 1);
    RESC(alB);
    FSM(pB0, pB1, alB, NT - 1); SBAR();
    PV(vb0 + bc * SHM_V, NT - 1);
#undef PSM
#undef FSM
#undef PV
#undef FAST_HALF
#undef TRA
#undef SG_R1_STEP
#undef PKV
    if (hi == 0) li_l[r32] = l_reg; asm volatile("s_waitcnt lgkmcnt(0)" ::: "memory");
    float rli[16];
#pragma unroll
    for (int r = 0; r < 16; ++r) rli[r] = __builtin_amdgcn_rcpf(li_l[crow(r, hi)]);
    { bf16_t* stg = (bf16_t*)(lds + LDS_OST) + wid * 2048;
#pragma unroll
      for (int r = 0; r < 16; ++r) { const int orow = crow(r, hi);
#pragma unroll
          for (int d0 = 0; d0 < 2; ++d0) stg[orow * 64 + d0 * 32 + r32] = f2bf(o[d0][r] * rli[r]); }
      asm volatile("s_waitcnt lgkmcnt(0)" ::: "memory");
      bf16_t* Ow = Qh + (size_t)(q0 + wid * QBLK) * ldq;
#pragma unroll
      for (int i = 0; i < 4; ++i) { const int row = i * 8 + (lane >> 3), ch = lane & 7; const u32x4 v = *(const u32x4*)(stg + row * 64 + ch * 8); if (!dry) *(u32x4*)(Ow + (size_t)row * ldq + ch * 8) = v; } }
    __syncthreads();
#undef SLOAD
#undef SWRITE
#undef RESC
}
}

__device__ __forceinline__ int map_in(int n) {
    if (n < 416) return n;
    if (n < 424) return 1952 + (n - 416);
    if (n < 512) return -1;
    if (n < 2048) return n - 512 + 416;
    if (n < 2560) return n - 2048 + 1960;
    if (n < 4096) return n - 2560 + 2472;
    return n - 4096 + 4008;
}
struct ConvD { const float* src; const float* kscale; bf16_t* dst; int ldsrc, K, N, dld, item; bool split512, mapped; };
__device__ __forceinline__ void conv_load(const ConvD& d, int lane, float (&x)[32], float& ks) {
    const int nblk = d.N / 32, kb = d.item / nblk, nb = d.item % nblk, k0 = 64 * kb, n0 = 32 * nb;
    const int sn = d.mapped ? map_in(n0 + (lane & 31)) : n0 + (lane & 31);
#pragma unroll
    for (int i = 0; i < 32; ++i) { const int kk = 2 * i + (lane >> 5); float v = 0.f; if (sn >= 0) v = __builtin_nontemporal_load(d.src + (size_t)(k0 + kk) * d.ldsrc + sn); x[i] = v; }
    ks = d.kscale ? d.kscale[k0 + lane] : 1.f;
}
__device__ __forceinline__ void conv_finish(const ConvD& d, LAS float* scr, int lane, const float (&x)[32], const float ks) {
    const int nblk = d.N / 32, kb = d.item / nblk, nb = d.item % nblk, k0 = 64 * kb, n0 = 32 * nb;
#pragma unroll
    for (int i = 0; i < 32; ++i) { const float s0 = __uint_as_float(__builtin_amdgcn_readlane(__float_as_uint(ks), 2 * i)), s1 = __uint_as_float(__builtin_amdgcn_readlane(__float_as_uint(ks), 2 * i + 1));
        scr[(2 * i + (lane >> 5)) * 33 + (lane & 31)] = x[i] * ((lane >> 5) ? s1 : s0); }
    asm volatile("s_waitcnt lgkmcnt(0)" ::: "memory");
    const int cch = lane & 7;
#pragma unroll
    for (int j = 0; j < 4; ++j) { const int n = (lane >> 3) + 8 * j; const LAS float* sp = scr + (8 * cch) * 33 + n;
        u32x4 o; o.x = pk_bf16(sp[0 * 33], sp[1 * 33]); o.y = pk_bf16(sp[2 * 33], sp[3 * 33]); o.z = pk_bf16(sp[4 * 33], sp[5 * 33]); o.w = pk_bf16(sp[6 * 33], sp[7 * 33]);
        bf16_t* dp = d.split512 ? (d.dst + ((size_t)(k0 >> 9) * d.N + n0 + n) * 512 + (k0 & 511) + 8 * cch) : (d.dst + (size_t)(n0 + n) * d.dld + k0 + 8 * cch);
        *(u32x4*)dp = o; }
    asm volatile("s_waitcnt lgkmcnt(0)" ::: "memory");
}
__device__ __forceinline__ void phase0(const Ctx& c, const int part) {
    PHASE_IDS(); ArgsP ap = get_args(); unsigned char* ws = ap->ws;
    const long gtid = (long)c.bid * 512 + tid, gthreads = (long)grid_g() * 512;
    const int gw = c.bid * 8 + wave, ngw = grid_g() * 8;
    LAS float* scr = (LAS float*)(c.lds + wave * 8448);
    constexpr int I_IN_ = 16 * 224, I_Q_ = 4 * 24, I_KV_ = 2 * 32, I_GLU_ = 8 * 16, I_BO_ = 8 * 32, I_OUT_ = 16 * 32, I_L = I_IN_ + I_Q_ + I_KV_ + I_GLU_ + 3 * I_BO_ + I_OUT_;
    auto conv_desc = [&](int it) -> ConvD { ConvD d; const int l = it / I_L; int r = it % I_L; d.kscale = nullptr; d.split512 = false; d.mapped = false;
        if (r < I_IN_) { d.src = ap->in[I_WIN] + (size_t)l * DM * IN_SRC; d.ldsrc = IN_SRC; d.K = DM; d.N = NIN; d.dst = (bf16_t*)(ws + WS_WIN) + (size_t)l * 2 * NIN * 512; d.dld = 512; d.split512 = true; d.mapped = true; d.kscale = ap->in[I_NORMG] + l * DM; d.item = r; return d; } r -= I_IN_;
        if (r < I_Q_) { d.src = ap->in[I_WQUP] + (size_t)l * 256 * 768; d.ldsrc = 768; d.K = 256; d.N = 768; d.dst = (bf16_t*)(ws + WS_WQ) + (size_t)l * 768 * 256; d.dld = 256; d.kscale = ap->in[I_QAN] + l * 256; d.item = r; return d; } r -= I_Q_;
        if (r < I_KV_) { d.src = ap->in[I_WKVUP] + (size_t)l * 128 * 1024; d.ldsrc = 1024; d.K = 128; d.N = 1024; d.dst = (bf16_t*)(ws + WS_WKV) + (size_t)l * 1024 * 256; d.dld = 256; d.kscale = ap->in[I_KVAN] + l * 128; d.item = r; return d; } r -= I_KV_;
        if (r < I_GLU_) { d.src = ap->in[I_WGLU] + (size_t)l * 512 * 512; d.ldsrc = 512; d.K = 512; d.N = 512; d.dst = (bf16_t*)(ws + WS_WGLU) + (size_t)l * 512 * 512; d.dld = 512; d.item = r; return d; } r -= I_GLU_;
        if (r < 3 * I_BO_) { const int br = r / I_BO_; d.src = ap->in[I_WBO] + ((size_t)l * 1536 + br * 512) * 1024; d.ldsrc = 1024; d.K = 512; d.N = 1024; d.dst = (bf16_t*)(ws + WS_WBO) + ((size_t)l * 3 + br) * 1024 * 512; d.dld = 512; d.item = r % I_BO_; return d; } r -= 3 * I_BO_;
        d.src = ap->in[I_WOUT] + (size_t)l * DM * DM; d.ldsrc = DM; d.K = DM; d.N = DM; d.dst = (bf16_t*)(ws + WS_WOUT) + (size_t)l * DM * DM; d.dld = DM; d.item = r; return d; };
    constexpr int N_A = 16 * 80, N_B = NL * I_L - N_A;
    auto item_of = [&](int idx) -> int { if (part == 0) return (idx / 80) * 224 + (idx % 80);
        return idx < 16 * 144 ? (idx / 144) * 224 + 80 + (idx % 144) : I_IN_ + (idx - 16 * 144); };
    const int n_items = part == 0 ? N_A : N_B;
    if (gw < n_items) {
        ConvD dc = conv_desc(item_of(gw)); float xc[32], kc; conv_load(dc, lane, xc, kc);
        for (int it = gw; it < n_items; it += ngw) {
            const int nit = it + ngw; const bool hn = nit < n_items;
            ConvD dn = dc; float xn[32], kn = 1.f;
#pragma unroll
            for (int i = 0; i < 32; ++i) xn[i] = 0.f;
            if (hn) { dn = conv_desc(item_of(nit)); conv_load(dn, lane, xn, kn); }
            SBAR();
            conv_finish(dc, scr, lane, xc, kc);
            dc = dn; kc = kn;
#pragma unroll
            for (int i = 0; i < 32; ++i) xc[i] = xn[i];
        }
    }
    if (part == 1) {
    for (long it = (wave == 1 ? (long)c.bid * 64 + lane : (long)NL * 32 * 64); it < NL * 32 * 64; it += (long)grid_g() * 64) {
        const int n = (int)(it & 63), g = (int)((it >> 6) & 31), l = (int)(it >> 11);
        const float dt = expf(ap->in[I_LDT][l * 32 + g]);
        const float lr = ap->in[I_LRE][(l * 32 + g) * 64 + n], li = ap->in[I_LIM][(l * 32 + g) * 64 + n];
        const float mag = expf(lr * dt), ang = li * dt;
        float rev = ang * 0.15915494309189535f; rev -= floorf(rev);
        const float are = mag * __builtin_amdgcn_cosf(rev), aim = mag * __builtin_amdgcn_sinf(rev);
        float pr = are, pi = aim;
#pragma unroll
        for (int s = 0; s < 6; ++s) { const float nr = pr * pr - pi * pi, ni = 2.f * pr * pi; pr = nr; pi = ni; }
        ((f32x4*)(ws + WS_TA))[it] = (f32x4){are, aim, pr, pi};
        const float den = lr * lr + li * li;
        const float fre = ((are - 1.f) * lr + aim * li) / den, fim = (aim * lr - (are - 1.f) * li) / den;
        const float* bre = ap->in[I_BRE] + it * 16; const float* bim = ap->in[I_BIM] + it * 16;
        float bbr[16], bbi[16];
#pragma unroll
        for (int cc = 0; cc < 16; ++cc) { const float br = bre[cc], bi = bim[cc]; bbr[cc] = fre * br - fim * bi; bbi[cc] = fre * bi + fim * br; }
        { const int nre = (n < 32) ? n : 64 + (n - 32), nim = nre + 32; bf16_t* tb = (bf16_t*)(ws + WS_TBB) + (size_t)(l * 32 + g) * 128 * 16;
          u32x4 w0, w1;
          w0.x = pk_bf16(bbr[0], bbr[1]); w0.y = pk_bf16(bbr[2], bbr[3]); w0.z = pk_bf16(bbr[4], bbr[5]); w0.w = pk_bf16(bbr[6], bbr[7]);
          w1.x = pk_bf16(bbr[8], bbr[9]); w1.y = pk_bf16(bbr[10], bbr[11]); w1.z = pk_bf16(bbr[12], bbr[13]); w1.w = pk_bf16(bbr[14], bbr[15]);
          *(u32x4*)(tb + nre * 16) = w0; *(u32x4*)(tb + nre * 16 + 8) = w1;
          w0.x = pk_bf16(bbi[0], bbi[1]); w0.y = pk_bf16(bbi[2], bbi[3]); w0.z = pk_bf16(bbi[4], bbi[5]); w0.w = pk_bf16(bbi[6], bbi[7]);
          w1.x = pk_bf16(bbi[8], bbi[9]); w1.y = pk_bf16(bbi[10], bbi[11]); w1.z = pk_bf16(bbi[12], bbi[13]); w1.w = pk_bf16(bbi[14], bbi[15]);
          *(u32x4*)(tb + nim * 16) = w0; *(u32x4*)(tb + nim * 16 + 8) = w1; }
        { bf16_t* tc = (bf16_t*)(ws + WS_TC) + (size_t)(l * 32 + g) * 16 * 128;
#pragma unroll
          for (int cc = 0; cc < 16; ++cc) { const float cr = ap->in[I_CRE][((size_t)(l * 32 + g) * 16 + cc) * 64 + n], ci = ap->in[I_CIM][((size_t)(l * 32 + g) * 16 + cc) * 64 + n];
              *(unsigned*)(tc + cc * 128 + 2 * n) = pk_bf16(cr, -ci); } }
    }
    }
    if (part == 0) { const float* x = ap->in[I_X]; bf16_t* XG = (bf16_t*)(ws + WS_XG); float* ss = (float*)(ws + WS_SS);
      f32x4 nxv[4];
      const int gwv = c.vb * 8 + wave; const bool g256 = grid_g() == 256; const int row_b = g256 ? gwv * 8 : gw, row_s = g256 ? 1 : ngw, row_e = g256 ? gwv * 8 + 8 : T_;
#pragma unroll
      for (int j = 0; j < 4; ++j) nxv[j] = __builtin_nontemporal_load((const f32x4*)(x + (size_t)(row_b < T_ ? row_b : 0) * DM + j * 256 + lane * 4));
      for (int row = row_b; row < row_e; row += row_s) { float s = 0.f; f32x4 v[4];
#pragma unroll
          for (int j = 0; j < 4; ++j) v[j] = nxv[j];
          { const int nrow = (row + row_s < row_e) ? row + row_s : row;
#pragma unroll
            for (int j = 0; j < 4; ++j) nxv[j] = __builtin_nontemporal_load((const f32x4*)(x + (size_t)nrow * DM + j * 256 + lane * 4)); }
          SBAR();
#pragma unroll
          for (int j = 0; j < 4; ++j) { const int col = j * 256 + lane * 4;
              s += (v[j][0] * v[j][0] + v[j][1] * v[j][1]) + (v[j][2] * v[j][2] + v[j][3] * v[j][3]);
              u32x2 w; w.x = pk_bf16(v[j][0], v[j][1]); w.y = pk_bf16(v[j][2], v[j][3]);
              *(u32x2*)(XG + ((size_t)(col >> 9) * T_ + row) * 512 + (col & 511)) = w; }
          s = wave_sum(s); if (lane == 0) ss[row] = s; }
      for (long i = gtid; i < T_; i += gthreads) ss[T_ + i] = 0.f;
      for (long i = gtid; i < 2 * NL * T_; i += gthreads) ((float*)(ws + WS_SSQ))[i] = 0.f;
      for (long i = gtid; i < 8 * 3456; i += gthreads) ((unsigned*)(ws + WS_PBAR))[i] = 0u;
      for (long i = gtid; i < (long)NL * 1024 * 16; i += gthreads) *(u32x4*)((bf16_t*)(ws + WS_WKV) + (i >> 4) * 256 + 128 + (i & 15) * 8) = (u32x4){0u, 0u, 0u, 0u}; }
}

struct S5Coef { float a1r, a1i, a2r, a2i, a3r, a3i, a4r, a4i; };
__device__ __forceinline__ S5Coef s5_coef(float ar, float ai) { S5Coef q; q.a1r = ar; q.a1i = ai; q.a2r = ar * ar - ai * ai; q.a2i = 2.f * ar * ai; q.a3r = q.a2r * ar - q.a2i * ai; q.a3i = q.a2r * ai + q.a2i * ar; q.a4r = q.a2r * q.a2r - q.a2i * q.a2i; q.a4i = 2.f * q.a2r * q.a2i; return q; }
__device__ __forceinline__ float other_half(float v, int hi) { auto rr = __builtin_amdgcn_permlane32_swap(__float_as_uint(v), __float_as_uint(v), false, false); return __uint_as_float(hi ? rr[0] : rr[1]); }
template <bool NEEDX>
__device__ __forceinline__ void s5_scan32(f32x16& xr, f32x16& xi, const S5Coef& q, float& sr, float& si, int hi) {
    float er[4], ei[4];
#pragma unroll
    for (int k = 0; k < 4; ++k) {
        const float r0 = xr[4 * k], i0 = xi[4 * k];
        const float r1 = q.a1r * r0 - q.a1i * i0 + xr[4 * k + 1], i1 = q.a1r * i0 + q.a1i * r0 + xi[4 * k + 1];
        const float r2 = q.a1r * r1 - q.a1i * i1 + xr[4 * k + 2], i2 = q.a1r * i1 + q.a1i * r1 + xi[4 * k + 2];
        const float r3 = q.a1r * r2 - q.a1i * i2 + xr[4 * k + 3], i3 = q.a1r * i2 + q.a1i * r2 + xi[4 * k + 3];
        if (NEEDX) { xr[4 * k + 1] = r1; xi[4 * k + 1] = i1; xr[4 * k + 2] = r2; xi[4 * k + 2] = i2; xr[4 * k + 3] = r3; xi[4 * k + 3] = i3; }
        er[k] = r3; ei[k] = i3;
    }
    float pr[4], pi[4];
#pragma unroll
    for (int k = 0; k < 4; ++k) {
        const float orr = other_half(er[k], hi), oii = other_half(ei[k], hi);
        const float e0r = hi ? orr : er[k], e0i = hi ? oii : ei[k], e1r = hi ? er[k] : orr, e1i = hi ? ei[k] : oii;
        const float p0r = sr, p0i = si;
        float nr = q.a4r * sr - q.a4i * si + e0r, ni = q.a4r * si + q.a4i * sr + e0i; sr = nr; si = ni;
        const float p1r = sr, p1i = si;
        nr = q.a4r * sr - q.a4i * si + e1r; ni = q.a4r * si + q.a4i * sr + e1i; sr = nr; si = ni;
        pr[k] = hi ? p1r : p0r; pi[k] = hi ? p1i : p0i;
    }
    if (NEEDX) {
#pragma unroll
        for (int k = 0; k < 4; ++k) {
            xr[4 * k + 0] += q.a1r * pr[k] - q.a1i * pi[k]; xi[4 * k + 0] += q.a1r * pi[k] + q.a1i * pr[k];
            xr[4 * k + 1] += q.a2r * pr[k] - q.a2i * pi[k]; xi[4 * k + 1] += q.a2r * pi[k] + q.a2i * pr[k];
            xr[4 * k + 2] += q.a3r * pr[k] - q.a3i * pi[k]; xi[4 * k + 2] += q.a3r * pi[k] + q.a3i * pr[k];
            xr[4 * k + 3] += q.a4r * pr[k] - q.a4i * pi[k]; xi[4 * k + 3] += q.a4r * pi[k] + q.a4i * pr[k];
        }
    }
}
constexpr int S5_XPITCH = 272, S5_XWAVE = 32 * S5_XPITCH;
template <bool FULL>
__device__ __forceinline__ void s5_pass(const Ctx& c, int l, bool dry) {
    PHASE_IDS(); ArgsP ap = get_args(); unsigned char* ws = ap->ws; bf16_t* P = (bf16_t*)(ws + WS_PROJ); const float* dsk = ap->in[I_S5D] + l * 512;
    const int cl = lane & 31, hi = lane >> 5;
    char* Xl = c.ldsg + wave * S5_XWAVE;
    const int gw = c.vb * 8 + wave, ngw = grid_g() * 8;
    for (int task = gw; task < NB_ * 32 * 8; task += ngw) {
        const int g = task & 31, q8 = (task >> 5) & 7, b = task >> 8;
        const int tb0 = (l * 32 + g) * 64;
        const f32x4 taA = ((const f32x4*)(ws + WS_TA))[tb0 + cl], taB = ((const f32x4*)(ws + WS_TA))[tb0 + 32 + cl];
        const S5Coef qA = s5_coef(taA[0], taA[1]), qB = s5_coef(taB[0], taB[1]);
        bf16x8 bbf[4];
        { const bf16_t* tbb = (const bf16_t*)(ws + WS_TBB) + (size_t)(l * 32 + g) * 128 * 16;
#pragma unroll
          for (int blk = 0; blk < 4; ++blk) bbf[blk] = *(const bf16x8*)(tbb + (blk * 32 + cl) * 16 + 8 * hi); }
        float sAr = 0.f, sAi = 0.f, sBr = 0.f, sBi = 0.f;
        bf16x8 cm[4];
        if (FULL) {
            const bf16_t* tcm = (const bf16_t*)(ws + WS_TC) + (size_t)(l * 32 + g) * 16 * 128;
#pragma unroll
            for (int ks = 0; ks < 4; ++ks) cm[ks] = *(const bf16x8*)(tcm + (lane & 15) * 128 + ks * 32 + 8 * (lane >> 4));
            const f32x2* Ep = (const f32x2*)(ws + WS_E) + ((size_t)(b * 32) * 32 + g) * 64;
            const int nprev = 4 * q8;
            for (int j0 = 0; j0 < nprev; j0 += 8) {
                f32x2 eA[8], eB[8];
#pragma unroll
                for (int i = 0; i < 8; ++i) { const int cp = (j0 + i < nprev) ? j0 + i : 0; eA[i] = Ep[(size_t)cp * 2048 + cl]; eB[i] = Ep[(size_t)cp * 2048 + 32 + cl]; }
#pragma unroll
                for (int i = 0; i < 8; ++i) if (j0 + i < nprev) {
                    float nr = taA[2] * sAr - taA[3] * sAi + eA[i][0], ni = taA[2] * sAi + taA[3] * sAr + eA[i][1]; sAr = nr; sAi = ni;
                    nr = taB[2] * sBr - taB[3] * sBi + eB[i][0]; ni = taB[2] * sBi + taB[3] * sBr + eB[i][1]; sBr = nr; sBi = ni; }
            }
        }
        const f32x4 dv = *(const f32x4*)(dsk + 16 * g + 4 * (lane >> 4));
        const size_t ubase = (size_t)(b * S_ + 4 * q8 * 64 + cl) * NPROJ + 2048 + 16 * g + 8 * hi;
        bf16x8 ua_n = *(const bf16x8*)(P + ubase);
        const size_t uebase = (size_t)(b * S_ + 4 * q8 * 64 + (lane & 15)) * NPROJ + 2048 + 16 * g + 4 * (lane >> 4);
        for (int i8 = 0; i8 < 8; ++i8) {
            const bf16x8 ua = ua_n;
            if (i8 < 7) ua_n = *(const bf16x8*)(P + ubase + (size_t)(i8 + 1) * 32 * NPROJ);
            u32x2 ue0 = (u32x2){0u, 0u}, ue1 = (u32x2){0u, 0u};
            if (FULL) { ue0 = *(const u32x2*)(P + uebase + (size_t)i8 * 32 * NPROJ); ue1 = *(const u32x2*)(P + uebase + (size_t)(i8 * 32 + 16) * NPROJ); }
            const int ch = 4 * q8 + (i8 >> 1), rb = i8 & 1, tok0 = b * S_ + ch * 64;
            if (!FULL && rb == 0) { sAr = 0.f; sAi = 0.f; sBr = 0.f; sBi = 0.f; }
            f32x16 bu0 = __builtin_amdgcn_mfma_f32_32x32x16_bf16(ua, bbf[0], f32x16{}, 0, 0, 0);
            f32x16 bu1 = __builtin_amdgcn_mfma_f32_32x32x16_bf16(ua, bbf[1], f32x16{}, 0, 0, 0);
            f32x16 bu2 = __builtin_amdgcn_mfma_f32_32x32x16_bf16(ua, bbf[2], f32x16{}, 0, 0, 0);
            f32x16 bu3 = __builtin_amdgcn_mfma_f32_32x32x16_bf16(ua, bbf[3], f32x16{}, 0, 0, 0);
            s5_scan32<FULL>(bu0, bu1, qA, sAr, sAi, hi);
            s5_scan32<FULL>(bu2, bu3, qB, sBr, sBi, hi);
            if (FULL) {
#pragma unroll
                for (int r = 0; r < 16; ++r) { const int t = (r & 3) + 8 * (r >> 2) + 4 * hi;
                    *(unsigned*)(Xl + t * S5_XPITCH + 4 * cl) = pk_bf16(bu0[r], bu1[r]);
                    *(unsigned*)(Xl + t * S5_XPITCH + 128 + 4 * cl) = pk_bf16(bu2[r], bu3[r]); }
                asm volatile("s_waitcnt lgkmcnt(0)" ::: "memory");
#pragma unroll
                for (int tb = 0; tb < 2; ++tb) {
                    f32x4 y = (f32x4){0.f, 0.f, 0.f, 0.f};
#pragma unroll
                    for (int ks = 0; ks < 4; ++ks) { const bf16x8 xb = *(const bf16x8*)(Xl + (16 * tb + (lane & 15)) * S5_XPITCH + (ks * 32 + 8 * (lane >> 4)) * 2);
                        y = __builtin_amdgcn_mfma_f32_16x16x32_bf16(cm[ks], xb, y, 0, 0, 0); }
                    const int q4 = lane >> 4;
                    const size_t tokz = (size_t)(tok0 + rb * 32 + tb * 16 + (lane & 15));
                    bf16_t* zp = (bf16_t*)(ws + WS_Z) + tokz * 512 + 16 * g + 4 * q4;
                    const u32x2 uu = tb ? ue1 : ue0;
                    const float y0 = y[0] + dv[0] * bf_lo(uu.x), y1 = y[1] + dv[1] * bf_hi(uu.x), y2 = y[2] + dv[2] * bf_lo(uu.y), y3 = y[3] + dv[3] * bf_hi(uu.y);
                    u32x2 w; w.x = pk_bf16(gelu_tanh(y0), gelu_tanh(y1)); w.y = pk_bf16(gelu_tanh(y2), gelu_tanh(y3));
                    if (!dry) *(u32x2*)zp = w;
                }
                asm volatile("s_waitcnt lgkmcnt(0)" ::: "memory");
            }
            if (!FULL && rb == 1) { if (hi == 0) { f32x2* Eo = (f32x2*)(ws + WS_E) + (size_t)((b * 32 + ch) * 32 + g) * 64; Eo[cl] = (f32x2){sAr, sAi}; Eo[32 + cl] = (f32x2){sBr, sBi}; } }
        }
    }
}

__device__ __forceinline__ void unpack8(const u32x4 w, float (&v)[8]) { v[0] = bf_lo(w.x); v[1] = bf_hi(w.x); v[2] = bf_lo(w.y); v[3] = bf_hi(w.y); v[4] = bf_lo(w.z); v[5] = bf_hi(w.z); v[6] = bf_lo(w.w); v[7] = bf_hi(w.w); }
__device__ __forceinline__ u32x4 pack8(const float (&v)[8]) { u32x4 w; w.x = pk_bf16(v[0], v[1]); w.y = pk_bf16(v[2], v[3]); w.z = pk_bf16(v[4], v[5]); w.w = pk_bf16(v[6], v[7]); return w; }
__device__ __forceinline__ void prep_phase(const Ctx& c, int l, bool dry) {
    PHASE_IDS(); ArgsP ap = get_args(); unsigned char* ws = ap->ws;

    bf16_t* P = (bf16_t*)(ws + WS_PROJ); bf16_t* QUP = (bf16_t*)(ws + WS_QUP); bf16_t* KVUP = (bf16_t*)(ws + WS_KVUP); bf16_t* KM = (bf16_t*)(ws + WS_KM);
    if (wave == 0) for (int bq = (grid_g() == 256) ? ((c.bid >> 3) < 8 ? (c.bid & 7) * 8 + (c.bid >> 3) : 64) : c.bid; bq < 64; bq += grid_g()) {
        const int bh = bq, b = bh >> 3, h = bh & 7; const float bf = ap->in[I_FBF][l * 8 + h];
        const float* ff = (const float*)(ws + WS_FF32) + (size_t)(b * S_) * 8 + h; float* cum = (float*)(ws + WS_CUM) + (size_t)bh * S_;
        float xv[32];
#pragma unroll
        for (int it = 0; it < 32; ++it) xv[it] = ff[(size_t)(it * 64 + lane) * 8];
        float carry = 0.f;
#pragma unroll
        for (int it = 0; it < 32; ++it) { const float xx = xv[it] + bf;
            float v = fminf(xx, 0.f) - log1pf(__expf(-fabsf(xx)));
            v += __builtin_bit_cast(float, __builtin_amdgcn_update_dpp(0, __builtin_bit_cast(int, v), 0x111, 0xF, 0xF, false));
            v += __builtin_bit_cast(float, __builtin_amdgcn_update_dpp(0, __builtin_bit_cast(int, v), 0x112, 0xF, 0xF, false));
            v += __builtin_bit_cast(float, __builtin_amdgcn_update_dpp(0, __builtin_bit_cast(int, v), 0x114, 0xF, 0xF, false));
            v += __builtin_bit_cast(float, __builtin_amdgcn_update_dpp(0, __builtin_bit_cast(int, v), 0x118, 0xF, 0xF, false));
            const int iv = __builtin_bit_cast(int, v);
            const float t0 = __builtin_bit_cast(float, __builtin_amdgcn_readlane(iv, 15)), t1 = __builtin_bit_cast(float, __builtin_amdgcn_readlane(iv, 31));
            const float t2 = __builtin_bit_cast(float, __builtin_amdgcn_readlane(iv, 47)), t3 = __builtin_bit_cast(float, __builtin_amdgcn_readlane(iv, 63));
            const int rw = lane >> 4;
            v += carry + (rw == 1 ? t0 : rw == 2 ? t0 + t1 : rw == 3 ? (t0 + t1) + t2 : 0.f);
            if (!dry) cum[it * 64 + lane] = v * LOG2E;
            carry += ((t0 + t1) + t2) + t3; }
    }
    const float* qn = ap->in[I_MQN] + l * 96; const float* kn = ap->in[I_MKN] + l * 96; const float* fqn = ap->in[I_FQN] + l * 64; const float* fkn = ap->in[I_FKN] + l * 64;
    const int* pos = (const int*)ap->in[I_POS];
    const int hd = lane >> 3, j = lane & 7;
    const float QSC = 0.10206207261596575f * LOG2E, FSC = 0.125f * LOG2E;
    const int gw = c.vb * 8 + wave, ngw = grid_g() * 8;
    const bool g256 = grid_g() == 256;
    const int row_b = g256 ? gw * 8 : gw, row_s = g256 ? 1 : ngw, row_e = g256 ? gw * 8 + 8 : T_;
    float gq[12], gk[12], gfq[8], gfk[8];
#pragma unroll
    for (int e = 0; e < 8; ++e) { gq[e] = qn[8 * j + e]; gk[e] = kn[8 * j + e]; gfq[e] = fqn[8 * j + e]; gfk[e] = fkn[8 * j + e]; }
    gq[8] = qn[64 + 2 * j]; gq[9] = qn[65 + 2 * j]; gq[10] = qn[80 + 2 * j]; gq[11] = qn[81 + 2 * j];
    gk[8] = kn[64 + 2 * j]; gk[9] = kn[65 + 2 * j]; gk[10] = kn[80 + 2 * j]; gk[11] = kn[81 + 2 * j];
    struct PrepIn { float pf; u32x4 q; unsigned q1, q2; u32x4 k; unsigned p1, p2; u32x4 fq, fk; };
    auto prep_load = [&](int row) -> PrepIn { PrepIn r_;
        const bf16_t* pr = P + (size_t)row * NPROJ; const bf16_t* qp = QUP + (size_t)row * 768 + 96 * hd; const bf16_t* kp = KM + (size_t)row * 768 + 96 * hd;
        r_.pf = (float)pos[row];
        r_.q = *(const u32x4*)(qp + 8 * j); r_.q1 = *(const unsigned*)(qp + 64 + 2 * j); r_.q2 = *(const unsigned*)(qp + 80 + 2 * j);
        r_.k = *(const u32x4*)(kp + 8 * j);
        r_.p1 = *(const unsigned*)(pr + 384 + 2 * j); r_.p2 = *(const unsigned*)(pr + 400 + 2 * j);
        r_.fq = *(const u32x4*)(pr + 512 + 64 * hd + 8 * j); r_.fk = *(const u32x4*)(pr + 1024 + 64 * hd + 8 * j); return r_; };
    PrepIn nx_ = prep_load(row_b < T_ ? row_b : 0);
    for (int row = row_b; row < row_e; row += row_s) {
        bf16_t* pr = P + (size_t)row * NPROJ;
        bf16_t* qp = QUP + (size_t)row * 768 + 96 * hd; bf16_t* ko = KM + (size_t)row * 768 + 96 * hd;
        bf16_t* fqp = pr + 512 + 64 * hd + 8 * j; bf16_t* fkp = pr + 1024 + 64 * hd + 8 * j;
        const PrepIn in_ = nx_;
        { const int nrow = row + row_s; nx_ = prep_load(nrow < row_e ? nrow : row); }
        SBAR();
        const float pf = in_.pf;
        const u32x4 l_q = in_.q; const unsigned l_q1 = in_.q1, l_q2 = in_.q2;
        const u32x4 l_k = in_.k; const unsigned l_p1 = in_.p1, l_p2 = in_.p2;
        const u32x4 l_fq = in_.fq, l_fk = in_.fk;
        float cs[2], sn[2];
#pragma unroll
        for (int e = 0; e < 2; ++e) { const int i = 2 * j + e; const float inv = exp2f(-(float)i * (13.287712379549449f / 16.f)); const float ang = pf * inv;
            float rev = ang * 0.15915494309189535f; rev -= floorf(rev); cs[e] = __builtin_amdgcn_cosf(rev); sn[e] = __builtin_amdgcn_sinf(rev); }
        u32x4 o_q, o_k, o_fq, o_fk; unsigned o_q1, o_q2, o_k1, o_k2;
        { float v[8]; unpack8(l_q, v);
          const float x1[2] = {bf_lo(l_q1), bf_hi(l_q1)}, x2[2] = {bf_lo(l_q2), bf_hi(l_q2)};
          float ssq = 0.f;
#pragma unroll
          for (int e = 0; e < 8; ++e) ssq += v[e] * v[e];
          float r1[2], r2[2];
#pragma unroll
          for (int e = 0; e < 2; ++e) { r1[e] = x1[e] * cs[e] - x2[e] * sn[e]; r2[e] = x1[e] * sn[e] + x2[e] * cs[e]; ssq += r1[e] * r1[e] + r2[e] * r2[e]; }
          const float rn = rsqrtf(sum8(ssq) * (1.f / 96) + EPS) * QSC;
#pragma unroll
          for (int e = 0; e < 8; ++e) v[e] *= rn * gq[e];
          o_q = pack8(v);
          o_q1 = pk_bf16(r1[0] * rn * gq[8], r1[1] * rn * gq[9]);
          o_q2 = pk_bf16(r2[0] * rn * gq[10], r2[1] * rn * gq[11]); }
        { float v[8]; unpack8(l_k, v);
          const float x1[2] = {bf_lo(l_p1), bf_hi(l_p1)}, x2[2] = {bf_lo(l_p2), bf_hi(l_p2)};
          float ssq = 0.f;
#pragma unroll
          for (int e = 0; e < 8; ++e) ssq += v[e] * v[e];
          float r1[2], r2[2];
#pragma unroll
          for (int e = 0; e < 2; ++e) { r1[e] = x1[e] * cs[e] - x2[e] * sn[e]; r2[e] = x1[e] * sn[e] + x2[e] * cs[e]; ssq += r1[e] * r1[e] + r2[e] * r2[e]; }
          const float rn = rsqrtf(sum8(ssq) * (1.f / 96) + EPS);
#pragma unroll
          for (int e = 0; e < 8; ++e) v[e] *= rn * gk[e];
          o_k = pack8(v);
          o_k1 = pk_bf16(r1[0] * rn * gk[8], r1[1] * rn * gk[9]);
          o_k2 = pk_bf16(r2[0] * rn * gk[10], r2[1] * rn * gk[11]); }
        { float v[8]; unpack8(l_fq, v); float ssq = 0.f;
#pragma unroll
          for (int e = 0; e < 8; ++e) ssq += v[e] * v[e];
          const float rn = rsqrtf(sum8(ssq) * (1.f / 64) + EPS) * FSC;
#pragma unroll
          for (int e = 0; e < 8; ++e) v[e] *= rn * gfq[e];
          o_fq = pack8(v); }
        { float v[8]; unpack8(l_fk, v); float ssq = 0.f;
#pragma unroll
          for (int e = 0; e < 8; ++e) ssq += v[e] * v[e];
          const float rn = rsqrtf(sum8(ssq) * (1.f / 64) + EPS);
#pragma unroll
          for (int e = 0; e < 8; ++e) v[e] *= rn * gfk[e];
          o_fk = pack8(v); }
        if (!dry) {
            *(u32x4*)(qp + 8 * j) = o_q; *(unsigned*)(qp + 64 + 2 * j) = o_q1; *(unsigned*)(qp + 80 + 2 * j) = o_q2;
            *(u32x4*)(ko + 8 * j) = o_k; *(unsigned*)(ko + 64 + 2 * j) = o_k1; *(unsigned*)(ko + 80 + 2 * j) = o_k2;
            *(u32x4*)fqp = o_fq; *(u32x4*)fkp = o_fk;
        }
    }
}

__device__ __forceinline__ void attn_phase(const Ctx& c, int l, bool dry) {
    PHASE_IDS(); ArgsP ap = get_args(); unsigned char* ws = ap->ws;
    bf16_t* P = (bf16_t*)(ws + WS_PROJ); bf16_t* QUP = (bf16_t*)(ws + WS_QUP); const bf16_t* KVUP = (const bf16_t*)(ws + WS_KVUP); const bf16_t* KM = (const bf16_t*)(ws + WS_KM);
    const float* CUM = (const float*)(ws + WS_CUM);
    float sbound;
    { float mq = fabsf(ap->in[I_FQN][l * 64 + lane]), mk = fabsf(ap->in[I_FKN][l * 64 + lane]);
#pragma unroll
      for (int o = 1; o < 64; o <<= 1) { mq = fmaxf(mq, __shfl_xor(mq, o)); mk = fmaxf(mk, __shfl_xor(mk, o)); }
      sbound = 2.f * 1.05f * 8.f * LOG2E * mq * mk; }
    bool trackM, trackF = !(sbound <= 120.f);
    { float mq = lane < 48 ? fmaxf(fabsf(ap->in[I_MQN][l * 96 + lane]), fabsf(ap->in[I_MQN][l * 96 + 48 + lane])) : 0.f, mk = lane < 48 ? fmaxf(fabsf(ap->in[I_MKN][l * 96 + lane]), fabsf(ap->in[I_MKN][l * 96 + 48 + lane])) : 0.f;
#pragma unroll
      for (int o = 1; o < 64; o <<= 1) { mq = fmaxf(mq, __shfl_xor(mq, o)); mk = fmaxf(mk, __shfl_xor(mk, o)); }
      trackM = !(1.05f * 9.7979590f * LOG2E * mq * mk <= 60.f); }
    for (int L = c.vb; L < 256; L += grid_g()) {
        const int bh = (L >> 5) * 8 + (L & 7), p = (L >> 3) & 3, b = bh >> 3, h = bh & 7; const size_t r0 = (size_t)b * S_;
        const float* cum = CUM + (size_t)bh * S_;
        int T0f[2];
#pragma unroll
        for (int e = 0; e < 2; ++e) { const int q0 = (2 * p + e) * 256, nb = q0 >> 6; const float c0 = cum[q0]; bool need = false;
            if (lane < nb) need = (sbound + c0 - cum[64 * lane + 63] >= -40.f);
            const unsigned long long bal = __ballot(need);
            T0f[e] = __builtin_amdgcn_readfirstlane((bal ? (__ffsll((long long)bal) - 1) : nb) & ~1); }
        if (!trackM) {
#pragma unroll 1
            for (int e = 0; e < 2; ++e)
                attn::attn_unit<96, false, false>(QUP + r0 * 768 + 96 * h, 768, KM + r0 * 768 + 96 * h, 768, KVUP + r0 * 512 + 64 * h, 512, nullptr, (e ? p : 7 - p) * 256, c.ldsg, dry, 0.f, 0);
        } else {
#pragma unroll 1
            for (int e = 0; e < 2; ++e)
                attn::attn_unit<96, false, true>(QUP + r0 * 768 + 96 * h, 768, KM + r0 * 768 + 96 * h, 768, KVUP + r0 * 512 + 64 * h, 512, nullptr, (e ? p : 7 - p) * 256, c.ldsg, dry, 0.f, 0);
        }
        if (!trackF) {
#pragma unroll 1
            for (int e = 0; e < 2; ++e)
                attn::attn_unit<64, true, false>(P + r0 * NPROJ + 512 + 64 * h, NPROJ, P + r0 * NPROJ + 1024 + 64 * h, NPROJ, P + r0 * NPROJ + 1536 + 64 * h, NPROJ, cum, (2 * p + e) * 256, c.ldsg, dry, sbound, e ? T0f[1] : T0f[0]);
        } else {
#pragma unroll 1
            for (int e = 0; e < 2; ++e)
                attn::attn_unit<64, true, true>(P + r0 * NPROJ + 512 + 64 * h, NPROJ, P + r0 * NPROJ + 1024 + 64 * h, NPROJ, P + r0 * NPROJ + 1536 + 64 * h, NPROJ, cum, (2 * p + e) * 256, c.ldsg, dry, sbound, e ? T0f[1] : T0f[0]);
        }
    }
}

#if USE_XCD_BAR
#define XB_TMO      128
#define XB_XCNT(j)  (256  + 64 * (j))
#define XB_XSUB(j)  (1280 + 64 * (j))
#define XB_XGEN(j)  (2304 + 64 * (j))
#define XB_TOP      3328
#define XB_TOPGEN   3392
#define XCD_BAR_WORDS 3456
#define XB_SPIN_CAP (1u << 22)
__device__ __forceinline__ unsigned xb_ld(unsigned* p)              { return __hip_atomic_load(p, __ATOMIC_RELAXED, __HIP_MEMORY_SCOPE_AGENT); }
__device__ __forceinline__ unsigned xb_add(unsigned* p, unsigned v) { return __hip_atomic_fetch_add(p, v, __ATOMIC_RELAXED, __HIP_MEMORY_SCOPE_AGENT); }
__device__ __forceinline__ unsigned xb_xcc_id() { return (unsigned)__builtin_amdgcn_s_getreg((3 << 11) | 20) & 0xFu; }
#define XB_SPIN(cond, bar) do { unsigned _sp = 0; while (cond) { __builtin_amdgcn_s_sleep(1); \
    if ((++_sp & 255u) == 0u) { if (xb_ld(&(bar)[XB_TMO])) break; if (_sp > XB_SPIN_CAP) { atomicAdd(&(bar)[XB_TMO], 1u); break; } } } } while (0)
struct XcdBarrier { unsigned* bar; unsigned x; volatile LAS unsigned* st; unsigned nexp; };
__device__ __forceinline__ XcdBarrier xcd_barrier_post(unsigned* bar, volatile LAS unsigned* st, unsigned nexp) {
    XcdBarrier b; b.bar = bar; b.x = xb_xcc_id(); b.st = st; b.nexp = nexp;
    if (threadIdx.x == 0) (void)xb_add(&bar[XB_XCNT(b.x)], 1u);
    return b;
}
__device__ __forceinline__ void xcd_barrier_complete(unsigned* bar, unsigned x, unsigned G, unsigned& nloc, unsigned& nx) {
    unsigned sum, cnt, mine, sp = 0u;
    for (;;) {
        sum = 0u; cnt = 0u; mine = 0u;
#pragma unroll
        for (unsigned j = 0; j < 16; ++j) { const unsigned c = xb_ld(&bar[XB_XCNT(j)]); sum += c; cnt += (c > 0u) ? 1u : 0u; mine = (j == x) ? c : mine; }
        if (sum == G) break;
        __builtin_amdgcn_s_sleep(1);
        if ((++sp & 255u) == 0u) { if (xb_ld(&bar[XB_TMO])) break; if (sp > XB_SPIN_CAP) { atomicAdd(&bar[XB_TMO], 1u); break; } }
    }
    nloc = mine > 0u ? mine : 1u; nx = cnt > 0u ? cnt : 1u;
}
__device__ __forceinline__ void xcd_barrier(const XcdBarrier& b) {
    asm volatile("s_waitcnt vmcnt(0)" ::: "memory");
    __syncthreads();
    if (threadIdx.x == 0) {
        unsigned* bar = b.bar;
        __builtin_amdgcn_s_waitcnt(0);
        unsigned nloc = b.st[0], nx = b.st[1];
        if (nloc == 0u) { xcd_barrier_complete(bar, b.x, b.nexp, nloc, nx); b.st[0] = nloc; b.st[1] = nx; }
        const bool one_xcd = (nx == 1u) && (nloc == b.nexp);
        if (one_xcd) {
            const unsigned k = b.st[2]; b.st[2] = k + 1u;
            (void)__hip_atomic_fetch_add(&bar[XB_XSUB(b.x)], 1u, __ATOMIC_RELAXED, __HIP_MEMORY_SCOPE_AGENT);
            const unsigned target = (k + 1u) * nloc;
            XB_SPIN(xb_ld(&bar[XB_XSUB(b.x)]) < target, bar);
            asm volatile("s_waitcnt vmcnt(0)" ::: "memory");
        } else if (const unsigned old = xb_add(&bar[XB_XSUB(b.x)], 1u), gen = old / nloc; old + 1u == (gen + 1u) * nloc) {
            if (!one_xcd) __builtin_amdgcn_fence(__ATOMIC_RELEASE, "agent");
            asm volatile("s_waitcnt vmcnt(0)" ::: "memory");
            const unsigned og = xb_add(&bar[XB_TOP], 1u);
            const unsigned tg = og / nx;
            if (og + 1u == (tg + 1u) * nx) xb_add(&bar[XB_TOPGEN], 1u);
            else XB_SPIN(xb_ld(&bar[XB_TOPGEN]) == tg, bar);
            if (!one_xcd) __builtin_amdgcn_fence(__ATOMIC_ACQUIRE, "agent");
            xb_add(&bar[XB_XGEN(b.x)], 1u);
            asm volatile("s_waitcnt vmcnt(0)" ::: "memory");
        } else {
            XB_SPIN(xb_ld(&bar[XB_XGEN(b.x)]) == gen, bar);
            if (!one_xcd) __builtin_amdgcn_fence(__ATOMIC_ACQUIRE, "agent");
            asm volatile("s_waitcnt vmcnt(0)" ::: "memory");
        }
        if (one_xcd) asm volatile("buffer_inv sc0\n\ts_waitcnt vmcnt(0)" ::: "memory");
    }
    __syncthreads();
}
#endif

constexpr int LDS_MAIN = 131072, LDS_BYTES = LDS_MAIN + 1024;
static_assert(attn::LDS_BYTES <= LDS_MAIN && 8 * S5_XWAVE <= LDS_MAIN && 8 * 8448 <= LDS_MAIN, "LDS map");

__device__ __forceinline__ void ph_inproj(const Ctx& c, int l) {
    ArgsP ap = get_args(); unsigned char* ws = ap->ws;
    SchedIn S{(const char*)(ws + WS_XG), (const char*)(ws + WS_WIN) + (size_t)l * 2 * NIN * 512 * 2, 0, grid_g(), c.bid};
    EpiProj E{(bf16_t*)(ws + WS_PROJ), (const float*)(ws + WS_SS) + (size_t)l * T_, (float*)(ws + WS_FF32), (float*)(ws + WS_SSQ) + (size_t)l * T_};
    pg8::gemm_phase(c.lds, 512, 512, 8, S, E);
}
__device__ __forceinline__ void ph_fv(const Ctx& c, int l) {
    ArgsP ap = get_args(); unsigned char* ws = ap->ws;
    SchedIn S{(const char*)(ws + WS_XG), (const char*)(ws + WS_WIN) + (size_t)l * 2 * NIN * 512 * 2, 1, grid_g(), c.bid};
    EpiProj E{(bf16_t*)(ws + WS_PROJ), (const float*)(ws + WS_SS) + (size_t)l * T_, (float*)(ws + WS_FF32), (float*)(ws + WS_SSQ) + (size_t)l * T_};
    pg8::gemm_phase(c.lds, 512, 512, 8, S, E);
}
__device__ __forceinline__ void ph_up(const Ctx& c, int l) {
    ArgsP ap = get_args(); unsigned char* ws = ap->ws;
    SchedUp S{(const char*)(ws + WS_PROJ), (const char*)(ws + WS_WQ) + (size_t)l * 768 * 256 * 2, (const char*)(ws + WS_WKV) + (size_t)l * 1024 * 256 * 2, grid_g(), c.bid};
    EpiUp E{(bf16_t*)(ws + WS_QUP), (bf16_t*)(ws + WS_KM), (bf16_t*)(ws + WS_KVUP), (const float*)(ws + WS_SSQ) + (size_t)l * T_}; pg8::gemm_phase(c.lds, NPROJ, 256, 4, S, E);
}
__device__ __forceinline__ void ph_gate(const Ctx& c, int l) {
    ArgsP ap = get_args(); unsigned char* ws = ap->ws;
    SchedGate S{(const char*)ws, l, grid_g(), c.bid};
    EpiGate E{ws, ap->in[I_BGLU] + l * 512, l};
    pg8::gemm_phase(c.lds, 512, 512, 8, S, E);
}
__device__ __forceinline__ void ph_merge(const Ctx& c, int l) {
    ArgsP ap = get_args(); unsigned char* ws = ap->ws;
    SchedMerge S{(const char*)ws, l, grid_g(), c.bid};
    EpiMerge E{ws, l, c.bid};
    pg8::gemm_phase(c.lds, 512, 512, 8, S, E);
}
__device__ __forceinline__ void ph_out(const Ctx& c, int l, bool dry) {
    ArgsP ap = get_args(); unsigned char* ws = ap->ws;
    SchedPlain S{(const char*)(ws + WS_PROJ) + (size_t)S_ * 1024 * 2, (size_t)256 * 1024 * 2, (size_t)10 << 20, (const char*)(ws + WS_WOUT) + (size_t)l * DM * DM * 2, (size_t)256 * 1024 * 2, 4, grid_g(), c.bid};
    const bool lastl = (l == NL - 1);
    EpiOut E{nullptr, ap->out, (bf16_t*)(ws + WS_XG), lastl ? nullptr : (float*)(ws + WS_SS) + (size_t)(l + 1) * T_, dry};
    pg8::gemm_phase(c.lds, 1024, 1024, 16, S, E);
}

__global__ void __launch_bounds__(512, 2) trunk_fwd(Args args) {
    extern __shared__ __attribute__((aligned(16))) unsigned char lds[];
    Ctx c; c.lds = (LAS unsigned char*)lds; c.ldsg = (char*)lds; c.G = gridDim.x; c.bid = blockIdx.x; c.vb = (gridDim.x == 256) ? (int)((blockIdx.x & 7) * 32 + (blockIdx.x >> 3)) : (int)blockIdx.x;
#if MK_LAUNCHES == 1
#if USE_XCD_BAR
    if (threadIdx.x < 8) ((volatile LAS unsigned*)(c.lds + LDS_MAIN))[threadIdx.x] = 0u;
    __syncthreads();
    XcdBarrier bar = xcd_barrier_post((unsigned*)(args.ws + WS_CTL) + 4096, (volatile LAS unsigned*)(c.lds + LDS_MAIN), gridDim.x);
    XcdBarrier pbar = bar;
#define GRID_BAR() xcd_barrier(bar)
#define PIPE_BAR() xcd_barrier(pbar)
#define HAVE_PIPE_BAR 1
#else
    cg::grid_group grid = cg::this_grid();
#define GRID_BAR() grid.sync()
#endif
#else
#define GRID_BAR() do {} while (0)
#endif
    const int lo = args.ph_lo, hi = args.ph_hi;
#ifndef PH_MASK
#define PH_MASK 0xfff
#endif
#define IN(k) (lo <= (k) && (k) < hi)
#define PHM(j) ((PH_MASK >> (j)) & 1)
#define SEAM(k) do { if (IN(k) && IN((k) + 1)) GRID_BAR(); } while (0)
#ifdef HAVE_PIPE_BAR
#define SEAMP(k) do { if (IN(k) && IN((k) + 1)) PIPE_BAR(); } while (0)
#else
#define SEAMP(k) SEAM(k)
#endif

#ifndef ENABLE_PROBES
#define ENABLE_PROBES 0
#endif
#if ENABLE_PROBES
    const int probe = args.probe;
#define REP(j) for (int rep = (probe == (j)) ? 0 : 1; rep < 2; ++rep)
#else
#define REP(j) for (int rep = 1; rep < 2; ++rep)
#endif
    if (PHM(0) && IN(0)) { REP(1) phase0(c, 0); } SEAM(0);
#ifdef HAVE_PIPE_BAR
    if (gridDim.x == 256 && lo == 0 && hi == NPH)
        pbar = xcd_barrier_post((unsigned*)(args.ws + WS_PBAR) + (blockIdx.x & 7) * XCD_BAR_WORDS, (volatile LAS unsigned*)(c.lds + LDS_MAIN) + 4, 32u);
#endif
    for (int l = 0; l < NL; ++l) {
        const int pb = 1 + 7 * l;
        if (PHM(1) && IN(pb + 0)) {
            if (l == 0 && (c.bid & 1)) { phase0(c, 1); __syncthreads(); }
            REP(2) ph_inproj(c, l);
            if (l == 0 && !(c.bid & 1)) phase0(c, 1); }
        if (l == 0) SEAM(pb + 0); else SEAMP(pb + 0);
#ifdef PIPE_SKEW_TICKS
        if (l == 0 && gridDim.x == 256) {
            const unsigned t0 = (unsigned)__builtin_amdgcn_s_memrealtime(), dt = (unsigned)__builtin_amdgcn_readfirstlane((int)(PIPE_SKEW_TICKS));
            while ((unsigned)__builtin_amdgcn_s_memrealtime() - t0 < dt) __builtin_amdgcn_s_sleep(8);
        }
#endif
        if (IN(pb + 1)) {
            if (c.bid & 1) { if (PHM(9)) REP(5) s5_pass<false>(c, l, false); if (PHM(2)) REP(4) ph_fv(c, l); if (PHM(2)) REP(3) ph_up(c, l); }
            else { if (PHM(2)) REP(4) ph_fv(c, l); if (PHM(2)) REP(3) ph_up(c, l); if (PHM(9)) REP(5) s5_pass<false>(c, l, false); } }
        SEAMP(pb + 1);
        if (IN(pb + 2)) {
            if (c.bid & 1) { if (PHM(10)) REP(7) s5_pass<true>(c, l, rep == 0); if (PHM(3)) REP(6) prep_phase(c, l, rep == 0); }
            else { if (PHM(3)) REP(6) prep_phase(c, l, rep == 0); if (PHM(10)) REP(7) s5_pass<true>(c, l, rep == 0); } }
        SEAMP(pb + 2);
        if (IN(pb + 3)) { if (PHM(4)) REP(8) attn_phase(c, l, rep == 0); }
        SEAMP(pb + 3);
        if (PHM(5) && IN(pb + 4)) REP(10) ph_gate(c, l);
        SEAMP(pb + 4);
        if (PHM(6) && IN(pb + 5)) REP(11) ph_merge(c, l);
        SEAMP(pb + 5);
        if (PHM(7) && IN(pb + 6)) REP(12) ph_out(c, l, rep == 0);
        SEAMP(pb + 6);
    }
#undef IN
#undef SEAM
}

extern "C" void kernel_launch(void* const* d_in, const int* in_sizes, int n_in, void* d_out, int out_size, void* d_ws, size_t ws_size, hipStream_t stream) {
    static int grid = 0;
    if (grid == 0) {
        if (n_in != 25 || in_sizes[0] != T_ * DM || out_size != T_ * DM || ws_size < WS_END) {
            fprintf(stderr, "kernel_launch: shape mismatch n_in %d in0 %d out %d ws %zu (need %zu)\n", n_in, n_in > 0 ? in_sizes[0] : -1, out_size, ws_size, (size_t)WS_END); grid = -1; return; }
        int dev = 0, cus = 0, per_cu = 0;
        hipGetDevice(&dev); hipDeviceGetAttribute(&cus, hipDeviceAttributeMultiprocessorCount, dev);
        if (hipFuncSetAttribute((const void*)trunk_fwd, hipFuncAttributeMaxDynamicSharedMemorySize, LDS_BYTES) != hipSuccess) { fprintf(stderr, "kernel_launch: hipFuncSetAttribute failed\n"); grid = -1; return; }
        if (hipOccupancyMaxActiveBlocksPerMultiprocessor(&per_cu, (const void*)trunk_fwd, 512, LDS_BYTES) != hipSuccess || per_cu < 1) { fprintf(stderr, "kernel_launch: occupancy query says %d\n", per_cu); per_cu = 1; }
        (void)hipGetLastError();
        grid = cus;
    }
    if (grid < 0) return;
    hipMemsetAsync((char*)d_ws + WS_CTL, 0, 64 * KiB, stream);
    Args a{};
    for (int i = 0; i < 25; ++i) a.in[i] = (const float*)d_in[i];
    a.out = (float*)d_out; a.ws = (unsigned char*)d_ws;
#ifdef PROBE_PHASE
    a.probe = PROBE_PHASE;
#endif
#if MK_LAUNCHES == 1
    a.ph_lo = 0; a.ph_hi = NPH;
#ifndef PLAIN_LAUNCH
#define PLAIN_LAUNCH 0
#endif
#if PLAIN_LAUNCH
    hipLaunchKernelGGL(trunk_fwd, dim3(grid), dim3(512), LDS_BYTES, stream, a);
#else
    void* kargs[] = {&a};
    hipError_t e = hipLaunchCooperativeKernel((const void*)trunk_fwd, dim3(grid), dim3(512), kargs, LDS_BYTES, stream);
    if (e != hipSuccess) fprintf(stderr, "cooperative launch failed: %s (grid %d)\n", hipGetErrorString(e), grid);
#endif
#else
    for (int ph = 0; ph < NPH; ++ph) { a.ph_lo = ph; a.ph_hi = ph + 1; hipLaunchKernelGGL(trunk_fwd, dim3(grid), dim3(512), LDS_BYTES, stream, a); }
#endif
}
```

```cpp
#include <hip/hip_runtime.h>
#include <hip/hip_cooperative_groups.h>
#include <cstdint>
#include <cstdio>
namespace cg = cooperative_groups;

#ifndef MK_LAUNCHES
#define MK_LAUNCHES 1
#endif
#ifndef USE_XCD_BAR
#define USE_XCD_BAR 1
#define CONV_FIRST 1
#define P2_ORDER 1
#define P3_ORDER 0
#endif

#define LAS __attribute__((address_space(3)))
typedef unsigned short bf16_t;
typedef short bf16x8 __attribute__((ext_vector_type(8)));
typedef short s16x4 __attribute__((ext_vector_type(4)));
typedef float f32x2 __attribute__((ext_vector_type(2)));
typedef float f32x4 __attribute__((ext_vector_type(4)));
typedef float f32x16 __attribute__((ext_vector_type(16)));
typedef unsigned u32x2 __attribute__((ext_vector_type(2)));
typedef unsigned u32x4 __attribute__((ext_vector_type(4)));

constexpr int T_ = 16384, S_ = 2048, NB_ = 8, DM = 1024, NL = 2;
constexpr int NPROJ = 2560;
constexpr int NIN = 7168;
constexpr int IN_SRC = 7080;
constexpr float EPS = 1e-6f;
constexpr float LOG2E = 1.4426950408889634f;
constexpr int NPH = 1 + 7 * NL;

constexpr size_t KiB = 1024, MiB = 1024 * 1024;
constexpr size_t WS_CTL = 0;
constexpr size_t WS_SS = 64 * KiB;
constexpr size_t WS_FF32 = 256 * KiB;
constexpr size_t WS_CUM = 768 * KiB;
constexpr size_t WS_TA = 1280 * KiB;
constexpr size_t WS_TBB = 1344 * KiB;
constexpr size_t WS_TC = 1856 * KiB;
constexpr size_t WS_SSQ = 2432 * KiB;
constexpr size_t WS_SSKV = 2560 * KiB;
constexpr size_t WS_PBAR = 2688 * KiB;
constexpr size_t WS_E = 3 * MiB;
constexpr size_t WS_WQ = 7 * MiB;
constexpr size_t WS_WKV = WS_WQ + 768 * KiB;
constexpr size_t WS_WGLU = WS_WKV + 1 * MiB;
constexpr size_t WS_WBO = WS_WGLU + 1 * MiB;
constexpr size_t WS_WOUT = WS_WBO + 6 * MiB;
constexpr size_t WS_WIN = 20 * MiB;
constexpr size_t WS_XG = 48 * MiB;
constexpr size_t WS_PROJ = 80 * MiB;
constexpr size_t WS_QUP = 160 * MiB;
constexpr size_t WS_KVUP = 184 * MiB;
constexpr size_t WS_KM = 216 * MiB;
constexpr size_t WS_Z = 240 * MiB;
constexpr size_t WS_END = 256 * MiB;
static_assert(WS_WOUT + 4 * MiB <= WS_WIN && WS_WIN + 28 * MiB <= WS_XG, "ws map");

__device__ __forceinline__ unsigned pk_bf16(float lo, float hi) {
    typedef __bf16 b2 __attribute__((ext_vector_type(2)));
    f32x2 v = {lo, hi}; b2 b = __builtin_convertvector(v, b2); return __builtin_bit_cast(unsigned, b);
}
__device__ __forceinline__ float bf_lo(unsigned w) { return __uint_as_float(w << 16); }
__device__ __forceinline__ float bf_hi(unsigned w) { return __uint_as_float(w & 0xffff0000u); }
__device__ __forceinline__ float bf2f(bf16_t h) { return __uint_as_float(((unsigned)h) << 16); }
__device__ __forceinline__ bf16_t f2bf(float f) { return (bf16_t)(pk_bf16(f, 0.f) & 0xffffu); }
__device__ __forceinline__ float sigmoidf_(float v) { return __builtin_amdgcn_rcpf(1.f + __expf(-v)); }
__device__ __forceinline__ float sig2_(float t) { return __builtin_amdgcn_rcpf(1.f + __builtin_amdgcn_exp2f(t)); }
__device__ __forceinline__ float siluf_(float v) { return v * __builtin_amdgcn_rcpf(1.f + __expf(-v)); }
__device__ __forceinline__ float gelu_tanh(float y) {
    const float v = 0.7978845608028654f * (y + 0.044715f * y * y * y);
    const float t = 1.f - 2.f * __builtin_amdgcn_rcpf(1.f + __expf(2.f * v));
    return 0.5f * y * (1.f + t);
}
template <int CTRL> __device__ __forceinline__ float dpp_f(float v) { return __builtin_bit_cast(float, __builtin_amdgcn_update_dpp(0, __builtin_bit_cast(int, v), CTRL, 0xF, 0xF, true)); }
__device__ __forceinline__ float sum8(float v) { v += dpp_f<0xB1>(v); v += dpp_f<0x4E>(v); v += dpp_f<0x141>(v); return v; }
__device__ __forceinline__ float wave_sum(float v) {
    v = sum8(v); v += dpp_f<0x140>(v);
    const int iv = __builtin_bit_cast(int, v);
    const float a = __builtin_bit_cast(float, __builtin_amdgcn_readlane(iv, 0)), b = __builtin_bit_cast(float, __builtin_amdgcn_readlane(iv, 16));
    const float c = __builtin_bit_cast(float, __builtin_amdgcn_readlane(iv, 32)), d = __builtin_bit_cast(float, __builtin_amdgcn_readlane(iv, 48));
    return (a + b) + (c + d);
}
#define SBAR() __builtin_amdgcn_sched_barrier(0)

namespace pg8 {
constexpr int BM = 256, BK = 64, HALF = 128, HTB = HALF * BK * 2, STAGE_BYTES = 8 * HTB;
__device__ __forceinline__ int lds_byte(int r, int c) { const int st = (r >> 4) * 2 + (c >> 5), rr = r & 15, cc = c & 31, ob = rr * 64 + cc * 2; return st * 1024 + (ob ^ (((ob >> 9) & 1) << 5)); }
__device__ __forceinline__ void stage_rc(int b, int& R, int& C) { const int st = b / 1024, sb = b % 1024, swz = sb ^ (((sb >> 9) & 1) << 5); R = (st >> 1) * 16 + swz / 64; C = (st & 1) * 32 + (swz % 64) / 2; }
__device__ __forceinline__ int perm32(int rho) { const int n = rho >> 4, i = rho & 15; return 8 * (i >> 2) + 4 * n + (i & 3); }

struct Unit { const char* A; const char* B; int pm, pn, kind; };

__device__ __forceinline__ bool tile_at(long L, int nM, int nN, int& pm, int& pn) {
    const int nwg = nM * nN; if (L >= nwg) return false;
    int wgid = (int)L; { const int q = nwg / 8, r = nwg % 8, xcd = wgid % 8, off = wgid / 8; wgid = (xcd < r ? xcd * (q + 1) : r * (q + 1) + (xcd - r) * q) + off; }
    const int WGM = 8, nig = WGM * nN, gid = wgid / nig, fm = gid * WGM;
    pm = fm + ((wgid % nig) & (WGM - 1)); pn = (wgid % nig) / WGM; return true;
}

template <class Epi, class Sched>
__device__ __forceinline__ void gemm_phase(LAS unsigned char* lds, const int lda, const int ldb, const int nt, const Sched& S, const Epi& E) {
    int tid = threadIdx.x; asm volatile("" : "+v"(tid));
    const int wid = __builtin_amdgcn_readfirstlane(tid >> 6), lane = tid & 63, wr = wid >> 2, wc = wid & 3, fr = lane & 15, fq = lane >> 4;
    unsigned voffA[2], voffB[2];
#pragma unroll
    for (int i = 0; i < 2; ++i) { int R, C; stage_rc(tid * 16 + i * 8192, R, C); const int Rb = Epi::PERM ? ((R & ~31) + perm32(R & 31)) : R;
        voffA[i] = (unsigned)(R * lda + C) * 2u; voffB[i] = (unsigned)(Rb * ldb + C) * 2u; }
    int ntv = nt; asm volatile("" : "+s"(ntv));
    const size_t kstep = (size_t)(BK * 2);
    const size_t hstepA = (size_t)HALF * lda * 2, hstepB = (size_t)HALF * ldb * 2;
    const unsigned ldsw = (unsigned)wid * 1024u;
    const int aoff = lds_byte(wr * 64 + fr, fq * 8), boff = lds_byte(wc * 32 + fr, fq * 8);
#define PG8_SA(b, h) (((b) * 2 + (h)) * HTB)
#define PG8_SB(b, h) ((4 + (b) * 2 + (h)) * HTB)
#define PG8_STAGE(bufoff, gbase, voff) do { _Pragma("unroll") for (int _i = 0; _i < 2; ++_i) \
        __builtin_amdgcn_global_load_lds((const unsigned*)((const char*)(gbase) + (voff)[_i]), (LAS unsigned*)(lds + (bufoff) + ldsw + _i * 8192), 16, 0, 0); } while (0)
#define PG8_LDA(dst, b, h) do { _Pragma("unroll") for (int m = 0; m < 4; ++m) _Pragma("unroll") for (int k = 0; k < 2; ++k) dst[m][k] = *(const LAS bf16x8*)(lds + PG8_SA(b, h) + aoff + m * 2048 + k * 1024); } while (0)
#define PG8_LDB(dst, b, h) do { _Pragma("unroll") for (int n = 0; n < 2; ++n) _Pragma("unroll") for (int k = 0; k < 2; ++k) dst[n][k] = *(const LAS bf16x8*)(lds + PG8_SB(b, h) + boff + n * 2048 + k * 1024); } while (0)
#define PG8_MMA(ai, bj, At, Bt) do { __builtin_amdgcn_s_setprio(1); _Pragma("unroll") for (int m = 0; m < 4; ++m) _Pragma("unroll") for (int n = 0; n < 2; ++n) _Pragma("unroll") for (int k = 0; k < 2; ++k) \
        acc[ai][bj][m][n] = __builtin_amdgcn_mfma_f32_16x16x32_bf16(Bt[n][k], At[m][k], acc[ai][bj][m][n], 0, 0, 0); __builtin_amdgcn_s_setprio(0); } while (0)
#define PG8_WAIT_V(n) asm volatile("s_waitcnt vmcnt(" #n ")" ::: "memory")
#define PG8_WAIT_L(n) asm volatile("s_waitcnt lgkmcnt(" #n ")" ::: "memory")
#define PG8_BAR __builtin_amdgcn_s_barrier()
#define PG8_SCHED __builtin_amdgcn_sched_barrier(0)
    Unit cur, nxt; int ui = 0;
    if (!S.next(0, cur)) return;
    f32x4 acc[2][2][4][2];
#pragma unroll
    for (int a = 0; a < 2; ++a)
#pragma unroll
        for (int b = 0; b < 2; ++b)
#pragma unroll
            for (int m = 0; m < 4; ++m)
#pragma unroll
                for (int n = 0; n < 2; ++n) acc[a][b][m][n] = (f32x4){0.f, 0.f, 0.f, 0.f};
    bf16x8 At[4][2], B0[2][2], B1[2][2];
    const char* cA = cur.A; const char* cB = cur.B;
    PG8_STAGE(PG8_SB(0, 0), cB, voffB); PG8_STAGE(PG8_SB(0, 1), cB + hstepB, voffB); PG8_STAGE(PG8_SA(0, 0), cA, voffA); PG8_STAGE(PG8_SA(0, 1), cA + hstepA, voffA);
    if (wr == 1) PG8_BAR;
    PG8_WAIT_V(2); PG8_BAR;
    PG8_STAGE(PG8_SB(1, 0), cB + kstep, voffB); PG8_STAGE(PG8_SA(1, 0), cA + kstep, voffA); PG8_STAGE(PG8_SB(1, 1), cB + hstepB + kstep, voffB);
    PG8_WAIT_V(6); PG8_BAR;
    for (;;) {
        const bool has_next = S.next(ui + 1, nxt);
        const char* nA = has_next ? nxt.A : cA; const char* nB = has_next ? nxt.B : cB;
        for (int t = 0; t < ntv; t += 2) {
            const bool last = (t == ntv - 2);
            const char* a1 = cA + (size_t)(t + 1) * kstep;
            const char* a2 = last ? nA : cA + (size_t)(t + 2) * kstep; const char* b2 = last ? nB : cB + (size_t)(t + 2) * kstep;
            const char* a3 = a2 + kstep; const char* b3 = b2 + kstep;
            PG8_LDB(B0, 0, 0); PG8_LDB(B1, 0, 1); PG8_SCHED; PG8_LDA(At, 0, 0); PG8_STAGE(PG8_SA(1, 1), a1 + hstepA, voffA);
            PG8_WAIT_V(8); PG8_WAIT_L(0); PG8_BAR; PG8_MMA(0, 0, At, B0); PG8_MMA(0, 1, At, B1); PG8_BAR; PG8_SCHED;
            PG8_LDA(At, 0, 1); PG8_STAGE(PG8_SB(0, 0), b2, voffB); PG8_STAGE(PG8_SB(0, 1), b2 + hstepB, voffB); PG8_STAGE(PG8_SA(0, 0), a2, voffA);
            PG8_WAIT_V(8); PG8_WAIT_L(0); PG8_BAR; PG8_MMA(1, 0, At, B0); PG8_MMA(1, 1, At, B1); PG8_BAR; PG8_SCHED;
            PG8_LDB(B0, 1, 0); PG8_LDB(B1, 1, 1); PG8_SCHED; PG8_LDA(At, 1, 0); PG8_STAGE(PG8_SA(0, 1), a2 + hstepA, voffA);
            PG8_WAIT_V(8); PG8_WAIT_L(0); PG8_BAR; PG8_MMA(0, 0, At, B0); PG8_MMA(0, 1, At, B1); PG8_BAR; PG8_SCHED;
            PG8_LDA(At, 1, 1); PG8_STAGE(PG8_SB(1, 0), b3, voffB); PG8_STAGE(PG8_SB(1, 1), b3 + hstepB, voffB); PG8_STAGE(PG8_SA(1, 0), a3, voffA);
            PG8_WAIT_V(8); PG8_WAIT_L(0); PG8_BAR; PG8_MMA(1, 0, At, B0); PG8_MMA(1, 1, At, B1); PG8_BAR; PG8_SCHED;
        }
        if (wr == 0) PG8_BAR;
        const bool keep = E(acc, cur, wr, wc, fr, fq);
        if (!has_next) break;
        if (!keep) {
#pragma unroll
            for (int a = 0; a < 2; ++a)
#pragma unroll
                for (int b = 0; b < 2; ++b)
#pragma unroll
                    for (int m = 0; m < 4; ++m)
#pragma unroll
                        for (int n = 0; n < 2; ++n) acc[a][b][m][n] = (f32x4){0.f, 0.f, 0.f, 0.f};
        }
        cur = nxt; cA = nA; cB = nB; ++ui;
        if (wr == 1) PG8_BAR;
    }
    PG8_WAIT_V(0);
    PG8_BAR;
#undef PG8_SA
#undef PG8_SB
#undef PG8_STAGE
#undef PG8_LDA
#undef PG8_LDB
#undef PG8_MMA
#undef PG8_WAIT_V
#undef PG8_WAIT_L
#undef PG8_BAR
#undef PG8_SCHED
}
}

struct Args {
    const float* in[25];
    float* out;
    unsigned char* ws;
    int ph_lo, ph_hi, probe, pad;
};
enum { I_X = 0, I_POS, I_NORMG, I_WIN, I_QAN, I_WQUP, I_KVAN, I_WKVUP, I_MQN, I_MKN, I_FBF, I_FQN, I_FKN,
       I_LRE, I_LIM, I_LDT, I_BRE, I_BIM, I_CRE, I_CIM, I_S5D, I_WGLU, I_BGLU, I_WBO, I_WOUT };

typedef const __attribute__((address_space(4))) Args* ArgsP;
__device__ __forceinline__ ArgsP get_args() { ArgsP p = (ArgsP)__builtin_amdgcn_kernarg_segment_ptr(); asm volatile("" : "+s"(p)); return p; }
__device__ __forceinline__ int grid_g() { int g = (int)gridDim.x; asm volatile("" : "+s"(g)); return g; }
struct Ctx {
    LAS unsigned char* lds;
    char* ldsg;
    int G, bid;
    int vb;
};
#define PHASE_IDS() int tid = threadIdx.x; asm volatile("" : "+v"(tid)); const int lane = tid & 63, wave = __builtin_amdgcn_readfirstlane(tid >> 6); (void)lane; (void)wave

using pg8::Unit;
using pg8::tile_at;

__device__ __forceinline__ float rstd_of(const float* ss, int row) { return rsqrtf(ss[row] * (1.f / DM) + EPS); }

struct SchedIn {
    const char* XG; const char* WIN; int mode, G, c;
    __device__ __forceinline__ bool next(int i, Unit& u) const {
        int pm, pn; if (!tile_at((long)(i >> 1) * G + c, 64, mode ? 2 : 8, pm, pn)) return false;
        pn = mode ? pn + 6 : (pn >= 6 ? pn + 2 : pn);
        const int h = i & 1;
        u.A = XG + ((size_t)h * T_ + (size_t)pm * 256) * 512 * 2;
        u.B = WIN + ((size_t)h * NIN + (size_t)pn * 256) * 512 * 2;
        u.pm = pm; u.pn = pn; u.kind = h; return true;
    }
};
struct EpiProj {
    static constexpr bool PERM = true;
    bf16_t* P; const float* ss; float* ff32; float* ssq;
    __device__ __forceinline__ bool operator()(f32x4 (&acc)[2][2][4][2], const Unit& u, int wr, int wc, int fr, int fq) const {
        if (u.kind == 0) return true;
        const int row0 = u.pm * 256 + wr * 64 + fr, col0 = u.pn * 256 + wc * 32 + 8 * fq;
        float rs[2][4];
#pragma unroll
        for (int ai = 0; ai < 2; ++ai)
#pragma unroll
            for (int m = 0; m < 4; ++m) rs[ai][m] = ss[row0 + ai * 128 + m * 16];
#pragma unroll
        for (int ai = 0; ai < 2; ++ai)
#pragma unroll
            for (int m = 0; m < 4; ++m) { const int row = row0 + ai * 128 + m * 16; const float r_ = rsqrtf(rs[ai][m] * (1.f / DM) + EPS); bf16_t* rp = P + (size_t)row * NPROJ + col0;
#pragma unroll
                for (int bj = 0; bj < 2; ++bj) { const f32x4 v0 = acc[ai][bj][m][0] * r_, v1 = acc[ai][bj][m][1] * r_;
                    u32x4 w; w.x = pk_bf16(v0[0], v0[1]); w.y = pk_bf16(v0[2], v0[3]); w.z = pk_bf16(v1[0], v1[1]); w.w = pk_bf16(v1[2], v1[3]);
                    *(u32x4*)(rp + bj * 128) = w;
                    if (u.pn == 1 && bj == 1 && wc == 1 && fq == 0) { float* f = ff32 + (size_t)row * 8; *(f32x4*)f = v0; *(f32x4*)(f + 4) = v1; } }
                if (u.pn < 2) {
                    const f32x4 a0 = acc[ai][0][m][0] * r_, a1 = acc[ai][0][m][1] * r_; float sq = (a0[0] * a0[0] + a0[1] * a0[1]) + (a0[2] * a0[2] + a0[3] * a0[3]) + (a1[0] * a1[0] + a1[1] * a1[1]) + (a1[2] * a1[2] + a1[3] * a1[3]);
                    if (u.pn == 0) { const f32x4 b0 = acc[ai][1][m][0] * r_, b1 = acc[ai][1][m][1] * r_; sq += (b0[0] * b0[0] + b0[1] * b0[1]) + (b0[2] * b0[2] + b0[3] * b0[3]) + (b1[0] * b1[0] + b1[1] * b1[1]) + (b1[2] * b1[2] + b1[3] * b1[3]); }
                    sq += __shfl_xor(sq, 16); sq += __shfl_xor(sq, 32);
                    if (fq == 0) atomicAdd(ssq + (u.pn == 0 ? 0 : NL * T_) + row, sq); } }
        return false;
    }
};

struct SchedUp { const char* P; const char* WQ; const char* WKV; int G, c;
    __device__ __forceinline__ bool next(int i, Unit& u) const {
        int pm, pn, kv;
        if (G == 256) {
            const int k = c >> 3, m = k >> 3;
            if (i >= ((0x2311 >> (4 * m)) & 15)) return false;
            const int e = (int)(0x0011003E00050004ull >> (16 * m + 3 * i)) & 7;
            kv = e >> 2; pn = e & 3; pm = 8 * (c & 7) + (k & 7); }
        else { int Gv = G, cv = c; asm volatile("" : "+s"(Gv), "+s"(cv)); const int L = i * Gv + cv;
            if (L >= 448) return false;
            if (L < 256) { pm = L >> 2; pn = L & 3; kv = 1; } else { const int n = L - 256; pm = n / 3; pn = n - 3 * pm; kv = 0; } }
        u.A = P + (size_t)pm * 256 * NPROJ * 2 + (kv ? 256 * 2 : 0); u.B = WQ + (kv ? (WKV - WQ) : 0) + (size_t)pn * 256 * 256 * 2; u.kind = kv;
        u.pm = pm; u.pn = pn; return true; }
};
struct SchedPlain { const char* A; size_t a_tile_bytes, a_batch_bytes; const char* B; size_t b_tile_bytes; int nN, G, c;
    __device__ __forceinline__ bool next(int i, Unit& u) const {
        int pm, pn; if (!tile_at((long)i * G + c, 64, nN, pm, pn)) return false;
        u.A = A + (size_t)(pm >> 3) * a_batch_bytes + (size_t)(pm & 7) * a_tile_bytes; u.B = B + (size_t)pn * b_tile_bytes; u.pm = pm; u.pn = pn; u.kind = 0; return true; }
};
struct EpiUp { static constexpr bool PERM = true; bf16_t* QUP; bf16_t* KM; bf16_t* VM; const float* ssq;
    __device__ __forceinline__ bool operator()(f32x4 (&acc)[2][2][4][2], const Unit& u, int wr, int wc, int fr, int fq) const {
        const int row0 = u.pm * 256 + wr * 64 + fr, col0 = u.pn * 256 + wc * 32 + 8 * fq;
        float rs[2][4];
#pragma unroll
        for (int ai = 0; ai < 2; ++ai)
#pragma unroll
            for (int m = 0; m < 4; ++m) rs[ai][m] = ssq[(u.kind ? NL * T_ : 0) + row0 + ai * 128 + m * 16];
        const float inv = u.kind ? (1.f / 128) : (1.f / 256);
        bf16_t* dbase[2]; int dstr[2];
#pragma unroll
        for (int bj = 0; bj < 2; ++bj) { const int col = col0 + bj * 128;
            if (u.kind == 0) { dbase[bj] = QUP + col; dstr[bj] = 768; }
            else { const int hd = col >> 7, d = col & 127; if (d < 64) { dbase[bj] = KM + 96 * hd + d; dstr[bj] = 768; } else { dbase[bj] = VM + 64 * hd + (d - 64); dstr[bj] = 512; } } }
#pragma unroll
        for (int ai = 0; ai < 2; ++ai)
#pragma unroll
            for (int m = 0; m < 4; ++m) { const int row = row0 + ai * 128 + m * 16; const float r_ = rsqrtf(rs[ai][m] * inv + EPS);
#pragma unroll
                for (int bj = 0; bj < 2; ++bj) { const f32x4 v0 = acc[ai][bj][m][0] * r_, v1 = acc[ai][bj][m][1] * r_;
                    u32x4 w; w.x = pk_bf16(v0[0], v0[1]); w.y = pk_bf16(v0[2], v0[3]); w.z = pk_bf16(v1[0], v1[1]); w.w = pk_bf16(v1[2], v1[3]);
                    *(u32x4*)(dbase[bj] + (size_t)row * dstr[bj]) = w; } }
        return false;
    }
};
struct SchedGate { const char* ws; int l, G, c;
    __device__ __forceinline__ bool next(int i, Unit& u) const {
        const char* XG = ws + WS_XG; const char* WIN = ws + WS_WIN + (size_t)l * 2 * NIN * 512 * 2; const char* Z = ws + WS_Z; const char* WGLU = ws + WS_WGLU + (size_t)l * 512 * 512 * 2;
        int pm, pn, j;
        if (G == 256) {
            const int x = c & 7, k = c >> 3;
            if (k < 16) { if (i >= 4) return false; pm = 8 * x + (k >> 1); pn = 2 * (k & 1) + (i >> 1); j = i & 1; }
            else { if (i >= 3) return false; const int kk = k - 16; pm = 8 * x + (kk >> 1); pn = 4 + (kk & 1); j = i - 1; }
        } else {
            int Gv = G; asm volatile("" : "+s"(Gv));
            const int t3 = (128 - c + Gv - 1) / Gv;
            const int ns5 = (c < 128) ? t3 : 0;
            if (i < 3 * ns5) { const int m = c + (i / 3) * G; pm = m >> 1; pn = 4 + (m & 1); j = i % 3 - 1; }
            else { const int i2 = i - 3 * ns5; const long n = (long)(i2 >> 1) * G + c; if (n >= 256) return false; pm = (int)(n >> 2); pn = (int)(n & 3); j = i2 & 1; }
        }
        if (j < 0) { u.A = Z + (size_t)pm * 256 * 512 * 2; u.B = WGLU + (size_t)(pn & 1) * 256 * 512 * 2; u.kind = 2; }
        else { u.A = XG + ((size_t)j * T_ + (size_t)pm * 256) * 512 * 2; u.B = WIN + ((size_t)j * NIN + 2560 + (size_t)pn * 256) * 512 * 2; u.kind = j; }
        u.pm = pm; u.pn = pn; return true;
    }
};
struct EpiGate { static constexpr bool PERM = true; unsigned char* ws; const float* bias; int l;
    __device__ __forceinline__ bool operator()(f32x4 (&acc)[2][2][4][2], const Unit& u, int wr, int wc, int fr, int fq) const {
        if (u.kind == 0) return true;
        bf16_t* P = (bf16_t*)(ws + WS_PROJ); const bf16_t* QUP = (const bf16_t*)(ws + WS_QUP); const bf16_t* Z = (const bf16_t*)(ws + WS_Z); bf16_t* ABO = (bf16_t*)(ws + WS_KVUP); const float* ss = (const float*)(ws + WS_SS) + (size_t)l * T_;
        const int br = u.pn >> 1;
        const int row0 = u.pm * 256 + wr * 64 + fr, c0 = (u.pn & 1) * 256 + wc * 32 + 8 * fq;
        if (u.kind == 2) {
            f32x4 bv[2][2];
#pragma unroll
            for (int bj = 0; bj < 2; ++bj) { bv[bj][0] = *(const f32x4*)(bias + c0 + bj * 128) * -LOG2E; bv[bj][1] = *(const f32x4*)(bias + c0 + bj * 128 + 4) * -LOG2E; }
#pragma unroll
            for (int ai = 0; ai < 2; ++ai) {
                u32x4 yv[4][2];
#pragma unroll
                for (int m = 0; m < 4; ++m)
#pragma unroll
                    for (int bj = 0; bj < 2; ++bj) yv[m][bj] = *(const u32x4*)(Z + (size_t)(row0 + ai * 128 + m * 16) * 512 + c0 + bj * 128);
#pragma unroll
                for (int m = 0; m < 4; ++m) { const int row = row0 + ai * 128 + m * 16;
#pragma unroll
                    for (int bj = 0; bj < 2; ++bj) { const int c = c0 + bj * 128; const f32x4 v0 = acc[ai][bj][m][0] * -LOG2E + bv[bj][0], v1 = acc[ai][bj][m][1] * -LOG2E + bv[bj][1];
                        const u32x4 z = yv[m][bj];
                        u32x4 w;
                        w.x = pk_bf16(bf_lo(z.x) * sig2_(v0[0]), bf_hi(z.x) * sig2_(v0[1]));
                        w.y = pk_bf16(bf_lo(z.y) * sig2_(v0[2]), bf_hi(z.y) * sig2_(v0[3]));
                        w.z = pk_bf16(bf_lo(z.z) * sig2_(v1[0]), bf_hi(z.z) * sig2_(v1[1]));
                        w.w = pk_bf16(bf_lo(z.w) * sig2_(v1[2]), bf_hi(z.w) * sig2_(v1[3]));
                        *(u32x4*)(P + (size_t)row * NPROJ + c) = w; } }
            }
            return false;
        }
        const unsigned abo2 = (br == 2) ? (unsigned)(u.pm >> 3) * (512u << 10) : 0u;
        float rs[2][4];
#pragma unroll
        for (int ai = 0; ai < 2; ++ai)
#pragma unroll
            for (int m = 0; m < 4; ++m) rs[ai][m] = ss[row0 + ai * 128 + m * 16];
#pragma unroll
        for (int ai = 0; ai < 2; ++ai) {
            u32x4 yv[4][2];
#pragma unroll
            for (int m = 0; m < 4; ++m) { const int row = row0 + ai * 128 + m * 16;
#pragma unroll
                for (int bj = 0; bj < 2; ++bj) { const int c = c0 + bj * 128;
                    const bf16_t* ysrc = (br == 0) ? (QUP + (size_t)row * 768 + 96 * (c >> 6) + (c & 63)) : (br == 1) ? (P + (size_t)row * NPROJ + 512 + c) : (P + (size_t)row * NPROJ + c);
                    yv[m][bj] = *(const u32x4*)ysrc; } }
#pragma unroll
            for (int m = 0; m < 4; ++m) { const int row = row0 + ai * 128 + m * 16; const float r_ = rsqrtf(rs[ai][m] * (1.f / DM) + EPS);
#pragma unroll
                for (int bj = 0; bj < 2; ++bj) { const int c = c0 + bj * 128;
                    const u32x4 y = yv[m][bj];
                    const f32x4 v0 = acc[ai][bj][m][0] * r_, v1 = acc[ai][bj][m][1] * r_;
                    u32x4 w;
                    w.x = pk_bf16(bf_lo(y.x) * siluf_(v0[0]), bf_hi(y.x) * siluf_(v0[1]));
                    w.y = pk_bf16(bf_lo(y.y) * siluf_(v0[2]), bf_hi(y.y) * siluf_(v0[3]));
                    w.z = pk_bf16(bf_lo(y.z) * siluf_(v1[0]), bf_hi(y.z) * siluf_(v1[1]));
                    w.w = pk_bf16(bf_lo(y.w) * siluf_(v1[2]), bf_hi(y.w) * siluf_(v1[3]));
                    *(u32x4*)(ABO + ((size_t)br * T_ + row) * 512 + abo2 + c) = w; } }
        }
        return false;
    }
};
enum { MOP_KEEP = 0, MOP_STORE_O = 1, MOP_GATE_RMW = 2, MOP_STORE_S = 3, MOP_O_RMW = 4, MOP_FIRST = 8 };
struct SchedMerge { const char* ws; int l, G, c;
    __device__ __forceinline__ bool next(int i, Unit& u) const {
        const char* ABO = ws + WS_KVUP; const char* WBO = ws + WS_WBO + (size_t)l * 3 * 1024 * 512 * 2; const char* XG = ws + WS_XG; const char* WIN = ws + WS_WIN + (size_t)l * 2 * NIN * 512 * 2;
        int pm, pn; if (!tile_at((long)(i / 9) * G + c, 64, 4, pm, pn)) return false;
        const int j = i % 9; int typ, br, h = 0, op;
        if (G != 256 || !(c & 1)) { br = j / 3; const int s_ = j % 3; typ = s_ != 0; h = s_ - 1; op = s_ == 0 ? MOP_STORE_O : s_ == 1 ? MOP_KEEP : (MOP_GATE_RMW | (br == 0 ? MOP_FIRST : 0)); }
        else if (j < 2) { typ = 1; br = 2; h = j; op = j ? MOP_STORE_S : MOP_KEEP; }
        else { const int jj = j - 2, g = jj / 3, r = jj % 3; br = g;
            if (g == 2) { typ = 0; op = MOP_O_RMW; }
            else if (r == 0) { typ = 0; op = MOP_STORE_O; }
            else { typ = 1; h = r - 1; op = r == 1 ? MOP_KEEP : (MOP_GATE_RMW | (g == 0 ? MOP_FIRST : 0)); } }
        if (typ == 0) { u.A = ABO + ((size_t)br * T_ + (size_t)pm * 256) * 512 * 2 + (br == 2 ? (size_t)(pm >> 3) << 20 : 0); u.B = WBO + ((size_t)br * 1024 + (size_t)pn * 256) * 512 * 2; }
        else { u.A = XG + ((size_t)h * T_ + (size_t)pm * 256) * 512 * 2; u.B = WIN + ((size_t)h * NIN + 4096 + (size_t)br * 1024 + (size_t)pn * 256) * 512 * 2; }
        u.pm = pm; u.pn = pn; u.kind = op; return true;
    }
};
struct EpiMerge { static constexpr bool PERM = true; unsigned char* ws; int l, bid;
    __device__ __forceinline__ bf16_t* scr2() const { unsigned b_ = (unsigned)bid; asm volatile("" : "+s"(b_)); const unsigned sb = b_ & 7u, sk = (b_ >> 3) & 31u;
        return (bf16_t*)(ws + (sk < 16u ? (unsigned)WS_Z + sb * (2u << 20) + sk * 131072u : (unsigned)WS_PROJ + sb * (10u << 20) + (8u << 20) + (sk - 16u) * 131072u)); }
    __device__ __forceinline__ bool operator()(f32x4 (&acc)[2][2][4][2], const Unit& u, int wr, int wc, int fr, int fq) const {
        const int op = u.kind & 7; const bool first = (u.kind & MOP_FIRST) != 0;
        if (op == MOP_KEEP) return true;
        bf16_t* OSCR = (bf16_t*)(ws + WS_PROJ) + (unsigned)(u.pm >> 3) * (3u << 20); bf16_t* MERGED = OSCR + (size_t)S_ * 1024; const float* ss = (const float*)(ws + WS_SS) + (size_t)l * T_;
        const int rt0 = wr * 64 + fr, ct0 = wc * 32 + 8 * fq;
        const int row0 = u.pm * 256 + rt0, col0 = u.pn * 256 + ct0;
        if (op == MOP_STORE_O) {
#pragma unroll
            for (int ai = 0; ai < 2; ++ai)
#pragma unroll
                for (int m = 0; m < 4; ++m) { const size_t off = (size_t)(row0 + ai * 128 + m * 16) * 1024 + col0;
#pragma unroll
                    for (int bj = 0; bj < 2; ++bj) { const f32x4 v0 = acc[ai][bj][m][0], v1 = acc[ai][bj][m][1];
                        u32x4 w; w.x = pk_bf16(v0[0], v0[1]); w.y = pk_bf16(v0[2], v0[3]); w.z = pk_bf16(v1[0], v1[1]); w.w = pk_bf16(v1[2], v1[3]);
                        *(u32x4*)(OSCR + off + bj * 128) = w; } }
            return false;
        }
        if (op == MOP_O_RMW) {
            bf16_t* SCR2 = scr2();
#pragma unroll
            for (int qd = 0; qd < 4; ++qd) { const int ai = qd >> 1, m0 = (qd & 1) * 2;
                u32x4 sv[2][2], pv[2][2];
#pragma unroll
                for (int mm = 0; mm < 2; ++mm) { const int rr = ai * 128 + (m0 + mm) * 16; const size_t off = (size_t)(row0 + rr) * 1024 + col0;
#pragma unroll
                    for (int bj = 0; bj < 2; ++bj) { sv[mm][bj] = *(const u32x4*)(SCR2 + (size_t)(rt0 + rr) * 256 + ct0 + bj * 128); pv[mm][bj] = *(const u32x4*)(MERGED + off + bj * 128); } }
#pragma unroll
                for (int mm = 0; mm < 2; ++mm) { const int m = m0 + mm; const size_t off = (size_t)(row0 + ai * 128 + m * 16) * 1024 + col0;
#pragma unroll
                    for (int bj = 0; bj < 2; ++bj) { const f32x4 v0 = acc[ai][bj][m][0], v1 = acc[ai][bj][m][1]; const u32x4 g = sv[mm][bj], p = pv[mm][bj];
                        u32x4 w;
                        w.x = pk_bf16(bf_lo(p.x) + bf_lo(g.x) * v0[0], bf_hi(p.x) + bf_hi(g.x) * v0[1]); w.y = pk_bf16(bf_lo(p.y) + bf_lo(g.y) * v0[2], bf_hi(p.y) + bf_hi(g.y) * v0[3]);
                        w.z = pk_bf16(bf_lo(p.z) + bf_lo(g.z) * v1[0], bf_hi(p.z) + bf_hi(g.z) * v1[1]); w.w = pk_bf16(bf_lo(p.w) + bf_lo(g.w) * v1[2], bf_hi(p.w) + bf_hi(g.w) * v1[3]);
                        *(u32x4*)(MERGED + off + bj * 128) = w; } }
            }
            return false;
        }
        if (op == MOP_STORE_S) {
            bf16_t* SCR2 = scr2();
            float rs[2][4];
#pragma unroll
            for (int ai = 0; ai < 2; ++ai)
#pragma unroll
                for (int m = 0; m < 4; ++m) rs[ai][m] = ss[row0 + ai * 128 + m * 16];
#pragma unroll
            for (int ai = 0; ai < 2; ++ai)
#pragma unroll
                for (int m = 0; m < 4; ++m) { const int rr = ai * 128 + m * 16; const float r_ = rsqrtf(rs[ai][m] * (1.f / DM) + EPS) * -LOG2E;
#pragma unroll
                    for (int bj = 0; bj < 2; ++bj) { const f32x4 v0 = acc[ai][bj][m][0] * r_, v1 = acc[ai][bj][m][1] * r_;
                        u32x4 w; w.x = pk_bf16(sig2_(v0[0]), sig2_(v0[1])); w.y = pk_bf16(sig2_(v0[2]), sig2_(v0[3])); w.z = pk_bf16(sig2_(v1[0]), sig2_(v1[1])); w.w = pk_bf16(sig2_(v1[2]), sig2_(v1[3]));
                        *(u32x4*)(SCR2 + (size_t)(rt0 + rr) * 256 + ct0 + bj * 128) = w; } }
            return false;
        }
        float rq[8];
#pragma unroll
        for (int g = 0; g < 8; ++g) rq[g] = ss[row0 + (g >> 2) * 128 + (g & 3) * 16];
        u32x4 ov[2][2], pv[2][2];
#define RMW_LOAD(g, b) do { const size_t off_ = (size_t)(row0 + ((g) >> 2) * 128 + ((g) & 3) * 16) * 1024 + col0; \
            _Pragma("unroll") for (int bj = 0; bj < 2; ++bj) { ov[b][bj] = *(const u32x4*)(OSCR + off_ + bj * 128); pv[b][bj] = (u32x4){0u, 0u, 0u, 0u}; if (!first) pv[b][bj] = *(const u32x4*)(MERGED + off_ + bj * 128); } } while (0)
        RMW_LOAD(0, 0);
#pragma unroll
        for (int g = 0; g < 8; ++g) { const int ai = g >> 2, m = g & 3, b = g & 1; const size_t off = (size_t)(row0 + ai * 128 + m * 16) * 1024 + col0;
            if (g + 1 < 8) RMW_LOAD(g + 1, (g + 1) & 1);
            const float r_ = rsqrtf(rq[g] * (1.f / DM) + EPS) * -LOG2E;
#pragma unroll
            for (int bj = 0; bj < 2; ++bj) { const f32x4 v0 = acc[ai][bj][m][0] * r_, v1 = acc[ai][bj][m][1] * r_;
                const u32x4 o = ov[b][bj], p = pv[b][bj];
                u32x4 w;
                w.x = pk_bf16(bf_lo(p.x) + bf_lo(o.x) * sig2_(v0[0]), bf_hi(p.x) + bf_hi(o.x) * sig2_(v0[1]));
                w.y = pk_bf16(bf_lo(p.y) + bf_lo(o.y) * sig2_(v0[2]), bf_hi(p.y) + bf_hi(o.y) * sig2_(v0[3]));
                w.z = pk_bf16(bf_lo(p.z) + bf_lo(o.z) * sig2_(v1[0]), bf_hi(p.z) + bf_hi(o.z) * sig2_(v1[1]));
                w.w = pk_bf16(bf_lo(p.w) + bf_lo(o.w) * sig2_(v1[2]), bf_hi(p.w) + bf_hi(o.w) * sig2_(v1[3]));
                *(u32x4*)(MERGED + off + bj * 128) = w; } }
#undef RMW_LOAD
        return false;
    }
};
struct EpiOut { static constexpr bool PERM = true; const float* xres; float* out; bf16_t* XG; float* ssn; bool dry;
    __device__ __forceinline__ bool operator()(f32x4 (&acc)[2][2][4][2], const Unit& u, int wr, int wc, int fr, int fq) const {
        const int row0 = u.pm * 256 + wr * 64 + fr, col0 = u.pn * 256 + wc * 32 + 8 * fq;
#pragma unroll
        for (int qd = 0; qd < 4; ++qd) { const int ai = qd >> 1, m0 = (qd & 1) * 2;
            f32x4 xr[2][2][2];
            if (xres) {
#pragma unroll
                for (int mm = 0; mm < 2; ++mm) { const size_t off = (size_t)(row0 + ai * 128 + (m0 + mm) * 16) * DM + col0;
#pragma unroll
                    for (int bj = 0; bj < 2; ++bj)
#pragma unroll
                        for (int n = 0; n < 2; ++n) xr[mm][bj][n] = __builtin_nontemporal_load((const f32x4*)(xres + off + bj * 128 + n * 4)); }
            } else {
                u32x4 xb[2][2];
#pragma unroll
                for (int mm = 0; mm < 2; ++mm) { const int row = row0 + ai * 128 + (m0 + mm) * 16;
#pragma unroll
                    for (int bj = 0; bj < 2; ++bj) { const int col = col0 + bj * 128; xb[mm][bj] = *(const u32x4*)(XG + ((size_t)(col >> 9) * T_ + row) * 512 + (col & 511)); } }
#pragma unroll
                for (int mm = 0; mm < 2; ++mm)
#pragma unroll
                    for (int bj = 0; bj < 2; ++bj) { const u32x4 b = xb[mm][bj]; xr[mm][bj][0] = (f32x4){bf_lo(b.x), bf_hi(b.x), bf_lo(b.y), bf_hi(b.y)}; xr[mm][bj][1] = (f32x4){bf_lo(b.z), bf_hi(b.z), bf_lo(b.w), bf_hi(b.w)}; }
            }
#pragma unroll
            for (int mm = 0; mm < 2; ++mm) { const int m = m0 + mm; const int row = row0 + ai * 128 + m * 16; const size_t off = (size_t)row * DM + col0; float sq = 0.f;
#pragma unroll
                for (int bj = 0; bj < 2; ++bj) { const f32x4 o0 = xr[mm][bj][0] + acc[ai][bj][m][0], o1 = xr[mm][bj][1] + acc[ai][bj][m][1];
                    if (!ssn && !dry) { __builtin_nontemporal_store(o0, (f32x4*)(out + off + bj * 128)); __builtin_nontemporal_store(o1, (f32x4*)(out + off + bj * 128 + 4)); }
                    if (ssn && !dry) { const int col = col0 + bj * 128; sq += ((o0[0] * o0[0] + o0[1] * o0[1]) + (o0[2] * o0[2] + o0[3] * o0[3])) + ((o1[0] * o1[0] + o1[1] * o1[1]) + (o1[2] * o1[2] + o1[3] * o1[3]));
                        u32x4 w; w.x = pk_bf16(o0[0], o0[1]); w.y = pk_bf16(o0[2], o0[3]); w.z = pk_bf16(o1[0], o1[1]); w.w = pk_bf16(o1[2], o1[3]);
                        *(u32x4*)(XG + ((size_t)(col >> 9) * T_ + row) * 512 + (col & 511)) = w; } }
                if (ssn && !dry) { sq += __shfl_xor(sq, 16); sq += __shfl_xor(sq, 32); if (fq == 0) atomicAdd(ssn + row, sq); } }
        }
        return false;
    }
};

namespace attn {
constexpr int QBLK = 32, KVBLK = 64;
constexpr int SHM_K = KVBLK * 256, SHM_V = KVBLK * 64 * 2;
constexpr int NBUF = 3;
constexpr int LDS_V = 0, LDS_K = NBUF * SHM_V, LDS_CK = LDS_K + NBUF * SHM_K, LDS_WS = LDS_CK + NBUF * 256, LDS_OST = LDS_WS + 8 * 256, LDS_BYTES = LDS_OST + 8 * 4096;
constexpr float THR2 = 8.f;
#define KSWZ(row, colB) ((row) * 256 + ((colB) ^ (((row) & 15) << 4)))
__device__ __forceinline__ int crow(int r, int hi) { return (r & 3) + 8 * (r >> 2) + 4 * hi; }
__device__ __forceinline__ void partialSM(f32x16& p0, f32x16& p1, float& m_reg, float& alpha) {
    float pmax = p0[0];
#pragma unroll
    for (int r = 1; r < 16; ++r) pmax = fmaxf(pmax, p0[r]);
#pragma unroll
    for (int r = 0; r < 16; ++r) pmax = fmaxf(pmax, p1[r]);
    { auto rr = __builtin_amdgcn_permlane32_swap(__float_as_uint(pmax), __float_as_uint(pmax), false, false);
      pmax = fmaxf(__uint_as_float(rr[0]), __uint_as_float(rr[1])); }
    if (__builtin_expect(__all(pmax <= THR2), 1)) { alpha = 1.f; }
    else { const float dl = fmaxf(pmax, 0.f); m_reg += dl; alpha = __builtin_amdgcn_exp2f(-dl);
#pragma unroll
        for (int r = 0; r < 16; ++r) { p0[r] -= dl; p1[r] -= dl; } }
#pragma unroll
    for (int r = 0; r < 16; ++r) p0[r] = __builtin_amdgcn_exp2f(p0[r]);
}
__device__ __forceinline__ void finishSM(f32x16& p0, f32x16& p1, float alpha, float& l_reg, bf16x8& pa0, bf16x8& pa1, bf16x8& pa2, bf16x8& pa3) {
#pragma unroll
    for (int r = 0; r < 16; ++r) p1[r] = __builtin_amdgcn_exp2f(p1[r]);
    float ps = 0;
#pragma unroll
    for (int r = 0; r < 16; ++r) ps += p0[r];
#pragma unroll
    for (int r = 0; r < 16; ++r) ps += p1[r];
    { auto rr = __builtin_amdgcn_permlane32_swap(__float_as_uint(ps), __float_as_uint(ps), false, false);
      ps = __uint_as_float(rr[0]) + __uint_as_float(rr[1]); }
    l_reg = l_reg * alpha + ps;
#define PK4(P, BASE, OUT) do { unsigned a0 = pk_bf16(P[BASE + 0], P[BASE + 1]), a1 = pk_bf16(P[BASE + 2], P[BASE + 3]);   \
    unsigned b0 = pk_bf16(P[BASE + 4], P[BASE + 5]), b1 = pk_bf16(P[BASE + 6], P[BASE + 7]);                              \
    auto r0 = __builtin_amdgcn_permlane32_swap(a0, b0, false, false); auto r1 = __builtin_amdgcn_permlane32_swap(a1, b1, false, false); \
    u32x4 w = {r0[0], r1[0], r0[1], r1[1]}; OUT = __builtin_bit_cast(bf16x8, w); } while (0)
    PK4(p0, 0, pa0); PK4(p0, 8, pa1); PK4(p1, 0, pa2); PK4(p1, 8, pa3);
#undef PK4
}
__device__ __forceinline__ void expHalf(f32x16& p) {
#pragma unroll
    for (int r = 0; r < 16; ++r) p[r] = __builtin_amdgcn_exp2f(p[r]);
}
__device__ __forceinline__ void packP(const f32x16& p0, const f32x16& p1, bf16x8& pa0, bf16x8& pa1, bf16x8& pa2, bf16x8& pa3) {
#define PK4(P, BASE, OUT) do { unsigned a0 = pk_bf16(P[BASE + 0], P[BASE + 1]), a1 = pk_bf16(P[BASE + 2], P[BASE + 3]);   \
    unsigned b0 = pk_bf16(P[BASE + 4], P[BASE + 5]), b1 = pk_bf16(P[BASE + 6], P[BASE + 7]);                              \
    auto r0 = __builtin_amdgcn_permlane32_swap(a0, b0, false, false); auto r1 = __builtin_amdgcn_permlane32_swap(a1, b1, false, false); \
    u32x4 w = {r0[0], r1[0], r0[1], r1[1]}; OUT = __builtin_bit_cast(bf16x8, w); } while (0)
    PK4(p0, 0, pa0); PK4(p0, 8, pa1); PK4(p1, 0, pa2); PK4(p1, 8, pa3);
#undef PK4
}
__device__ __forceinline__ void sumP(const f32x16& p0, const f32x16& p1, float& l_reg) {
    float s0 = p0[0] + p0[1], s1 = p0[2] + p0[3], s2 = p1[0] + p1[1], s3 = p1[2] + p1[3];
#pragma unroll
    for (int r = 4; r < 16; r += 4) { s0 += p0[r] + p0[r + 1]; s1 += p0[r + 2] + p0[r + 3]; s2 += p1[r] + p1[r + 1]; s3 += p1[r + 2] + p1[r + 3]; }
    float ps = (s0 + s1) + (s2 + s3);
    { auto rr = __builtin_amdgcn_permlane32_swap(__float_as_uint(ps), __float_as_uint(ps), false, false); ps = __uint_as_float(rr[0]) + __uint_as_float(rr[1]); }
    l_reg += ps;
}
__device__ __forceinline__ void pv_sum(f32x16& la, bf16x8 pa0, bf16x8 pa1, bf16x8 pa2, bf16x8 pa3) {
    const u32x4 ow = {0x3F803F80u, 0x3F803F80u, 0x3F803F80u, 0x3F803F80u}; const bf16x8 ones = __builtin_bit_cast(bf16x8, ow);
    la = __builtin_amdgcn_mfma_f32_32x32x16_bf16(pa0, ones, la, 0, 0, 0);
    la = __builtin_amdgcn_mfma_f32_32x32x16_bf16(pa1, ones, la, 0, 0, 0);
    la = __builtin_amdgcn_mfma_f32_32x32x16_bf16(pa2, ones, la, 0, 0, 0);
    la = __builtin_amdgcn_mfma_f32_32x32x16_bf16(pa3, ones, la, 0, 0, 0);
}
__device__ __forceinline__ int v_st(int k, int c) { const int kk = (k & ~0xC) | ((k & 4) << 1) | ((k & 8) >> 1); return ((kk >> 3) * 2 + (c >> 5)) * 512 + ((kk & 7) * 32 + (c & 31)) * 2; }
__device__ __forceinline__ int v_rd_base(int lane) { return ((lane & 3) << 3) | (((lane >> 2) & 3) << 6) | (((lane >> 4) & 1) << 5) | (((lane >> 5) & 1) << 8); }
constexpr int v_rd_off(int d0, int ks, int half) { return d0 * 512 + ks * 2048 + half * 1024; }
template <int OFF> __device__ __forceinline__ s16x4 tr_read(int vb) {
    s16x4 r; asm volatile("ds_read_b64_tr_b16 %0, %1 offset:%2" : "=&v"(r) : "v"(vb), "i"(OFF) : "memory"); return r;
}
template <int OFF> __device__ __forceinline__ s16x4 trb(int vb) {
    return __builtin_amdgcn_ds_read_tr16_b64_v4i16((LAS s16x4*)(size_t)(unsigned)(vb + OFF));
}
#define SG(mask, n) __builtin_amdgcn_sched_group_barrier(mask, n, 0)
#define SGI(mask, n, id) __builtin_amdgcn_sched_group_barrier(mask, n, id)
#define SG_MFMA 0x008
#define SG_VALU 0x002
#define SG_DSR  0x100
template <int D0> __device__ __forceinline__ void pv_one(f32x16& od, int vb, bf16x8 pa0, bf16x8 pa1, bf16x8 pa2, bf16x8 pa3) {
    const s16x4 l0 = tr_read<v_rd_off(D0, 0, 0)>(vb), h0 = tr_read<v_rd_off(D0, 0, 1)>(vb), l1 = tr_read<v_rd_off(D0, 1, 0)>(vb), h1 = tr_read<v_rd_off(D0, 1, 1)>(vb);
    const s16x4 l2 = tr_read<v_rd_off(D0, 2, 0)>(vb), h2 = tr_read<v_rd_off(D0, 2, 1)>(vb), l3 = tr_read<v_rd_off(D0, 3, 0)>(vb), h3 = tr_read<v_rd_off(D0, 3, 1)>(vb);
    asm volatile("s_waitcnt lgkmcnt(0)" ::: "memory"); SBAR();
#define PKV(L, H) (bf16x8){L[0], L[1], L[2], L[3], H[0], H[1], H[2], H[3]}
    od = __builtin_amdgcn_mfma_f32_32x32x16_bf16(pa0, PKV(l0, h0), od, 0, 0, 0);
    od = __builtin_amdgcn_mfma_f32_32x32x16_bf16(pa1, PKV(l1, h1), od, 0, 0, 0);
    od = __builtin_amdgcn_mfma_f32_32x32x16_bf16(pa2, PKV(l2, h2), od, 0, 0, 0);
    od = __builtin_amdgcn_mfma_f32_32x32x16_bf16(pa3, PKV(l3, h3), od, 0, 0, 0);
#undef PKV
}

template <int DQK, bool FOX, bool TRACK>
__device__ __forceinline__ void attn_unit(bf16_t* Qh, int ldq, const bf16_t* Kh, int ldk, const bf16_t* Vh, int ldv, const float* cum, int q0, char* lds, bool dry, float sbound, int T0, const float* qgain, const int* posb, float qscale) {
    constexpr int ND = DQK / 16, KCH = DQK / 8;
    int tid = threadIdx.x; asm volatile("" : "+v"(tid));
    const int wid = __builtin_amdgcn_readfirstlane(tid >> 6), lane = tid & 63, r32 = lane & 31, hi = lane >> 5;
    char* V_lds = lds + LDS_V; char* K_lds = lds + LDS_K; float* CK_lds = (float*)(lds + LDS_CK);
    float* ws = (float*)(lds + LDS_WS) + wid * 64; float* li_l = ws; float* al_l = ws + 32;
    float m_reg = 0.f, l_reg = 0; f32x16 o[2]; o[0] = f32x16{}; o[1] = f32x16{}; bf16x8 qr[ND];
    const int qrow = q0 + wid * QBLK + r32;
    { const bf16_t* Qw = Qh + (size_t)qrow * ldq + hi * 8;
#pragma unroll
      for (int d0 = 0; d0 < ND; ++d0) qr[d0] = *reinterpret_cast<const bf16x8*>(Qw + d0 * 16); }
    float cq = 0.f; if (FOX) cq = cum[qrow];
    const int kr0 = tid / KCH, kc0 = tid % KCH;
    const int kr1 = (tid + 512) / KCH, kc1 = (tid + 512) % KCH;
    const bool k2 = (KCH * 64 > 512) && (tid + 512 < KCH * 64);
    const int vr = tid >> 3, vc = (tid & 7) * 8, vst = v_st(vr, vc);
    const int vb0 = (int)(uintptr_t)V_lds + v_rd_base(lane);
    struct Stg { bf16x8 k0, k1, v; f32x4 ck; } st[2];
    const int kr1c = (kr1 < 64) ? kr1 : 63;
    const int ckc = (tid & 15) * 4;
#define SLOAD(i, k0_) do { st[i].k0 = *reinterpret_cast<const bf16x8*>(Kh + (size_t)((k0_) + kr0) * ldk + kc0 * 8); \
      if (KCH * 64 > 512) st[i].k1 = *reinterpret_cast<const bf16x8*>(Kh + (size_t)((k0_) + kr1c) * ldk + kc1 * 8); \
      st[i].v = *reinterpret_cast<const bf16x8*>(Vh + (size_t)((k0_) + vr) * ldv + vc); \
      if (FOX) st[i].ck = *reinterpret_cast<const f32x4*>(cum + (k0_) + ckc); } while (0)
#define SWRITE(b, i) do { *(bf16x8*)(K_lds + (b) * SHM_K + KSWZ(kr0, kc0 * 16)) = st[i].k0; \
      if (k2) *(bf16x8*)(K_lds + (b) * SHM_K + KSWZ(kr1, kc1 * 16)) = st[i].k1; \
      *(bf16x8*)(V_lds + (b) * SHM_V + vst) = st[i].v; \
      if (FOX && tid < 16) *(f32x4*)(CK_lds + (b) * 64 + tid * 4) = st[i].ck; } while (0)
#define RESC(a) do { if (TRACK && __any((a) < 1.f)) { if (hi == 0) al_l[r32] = (a); asm volatile("s_waitcnt lgkmcnt(0)" ::: "memory"); \
      _Pragma("unroll") for (int d = 0; d < 2; ++d) _Pragma("unroll") for (int r = 0; r < 16; ++r) o[d][r] *= al_l[crow(r, hi)]; } } while (0)
    const int NT = (q0 + 256) / KVBLK;
    const int tlast = __builtin_amdgcn_readfirstlane((q0 + wid * QBLK + (FOX ? 31 : 0)) >> 6);
    int tfirst = 0;
    if (FOX && TRACK) { const float c0w = cum[q0 + wid * QBLK]; bool need = false; const int nbw = (q0 + wid * QBLK) >> 6;
        if (lane < nbw) need = (sbound + c0w - cum[64 * lane + 63] >= -40.f);
        const unsigned long long bal = __ballot(need);
        tfirst = __builtin_amdgcn_readfirstlane(bal ? (__ffsll((long long)bal) - 1) : nbw); }
    auto qkt = [&](f32x16& p0, f32x16& p1, int b, int t) {
        if (t > tlast || t < tfirst) return;
        const char* Ks = K_lds + b * SHM_K;
        if (FOX) { const float* ck = CK_lds + b * 64; const float cqm = TRACK ? cq - m_reg : cq;
#pragma unroll
            for (int g = 0; g < 4; ++g) { const f32x4 c0 = *(const f32x4*)(ck + 8 * g + 4 * hi), c1 = *(const f32x4*)(ck + 32 + 8 * g + 4 * hi);
#pragma unroll
                for (int i = 0; i < 4; ++i) { p0[4 * g + i] = cqm - c0[i]; p1[4 * g + i] = cqm - c1[i]; } }
        } else if (TRACK) { const float nm = -m_reg;
#pragma unroll
            for (int r = 0; r < 16; ++r) { p0[r] = nm; p1[r] = nm; } }
        else { p0 = f32x16{}; p1 = f32x16{}; }
#pragma unroll
        for (int d0 = 0; d0 < ND; ++d0) { const int cb = (d0 * 16 + hi * 8) * 2;
            const bf16x8 b0 = *reinterpret_cast<const bf16x8*>(Ks + KSWZ(r32, cb));
            const bf16x8 b1 = *reinterpret_cast<const bf16x8*>(Ks + KSWZ(32 + r32, cb));
            p0 = __builtin_amdgcn_mfma_f32_32x32x16_bf16(b0, qr[d0], p0, 0, 0, 0);
            p1 = __builtin_amdgcn_mfma_f32_32x32x16_bf16(b1, qr[d0], p1, 0, 0, 0); }
        if (FOX && t >= NT - 4) {
            asm volatile("" ::: "memory");
            const int kb = t * KVBLK + 4 * hi;
#pragma unroll
            for (int r = 0; r < 16; ++r) { const int kv = kb + (r & 3) + 8 * (r >> 2);
                if (kv > qrow) p0[r] = -INFINITY; if (kv + 32 > qrow) p1[r] = -INFINITY; }
        }
    };
#define PSM(P0, P1, AL, t) do { if (TRACK) { if ((t) <= tlast && (t) >= tfirst) partialSM(P0, P1, m_reg, AL); else AL = 1.f; } else if ((t) <= tlast && (t) >= tfirst) expHalf(P0); } while (0)
#define FSM(P0, P1, AL, t) do { if ((t) <= tlast && (t) >= tfirst) { if (TRACK) finishSM(P0, P1, AL, l_reg, pa0, pa1, pa2, pa3); else { expHalf(P1); sumP(P0, P1, l_reg); packP(P0, P1, pa0, pa1, pa2, pa3); } } } while (0)
#define PV(vb, t) do { if ((t) <= tlast && (t) >= tfirst) { pv_one<0>(o[0], vb, pa0, pa1, pa2, pa3); pv_one<1>(o[1], vb, pa0, pa1, pa2, pa3); } } while (0)
    f32x16 pA0, pA1, pB0, pB1; float alA, alB; bf16x8 pa0, pa1, pa2, pa3;
#define PKV(L, H) (bf16x8){L[0], L[1], L[2], L[3], H[0], H[1], H[2], H[3]}
#define SG_R1_STEP(nr) SG(SG_MFMA, 1); SG(SG_VALU, FOX ? 10 : 7); SG(SG_DSR, nr)
#define TRA(OFF) tr_read<OFF>(vbp_)
#define FAST_HALF(X0, X1, Y0, Y1, LOADSTMT, WRITESTMT) do { \
        SBAR(); \
        { const char* Ks = K_lds + bc * SHM_K; \
          if (FOX) { const float* ck = CK_lds + bc * 64; \
              _Pragma("unroll") for (int g = 0; g < 4; ++g) { const f32x4 c0 = *(const f32x4*)(ck + 8 * g + 4 * hi), c1 = *(const f32x4*)(ck + 32 + 8 * g + 4 * hi); \
                  _Pragma("unroll") for (int i = 0; i < 4; ++i) { X0[4 * g + i] = cq - c0[i]; X1[4 * g + i] = cq - c1[i]; } } } \
          else { X0 = f32x16{}; X1 = f32x16{}; } \
          _Pragma("unroll") for (int d0 = 0; d0 < ND; ++d0) { const int cb = (d0 * 16 + hi * 8) * 2; \
              const bf16x8 b0 = *reinterpret_cast<const bf16x8*>(Ks + KSWZ(r32, cb)); \
              const bf16x8 b1 = *reinterpret_cast<const bf16x8*>(Ks + KSWZ(32 + r32, cb)); \
              X0 = __builtin_amdgcn_mfma_f32_32x32x16_bf16(b0, qr[d0], X0, 0, 0, 0); \
              X1 = __builtin_amdgcn_mfma_f32_32x32x16_bf16(b1, qr[d0], X1, 0, 0, 0); } } \
        expHalf(Y1); sumP(Y0, Y1, l_reg); packP(Y0, Y1, pa0, pa1, pa2, pa3); \
        if (FOX) { SG(SG_DSR, 12); SG(SG_VALU, 32); SG_R1_STEP(1); SG_R1_STEP(1); SG_R1_STEP(1); SG_R1_STEP(1); SG_R1_STEP(0); SG_R1_STEP(0); SG_R1_STEP(0); SG_R1_STEP(0); } \
        else { SG(SG_DSR, 4); SG_R1_STEP(1); SG_R1_STEP(1); SG_R1_STEP(1); SG_R1_STEP(1); SG_R1_STEP(1); SG_R1_STEP(1); SG_R1_STEP(1); SG_R1_STEP(1); SG_R1_STEP(0); SG_R1_STEP(0); SG_R1_STEP(0); SG_R1_STEP(0); } \
        asm volatile("" : "+v"(X0), "+v"(X1), "+v"(pa0), "+v"(pa1), "+v"(pa2), "+v"(pa3), "+v"(l_reg));     \
        const int vbp_ = vb0 + bp * SHM_V; \
        const s16x4 va0 = TRA(v_rd_off(0, 0, 0)), va1 = TRA(v_rd_off(0, 0, 1)), va2 = TRA(v_rd_off(0, 1, 0)), va3 = TRA(v_rd_off(0, 1, 1)); \
        const s16x4 va4 = TRA(v_rd_off(0, 2, 0)), va5 = TRA(v_rd_off(0, 2, 1)), va6 = TRA(v_rd_off(0, 3, 0)), va7 = TRA(v_rd_off(0, 3, 1)); \
        SBAR(); \
        LOADSTMT; \
        asm volatile("s_waitcnt lgkmcnt(0)" ::: "memory"); SBAR(); \
        const s16x4 vc0 = TRA(v_rd_off(1, 0, 0)), vc1 = TRA(v_rd_off(1, 0, 1)), vc2 = TRA(v_rd_off(1, 1, 0)), vc3 = TRA(v_rd_off(1, 1, 1)); \
        const s16x4 vc4 = TRA(v_rd_off(1, 2, 0)), vc5 = TRA(v_rd_off(1, 2, 1)), vc6 = TRA(v_rd_off(1, 3, 0)), vc7 = TRA(v_rd_off(1, 3, 1)); \
        o[0] = __builtin_amdgcn_mfma_f32_32x32x16_bf16(pa0, PKV(va0, va1), o[0], 0, 0, 0); \
        o[0] = __builtin_amdgcn_mfma_f32_32x32x16_bf16(pa1, PKV(va2, va3), o[0], 0, 0, 0); \
        o[0] = __builtin_amdgcn_mfma_f32_32x32x16_bf16(pa2, PKV(va4, va5), o[0], 0, 0, 0); \
        o[0] = __builtin_amdgcn_mfma_f32_32x32x16_bf16(pa3, PKV(va6, va7), o[0], 0, 0, 0); \
        _Pragma("unroll") for (int r = 0; r < 8; ++r) X0[r] = __builtin_amdgcn_exp2f(X0[r]); \
        SGI(SG_MFMA, 1, 1); SGI(SG_VALU, 2, 1); SGI(SG_MFMA, 1, 1); SGI(SG_VALU, 2, 1); SGI(SG_MFMA, 1, 1); SGI(SG_VALU, 2, 1); SGI(SG_MFMA, 1, 1); SGI(SG_VALU, 2, 1); \
        asm volatile("" : "+v"(X0), "+v"(o[0])); \
        asm volatile("s_waitcnt lgkmcnt(0)" ::: "memory"); SBAR(); \
        o[1] = __builtin_amdgcn_mfma_f32_32x32x16_bf16(pa0, PKV(vc0, vc1), o[1], 0, 0, 0); \
        o[1] = __builtin_amdgcn_mfma_f32_32x32x16_bf16(pa1, PKV(vc2, vc3), o[1], 0, 0, 0); \
        o[1] = __builtin_amdgcn_mfma_f32_32x32x16_bf16(pa2, PKV(vc4, vc5), o[1], 0, 0, 0); \
        o[1] = __builtin_amdgcn_mfma_f32_32x32x16_bf16(pa3, PKV(vc6, vc7), o[1], 0, 0, 0); \
        _Pragma("unroll") for (int r = 8; r < 16; ++r) X0[r] = __builtin_amdgcn_exp2f(X0[r]); \
        SGI(SG_MFMA, 1, 2); SGI(SG_VALU, 2, 2); SGI(SG_MFMA, 1, 2); SGI(SG_VALU, 2, 2); SGI(SG_MFMA, 1, 2); SGI(SG_VALU, 2, 2); SGI(SG_MFMA, 1, 2); SGI(SG_VALU, 2, 2); \
        asm volatile("" : "+v"(X0), "+v"(o[1])); \
        SBAR(); \
        WRITESTMT; __syncthreads(); } while (0)
    SLOAD(0, T0 * KVBLK); SLOAD(1, (T0 + 1) * KVBLK); SBAR();
    { float ssq = 0.f;
#pragma unroll
      for (int d0 = 0; d0 < ND; ++d0)
#pragma unroll
          for (int e = 0; e < 8; ++e) { const float v = __uint_as_float((unsigned)(unsigned short)qr[d0][e] << 16); ssq += v * v; }
      { auto rr = __builtin_amdgcn_permlane32_swap(__float_as_uint(ssq), __float_as_uint(ssq), false, false); ssq = __uint_as_float(rr[0]) + __uint_as_float(rr[1]); }
      const float rn = rsqrtf(ssq * (1.f / DQK) + EPS) * qscale;
      constexpr int NPL = FOX ? ND : 4;
#pragma unroll
      for (int d0 = 0; d0 < NPL; ++d0) { u32x4 w;
#pragma unroll
          for (int e2 = 0; e2 < 4; ++e2) w[e2] = pk_bf16(__uint_as_float((unsigned)(unsigned short)qr[d0][2 * e2] << 16) * rn, __uint_as_float((unsigned)(unsigned short)qr[d0][2 * e2 + 1] << 16) * rn);
          qr[d0] = __builtin_bit_cast(bf16x8, w); }
      if (!FOX) { const float pf = (float)posb[qrow] * 0.15915494309189535f; float r1[8], r2[8];
#pragma unroll
          for (int e = 0; e < 8; ++e) { const float inv = hi ? exp2f(-(float)(8 + e) * (13.287712379549449f / 16.f)) : exp2f(-(float)e * (13.287712379549449f / 16.f));
              const float rev = __builtin_amdgcn_fractf(pf * inv); const float cs = __builtin_amdgcn_cosf(rev), sn = __builtin_amdgcn_sinf(rev);
              const float x1 = __uint_as_float((unsigned)(unsigned short)qr[4][e] << 16) * rn, x2 = __uint_as_float((unsigned)(unsigned short)qr[5][e] << 16) * rn;
              r1[e] = x1 * cs - x2 * sn; r2[e] = x1 * sn + x2 * cs; }
          u32x4 wa, wb;
#pragma unroll
          for (int e2 = 0; e2 < 4; ++e2) { wa[e2] = pk_bf16(r1[2 * e2], r1[2 * e2 + 1]); wb[e2] = pk_bf16(r2[2 * e2], r2[2 * e2 + 1]); }
          qr[ND - 2] = __builtin_bit_cast(bf16x8, wa); qr[ND - 1] = __builtin_bit_cast(bf16x8, wb); } }
    SWRITE(0, 0); __syncthreads();
    qkt(pA0, pA1, 0, T0); PSM(pA0, pA1, alA, T0);
    SLOAD(0, (T0 + 2) * KVBLK); SBAR();
    SWRITE(1, 1); __syncthreads();
    int bp = 0, bc = 1, bn = 2;
    int j = T0 + 1;
    if (!TRACK) {
        const int JF = FOX ? NT - 5 : NT - 4;
        for (; j + 1 <= JF; j += 2) {
            FAST_HALF(pB0, pB1, pA0, pA1, SLOAD(1, (j + 2) * KVBLK), SWRITE(bn, 0));
            { const int t_ = bp; bp = bc; bc = bn; bn = t_; }
            FAST_HALF(pA0, pA1, pB0, pB1, SLOAD(0, (j + 3) * KVBLK), SWRITE(bn, 1));
            { const int t_ = bp; bp = bc; bc = bn; bn = t_; }
        }
    }
    for (; j + 1 < NT; j += 2) {
        SBAR(); qkt(pB0, pB1, bc, j);
        FSM(pA0, pA1, alA, j - 1); SBAR();
        SLOAD(1, (j + 2) * KVBLK); SBAR();
        PV(vb0 + bp * SHM_V, j - 1); PSM(pB0, pB1, alB, j);
        SWRITE(bn, 0);
        RESC(alB); __syncthreads();
        { const int t_ = bp; bp = bc; bc = bn; bn = t_; }
        SBAR(); qkt(pA0, pA1, bc, j + 1);
        FSM(pB0, pB1, alB, j); SBAR();
        if (j + 3 < NT) SLOAD(0, (j + 3) * KVBLK); SBAR();
        PV(vb0 + bp * SHM_V, j); PSM(pA0, pA1, alA, j + 1);
        SWRITE(bn, 1);
        RESC(alA); __syncthreads();
        { const int t_ = bp; bp = bc; bc = bn; bn = t_; }
    }
    SBAR(); qkt(pB0, pB1, bc, NT - 1);
    FSM(pA0, pA1, alA, NT - 2); SBAR();
    PV(vb0 + bp * SHM_V, NT - 2); PSM(pB0, pB1, alB, NT - 1);
    RESC(alB);
    FSM(pB0, pB1, alB, NT - 1); SBAR();
    PV(vb0 + bc * SHM_V, NT - 1);
#undef PSM
#undef FSM
#undef PV
#undef FAST_HALF
#undef TRA
#undef SG_R1_STEP
#undef PKV
    if (hi == 0) li_l[r32] = l_reg; asm volatile("s_waitcnt lgkmcnt(0)" ::: "memory");
    float rli[16];
#pragma unroll
    for (int r = 0; r < 16; ++r) rli[r] = __builtin_amdgcn_rcpf(li_l[crow(r, hi)]);
    { bf16_t* stg = (bf16_t*)(lds + LDS_OST) + wid * 2048;
#pragma unroll
      for (int r = 0; r < 16; ++r) { const int orow = crow(r, hi);
#pragma unroll
          for (int d0 = 0; d0 < 2; ++d0) stg[orow * 64 + d0 * 32 + r32] = f2bf(o[d0][r] * rli[r]); }
      asm volatile("s_waitcnt lgkmcnt(0)" ::: "memory");
      bf16_t* Ow = Qh + (size_t)(q0 + wid * QBLK) * ldq;
#pragma unroll
      for (int i = 0; i < 4; ++i) { const int row = i * 8 + (lane >> 3), ch = lane & 7; const u32x4 v = *(const u32x4*)(stg + row * 64 + ch * 8); if (!dry) *(u32x4*)(Ow + (size_t)row * ldq + ch * 8) = v; } }
    __syncthreads();
#undef SLOAD
#undef SWRITE
#undef RESC
}
}

__device__ __forceinline__ int map_in(int n) {
    if (n < 416) return n;
    if (n < 424) return 1952 + (n - 416);
    if (n < 512) return -1;
    if (n < 2048) return n - 512 + 416;
    if (n < 2560) return n - 2048 + 1960;
    if (n < 4096) return n - 2560 + 2472;
    return n - 4096 + 4008;
}
struct ConvD { const float* src; const float* kscale; bf16_t* dst; int ldsrc, K, N, dld, item, k0, n0; bool split512, mapped; };
struct ConvK { f32x4 a, b; };
__device__ __forceinline__ void conv_load(const ConvD& d, int lane, float (&x)[32], ConvK& ks) {
    const int k0 = d.k0, n0 = d.n0;
    const int kr = lane >> 3, nc = lane & 7;
    const int sn = d.mapped ? map_in(n0 + 4 * nc) : n0 + 4 * nc;
#pragma unroll
    for (int i = 0; i < 8; ++i) { f32x4 v = (f32x4){0.f, 0.f, 0.f, 0.f}; if (sn >= 0) v = __builtin_nontemporal_load((const f32x4*)(d.src + (size_t)(k0 + 8 * i + kr) * d.ldsrc + sn));
        x[4 * i] = v[0]; x[4 * i + 1] = v[1]; x[4 * i + 2] = v[2]; x[4 * i + 3] = v[3]; }
    ks.a = (f32x4){1.f, 1.f, 1.f, 1.f}; ks.b = ks.a;
    if (d.kscale) { ks.a = *(const f32x4*)(d.kscale + k0 + 8 * (lane & 7)); ks.b = *(const f32x4*)(d.kscale + k0 + 8 * (lane & 7) + 4); }
}
__device__ __forceinline__ void conv_finish(const ConvD& d, LAS float* scr, int lane, const float (&x)[32], const ConvK& ks) {
    const int k0 = d.k0, n0 = d.n0;
    const int kr = lane >> 3, nc = lane & 7;
#pragma unroll
    for (int i = 0; i < 8; ++i)
#pragma unroll
        for (int e = 0; e < 4; ++e) scr[(8 * i + kr) * 33 + 4 * nc + e] = x[4 * i + e];
    asm volatile("s_waitcnt lgkmcnt(0)" ::: "memory");
    const int cch = lane & 7;
#pragma unroll
    for (int j = 0; j < 4; ++j) { const int n = (lane >> 3) + 8 * j; const LAS float* sp = scr + (8 * cch) * 33 + n;
        u32x4 o; o.x = pk_bf16(sp[0 * 33] * ks.a[0], sp[1 * 33] * ks.a[1]); o.y = pk_bf16(sp[2 * 33] * ks.a[2], sp[3 * 33] * ks.a[3]); o.z = pk_bf16(sp[4 * 33] * ks.b[0], sp[5 * 33] * ks.b[1]); o.w = pk_bf16(sp[6 * 33] * ks.b[2], sp[7 * 33] * ks.b[3]);
        bf16_t* dp = d.split512 ? (d.dst + ((size_t)(k0 >> 9) * d.N + n0 + n) * 512 + (k0 & 511) + 8 * cch) : (d.dst + (size_t)(n0 + n) * d.dld + k0 + 8 * cch);
        *(u32x4*)dp = o; }
    asm volatile("s_waitcnt lgkmcnt(0)" ::: "memory");
}
__device__ __forceinline__ void phase0(const Ctx& c, const int part) {
    PHASE_IDS(); ArgsP ap = get_args(); unsigned char* ws = ap->ws;
    const long gtid = (long)c.bid * 512 + tid, gthreads = (long)grid_g() * 512;
    const int gw = c.bid * 8 + wave, ngw = grid_g() * 8;
    LAS float* scr = (LAS float*)(c.lds + wave * 8448);
    constexpr int I_IN_ = 16 * 224, I_Q_ = 4 * 24, I_KV_ = 2 * 32, I_GLU_ = 8 * 16, I_BO_ = 8 * 32, I_OUT_ = 16 * 32, I_L = I_IN_ + I_Q_ + I_KV_ + I_GLU_ + 3 * I_BO_ + I_OUT_;
    auto conv_desc = [&](int it) -> ConvD { ConvD d; const int l = it / I_L; int r = it % I_L; d.kscale = nullptr; d.split512 = false; d.mapped = false;
        if (r < I_IN_) { d.src = ap->in[I_WIN] + (size_t)l * DM * IN_SRC; d.ldsrc = IN_SRC; d.K = DM; d.N = NIN; d.dst = (bf16_t*)(ws + WS_WIN) + (size_t)l * 2 * NIN * 512; d.dld = 512; d.split512 = true; d.mapped = true; d.kscale = ap->in[I_NORMG] + l * DM; d.item = r; { constexpr int nb_ = NIN / 32; d.k0 = 64 * (d.item / nb_); d.n0 = 32 * (d.item % nb_); } return d; } r -= I_IN_;
        if (r < I_Q_) { d.src = ap->in[I_WQUP] + (size_t)l * 256 * 768; d.ldsrc = 768; d.K = 256; d.N = 768; d.dst = (bf16_t*)(ws + WS_WQ) + (size_t)l * 768 * 256; d.dld = 256; d.kscale = ap->in[I_QAN] + l * 256; d.item = r; { constexpr int nb_ = 768 / 32; d.k0 = 64 * (d.item / nb_); d.n0 = 32 * (d.item % nb_); } return d; } r -= I_Q_;
        if (r < I_KV_) { d.src = ap->in[I_WKVUP] + (size_t)l * 128 * 1024; d.ldsrc = 1024; d.K = 128; d.N = 1024; d.dst = (bf16_t*)(ws + WS_WKV) + (size_t)l * 1024 * 256; d.dld = 256; d.kscale = ap->in[I_KVAN] + l * 128; d.item = r; { constexpr int nb_ = 1024 / 32; d.k0 = 64 * (d.item / nb_); d.n0 = 32 * (d.item % nb_); } return d; } r -= I_KV_;
        if (r < I_GLU_) { d.src = ap->in[I_WGLU] + (size_t)l * 512 * 512; d.ldsrc = 512; d.K = 512; d.N = 512; d.dst = (bf16_t*)(ws + WS_WGLU) + (size_t)l * 512 * 512; d.dld = 512; d.item = r; { constexpr int nb_ = 512 / 32; d.k0 = 64 * (d.item / nb_); d.n0 = 32 * (d.item % nb_); } return d; } r -= I_GLU_;
        if (r < 3 * I_BO_) { const int br = r / I_BO_; d.src = ap->in[I_WBO] + ((size_t)l * 1536 + br * 512) * 1024; d.ldsrc = 1024; d.K = 512; d.N = 1024; d.dst = (bf16_t*)(ws + WS_WBO) + ((size_t)l * 3 + br) * 1024 * 512; d.dld = 512; d.item = r % I_BO_; { constexpr int nb_ = 1024 / 32; d.k0 = 64 * (d.item / nb_); d.n0 = 32 * (d.item % nb_); } return d; } r -= 3 * I_BO_;
        d.src = ap->in[I_WOUT] + (size_t)l * DM * DM; d.ldsrc = DM; d.K = DM; d.N = DM; d.dst = (bf16_t*)(ws + WS_WOUT) + (size_t)l * DM * DM; d.dld = DM; d.item = r; { constexpr int nb_ = DM / 32; d.k0 = 64 * (d.item / nb_); d.n0 = 32 * (d.item % nb_); } return d; };
    constexpr int N_A = 16 * 80, N_B = NL * I_L - N_A;
    auto item_of = [&](int idx) -> int { if (part == 0) return (idx / 80) * 224 + (idx % 80);
        return idx < 16 * 144 ? (idx / 144) * 224 + 80 + (idx % 144) : I_IN_ + (idx - 16 * 144); };
    const int n_items = part == 0 ? N_A : N_B;
    if (gw < n_items) {
        ConvD dc = conv_desc(item_of(gw)); float xc[32]; ConvK kc; conv_load(dc, lane, xc, kc);
        for (int it = gw; it < n_items; it += ngw) {
            const int nit = it + ngw; const bool hn = nit < n_items;
            ConvD dn = dc; float xn[32]; ConvK kn = kc;
#pragma unroll
            for (int i = 0; i < 32; ++i) xn[i] = 0.f;
            if (hn) { dn = conv_desc(item_of(nit)); conv_load(dn, lane, xn, kn); }
            SBAR();
            conv_finish(dc, scr, lane, xc, kc);
            dc = dn; kc = kn;
#pragma unroll
            for (int i = 0; i < 32; ++i) xc[i] = xn[i];
        }
    }
    if (part == 1) {
    for (long it = (wave == 1 ? (long)c.bid * 64 + lane : (long)NL * 32 * 64); it < NL * 32 * 64; it += (long)grid_g() * 64) {
        const int n = (int)(it & 63), g = (int)((it >> 6) & 31), l = (int)(it >> 11);
        const float dt = expf(ap->in[I_LDT][l * 32 + g]);
        const float lr = ap->in[I_LRE][(l * 32 + g) * 64 + n], li = ap->in[I_LIM][(l * 32 + g) * 64 + n];
        const float mag = expf(lr * dt), ang = li * dt;
        float rev = ang * 0.15915494309189535f; rev -= floorf(rev);
        const float are = mag * __builtin_amdgcn_cosf(rev), aim = mag * __builtin_amdgcn_sinf(rev);
        float pr = are, pi = aim;
#pragma unroll
        for (int s = 0; s < 6; ++s) { const float nr = pr * pr - pi * pi, ni = 2.f * pr * pi; pr = nr; pi = ni; }
        ((f32x4*)(ws + WS_TA))[it] = (f32x4){are, aim, pr, pi};
        const float den = lr * lr + li * li;
        const float fre = ((are - 1.f) * lr + aim * li) / den, fim = (aim * lr - (are - 1.f) * li) / den;
        const float* bre = ap->in[I_BRE] + it * 16; const float* bim = ap->in[I_BIM] + it * 16;
        float bbr[16], bbi[16];
#pragma unroll
        for (int cc = 0; cc < 16; ++cc) { const float br = bre[cc], bi = bim[cc]; bbr[cc] = fre * br - fim * bi; bbi[cc] = fre * bi + fim * br; }
        { const int nre = (n < 32) ? n : 64 + (n - 32), nim = nre + 32; bf16_t* tb = (bf16_t*)(ws + WS_TBB) + (size_t)(l * 32 + g) * 128 * 16;
          u32x4 w0, w1;
          w0.x = pk_bf16(bbr[0], bbr[1]); w0.y = pk_bf16(bbr[2], bbr[3]); w0.z = pk_bf16(bbr[4], bbr[5]); w0.w = pk_bf16(bbr[6], bbr[7]);
          w1.x = pk_bf16(bbr[8], bbr[9]); w1.y = pk_bf16(bbr[10], bbr[11]); w1.z = pk_bf16(bbr[12], bbr[13]); w1.w = pk_bf16(bbr[14], bbr[15]);
          *(u32x4*)(tb + nre * 16) = w0; *(u32x4*)(tb + nre * 16 + 8) = w1;
          w0.x = pk_bf16(bbi[0], bbi[1]); w0.y = pk_bf16(bbi[2], bbi[3]); w0.z = pk_bf16(bbi[4], bbi[5]); w0.w = pk_bf16(bbi[6], bbi[7]);
          w1.x = pk_bf16(bbi[8], bbi[9]); w1.y = pk_bf16(bbi[10], bbi[11]); w1.z = pk_bf16(bbi[12], bbi[13]); w1.w = pk_bf16(bbi[14], bbi[15]);
          *(u32x4*)(tb + nim * 16) = w0; *(u32x4*)(tb + nim * 16 + 8) = w1; }
        { bf16_t* tc = (bf16_t*)(ws + WS_TC) + (size_t)(l * 32 + g) * 16 * 128;
#pragma unroll
          for (int cc = 0; cc < 16; ++cc) { const float cr = ap->in[I_CRE][((size_t)(l * 32 + g) * 16 + cc) * 64 + n], ci = ap->in[I_CIM][((size_t)(l * 32 + g) * 16 + cc) * 64 + n];
              *(unsigned*)(tc + cc * 128 + 2 * n) = pk_bf16(cr, -ci); } }
    }
    }
    if (part == 0) { const float* x = ap->in[I_X]; bf16_t* XG = (bf16_t*)(ws + WS_XG); float* ss = (float*)(ws + WS_SS);
      f32x4 nxv[4];
      const int gwv = c.vb * 8 + wave; const bool g256 = grid_g() == 256; const int row_b = g256 ? gwv * 8 : gw, row_s = g256 ? 1 : ngw, row_e = g256 ? gwv * 8 + 8 : T_;
#pragma unroll
      for (int j = 0; j < 4; ++j) nxv[j] = __builtin_nontemporal_load((const f32x4*)(x + (size_t)(row_b < T_ ? row_b : 0) * DM + (j >> 1) * 512 + lane * 8 + (j & 1) * 4));
      for (int row = row_b; row < row_e; row += row_s) { float s = 0.f; f32x4 v[4];
#pragma unroll
          for (int j = 0; j < 4; ++j) v[j] = nxv[j];
          { const int nrow = (row + row_s < row_e) ? row + row_s : row;
#pragma unroll
            for (int j = 0; j < 4; ++j) nxv[j] = __builtin_nontemporal_load((const f32x4*)(x + (size_t)nrow * DM + (j >> 1) * 512 + lane * 8 + (j & 1) * 4)); }
          SBAR();
#pragma unroll
          for (int j2 = 0; j2 < 2; ++j2) { const f32x4 a = v[2 * j2], b = v[2 * j2 + 1];
              s += ((a[0] * a[0] + a[1] * a[1]) + (a[2] * a[2] + a[3] * a[3])) + ((b[0] * b[0] + b[1] * b[1]) + (b[2] * b[2] + b[3] * b[3]));
              u32x4 w; w.x = pk_bf16(a[0], a[1]); w.y = pk_bf16(a[2], a[3]); w.z = pk_bf16(b[0], b[1]); w.w = pk_bf16(b[2], b[3]);
              *(u32x4*)(XG + ((size_t)j2 * T_ + row) * 512 + lane * 8) = w; }
          s = wave_sum(s); if (lane == 0) ss[row] = s; }
      for (long i = gtid; i < T_; i += gthreads) ss[T_ + i] = 0.f;
      for (long i = gtid; i < 2 * NL * T_; i += gthreads) ((float*)(ws + WS_SSQ))[i] = 0.f;
      for (long i = gtid; i < 8 * 3456; i += gthreads) ((unsigned*)(ws + WS_PBAR))[i] = 0u;
      for (long i = gtid; i < (long)NL * 1024 * 16; i += gthreads) *(u32x4*)((bf16_t*)(ws + WS_WKV) + (i >> 4) * 256 + 128 + (i & 15) * 8) = (u32x4){0u, 0u, 0u, 0u}; }
}

struct S5Coef { float a1r, a1i, a2r, a2i, a3r, a3i, a4r, a4i; };
__device__ __forceinline__ S5Coef s5_coef(float ar, float ai) { S5Coef q; q.a1r = ar; q.a1i = ai; q.a2r = ar * ar - ai * ai; q.a2i = 2.f * ar * ai; q.a3r = q.a2r * ar - q.a2i * ai; q.a3i = q.a2r * ai + q.a2i * ar; q.a4r = q.a2r * q.a2r - q.a2i * q.a2i; q.a4i = 2.f * q.a2r * q.a2i; return q; }
__device__ __forceinline__ float other_half(float v, int hi) { auto rr = __builtin_amdgcn_permlane32_swap(__float_as_uint(v), __float_as_uint(v), false, false); return __uint_as_float(hi ? rr[0] : rr[1]); }
template <bool NEEDX>
__device__ __forceinline__ void s5_scan32(f32x16& xr, f32x16& xi, const S5Coef& q, float& sr, float& si, int hi) {
    float er[4], ei[4];
#pragma unroll
    for (int k = 0; k < 4; ++k) {
        const float r0 = xr[4 * k], i0 = xi[4 * k];
        const float r1 = q.a1r * r0 - q.a1i * i0 + xr[4 * k + 1], i1 = q.a1r * i0 + q.a1i * r0 + xi[4 * k + 1];
        const float r2 = q.a1r * r1 - q.a1i * i1 + xr[4 * k + 2], i2 = q.a1r * i1 + q.a1i * r1 + xi[4 * k + 2];
        const float r3 = q.a1r * r2 - q.a1i * i2 + xr[4 * k + 3], i3 = q.a1r * i2 + q.a1i * r2 + xi[4 * k + 3];
        if (NEEDX) { xr[4 * k + 1] = r1; xi[4 * k + 1] = i1; xr[4 * k + 2] = r2; xi[4 * k + 2] = i2; xr[4 * k + 3] = r3; xi[4 * k + 3] = i3; }
        er[k] = r3; ei[k] = i3;
    }
    float pr[4], pi[4];
#pragma unroll
    for (int k = 0; k < 4; ++k) {
        const float orr = other_half(er[k], hi), oii = other_half(ei[k], hi);
        const float e0r = hi ? orr : er[k], e0i = hi ? oii : ei[k], e1r = hi ? er[k] : orr, e1i = hi ? ei[k] : oii;
        const float p0r = sr, p0i = si;
        float nr = q.a4r * sr - q.a4i * si + e0r, ni = q.a4r * si + q.a4i * sr + e0i; sr = nr; si = ni;
        const float p1r = sr, p1i = si;
        nr = q.a4r * sr - q.a4i * si + e1r; ni = q.a4r * si + q.a4i * sr + e1i; sr = nr; si = ni;
        pr[k] = hi ? p1r : p0r; pi[k] = hi ? p1i : p0i;
    }
    if (NEEDX) {
#pragma unroll
        for (int k = 0; k < 4; ++k) {
            xr[4 * k + 0] += q.a1r * pr[k] - q.a1i * pi[k]; xi[4 * k + 0] += q.a1r * pi[k] + q.a1i * pr[k];
            xr[4 * k + 1] += q.a2r * pr[k] - q.a2i * pi[k]; xi[4 * k + 1] += q.a2r * pi[k] + q.a2i * pr[k];
            xr[4 * k + 2] += q.a3r * pr[k] - q.a3i * pi[k]; xi[4 * k + 2] += q.a3r * pi[k] + q.a3i * pr[k];
            xr[4 * k + 3] += q.a4r * pr[k] - q.a4i * pi[k]; xi[4 * k + 3] += q.a4r * pi[k] + q.a4i * pr[k];
        }
    }
}
constexpr int S5_XPITCH = 272, S5_XWAVE = 32 * S5_XPITCH;
template <bool FULL, bool CHT = false>
__device__ __forceinline__ void s5_pass(const Ctx& c, int l, bool dry) {
    PHASE_IDS(); ArgsP ap = get_args(); unsigned char* ws = ap->ws; bf16_t* P = (bf16_t*)(ws + WS_PROJ); const float* dsk = ap->in[I_S5D] + l * 512;
    const int cl = lane & 31, hi = lane >> 5;
    char* Xl = c.ldsg + wave * S5_XWAVE;
    const int gw = c.vb * 8 + wave, ngw = grid_g() * 8;
    const int cm = (c.bid >> 6) & 3, ct0 = (0x50301800 >> (8 * cm)) & 0xff, ctn = (0x06040303 >> (8 * cm)) & 0xff;
    for (int task = CHT ? 0 : gw; task < (CHT ? ctn : NB_ * 32 * 8); task += (CHT ? 1 : ngw)) {
        int g, b, ch0; constexpr int nrb = CHT ? 2 : 8;
        if (CHT) { const int t = ct0 + wave + 8 * task; g = t & 31; b = c.bid & 7; ch0 = 4 * ((c.bid >> 3) & 7) + (t >> 5); }
        else { g = task & 31; b = task >> 8; ch0 = 4 * ((task >> 5) & 7); }
        const int tb0 = (l * 32 + g) * 64;
        const f32x4 taA = ((const f32x4*)(ws + WS_TA))[tb0 + cl], taB = ((const f32x4*)(ws + WS_TA))[tb0 + 32 + cl];
        const S5Coef qA = s5_coef(taA[0], taA[1]), qB = s5_coef(taB[0], taB[1]);
        bf16x8 bbf[4];
        { const bf16_t* tbb = (const bf16_t*)(ws + WS_TBB) + (size_t)(l * 32 + g) * 128 * 16;
#pragma unroll
          for (int blk = 0; blk < 4; ++blk) bbf[blk] = *(const bf16x8*)(tbb + (blk * 32 + cl) * 16 + 8 * hi); }
        float sAr = 0.f, sAi = 0.f, sBr = 0.f, sBi = 0.f;
        bf16x8 cm[4];
        if (FULL) {
            const bf16_t* tcm = (const bf16_t*)(ws + WS_TC) + (size_t)(l * 32 + g) * 16 * 128;
#pragma unroll
            for (int ks = 0; ks < 4; ++ks) cm[ks] = *(const bf16x8*)(tcm + (lane & 15) * 128 + ks * 32 + 8 * (lane >> 4));
            const f32x2* Ep = (const f32x2*)(ws + WS_E) + ((size_t)(b * 32) * 32 + g) * 64;
            const int nprev = ch0;
            for (int j0 = 0; j0 < nprev; j0 += 8) {
                f32x2 eA[8], eB[8];
#pragma unroll
                for (int i = 0; i < 8; ++i) { const int cp = (j0 + i < nprev) ? j0 + i : 0; eA[i] = Ep[(size_t)cp * 2048 + cl]; eB[i] = Ep[(size_t)cp * 2048 + 32 + cl]; }
#pragma unroll
                for (int i = 0; i < 8; ++i) if (j0 + i < nprev) {
                    float nr = taA[2] * sAr - taA[3] * sAi + eA[i][0], ni = taA[2] * sAi + taA[3] * sAr + eA[i][1]; sAr = nr; sAi = ni;
                    nr = taB[2] * sBr - taB[3] * sBi + eB[i][0]; ni = taB[2] * sBi + taB[3] * sBr + eB[i][1]; sBr = nr; sBi = ni; }
            }
        }
        const f32x4 dv = *(const f32x4*)(dsk + 16 * g + 4 * (lane >> 4));
        const size_t ubase = (size_t)(b * S_ + ch0 * 64 + cl) * NPROJ + 2048 + 16 * g + 8 * hi;
        bf16x8 ua_n = *(const bf16x8*)(P + ubase);
        const size_t uebase = (size_t)(b * S_ + ch0 * 64 + (lane & 15)) * NPROJ + 2048 + 16 * g + 4 * (lane >> 4);
        for (int i8 = 0; i8 < nrb; ++i8) {
            const bf16x8 ua = ua_n;
            if (i8 + 1 < nrb) ua_n = *(const bf16x8*)(P + ubase + (size_t)(i8 + 1) * 32 * NPROJ);
            u32x2 ue0 = (u32x2){0u, 0u}, ue1 = (u32x2){0u, 0u};
            if (FULL) { ue0 = *(const u32x2*)(P + uebase + (size_t)i8 * 32 * NPROJ); ue1 = *(const u32x2*)(P + uebase + (size_t)(i8 * 32 + 16) * NPROJ); }
            const int ch = ch0 + (i8 >> 1), rb = i8 & 1, tok0 = b * S_ + ch * 64;
            if (!FULL && rb == 0) { sAr = 0.f; sAi = 0.f; sBr = 0.f; sBi = 0.f; }
            f32x16 bu0 = __builtin_amdgcn_mfma_f32_32x32x16_bf16(ua, bbf[0], f32x16{}, 0, 0, 0);
            f32x16 bu1 = __builtin_amdgcn_mfma_f32_32x32x16_bf16(ua, bbf[1], f32x16{}, 0, 0, 0);
            f32x16 bu2 = __builtin_amdgcn_mfma_f32_32x32x16_bf16(ua, bbf[2], f32x16{}, 0, 0, 0);
            f32x16 bu3 = __builtin_amdgcn_mfma_f32_32x32x16_bf16(ua, bbf[3], f32x16{}, 0, 0, 0);
            s5_scan32<FULL>(bu0, bu1, qA, sAr, sAi, hi);
            s5_scan32<FULL>(bu2, bu3, qB, sBr, sBi, hi);
            if (FULL) {
#pragma unroll
                for (int r = 0; r < 16; ++r) { const int t = (r & 3) + 8 * (r >> 2) + 4 * hi;
                    *(unsigned*)(Xl + t * S5_XPITCH + 4 * cl) = pk_bf16(bu0[r], bu1[r]);
                    *(unsigned*)(Xl + t * S5_XPITCH + 128 + 4 * cl) = pk_bf16(bu2[r], bu3[r]); }
                asm volatile("s_waitcnt lgkmcnt(0)" ::: "memory");
#pragma unroll
                for (int tb = 0; tb < 2; ++tb) {
                    f32x4 y = (f32x4){0.f, 0.f, 0.f, 0.f};
#pragma unroll
                    for (int ks = 0; ks < 4; ++ks) { const bf16x8 xb = *(const bf16x8*)(Xl + (16 * tb + (lane & 15)) * S5_XPITCH + (ks * 32 + 8 * (lane >> 4)) * 2);
                        y = __builtin_amdgcn_mfma_f32_16x16x32_bf16(cm[ks], xb, y, 0, 0, 0); }
                    const int q4 = lane >> 4;
                    const size_t tokz = (size_t)(tok0 + rb * 32 + tb * 16 + (lane & 15));
                    bf16_t* zp = (bf16_t*)(ws + WS_Z) + tokz * 512 + 16 * g + 4 * q4;
                    const u32x2 uu = tb ? ue1 : ue0;
                    const float y0 = y[0] + dv[0] * bf_lo(uu.x), y1 = y[1] + dv[1] * bf_hi(uu.x), y2 = y[2] + dv[2] * bf_lo(uu.y), y3 = y[3] + dv[3] * bf_hi(uu.y);
                    u32x2 w; w.x = pk_bf16(gelu_tanh(y0), gelu_tanh(y1)); w.y = pk_bf16(gelu_tanh(y2), gelu_tanh(y3));
                    if (!dry) *(u32x2*)zp = w;
                }
                asm volatile("s_waitcnt lgkmcnt(0)" ::: "memory");
            }
            if (!FULL && rb == 1) { if (hi == 0) { f32x2* Eo = (f32x2*)(ws + WS_E) + (size_t)((b * 32 + ch) * 32 + g) * 64; Eo[cl] = (f32x2){sAr, sAi}; Eo[32 + cl] = (f32x2){sBr, sBi}; } }
        }
    }
}

__device__ __forceinline__ void unpack8(const u32x4 w, float (&v)[8]) { v[0] = bf_lo(w.x); v[1] = bf_hi(w.x); v[2] = bf_lo(w.y); v[3] = bf_hi(w.y); v[4] = bf_lo(w.z); v[5] = bf_hi(w.z); v[6] = bf_lo(w.w); v[7] = bf_hi(w.w); }
__device__ __forceinline__ u32x4 pack8(const float (&v)[8]) { u32x4 w; w.x = pk_bf16(v[0], v[1]); w.y = pk_bf16(v[2], v[3]); w.z = pk_bf16(v[4], v[5]); w.w = pk_bf16(v[6], v[7]); return w; }
__device__ __forceinline__ void prep_phase(const Ctx& c, int l, bool dry) {
    PHASE_IDS(); ArgsP ap = get_args(); unsigned char* ws = ap->ws;

    bf16_t* P = (bf16_t*)(ws + WS_PROJ); bf16_t* QUP = (bf16_t*)(ws + WS_QUP); bf16_t* KVUP = (bf16_t*)(ws + WS_KVUP); bf16_t* KM = (bf16_t*)(ws + WS_KM);
    if (wave == 0) for (int bq = (grid_g() == 256) ? ((c.bid >> 3) < 8 ? (c.bid & 7) * 8 + (c.bid >> 3) : 64) : c.bid; bq < 64; bq += grid_g()) {
        const int bh = bq, b = bh >> 3, h = bh & 7; const float bf = ap->in[I_FBF][l * 8 + h];
        const float* ff = (const float*)(ws + WS_FF32) + (size_t)(b * S_) * 8 + h; float* cum = (float*)(ws + WS_CUM) + (size_t)bh * S_;
        float xv[32];
#pragma unroll
        for (int it = 0; it < 32; ++it) xv[it] = ff[(size_t)(it * 64 + lane) * 8];
        float carry = 0.f;
#pragma unroll
        for (int it = 0; it < 32; ++it) { const float xx = xv[it] + bf;
            float v = fminf(xx, 0.f) - __logf(1.f + __expf(-fabsf(xx)));
            v += __builtin_bit_cast(float, __builtin_amdgcn_update_dpp(0, __builtin_bit_cast(int, v), 0x111, 0xF, 0xF, false));
            v += __builtin_bit_cast(float, __builtin_amdgcn_update_dpp(0, __builtin_bit_cast(int, v), 0x112, 0xF, 0xF, false));
            v += __builtin_bit_cast(float, __builtin_amdgcn_update_dpp(0, __builtin_bit_cast(int, v), 0x114, 0xF, 0xF, false));
            v += __builtin_bit_cast(float, __builtin_amdgcn_update_dpp(0, __builtin_bit_cast(int, v), 0x118, 0xF, 0xF, false));
            const int iv = __builtin_bit_cast(int, v);
            const float t0 = __builtin_bit_cast(float, __builtin_amdgcn_readlane(iv, 15)), t1 = __builtin_bit_cast(float, __builtin_amdgcn_readlane(iv, 31));
            const float t2 = __builtin_bit_cast(float, __builtin_amdgcn_readlane(iv, 47)), t3 = __builtin_bit_cast(float, __builtin_amdgcn_readlane(iv, 63));
            const int rw = lane >> 4;
            v += carry + (rw == 1 ? t0 : rw == 2 ? t0 + t1 : rw == 3 ? (t0 + t1) + t2 : 0.f);
            if (!dry) cum[it * 64 + lane] = v * LOG2E;
            carry += ((t0 + t1) + t2) + t3; }
    }
    const float* qn = ap->in[I_MQN] + l * 96; const float* kn = ap->in[I_MKN] + l * 96; const float* fqn = ap->in[I_FQN] + l * 64; const float* fkn = ap->in[I_FKN] + l * 64;
    const int* pos = (const int*)ap->in[I_POS];
    const int hd = lane >> 3, j = lane & 7;
    const float QSC = 0.10206207261596575f * LOG2E, FSC = 0.125f * LOG2E;
    const int gw = c.vb * 8 + wave, ngw = grid_g() * 8;
    const bool g256 = grid_g() == 256;
    const int row_b = g256 ? gw * 8 : gw, row_s = g256 ? 1 : ngw, row_e = g256 ? gw * 8 + 8 : T_;
    float gq[12], gk[12], gfq[8], gfk[8];
#pragma unroll
    for (int e = 0; e < 8; ++e) { gq[e] = qn[8 * j + e]; gk[e] = kn[8 * j + e]; gfq[e] = fqn[8 * j + e]; gfk[e] = fkn[8 * j + e]; }
    gq[8] = qn[64 + 2 * j]; gq[9] = qn[65 + 2 * j]; gq[10] = qn[80 + 2 * j]; gq[11] = qn[81 + 2 * j];
    gk[8] = kn[64 + 2 * j]; gk[9] = kn[65 + 2 * j]; gk[10] = kn[80 + 2 * j]; gk[11] = kn[81 + 2 * j];
#pragma unroll
    for (int e = 0; e < 12; ++e) gk[e] *= gq[e];
#pragma unroll
    for (int e = 0; e < 8; ++e) gfk[e] *= gfq[e];
    struct PrepIn { float pf; u32x4 k; unsigned p1, p2; u32x4 fk; };
    auto prep_load = [&](int row) -> PrepIn { PrepIn r_;
        const bf16_t* pr = P + (size_t)row * NPROJ; const bf16_t* kp = KM + (size_t)row * 768 + 96 * hd;
        r_.pf = (float)pos[row];
        r_.k = *(const u32x4*)(kp + 8 * j);
        r_.p1 = *(const unsigned*)(pr + 384 + 2 * j); r_.p2 = *(const unsigned*)(pr + 400 + 2 * j);
        r_.fk = *(const u32x4*)(pr + 1024 + 64 * hd + 8 * j); return r_; };
    PrepIn nx_ = prep_load(row_b < T_ ? row_b : 0);
    for (int row = row_b; row < row_e; row += row_s) {
        bf16_t* pr = P + (size_t)row * NPROJ;
        bf16_t* qp = QUP + (size_t)row * 768 + 96 * hd; bf16_t* ko = KM + (size_t)row * 768 + 96 * hd;
        bf16_t* fqp = pr + 512 + 64 * hd + 8 * j; bf16_t* fkp = pr + 1024 + 64 * hd + 8 * j;
        const PrepIn in_ = nx_;
        { const int nrow = row + row_s; nx_ = prep_load(nrow < row_e ? nrow : row); }
        SBAR();
        const float pf = in_.pf;
        const u32x4 l_k = in_.k; const unsigned l_p1 = in_.p1, l_p2 = in_.p2;
        const u32x4 l_fk = in_.fk;
        float cs[2], sn[2];
#pragma unroll
        for (int e = 0; e < 2; ++e) { const int i = 2 * j + e; const float inv = exp2f(-(float)i * (13.287712379549449f / 16.f)); const float ang = pf * inv;
            float rev = ang * 0.15915494309189535f; rev -= floorf(rev); cs[e] = __builtin_amdgcn_cosf(rev); sn[e] = __builtin_amdgcn_sinf(rev); }
        u32x4 o_k, o_fk; unsigned o_k1, o_k2;
        { float v[8]; unpack8(l_k, v);
          const float x1[2] = {bf_lo(l_p1), bf_hi(l_p1)}, x2[2] = {bf_lo(l_p2), bf_hi(l_p2)};
          float ssq = 0.f;
#pragma unroll
          for (int e = 0; e < 8; ++e) ssq += v[e] * v[e];
          float r1[2], r2[2];
#pragma unroll
          for (int e = 0; e < 2; ++e) { r1[e] = x1[e] * cs[e] - x2[e] * sn[e]; r2[e] = x1[e] * sn[e] + x2[e] * cs[e]; ssq += r1[e] * r1[e] + r2[e] * r2[e]; }
          const float rn = rsqrtf(sum8(ssq) * (1.f / 96) + EPS);
#pragma unroll
          for (int e = 0; e < 8; ++e) v[e] *= rn * gk[e];
          o_k = pack8(v);
          o_k1 = pk_bf16(r1[0] * rn * gk[8], r1[1] * rn * gk[9]);
          o_k2 = pk_bf16(r2[0] * rn * gk[10], r2[1] * rn * gk[11]); }
        { float v[8]; unpack8(l_fk, v); float ssq = 0.f;
#pragma unroll
          for (int e = 0; e < 8; ++e) ssq += v[e] * v[e];
          const float rn = rsqrtf(sum8(ssq) * (1.f / 64) + EPS);
#pragma unroll
          for (int e = 0; e < 8; ++e) v[e] *= rn * gfk[e];
          o_fk = pack8(v); }
        if (!dry) {
            *(u32x4*)(ko + 8 * j) = o_k; *(unsigned*)(ko + 64 + 2 * j) = o_k1; *(unsigned*)(ko + 80 + 2 * j) = o_k2;
            *(u32x4*)fkp = o_fk;
        }
    }
}

__device__ __forceinline__ void attn_phase(const Ctx& c, int l, bool dry) {
    PHASE_IDS(); ArgsP ap = get_args(); unsigned char* ws = ap->ws;
    bf16_t* P = (bf16_t*)(ws + WS_PROJ); bf16_t* QUP = (bf16_t*)(ws + WS_QUP); const bf16_t* KVUP = (const bf16_t*)(ws + WS_KVUP); const bf16_t* KM = (const bf16_t*)(ws + WS_KM);
    const float* CUM = (const float*)(ws + WS_CUM);
    float sbound;
    { float mq = fabsf(ap->in[I_FQN][l * 64 + lane]), mk = fabsf(ap->in[I_FKN][l * 64 + lane]);
#pragma unroll
      for (int o = 1; o < 64; o <<= 1) { mq = fmaxf(mq, __shfl_xor(mq, o)); mk = fmaxf(mk, __shfl_xor(mk, o)); }
      sbound = 2.f * 1.05f * 8.f * LOG2E * mq * mk; }
    bool trackM, trackF = !(sbound <= 120.f);
    { float mq = lane < 48 ? fmaxf(fabsf(ap->in[I_MQN][l * 96 + lane]), fabsf(ap->in[I_MQN][l * 96 + 48 + lane])) : 0.f, mk = lane < 48 ? fmaxf(fabsf(ap->in[I_MKN][l * 96 + lane]), fabsf(ap->in[I_MKN][l * 96 + 48 + lane])) : 0.f;
#pragma unroll
      for (int o = 1; o < 64; o <<= 1) { mq = fmaxf(mq, __shfl_xor(mq, o)); mk = fmaxf(mk, __shfl_xor(mk, o)); }
      trackM = !(1.05f * 9.7979590f * LOG2E * mq * mk <= 60.f); }
    for (int L = c.vb; L < 256; L += grid_g()) {
        const int bh = (L >> 5) * 8 + (L & 7), p = (L >> 3) & 3, b = bh >> 3, h = bh & 7; const size_t r0 = (size_t)b * S_;
        const float* cum = CUM + (size_t)bh * S_;
        int T0f[2];
#pragma unroll
        for (int e = 0; e < 2; ++e) { const int q0 = (2 * p + e) * 256, nb = q0 >> 6; const float c0 = cum[q0]; bool need = false;
            if (lane < nb) need = (sbound + c0 - cum[64 * lane + 63] >= -40.f);
            const unsigned long long bal = __ballot(need);
            T0f[e] = __builtin_amdgcn_readfirstlane((bal ? (__ffsll((long long)bal) - 1) : nb) & ~1); }
        if (!trackM) {
#pragma unroll 1
            for (int e = 0; e < 2; ++e)
                attn::attn_unit<96, false, false>(QUP + r0 * 768 + 96 * h, 768, KM + r0 * 768 + 96 * h, 768, KVUP + r0 * 512 + 64 * h, 512, nullptr, (e ? p : 7 - p) * 256, c.ldsg, dry, 0.f, 0, ap->in[I_MQN] + l * 96, (const int*)ap->in[I_POS] + r0, 0.10206207261596575f * LOG2E);
        } else {
#pragma unroll 1
            for (int e = 0; e < 2; ++e)
                attn::attn_unit<96, false, true>(QUP + r0 * 768 + 96 * h, 768, KM + r0 * 768 + 96 * h, 768, KVUP + r0 * 512 + 64 * h, 512, nullptr, (e ? p : 7 - p) * 256, c.ldsg, dry, 0.f, 0, ap->in[I_MQN] + l * 96, (const int*)ap->in[I_POS] + r0, 0.10206207261596575f * LOG2E);
        }
        if (!trackF) {
#pragma unroll 1
            for (int e = 0; e < 2; ++e)
                attn::attn_unit<64, true, false>(P + r0 * NPROJ + 512 + 64 * h, NPROJ, P + r0 * NPROJ + 1024 + 64 * h, NPROJ, P + r0 * NPROJ + 1536 + 64 * h, NPROJ, cum, (2 * p + e) * 256, c.ldsg, dry, sbound, e ? T0f[1] : T0f[0], ap->in[I_FQN] + l * 64, nullptr, 0.125f * LOG2E);
        } else {
#pragma unroll 1
            for (int e = 0; e < 2; ++e)
                attn::attn_unit<64, true, true>(P + r0 * NPROJ + 512 + 64 * h, NPROJ, P + r0 * NPROJ + 1024 + 64 * h, NPROJ, P + r0 * NPROJ + 1536 + 64 * h, NPROJ, cum, (2 * p + e) * 256, c.ldsg, dry, sbound, e ? T0f[1] : T0f[0], ap->in[I_FQN] + l * 64, nullptr, 0.125f * LOG2E);
        }
    }
}

#if USE_XCD_BAR
#define XB_TMO      128
#define XB_XCNT(j)  (256  + 64 * (j))
#define XB_XSUB(j)  (1280 + 64 * (j))
#define XB_XGEN(j)  (2304 + 64 * (j))
#define XB_TOP      3328
#define XB_TOPGEN   3392
#define XCD_BAR_WORDS 3456
#define XB_SPIN_CAP (1u << 22)
__device__ __forceinline__ unsigned xb_ld(unsigned* p)              { return __hip_atomic_load(p, __ATOMIC_RELAXED, __HIP_MEMORY_SCOPE_AGENT); }
__device__ __forceinline__ unsigned xb_add(unsigned* p, unsigned v) { return __hip_atomic_fetch_add(p, v, __ATOMIC_RELAXED, __HIP_MEMORY_SCOPE_AGENT); }
__device__ __forceinline__ unsigned xb_xcc_id() { return (unsigned)__builtin_amdgcn_s_getreg((3 << 11) | 20) & 0xFu; }
#define XB_SPIN(cond, bar) do { unsigned _sp = 0; while (cond) { __builtin_amdgcn_s_sleep(1); \
    if ((++_sp & 255u) == 0u) { if (xb_ld(&(bar)[XB_TMO])) break; if (_sp > XB_SPIN_CAP) { atomicAdd(&(bar)[XB_TMO], 1u); break; } } } } while (0)
struct XcdBarrier { unsigned* bar; unsigned x; volatile LAS unsigned* st; unsigned nexp; };
__device__ __forceinline__ XcdBarrier xcd_barrier_post(unsigned* bar, volatile LAS unsigned* st, unsigned nexp) {
    XcdBarrier b; b.bar = bar; b.x = xb_xcc_id(); b.st = st; b.nexp = nexp;
    if (threadIdx.x == 0) (void)xb_add(&bar[XB_XCNT(b.x)], 1u);
    return b;
}
__device__ __forceinline__ void xcd_barrier_complete(unsigned* bar, unsigned x, unsigned G, unsigned& nloc, unsigned& nx) {
    unsigned sum, cnt, mine, sp = 0u;
    for (;;) {
        sum = 0u; cnt = 0u; mine = 0u;
#pragma unroll
        for (unsigned j = 0; j < 16; ++j) { const unsigned c = xb_ld(&bar[XB_XCNT(j)]); sum += c; cnt += (c > 0u) ? 1u : 0u; mine = (j == x) ? c : mine; }
        if (sum == G) break;
        __builtin_amdgcn_s_sleep(1);
        if ((++sp & 255u) == 0u) { if (xb_ld(&bar[XB_TMO])) break; if (sp > XB_SPIN_CAP) { atomicAdd(&bar[XB_TMO], 1u); break; } }
    }
    nloc = mine > 0u ? mine : 1u; nx = cnt > 0u ? cnt : 1u;
}
__device__ __forceinline__ void xcd_barrier(const XcdBarrier& b) {
    asm volatile("s_waitcnt vmcnt(0)" ::: "memory");
    __syncthreads();
    if (threadIdx.x == 0) {
        unsigned* bar = b.bar;
        __builtin_amdgcn_s_waitcnt(0);
        unsigned nloc = b.st[0], nx = b.st[1];
        if (nloc == 0u) { xcd_barrier_complete(bar, b.x, b.nexp, nloc, nx); b.st[0] = nloc; b.st[1] = nx; }
        const bool one_xcd = (nx == 1u) && (nloc == b.nexp);
        if (one_xcd) {
            const unsigned k = b.st[2]; b.st[2] = k + 1u;
            (void)__hip_atomic_fetch_add(&bar[XB_XSUB(b.x)], 1u, __ATOMIC_RELAXED, __HIP_MEMORY_SCOPE_AGENT);
            asm volatile("buffer_inv sc1" ::: "memory");
            const unsigned target = (k + 1u) * nloc;
            XB_SPIN(xb_ld(&bar[XB_XSUB(b.x)]) < target, bar);
            asm volatile("s_waitcnt vmcnt(0)" ::: "memory");
        } else if (const unsigned old = xb_add(&bar[XB_XSUB(b.x)], 1u), gen = old / nloc; old + 1u == (gen + 1u) * nloc) {
            if (!one_xcd) __builtin_amdgcn_fence(__ATOMIC_RELEASE, "agent");
            asm volatile("s_waitcnt vmcnt(0)" ::: "memory");
            const unsigned og = xb_add(&bar[XB_TOP], 1u);
            const unsigned tg = og / nx;
            if (og + 1u == (tg + 1u) * nx) xb_add(&bar[XB_TOPGEN], 1u);
            else XB_SPIN(xb_ld(&bar[XB_TOPGEN]) == tg, bar);
            if (!one_xcd) __builtin_amdgcn_fence(__ATOMIC_ACQUIRE, "agent");
            xb_add(&bar[XB_XGEN(b.x)], 1u);
            asm volatile("s_waitcnt vmcnt(0)" ::: "memory");
        } else {
            XB_SPIN(xb_ld(&bar[XB_XGEN(b.x)]) == gen, bar);
            if (!one_xcd) __builtin_amdgcn_fence(__ATOMIC_ACQUIRE, "agent");
            asm volatile("s_waitcnt vmcnt(0)" ::: "memory");
        }

    }
    __syncthreads();
}
#endif

constexpr int LDS_MAIN = 131072, LDS_BYTES = LDS_MAIN + 1024;
static_assert(attn::LDS_BYTES <= LDS_MAIN && 8 * S5_XWAVE <= LDS_MAIN && 8 * 8448 <= LDS_MAIN, "LDS map");

__device__ __forceinline__ void ph_inproj(const Ctx& c, int l) {
    ArgsP ap = get_args(); unsigned char* ws = ap->ws;
    SchedIn S{(const char*)(ws + WS_XG), (const char*)(ws + WS_WIN) + (size_t)l * 2 * NIN * 512 * 2, 0, grid_g(), c.bid};
    EpiProj E{(bf16_t*)(ws + WS_PROJ), (const float*)(ws + WS_SS) + (size_t)l * T_, (float*)(ws + WS_FF32), (float*)(ws + WS_SSQ) + (size_t)l * T_};
    pg8::gemm_phase(c.lds, 512, 512, 8, S, E);
}
__device__ __forceinline__ void ph_s5e(const Ctx& c, int l) { if (grid_g() == 256) s5_pass<false, true>(c, l, false); else s5_pass<false, false>(c, l, false); }
__device__ __forceinline__ void ph_fv(const Ctx& c, int l) {
    ArgsP ap = get_args(); unsigned char* ws = ap->ws;
    SchedIn S{(const char*)(ws + WS_XG), (const char*)(ws + WS_WIN) + (size_t)l * 2 * NIN * 512 * 2, 1, grid_g(), c.bid};
    EpiProj E{(bf16_t*)(ws + WS_PROJ), (const float*)(ws + WS_SS) + (size_t)l * T_, (float*)(ws + WS_FF32), (float*)(ws + WS_SSQ) + (size_t)l * T_};
    pg8::gemm_phase(c.lds, 512, 512, 8, S, E);
}
__device__ __forceinline__ void ph_up(const Ctx& c, int l) {
    ArgsP ap = get_args(); unsigned char* ws = ap->ws;
    SchedUp S{(const char*)(ws + WS_PROJ), (const char*)(ws + WS_WQ) + (size_t)l * 768 * 256 * 2, (const char*)(ws + WS_WKV) + (size_t)l * 1024 * 256 * 2, grid_g(), c.bid};
    EpiUp E{(bf16_t*)(ws + WS_QUP), (bf16_t*)(ws + WS_KM), (bf16_t*)(ws + WS_KVUP), (const float*)(ws + WS_SSQ) + (size_t)l * T_}; pg8::gemm_phase(c.lds, NPROJ, 256, 4, S, E);
}
__device__ __forceinline__ void ph_gate(const Ctx& c, int l) {
    ArgsP ap = get_args(); unsigned char* ws = ap->ws;
    SchedGate S{(const char*)ws, l, grid_g(), c.bid};
    EpiGate E{ws, ap->in[I_BGLU] + l * 512, l};
    pg8::gemm_phase(c.lds, 512, 512, 8, S, E);
}
__device__ __forceinline__ void ph_merge(const Ctx& c, int l) {
    ArgsP ap = get_args(); unsigned char* ws = ap->ws;
    SchedMerge S{(const char*)ws, l, grid_g(), c.bid};
    EpiMerge E{ws, l, c.bid};
    pg8::gemm_phase(c.lds, 512, 512, 8, S, E);
}
__device__ __forceinline__ void ph_out(const Ctx& c, int l, bool dry) {
    ArgsP ap = get_args(); unsigned char* ws = ap->ws;
    SchedPlain S{(const char*)(ws + WS_PROJ) + (size_t)S_ * 1024 * 2, (size_t)256 * 1024 * 2, (size_t)10 << 20, (const char*)(ws + WS_WOUT) + (size_t)l * DM * DM * 2, (size_t)256 * 1024 * 2, 4, grid_g(), c.bid};
    const bool lastl = (l == NL - 1);
    EpiOut E{nullptr, ap->out, (bf16_t*)(ws + WS_XG), lastl ? nullptr : (float*)(ws + WS_SS) + (size_t)(l + 1) * T_, dry};
    pg8::gemm_phase(c.lds, 1024, 1024, 16, S, E);
}

__global__ void __launch_bounds__(512, 2) trunk_fwd(Args args) {
    extern __shared__ __attribute__((aligned(16))) unsigned char lds[];
    Ctx c; c.lds = (LAS unsigned char*)lds; c.ldsg = (char*)lds; c.G = gridDim.x; c.bid = blockIdx.x; c.vb = (gridDim.x == 256) ? (int)((blockIdx.x & 7) * 32 + (blockIdx.x >> 3)) : (int)blockIdx.x;
#if MK_LAUNCHES == 1
#if USE_XCD_BAR
    if (threadIdx.x < 8) ((volatile LAS unsigned*)(c.lds + LDS_MAIN))[threadIdx.x] = 0u;
    __syncthreads();
    XcdBarrier bar = xcd_barrier_post((unsigned*)(args.ws + WS_CTL) + 4096, (volatile LAS unsigned*)(c.lds + LDS_MAIN), gridDim.x);
    XcdBarrier pbar = bar;
#define GRID_BAR() xcd_barrier(bar)
#define PIPE_BAR() xcd_barrier(pbar)
#define HAVE_PIPE_BAR 1
#else
    cg::grid_group grid = cg::this_grid();
#define GRID_BAR() grid.sync()
#endif
#else
#define GRID_BAR() do {} while (0)
#endif
    const int lo = args.ph_lo, hi = args.ph_hi;
#ifndef PH_MASK
#define PH_MASK 0xfff
#endif
#define IN(k) (lo <= (k) && (k) < hi)
#define PHM(j) ((PH_MASK >> (j)) & 1)
#define SEAM(k) do { if (IN(k) && IN((k) + 1)) GRID_BAR(); } while (0)
#ifdef HAVE_PIPE_BAR
#define SEAMP(k) do { if (IN(k) && IN((k) + 1)) PIPE_BAR(); } while (0)
#else
#define SEAMP(k) SEAM(k)
#endif

#ifndef ENABLE_PROBES
#define ENABLE_PROBES 0
#endif
#if ENABLE_PROBES
    const int probe = args.probe;
#define REP(j) for (int rep = (probe == (j)) ? 0 : 1; rep < 2; ++rep)
#else
#define REP(j) for (int rep = 1; rep < 2; ++rep)
#endif
    if (PHM(0) && IN(0)) { REP(1) phase0(c, 0); } SEAM(0);
#ifdef HAVE_PIPE_BAR
    if (gridDim.x == 256 && lo == 0 && hi == NPH)
        pbar = xcd_barrier_post((unsigned*)(args.ws + WS_PBAR) + (blockIdx.x & 7) * XCD_BAR_WORDS, (volatile LAS unsigned*)(c.lds + LDS_MAIN) + 4, 32u);
#endif
    for (int l = 0; l < NL; ++l) {
        const int pb = 1 + 7 * l;
        if (PHM(1) && IN(pb + 0)) {
            if (l == 0 && ((c.bid & 1) || CONV_FIRST)) { phase0(c, 1); __syncthreads(); }
            REP(2) ph_inproj(c, l);
            if (l == 0 && !((c.bid & 1) || CONV_FIRST)) phase0(c, 1); }
        if (l == 0) SEAM(pb + 0); else SEAMP(pb + 0);
#ifdef PIPE_SKEW_TICKS
        if (l == 0 && gridDim.x == 256) {
            const unsigned t0 = (unsigned)__builtin_amdgcn_s_memrealtime(), dt = (unsigned)__builtin_amdgcn_readfirstlane((int)(PIPE_SKEW_TICKS));
            while ((unsigned)__builtin_amdgcn_s_memrealtime() - t0 < dt) __builtin_amdgcn_s_sleep(8);
        }
#endif
        if (IN(pb + 1)) {
            if (P2_ORDER == 0 ? (c.bid & 1) : (P2_ORDER == 1)) { if (PHM(9)) REP(5) ph_s5e(c, l); if (PHM(2)) REP(4) ph_fv(c, l); if (PHM(2)) REP(3) ph_up(c, l); }
            else { if (PHM(2)) REP(4) ph_fv(c, l); if (PHM(2)) REP(3) ph_up(c, l); if (PHM(9)) REP(5) ph_s5e(c, l); } }
        SEAMP(pb + 1);
        if (IN(pb + 2)) {
            if (P3_ORDER == 0 ? (c.bid & 1) : (P3_ORDER == 1)) { if (PHM(10)) REP(7) s5_pass<true>(c, l, rep == 0); if (PHM(3)) REP(6) prep_phase(c, l, rep == 0); }
            else { if (PHM(3)) REP(6) prep_phase(c, l, rep == 0); if (PHM(10)) REP(7) s5_pass<true>(c, l, rep == 0); } }
        SEAMP(pb + 2);
        if (IN(pb + 3)) { if (PHM(4)) REP(8) attn_phase(c, l, rep == 0); }
        SEAMP(pb + 3);
        if (PHM(5) && IN(pb + 4)) REP(10) ph_gate(c, l);
        SEAMP(pb + 4);
        if (PHM(6) && IN(pb + 5)) REP(11) ph_merge(c, l);
        SEAMP(pb + 5);
        if (PHM(7) && IN(pb + 6)) REP(12) ph_out(c, l, rep == 0);
        SEAMP(pb + 6);
    }
#undef IN
#undef SEAM
}

extern "C" void kernel_launch(void* const* d_in, const int* in_sizes, int n_in, void* d_out, int out_size, void* d_ws, size_t ws_size, hipStream_t stream) {
    static int grid = 0;
    if (grid == 0) {
        if (n_in != 25 || in_sizes[0] != T_ * DM || out_size != T_ * DM || ws_size < WS_END) {
            fprintf(stderr, "kernel_launch: shape mismatch n_in %d in0 %d out %d ws %zu (need %zu)\n", n_in, n_in > 0 ? in_sizes[0] : -1, out_size, ws_size, (size_t)WS_END); grid = -1; return; }
        int dev = 0, cus = 0, per_cu = 0;
        hipGetDevice(&dev); hipDeviceGetAttribute(&cus, hipDeviceAttributeMultiprocessorCount, dev);
        if (hipFuncSetAttribute((const void*)trunk_fwd, hipFuncAttributeMaxDynamicSharedMemorySize, LDS_BYTES) != hipSuccess) { fprintf(stderr, "kernel_launch: hipFuncSetAttribute failed\n"); grid = -1; return; }
        if (hipOccupancyMaxActiveBlocksPerMultiprocessor(&per_cu, (const void*)trunk_fwd, 512, LDS_BYTES) != hipSuccess || per_cu < 1) { fprintf(stderr, "kernel_launch: occupancy query says %d\n", per_cu); per_cu = 1; }
        (void)hipGetLastError();
        grid = cus;
    }
    if (grid < 0) return;
    hipMemsetAsync((char*)d_ws + WS_CTL, 0, 64 * KiB, stream);
    Args a{};
    for (int i = 0; i < 25; ++i) a.in[i] = (const float*)d_in[i];
    a.out = (float*)d_out; a.ws = (unsigned char*)d_ws;
#ifdef PROBE_PHASE
    a.probe = PROBE_PHASE;
#endif
#if MK_LAUNCHES == 1
    a.ph_lo = 0; a.ph_hi = NPH;
#ifndef PLAIN_LAUNCH
#define PLAIN_LAUNCH 0
#endif
#if PLAIN_LAUNCH
    hipLaunchKernelGGL(trunk_fwd, dim3(grid), dim3(512), LDS_BYTES, stream, a);
#else
    void* kargs[] = {&a};
    hipError_t e = hipLaunchCooperativeKernel((const void*)trunk_fwd, dim3(grid), dim3(512), kargs, LDS_BYTES, stream);
    if (e != hipSuccess) fprintf(stderr, "cooperative launch failed: %s (grid %d)\n", hipGetErrorString(e), grid);
#endif
#else
    for (int ph = 0; ph < NPH; ++ph) { a.ph_lo = ph; a.ph_hi = ph + 1; hipLaunchKernelGGL(trunk_fwd, dim3(grid), dim3(512), LDS_BYTES, stream, a); }
#endif
}
```
